# Optimizing an MI355X kernel written in HIP

```python
import math
import jax, jax.numpy as jnp
from jax import lax
import numpy as np

D_MODEL = 2048
BATCH = 8
SEQ = 2048
DEPTH = 2

DIFF_HEAD_DIM = 128
ATTN_WIDTH = D_MODEL // 2
DIFF_HEADS = ATTN_WIDTH // (2 * DIFF_HEAD_DIM)
QK_WIDTH = DIFF_HEADS * 2 * DIFF_HEAD_DIM
POOL_WINDOWS = (2, 4, 8, 16)
POOL_WIDTH = D_MODEL // 4
POOL_GROUP = POOL_WIDTH // len(POOL_WINDOWS)
CONV_WIDTH = D_MODEL // 4
CONV_TAPS = 3
IN_WIDTH = 2 * QK_WIDTH + ATTN_WIDTH + POOL_WIDTH + 3 * CONV_WIDTH
SPLIT_POINTS = (QK_WIDTH, 2 * QK_WIDTH, 2 * QK_WIDTH + ATTN_WIDTH,
                2 * QK_WIDTH + ATTN_WIDTH + POOL_WIDTH,
                2 * QK_WIDTH + ATTN_WIDTH + POOL_WIDTH + CONV_WIDTH,
                2 * QK_WIDTH + ATTN_WIDTH + POOL_WIDTH + 2 * CONV_WIDTH)
ROPE_THETA = 10000.0
Q_BLOCK = 128
D_FF_DENSE = 5632
N_EXPERTS = 8
TOP_K = 2
D_FF_EXPERT = 7168
N_DENSE = (DEPTH + 1) // 2
N_MOE = DEPTH // 2
EPS = 1e-6
NEG_INF = -1e30

kernel_name = 'hybrid_diffattn_pool_conv_moe'


def rms_norm(x, g):
    xf = x.astype(jnp.float32)
    y = xf * lax.rsqrt(jnp.mean(xf * xf, axis=-1, keepdims=True) + EPS)
    return y.astype(x.dtype) * g


def rotary(x, cos, sin):
    x1, x2 = jnp.split(x, 2, axis=-1)
    return jnp.concatenate([x1 * cos - x2 * sin, x1 * sin + x2 * cos], axis=-1)


def diff_attention(q, k, v, lam):
    B, S, H, _, d = q.shape
    nb = S // Q_BLOCK
    scale = d ** -0.5
    qb = q.reshape(B, nb, Q_BLOCK, H, 2, d).transpose(1, 0, 2, 3, 4, 5)
    key_pos = jnp.arange(S)

    def block(args):
        i, qi = args
        s = jnp.einsum('bqhmd,bkhmd->bhmqk', qi, k).astype(jnp.float32) * scale
        q_pos = i * Q_BLOCK + jnp.arange(Q_BLOCK)
        mask = key_pos[None, :] <= q_pos[:, None]
        p = jax.nn.softmax(jnp.where(mask, s, NEG_INF), axis=-1)
        a = p[:, :, 0] - lam * p[:, :, 1]
        return jnp.einsum('bhqk,bkhe->bqhe', a.astype(v.dtype), v)

    o = lax.map(block, (jnp.arange(nb), qb))
    return o.transpose(1, 0, 2, 3, 4).reshape(B, S, H, 2 * d)


def pool_mixer(u, w_pool, pool_scale):
    B, S, _ = u.shape
    uf = u.astype(jnp.float32).reshape(B, S, len(POOL_WINDOWS), POOL_GROUP)
    outs = []
    for gi, w in enumerate(POOL_WINDOWS):
        g = uf[:, :, gi]
        c = jnp.cumsum(g, axis=1)
        c_shift = jnp.pad(c, ((0, 0), (w, 0), (0, 0)))[:, :S]
        count = jnp.minimum(jnp.arange(S) + 1, w).astype(jnp.float32)
        outs.append((c - c_shift) / count[None, :, None] - g)
    pooled = jnp.stack(outs, axis=2).astype(u.dtype)
    y = jnp.einsum('bsgc,gcd->bsgd', pooled, w_pool)
    return y.reshape(B, S, POOL_WIDTH) * pool_scale


def short_conv_mixer(gate_b, gate_c, h, conv_w):
    S = h.shape[1]
    u = jnp.pad(gate_c * h, ((0, 0), (CONV_TAPS - 1, 0), (0, 0)))
    y = sum(conv_w[j] * u[:, j:j + S] for j in range(CONV_TAPS))
    return gate_b * y


def hybrid_mixer(h, cos, sin, lam_init, w_in, q_g, k_g, lam_vecs, sub_g, w_pool, pool_scale, conv_w, w_out):
    B, S, _ = h.shape
    z = h @ w_in
    q, k, v, u_pool, gate_b, gate_c, u_conv = jnp.split(z, SPLIT_POINTS, axis=-1)
    q = rotary(rms_norm(q.reshape(B, S, DIFF_HEADS, 2, DIFF_HEAD_DIM), q_g), cos, sin)
    k = rotary(rms_norm(k.reshape(B, S, DIFF_HEADS, 2, DIFF_HEAD_DIM), k_g), cos, sin)
    v = v.reshape(B, S, DIFF_HEADS, 2 * DIFF_HEAD_DIM)
    lf = lam_vecs.astype(jnp.float32)
    lam = jnp.exp(jnp.sum(lf[0] * lf[1])) - jnp.exp(jnp.sum(lf[2] * lf[3])) + lam_init
    attn = rms_norm(diff_attention(q, k, v, lam), sub_g) * (1.0 - lam_init)
    attn = attn.reshape(B, S, ATTN_WIDTH)
    pool = pool_mixer(u_pool, w_pool, pool_scale)
    conv = short_conv_mixer(gate_b, gate_c, u_conv, conv_w)
    return jnp.concatenate([attn, pool, conv], axis=-1) @ w_out


def swiglu(h, wg, wu, wd):
    return (jax.nn.silu(h @ wg) * (h @ wu)) @ wd


def moe_swiglu(h, router_w, wg, wu, wd):
    B, S, D = h.shape
    t = h.reshape(B * S, D)
    logits = (t @ router_w).astype(jnp.float32)
    top_vals, top_idx = lax.top_k(logits, TOP_K)
    gates = jax.nn.softmax(top_vals, axis=-1)
    combine = jnp.sum(jax.nn.one_hot(top_idx, N_EXPERTS, dtype=jnp.float32) * gates[..., None], axis=1)
    combine = combine.astype(t.dtype)
    out = jnp.zeros_like(t)
    for e in range(N_EXPERTS):
        out = out + combine[:, e:e + 1] * swiglu(t, wg[e], wu[e], wd[e])
    return out.reshape(B, S, D)


def setup_inputs(seed: int = 0) -> dict:
    key = jax.random.key(seed)
    ks = jax.random.split(key, 20)
    f32 = jnp.float32
    nrm = lambda k, shape, s: jax.random.normal(k, shape, f32) * s
    d = DIFF_HEAD_DIM
    offsets = jax.random.randint(ks[1], (BATCH, 1), 0, 4096, dtype=jnp.int32)
    return {
        'x': nrm(ks[0], (BATCH, SEQ, D_MODEL), 1.0),
        'positions': offsets + jnp.arange(SEQ, dtype=jnp.int32)[None, :],
        'attn_norm_g': 1.0 + nrm(ks[2], (DEPTH, D_MODEL), 0.02),
        'w_in': nrm(ks[3], (DEPTH, D_MODEL, IN_WIDTH), D_MODEL ** -0.5),
        'q_norm_g': 1.0 + nrm(ks[4], (DEPTH, d), 0.02),
        'k_norm_g': 1.0 + nrm(ks[5], (DEPTH, d), 0.02),
        'lambda_vecs': nrm(ks[6], (DEPTH, 4, d), 0.1),
        'attn_out_norm_g': 1.0 + nrm(ks[7], (DEPTH, 2 * d), 0.02),
        'w_pool': nrm(ks[8], (DEPTH, len(POOL_WINDOWS), POOL_GROUP, POOL_GROUP), POOL_GROUP ** -0.5),
        'pool_scale': 1.0 + nrm(ks[9], (DEPTH, POOL_WIDTH), 0.1),
        'conv_w': nrm(ks[10], (DEPTH, CONV_TAPS, CONV_WIDTH), CONV_TAPS ** -0.5),
        'w_out': nrm(ks[11], (DEPTH, D_MODEL, D_MODEL), D_MODEL ** -0.5),
        'ffn_norm_g': 1.0 + nrm(ks[12], (DEPTH, D_MODEL), 0.02),
        'dense_w_gate': nrm(ks[13], (N_DENSE, D_MODEL, D_FF_DENSE), D_MODEL ** -0.5),
        'dense_w_up': nrm(ks[14], (N_DENSE, D_MODEL, D_FF_DENSE), D_MODEL ** -0.5),
        'dense_w_down': nrm(ks[15], (N_DENSE, D_FF_DENSE, D_MODEL), D_FF_DENSE ** -0.5),
        'router_w': nrm(ks[16], (N_MOE, D_MODEL, N_EXPERTS), D_MODEL ** -0.5),
        'moe_w_gate': nrm(ks[17], (N_MOE, N_EXPERTS, D_MODEL, D_FF_EXPERT), D_MODEL ** -0.5),
        'moe_w_up': nrm(ks[18], (N_MOE, N_EXPERTS, D_MODEL, D_FF_EXPERT), D_MODEL ** -0.5),
        'moe_w_down': nrm(ks[19], (N_MOE, N_EXPERTS, D_FF_EXPERT, D_MODEL), D_FF_EXPERT ** -0.5),
    }


def reference(x, positions, attn_norm_g, w_in, q_norm_g, k_norm_g, lambda_vecs, attn_out_norm_g,
              w_pool, pool_scale, conv_w, w_out, ffn_norm_g, dense_w_gate, dense_w_up, dense_w_down,
              router_w, moe_w_gate, moe_w_up, moe_w_down):
    inv_freq = 1.0 / (ROPE_THETA ** (jnp.arange(0, DIFF_HEAD_DIM, 2, dtype=jnp.float32) / DIFF_HEAD_DIM))
    ang = positions.astype(jnp.float32)[..., None] * inv_freq
    cos = jnp.cos(ang).astype(x.dtype)[:, :, None, None, :]
    sin = jnp.sin(ang).astype(x.dtype)[:, :, None, None, :]
    for l in range(DEPTH):
        lam_init = 0.8 - 0.6 * math.exp(-0.3 * l)
        h = rms_norm(x, attn_norm_g[l])
        x = x + hybrid_mixer(h, cos, sin, lam_init, w_in[l], q_norm_g[l], k_norm_g[l], lambda_vecs[l],
                             attn_out_norm_g[l], w_pool[l], pool_scale[l], conv_w[l], w_out[l])
        h = rms_norm(x, ffn_norm_g[l])
        if l % 2 == 0:
            j = l // 2
            x = x + swiglu(h, dense_w_gate[j], dense_w_up[j], dense_w_down[j])
        else:
            j = l // 2
            x = x + moe_swiglu(h, router_w[j], moe_w_gate[j], moe_w_up[j], moe_w_down[j])
    return x
```

```cpp
#include <hip/hip_runtime.h>
#include <hip/hip_bf16.h>
#include <cstdio>
#include <cstdint>

#define LAS __attribute__((address_space(3)))
#define GAS __attribute__((address_space(1)))
typedef unsigned short bf16_t;
typedef short bf16x8 __attribute__((ext_vector_type(8)));
typedef short s16x4 __attribute__((ext_vector_type(4)));
typedef float f32x4 __attribute__((ext_vector_type(4)));
typedef float f32x2 __attribute__((ext_vector_type(2)));
typedef float f32x16 __attribute__((ext_vector_type(16)));
typedef unsigned u32x4 __attribute__((ext_vector_type(4)));
typedef unsigned u32x2 __attribute__((ext_vector_type(2)));
typedef int i32x4 __attribute__((ext_vector_type(4)));

constexpr int DM = 2048, NB = 8, SEQ = 2048, NTOK = NB * SEQ, DEPTH = 2;
constexpr int INW = 5120, FFD = 5632, NEXP = 8, FFE = 7168;
constexpr int ZQ = 0, ZK = 1024, ZV = 2048, ZP = 3072, ZGB = 3584, ZGC = 4096, ZH = 4608;
constexpr int MOE_ROWS = NTOK * 2 + NEXP * 256;
constexpr float EPS = 1e-6f;

constexpr size_t MiB = 1u << 20;
constexpr size_t WS_CTL = 0, CTL_ZERO_BYTES = 1 * MiB;
constexpr size_t WS_COS = 1 * MiB, WS_SIN = 5 * MiB;
constexpr size_t WS_WPT = 9 * MiB;
constexpr size_t WS_TOKE = 10 * MiB;
constexpr size_t WS_TOKR = WS_TOKE + 128 * 1024;
constexpr size_t WS_TOKG = WS_TOKR + 128 * 1024;
constexpr size_t WS_TOKS = WS_TOKG + 128 * 1024;
constexpr size_t WS_CNTWG = WS_TOKS + 128 * 1024;
constexpr size_t WS_WIN = 16 * MiB;
constexpr size_t WS_WOUT = WS_WIN + 40 * MiB;
constexpr size_t WS_WDGU = WS_WOUT + 16 * MiB;
constexpr size_t WS_WDD = WS_WDGU + 44 * MiB;
constexpr size_t WS_WMGU = WS_WDD + 22 * MiB;
constexpr size_t WS_WMD = WS_WMGU + 448 * MiB;
constexpr size_t WS_ACT0 = WS_WMD + 224 * MiB;
constexpr size_t WS_Z = WS_ACT0;
constexpr size_t WS_AO = WS_ACT0 + 160 * MiB;
constexpr size_t WS_MIX = WS_ACT0 + 288 * MiB;
constexpr size_t WS_XN = WS_ACT0 + 352 * MiB;
constexpr size_t WS_ACTM = WS_ACT0;
constexpr size_t WS_HP = WS_ACT0 + 476 * MiB;
constexpr size_t WS_Y = WS_ACT0 + 612 * MiB;
constexpr size_t WS_ACTD = WS_ACT0 + 476 * MiB;
constexpr size_t WS_END = WS_ACT0 + 884 * MiB;
static_assert(WS_ACT0 == 810 * MiB, "map");
static_assert((size_t)MOE_ROWS * FFE * 2 <= 476 * MiB && (size_t)MOE_ROWS * DM * 2 <= 136 * MiB && (size_t)MOE_ROWS * DM * 4 <= 272 * MiB, "map");

#ifndef PH_MASK
#define PH_MASK 0xffff
#endif
constexpr int CW_TMO = 0, CW_CODE = 1, CW_BAR = 4096;

constexpr int RING_BYTES = 131072;
constexpr int LDSCTL_OFF = RING_BYTES;
constexpr int LDS_BYTES = 147456;
constexpr int LW_CNT = 16, LW_TOT = 24, LW_PRE = 32, LW_BP = 40, LW_TOFF = 48;

#define LDS_WAIT() asm volatile("s_waitcnt lgkmcnt(0)" ::: "memory")
#define VM_WAIT() asm volatile("s_waitcnt vmcnt(0)" ::: "memory")

__device__ __forceinline__ unsigned cvt_pk_bf16(float lo, float hi) { unsigned r; asm volatile("v_cvt_pk_bf16_f32 %0, %1, %2" : "=v"(r) : "v"(lo), "v"(hi)); return r; }
__device__ __forceinline__ float bflo(unsigned w) { return __uint_as_float(w << 16); }
__device__ __forceinline__ float bfhi(unsigned w) { return __uint_as_float(w & 0xffff0000u); }
__device__ __forceinline__ float wave_sum(float v) {
#pragma unroll
    for (int o = 1; o < 64; o <<= 1) v += __shfl_xor(v, o);
    return v;
}

__device__ __forceinline__ int ltid() { int t = threadIdx.x; asm volatile("" : "+v"(t)); return t; }

namespace pg8 {
constexpr int BM = 256, BK = 64, HALF = 128, HTB = HALF * BK * 2, STAGE_BYTES = 8 * HTB, NXCD = 8, WGM = 8;
__host__ __device__ __forceinline__ int lds_byte(int r, int c) { const int st = (r >> 4) * 2 + (c >> 5), rr = r & 15, cc = c & 31, ob = rr * 64 + cc * 2; return st * 1024 + (ob ^ (((ob >> 9) & 1) << 5)); }
__host__ __device__ __forceinline__ void stage_rc(int b, int& R, int& C) { const int st = b / 1024, sb = b % 1024, swz = sb ^ (((sb >> 9) & 1) << 5); R = (st >> 1) * 16 + swz / 64; C = (st & 1) * 32 + (swz % 64) / 2; }
__host__ __device__ __forceinline__ int perm32(int rho) { const int n = rho >> 4, i = rho & 15; return 8 * (i >> 2) + 4 * n + (i & 3); }

struct Unit { int pm, pn, e; };
struct Gemm { const bf16_t* A; const bf16_t* Bt; int K; size_t estride; };

struct StaticOrder {
    int nM, nN, nwg, G, c;
    __device__ __forceinline__ void init(int nM_, int nN_, int G_, int c_) { nM = nM_; nN = nN_; nwg = nM * nN; G = G_; c = c_; }
    __device__ __forceinline__ bool next(int i, Unit& u) const {
        const long L = (long)i * G + c; if (L >= nwg) return false;
        int wgid = (int)L; { const int q = nwg / NXCD, r = nwg % NXCD, xcd = wgid % NXCD, off = wgid / NXCD; wgid = (xcd < r ? xcd * (q + 1) : r * (q + 1) + (xcd - r) * q) + off; }
        const int nig = WGM * nN, gid = wgid / nig, fm = gid * WGM, gsz = (nM - fm) < WGM ? (nM - fm) : WGM;
        u.pm = fm + ((wgid % nig) % gsz); u.pn = (wgid % nig) / gsz; u.e = 0; return true;
    }
};
struct MoeOrder {
    StaticOrder S; int t1, t2, t3, t4, t5, t6, t7;
    __device__ __forceinline__ bool next(int i, Unit& u) const {
        if (!S.next(i, u)) return false;
        const int p = u.pm; u.e = __builtin_amdgcn_readfirstlane((p >= t1) + (p >= t2) + (p >= t3) + (p >= t4) + (p >= t5) + (p >= t6) + (p >= t7)); return true;
    }
};

struct EpiBf16 {
    static constexpr bool PERM = true;
    bf16_t* O; int ldc;
    __device__ __forceinline__ void operator()(const f32x4 (&acc)[2][2][4][2], const Unit& u, int wr, int wc, int fr, int fq) const {
        const int row0 = u.pm * BM + wr * 64 + fr, col0 = u.pn * BM + wc * 32 + 8 * fq;
#pragma unroll
        for (int ai = 0; ai < 2; ++ai)
#pragma unroll
            for (int m = 0; m < 4; ++m) { bf16_t* rowp = O + (size_t)(row0 + ai * HALF + m * 16) * ldc + col0;
#pragma unroll
                for (int bj = 0; bj < 2; ++bj) { const f32x4 v0 = acc[ai][bj][m][0], v1 = acc[ai][bj][m][1];
                    u32x4 w; w.x = cvt_pk_bf16(v0[0], v0[1]); w.y = cvt_pk_bf16(v0[2], v0[3]); w.z = cvt_pk_bf16(v1[0], v1[1]); w.w = cvt_pk_bf16(v1[2], v1[3]);
                    *(u32x4*)(rowp + bj * HALF) = w; } }
    }
};
__device__ __forceinline__ float silu_mul(float g, float u) { return g * __builtin_amdgcn_rcpf(1.0f + __builtin_amdgcn_exp2f(-1.4426950408889634f * g)) * u; }
struct EpiSwiglu {
    static constexpr bool PERM = true;
    bf16_t* O; int ldc;
    __device__ __forceinline__ void operator()(const f32x4 (&acc)[2][2][4][2], const Unit& u, int wr, int wc, int fr, int fq) const {
        const int row0 = u.pm * BM + wr * 64 + fr, col0 = u.pn * HALF + wc * 32 + 8 * fq;
#pragma unroll
        for (int ai = 0; ai < 2; ++ai)
#pragma unroll
            for (int m = 0; m < 4; ++m) { bf16_t* rowp = O + (size_t)(row0 + ai * HALF + m * 16) * ldc + col0;
                const f32x4 g0 = acc[ai][0][m][0], g1 = acc[ai][0][m][1], u0 = acc[ai][1][m][0], u1 = acc[ai][1][m][1];
                u32x4 w;
                w.x = cvt_pk_bf16(silu_mul(g0[0], u0[0]), silu_mul(g0[1], u0[1])); w.y = cvt_pk_bf16(silu_mul(g0[2], u0[2]), silu_mul(g0[3], u0[3]));
                w.z = cvt_pk_bf16(silu_mul(g1[0], u1[0]), silu_mul(g1[1], u1[1])); w.w = cvt_pk_bf16(silu_mul(g1[2], u1[2]), silu_mul(g1[3], u1[3]));
                *(u32x4*)rowp = w; }
    }
};
struct EpiResF32 {
    static constexpr bool PERM = false;
    const float* R; float* O; int ldc;
    __device__ __forceinline__ void operator()(const f32x4 (&acc)[2][2][4][2], const Unit& u, int wr, int wc, int fr, int fq) const {
        const int col0 = u.pn * BM + wc * 32 + 4 * fq;
#pragma unroll
        for (int ai = 0; ai < 2; ++ai)
#pragma unroll
            for (int m = 0; m < 4; ++m) { const size_t off = (size_t)(u.pm * BM + ai * HALF + wr * 64 + m * 16 + fr) * ldc + col0;
#pragma unroll
                for (int bj = 0; bj < 2; ++bj)
#pragma unroll
                    for (int n = 0; n < 2; ++n) { const f32x4 bs = *(const f32x4*)(R + off + bj * HALF + n * 16); *(f32x4*)(O + off + bj * HALF + n * 16) = bs + acc[ai][bj][m][n]; }
                asm volatile("" ::: "memory"); }
    }
};
struct EpiF32 {
    static constexpr bool PERM = false;
    float* O; int ldc;
    __device__ __forceinline__ void operator()(const f32x4 (&acc)[2][2][4][2], const Unit& u, int wr, int wc, int fr, int fq) const {
        const int col0 = u.pn * BM + wc * 32 + 4 * fq;
#pragma unroll
        for (int ai = 0; ai < 2; ++ai)
#pragma unroll
            for (int m = 0; m < 4; ++m) { const size_t off = (size_t)(u.pm * BM + ai * HALF + wr * 64 + m * 16 + fr) * ldc + col0;
#pragma unroll
                for (int bj = 0; bj < 2; ++bj)
#pragma unroll
                    for (int n = 0; n < 2; ++n) *(f32x4*)(O + off + bj * HALF + n * 16) = acc[ai][bj][m][n]; }
    }
};

__device__ __forceinline__ void glds16s(unsigned voff, const char* sbase, unsigned lds_dst) { unsigned keep;
    asm volatile("s_mov_b32 %0, m0\n\ts_mov_b32 m0, %3\n\ts_nop 0\n\tglobal_load_lds_dwordx4 %1, %2\n\ts_mov_b32 m0, %0" : "=&s"(keep) : "v"(voff), "s"(sbase), "s"(lds_dst) : "memory"); }
template <class Epi, class Sched>
__device__ __forceinline__ void gemm_phase(LAS unsigned char* lds, const Gemm g, const Sched& S, const Epi& E) {
    const int tid = ltid(), wid = __builtin_amdgcn_readfirstlane(tid >> 6), lane = tid & 63, wr = wid >> 2, wc = wid & 3, fr = lane & 15, fq = lane >> 4;
    const int K = g.K, nt = K / BK;
    unsigned voffA[2], voffB[2];
#pragma unroll
    for (int i = 0; i < 2; ++i) { int R, C; stage_rc(tid * 16 + i * 8192, R, C); const int Rb = Epi::PERM ? ((R & ~31) + perm32(R & 31)) : R;
        voffA[i] = (unsigned)(R * K + C) * 2u; voffB[i] = (unsigned)(Rb * K + C) * 2u; }
    const size_t kstep = (size_t)(BK * 2);
    const size_t hstep = (size_t)HALF * K * 2;
    const size_t tstep = 2 * hstep;
    const unsigned ldsb = (unsigned)(uintptr_t)lds + (unsigned)wid * 1024u;
    const int aoff = lds_byte(wr * 64 + fr, fq * 8), boff = lds_byte(wc * 32 + fr, fq * 8);
#define PG8_SA(b, h) (((b) * 2 + (h)) * HTB)
#define PG8_SB(b, h) ((4 + (b) * 2 + (h)) * HTB)
#define PG8_STAGE(bufoff, gbase, voff) do { _Pragma("unroll") for (int _i = 0; _i < 2; ++_i) \
        glds16s((voff)[_i], (const char*)(gbase), ldsb + (unsigned)((bufoff) + _i * 8192)); } while (0)
#define PG8_LDA(dst, b, h) do { _Pragma("unroll") for (int m = 0; m < 4; ++m) _Pragma("unroll") for (int k = 0; k < 2; ++k) dst[m][k] = *(const LAS bf16x8*)(lds + PG8_SA(b, h) + aoff + m * 2048 + k * 1024); } while (0)
#define PG8_LDB(dst, b, h) do { _Pragma("unroll") for (int n = 0; n < 2; ++n) _Pragma("unroll") for (int k = 0; k < 2; ++k) dst[n][k] = *(const LAS bf16x8*)(lds + PG8_SB(b, h) + boff + n * 2048 + k * 1024); } while (0)
#define PG8_MMA(ai, bj, At, Bt) do { __builtin_amdgcn_s_setprio(1); _Pragma("unroll") for (int m = 0; m < 4; ++m) _Pragma("unroll") for (int n = 0; n < 2; ++n) _Pragma("unroll") for (int k = 0; k < 2; ++k) \
        acc[ai][bj][m][n] = __builtin_amdgcn_mfma_f32_16x16x32_bf16(Bt[n][k], At[m][k], acc[ai][bj][m][n], 0, 0, 0); __builtin_amdgcn_s_setprio(0); } while (0)
#define PG8_WAIT_V(n) asm volatile("s_waitcnt vmcnt(" #n ")" ::: "memory")
#define PG8_WAIT_L(n) asm volatile("s_waitcnt lgkmcnt(" #n ")" ::: "memory")
#define PG8_BAR __builtin_amdgcn_s_barrier()
#define PG8_SCHED __builtin_amdgcn_sched_barrier(0)
    Unit cur, nxt; int ui = 0;
    if (!S.next(0, cur)) return;
    f32x4 acc[2][2][4][2];
#pragma unroll
    for (int a = 0; a < 2; ++a)
#pragma unroll
        for (int b = 0; b < 2; ++b)
#pragma unroll
            for (int m = 0; m < 4; ++m)
#pragma unroll
                for (int n = 0; n < 2; ++n) acc[a][b][m][n] = (f32x4){0.f, 0.f, 0.f, 0.f};
    bf16x8 At[4][2], B0[2][2], B1[2][2];
    const char* cA = (const char*)g.A + (size_t)cur.pm * tstep; const char* cB = (const char*)g.Bt + (size_t)cur.e * g.estride + (size_t)cur.pn * tstep;
    PG8_STAGE(PG8_SB(0, 0), cB, voffB); PG8_STAGE(PG8_SB(0, 1), cB + hstep, voffB); PG8_STAGE(PG8_SA(0, 0), cA, voffA); PG8_STAGE(PG8_SA(0, 1), cA + hstep, voffA);
    if (wr == 1) PG8_BAR;
    PG8_WAIT_V(2); PG8_BAR;
    PG8_STAGE(PG8_SB(1, 0), cB + kstep, voffB); PG8_STAGE(PG8_SA(1, 0), cA + kstep, voffA); PG8_STAGE(PG8_SB(1, 1), cB + hstep + kstep, voffB);
    PG8_WAIT_V(6); PG8_BAR;
    for (;;) {
        const bool has_next = S.next(ui + 1, nxt);
        const char* nA = has_next ? (const char*)g.A + (size_t)nxt.pm * tstep : cA; const char* nB = has_next ? (const char*)g.Bt + (size_t)nxt.e * g.estride + (size_t)nxt.pn * tstep : cB;
        for (int t = 0; t < nt; t += 2) {
            const bool last = (t == nt - 2);
            const char* a1 = cA + (size_t)(t + 1) * kstep;
            const char* a2 = last ? nA : cA + (size_t)(t + 2) * kstep; const char* b2 = last ? nB : cB + (size_t)(t + 2) * kstep;
            const char* a3 = a2 + kstep; const char* b3 = b2 + kstep;
            PG8_LDB(B0, 0, 0); PG8_LDB(B1, 0, 1); PG8_SCHED; PG8_LDA(At, 0, 0); PG8_STAGE(PG8_SA(1, 1), a1 + hstep, voffA);
            PG8_WAIT_V(8); PG8_WAIT_L(0); PG8_BAR; PG8_MMA(0, 0, At, B0); PG8_MMA(0, 1, At, B1); PG8_BAR; PG8_SCHED;
            PG8_LDA(At, 0, 1); PG8_STAGE(PG8_SB(0, 0), b2, voffB); PG8_STAGE(PG8_SB(0, 1), b2 + hstep, voffB); PG8_STAGE(PG8_SA(0, 0), a2, voffA);
            PG8_WAIT_V(8); PG8_WAIT_L(0); PG8_BAR; PG8_MMA(1, 0, At, B0); PG8_MMA(1, 1, At, B1); PG8_BAR; PG8_SCHED;
            PG8_LDB(B0, 1, 0); PG8_LDB(B1, 1, 1); PG8_SCHED; PG8_LDA(At, 1, 0); PG8_STAGE(PG8_SA(0, 1), a2 + hstep, voffA);
            PG8_WAIT_V(8); PG8_WAIT_L(0); PG8_BAR; PG8_MMA(0, 0, At, B0); PG8_MMA(0, 1, At, B1); PG8_BAR; PG8_SCHED;
            PG8_LDA(At, 1, 1); PG8_STAGE(PG8_SB(1, 0), b3, voffB); PG8_STAGE(PG8_SB(1, 1), b3 + hstep, voffB); PG8_STAGE(PG8_SA(1, 0), a3, voffA);
            PG8_WAIT_V(8); PG8_WAIT_L(0); PG8_BAR; PG8_MMA(1, 0, At, B0); PG8_MMA(1, 1, At, B1); PG8_BAR; PG8_SCHED;
        }
        if (wr == 0) PG8_BAR;
        E(acc, cur, wr, wc, fr, fq);
        if (!has_next) break;
#pragma unroll
        for (int a = 0; a < 2; ++a)
#pragma unroll
            for (int b = 0; b < 2; ++b)
#pragma unroll
                for (int m = 0; m < 4; ++m)
#pragma unroll
                    for (int n = 0; n < 2; ++n) acc[a][b][m][n] = (f32x4){0.f, 0.f, 0.f, 0.f};
        cur = nxt; cA = nA; cB = nB; ++ui;
        if (wr == 1) PG8_BAR;
    }
    PG8_WAIT_V(0);
    PG8_BAR;
#undef PG8_SA
#undef PG8_SB
#undef PG8_STAGE
#undef PG8_LDA
#undef PG8_LDB
#undef PG8_MMA
#undef PG8_WAIT_V
#undef PG8_WAIT_L
#undef PG8_BAR
#undef PG8_SCHED
}
}

namespace att {
constexpr int D = 128, LDZ = INW, LDO = DM;
constexpr float SCALE = 0.08838834764831845f;
constexpr float THR = 8.f;
constexpr int NW = 8, QBLK = 32, KVBLK = 64, QB = NW * QBLK;
constexpr int SHM_V = KVBLK * D * 2, SHM_K = KVBLK * D * 2;
constexpr int ATT_LDS_BYTES = 2 * SHM_V + 2 * SHM_K + NW * 64 * 4;
#define KSWZ(row, colB) ((row) * 256 + ((colB) ^ (((row) & 7) << 4)))
#define SBAR() __builtin_amdgcn_sched_barrier(0)
__device__ __forceinline__ int v_st(int k, int c) { const int kk = (k & ~0xC) | ((k & 4) << 1) | ((k & 8) >> 1); return ((kk >> 3) * 4 + (c >> 5)) * 512 + ((kk & 7) * 32 + (c & 31)) * 2; }
__device__ __forceinline__ int v_rd_base(int lane) { return ((lane & 3) << 3) | (((lane >> 2) & 3) << 6) | (((lane >> 4) & 1) << 5) | (((lane >> 5) & 1) << 8); }
constexpr int v_rd_off(int d0, int ks, int half) { return d0 * 512 + ks * 4096 + half * 2048; }
__device__ __forceinline__ int crow(int r, int hi) { return (r & 3) + 8 * (r >> 2) + 4 * hi; }
__device__ __forceinline__ bf16x8 load8(const bf16_t* p) { return *reinterpret_cast<const bf16x8*>(p); }
__device__ __forceinline__ void mask_tile(f32x16& p0, f32x16& p1, int dq, unsigned W) {
    const float NEG = -__builtin_inff();
#pragma unroll
    for (int r = 0; r < 16; ++r) {
        const int c = (r & 3) + 8 * (r >> 2);
        if ((unsigned)(dq - c) >= W) p0[r] = NEG;
        if ((unsigned)(dq - c - 32) >= W) p1[r] = NEG;
    }
}
__device__ __forceinline__ void partialSM(f32x16& p0, f32x16& p1, float& m_reg, float& mn, float& alpha) {
    float pmax = p0[0];
#pragma unroll
    for (int r = 1; r < 16; ++r) pmax = fmaxf(pmax, p0[r]);
#pragma unroll
    for (int r = 0; r < 16; ++r) pmax = fmaxf(pmax, p1[r]);
    { auto rr = __builtin_amdgcn_permlane32_swap(__float_as_uint(pmax), __float_as_uint(pmax), false, false);
      pmax = fmaxf(__uint_as_float(rr[0]), __uint_as_float(rr[1])); }
    constexpr float C2 = 1.4426950408889634f * SCALE;
    if (__builtin_expect(__all((pmax - m_reg) * SCALE <= THR), 1)) { mn = m_reg; alpha = 1.f; }
    else { mn = fmaxf(m_reg, pmax); alpha = __builtin_amdgcn_exp2f((m_reg - mn) * C2); m_reg = mn; }
    const float mnL = -mn * C2;
#pragma unroll
    for (int r = 0; r < 16; ++r) p0[r] = fmaf(p0[r], C2, mnL);
#pragma unroll
    for (int r = 0; r < 16; ++r) p1[r] = fmaf(p1[r], C2, mnL);
#pragma unroll
    for (int r = 0; r < 16; ++r) p0[r] = __builtin_amdgcn_exp2f(p0[r]);
}
__device__ __forceinline__ void finishSM(f32x16& p0, f32x16& p1, float alpha, float& l_reg, bf16x8& pa0, bf16x8& pa1, bf16x8& pa2, bf16x8& pa3) {
#pragma unroll
    for (int r = 0; r < 16; ++r) p1[r] = __builtin_amdgcn_exp2f(p1[r]);
    float ps = 0;
#pragma unroll
    for (int r = 0; r < 16; ++r) ps += p0[r];
#pragma unroll
    for (int r = 0; r < 16; ++r) ps += p1[r];
    { auto rr = __builtin_amdgcn_permlane32_swap(__float_as_uint(ps), __float_as_uint(ps), false, false);
      ps = __uint_as_float(rr[0]) + __uint_as_float(rr[1]); }
    l_reg = l_reg * alpha + ps;
#define PK4(P, B_, OUT) do { unsigned a0 = cvt_pk_bf16(P[B_+0], P[B_+1]), a1 = cvt_pk_bf16(P[B_+2], P[B_+3]);                          \
        unsigned b0 = cvt_pk_bf16(P[B_+4], P[B_+5]), b1 = cvt_pk_bf16(P[B_+6], P[B_+7]);                                             \
        auto r0 = __builtin_amdgcn_permlane32_swap(a0, b0, false, false); auto r1 = __builtin_amdgcn_permlane32_swap(a1, b1, false, false); \
        u32x4 w = {r0[0], r1[0], r0[1], r1[1]}; OUT = *reinterpret_cast<bf16x8*>(&w); } while (0)
    PK4(p0, 0, pa0); PK4(p0, 8, pa1); PK4(p1, 0, pa2); PK4(p1, 8, pa3);
#undef PK4
}
template <int KB>
__device__ __forceinline__ void qkt(f32x16& p0, f32x16& p1, const char* K_lds, int r32, int hi, const bf16x8* qr) {
    p0 = f32x16{}; p1 = f32x16{};
    const char* kb[4];
#pragma unroll
    for (int dd = 0; dd < 4; ++dd) kb[dd] = K_lds + KB * SHM_K + KSWZ(r32, (dd * 16 + hi * 8) * 2);
#pragma unroll
    for (int d0 = 0; d0 < 8; ++d0) { const char* a = kb[d0 & 3] + (d0 >> 2) * 128;
        bf16x8 b0 = *reinterpret_cast<const bf16x8*>(a);
        bf16x8 b1 = *reinterpret_cast<const bf16x8*>(a + 32 * 256);
        p0 = __builtin_amdgcn_mfma_f32_32x32x16_bf16(b0, qr[d0], p0, 0, 0, 0);
        p1 = __builtin_amdgcn_mfma_f32_32x32x16_bf16(b1, qr[d0], p1, 0, 0, 0); }
}
template <int VB>
__device__ __forceinline__ void pv_tile(f32x16* o, int vb0, bf16x8 pa0, bf16x8 pa1, bf16x8 pa2, bf16x8 pa3) {
#define TRRD(dst, off) asm volatile("ds_read_b64_tr_b16 %0, %1 offset:%2" : "=&v"(dst) : "v"(vb0), "i"(off) : "memory")
#define PV_D0(d0) do { s16x4 l0, l1, l2, l3, h0, h1, h2, h3; constexpr int b_ = VB * SHM_V + v_rd_off(d0, 0, 0); \
        TRRD(l0, b_); TRRD(h0, b_ + 2048); TRRD(l1, b_ + 4096); TRRD(h1, b_ + 6144); TRRD(l2, b_ + 8192); TRRD(h2, b_ + 10240); TRRD(l3, b_ + 12288); TRRD(h3, b_ + 14336); \
        asm volatile("s_waitcnt lgkmcnt(0)" ::: "memory"); SBAR();   \
        o[d0] = __builtin_amdgcn_mfma_f32_32x32x16_bf16(pa0, (bf16x8){l0[0], l0[1], l0[2], l0[3], h0[0], h0[1], h0[2], h0[3]}, o[d0], 0, 0, 0);   \
        o[d0] = __builtin_amdgcn_mfma_f32_32x32x16_bf16(pa1, (bf16x8){l1[0], l1[1], l1[2], l1[3], h1[0], h1[1], h1[2], h1[3]}, o[d0], 0, 0, 0);   \
        o[d0] = __builtin_amdgcn_mfma_f32_32x32x16_bf16(pa2, (bf16x8){l2[0], l2[1], l2[2], l2[3], h2[0], h2[1], h2[2], h2[3]}, o[d0], 0, 0, 0);   \
        o[d0] = __builtin_amdgcn_mfma_f32_32x32x16_bf16(pa3, (bf16x8){l3[0], l3[1], l3[2], l3[3], h3[0], h3[1], h3[2], h3[3]}, o[d0], 0, 0, 0); } while (0)
    PV_D0(0); PV_D0(1); PV_D0(2); PV_D0(3);
#undef PV_D0
#undef TRRD
}
struct BlockRef { const bf16_t* Q; const bf16_t* K; const bf16_t* V; float* O; int P0; };
struct Seam { bf16x8 qr[8]; bf16x8 st_v0, st_v1, st_k0, st_k1; };
#define ROW(p, k0, rr) ((p) + (size_t)((k0) + (rr)) * LDZ + sc)
#define VMW() asm volatile("s_waitcnt vmcnt(0)" ::: "memory")
#define VMWN(n) asm volatile("s_waitcnt vmcnt(%0)" :: "i"(n) : "memory")
#define SLOAD_H(Kp, Vp, k0) do { S.st_v0 = load8(ROW(Vp, k0, sr)); S.st_v1 = load8(ROW(Vp, k0, 32 + sr));              \
                         S.st_k0 = load8(ROW(Kp, k0, sr)); S.st_k1 = load8(ROW(Kp, k0, 32 + sr)); } while (0)
#define SWRITE_HK(bf) do { *(bf16x8*)(K_lds + (bf) * SHM_K + kws) = S.st_k0; *(bf16x8*)(K_lds + (bf) * SHM_K + kws + 32 * 256) = S.st_k1; } while (0)
#define SWRITE_HV(bf) do { *(bf16x8*)(V_lds + (bf) * SHM_V + vst0) = S.st_v0; *(bf16x8*)(V_lds + (bf) * SHM_V + vst1) = S.st_v1; } while (0)
#define SWRITE_H(bf) do { SWRITE_HV(bf); SWRITE_HK(bf); } while (0)
__device__ __forceinline__ void causal_prime(const BlockRef& cur, char* lds, Seam& S) {
    const int tid = ltid(), wid = __builtin_amdgcn_readfirstlane(tid >> 6), lane = tid & 63, r32 = lane & 31, hi = lane >> 5;
    const int sr = tid >> 4, sc = (tid & 15) * 8, kws = KSWZ(sr, sc * 2); char* K_lds = lds + 2 * SHM_V;
    const int kb0 = 0;
#pragma unroll
    for (int d0 = 0; d0 < 8; ++d0) S.qr[d0] = load8(cur.Q + (size_t)(wid * QBLK + r32) * LDZ + d0 * 16 + hi * 8);
    SLOAD_H(cur.K, cur.V, kb0); VMW(); SWRITE_HK(0);
    __syncthreads();
}
__device__ __forceinline__ void causal_block(const BlockRef& cur, const BlockRef& nxt, int skv, char* lds, Seam& S) {
    const int tid = ltid(), wid = __builtin_amdgcn_readfirstlane(tid >> 6), lane = tid & 63, r32 = lane & 31, hi = lane >> 5;
    const int W = 1 << 30;
    const int j_lo = 0;
    int j_hi = (cur.P0 + QB - 1) / KVBLK + 1; if (j_hi > skv / KVBLK) j_hi = skv / KVBLK;
    const int NT = j_hi - j_lo;
    const int kbn = 0;
    const int qlo = cur.P0 + wid * QBLK, qm = qlo + r32 - 4 * hi;
    char* V_lds = lds; char* K_lds = lds + 2 * SHM_V;
    float* ws = (float*)(lds + 2 * SHM_V + 2 * SHM_K) + wid * 64; float* li_l = ws, * al_l = ws + 32;
    float m_reg = -1e30f, l_reg = 0; f32x16 o[4] = {};
    const int sr = tid >> 4, sc = (tid & 15) * 8, vst0 = v_st(sr, sc), vst1 = v_st(32 + sr, sc), kws = KSWZ(sr, sc * 2);
    const int vb0 = (int)(uintptr_t)V_lds + v_rd_base(lane);
    const bf16_t* Kh = cur.K; const bf16_t* Vh = cur.V;
#define RESC(a) do { if (__any((a) < 1.f)) { if (hi == 0) al_l[r32] = (a); asm volatile("s_waitcnt lgkmcnt(0)" ::: "memory");              \
                     _Pragma("unroll") for (int d_ = 0; d_ < 4; ++d_) _Pragma("unroll") for (int r = 0; r < 16; ++r) o[d_][r] *= al_l[crow(r, hi)]; } } while (0)
#define KBASE(t) ((j_lo + (t)) * KVBLK)
#define MASKT(P0_, P1_, t) do { const int kb_ = KBASE(t); if (kb_ + KVBLK - 1 > qlo) mask_tile(P0_, P1_, qm - kb_, (unsigned)W); } while (0)
    constexpr int NQL = 8;
#define SEAM_K0() do { VMWN(NQL); SWRITE_HK(0); SBAR(); } while (0)
    f32x16 pA0, pA1, pB0, pB1; float mnA, mnB, alA, alB; bf16x8 pa0, pa1, pa2, pa3;
    SWRITE_HV(0); SBAR();
    if (NT > 1) { SLOAD_H(Kh, Vh, KBASE(1)); }
    SBAR(); qkt<0>(pA0, pA1, K_lds, r32, hi, S.qr);
    MASKT(pA0, pA1, 0); partialSM(pA0, pA1, m_reg, mnA, alA);
    if (NT > 1) { VMW(); SWRITE_H(1); }
    __syncthreads();
#define HALF_STEP(PX0, PX1, mnX, alX, PY0, PY1, alY, t, KB, VB, SB) do {                                                      \
        SBAR(); qkt<KB>(PX0, PX1, K_lds, r32, hi, S.qr);                                                                      \
        finishSM(PY0, PY1, alY, l_reg, pa0, pa1, pa2, pa3); SBAR();                                                           \
        if ((t) + 1 < NT) { SLOAD_H(Kh, Vh, KBASE((t) + 1)); SBAR(); }                                                        \
        pv_tile<VB>(o, vb0, pa0, pa1, pa2, pa3); MASKT(PX0, PX1, (t)); partialSM(PX0, PX1, m_reg, mnX, alX);                  \
        __syncthreads();                                                                                                      \
        if ((t) + 1 < NT) { VMW(); SWRITE_H(SB); }                                                                            \
        RESC(alX); __syncthreads(); } while (0)
    for (int t = 1; t + 1 < NT; t += 2) {
        HALF_STEP(pB0, pB1, mnB, alB, pA0, pA1, alA, t, 1, 0, 0);
        HALF_STEP(pA0, pA1, mnA, alA, pB0, pB1, alB, t + 1, 0, 1, 1);
    }
    const bool even = (NT & 1) == 0;
    if (even) { SBAR(); qkt<1>(pB0, pB1, K_lds, r32, hi, S.qr); SBAR(); }
    SLOAD_H(nxt.K, nxt.V, kbn); SBAR();
#pragma unroll
    for (int d0 = 0; d0 < 8; ++d0) S.qr[d0] = load8(nxt.Q + (size_t)(wid * QBLK + r32) * LDZ + d0 * 16 + hi * 8);
    SBAR();
    finishSM(pA0, pA1, alA, l_reg, pa0, pa1, pa2, pa3); SBAR();
    pv_tile<0>(o, vb0, pa0, pa1, pa2, pa3);
    if (even) { MASKT(pB0, pB1, NT - 1); partialSM(pB0, pB1, m_reg, mnB, alB); __syncthreads(); RESC(alB);
        finishSM(pB0, pB1, alB, l_reg, pa0, pa1, pa2, pa3); SBAR(); pv_tile<1>(o, vb0, pa0, pa1, pa2, pa3); }
    SBAR(); SEAM_K0();
    if (hi == 0) li_l[r32] = l_reg; asm volatile("s_waitcnt lgkmcnt(0)" ::: "memory");
    float rli[16];
#pragma unroll
    for (int r = 0; r < 16; ++r) rli[r] = __builtin_amdgcn_rcpf(li_l[crow(r, hi)]);
    float* Ow = cur.O + (size_t)(wid * QBLK) * LDO;
#pragma unroll
    for (int r = 0; r < 16; ++r) { const int orow = crow(r, hi);
#pragma unroll
        for (int d0 = 0; d0 < 4; ++d0) { const float v = o[d0][r] * rli[r]; Ow[(size_t)orow * LDO + d0 * 32 + r32] = v; } }
    __syncthreads();
#undef RESC
#undef KBASE
#undef MASKT
#undef SEAM_K0
#undef HALF_STEP
}
#undef ROW
#undef VMW
#undef VMWN
#undef SLOAD_H
#undef SWRITE_HK
#undef SWRITE_HV
#undef SWRITE_H
#undef KSWZ
#undef SBAR
}

#define XB_TMO      128
#define XB_XCNT(j)  (256  + 64 * (j))
#define XB_XSUB(j)  (1280 + 64 * (j))
#define XB_XGEN(j)  (2304 + 64 * (j))
#define XB_TOP      3328
#define XB_TOPGEN   3392
#define XCD_BAR_WORDS 3456
#define XB_SPIN_CAP (1u << 18)

__device__ __forceinline__ unsigned xb_ld(unsigned* p)              { return __hip_atomic_load(p, __ATOMIC_RELAXED, __HIP_MEMORY_SCOPE_AGENT); }
__device__ __forceinline__ unsigned xb_add(unsigned* p, unsigned v) { return __hip_atomic_fetch_add(p, v, __ATOMIC_RELAXED, __HIP_MEMORY_SCOPE_AGENT); }
__device__ __forceinline__ unsigned xb_xcc_id() { return (unsigned)__builtin_amdgcn_s_getreg((3 << 11) | 20) & 0xFu; }
#define XB_SPIN(cond, bar) do { unsigned _sp = 0; while (cond) { __builtin_amdgcn_s_sleep(1); \
    if ((++_sp & 255u) == 0u) { if (xb_ld(&(bar)[XB_TMO])) break; if (_sp > XB_SPIN_CAP) { atomicAdd(&(bar)[XB_TMO], 1u); break; } } } } while (0)

struct XcdBarrier {
    unsigned* bar; unsigned x;
    volatile LAS unsigned* st;
};

__device__ __forceinline__ XcdBarrier xcd_barrier_post(unsigned* bar, volatile LAS unsigned* st) {
    XcdBarrier b; b.bar = bar; b.x = xb_xcc_id(); b.st = st;
    if (threadIdx.x == 0) (void)xb_add(&bar[XB_XCNT(b.x)], 1u);
    return b;
}
__device__ __forceinline__ void xcd_barrier_complete(unsigned* bar, unsigned x, unsigned& nloc, unsigned& nx) {
    const unsigned G = gridDim.x * gridDim.y * gridDim.z;
    unsigned sum, cnt, mine, sp = 0u;
    for (;;) {
        sum = 0u; cnt = 0u; mine = 0u;
#pragma unroll
        for (unsigned j = 0; j < 16; ++j) { const unsigned c = xb_ld(&bar[XB_XCNT(j)]); sum += c; cnt += (c > 0u) ? 1u : 0u; mine = (j == x) ? c : mine; }
        if (sum == G) break;
        __builtin_amdgcn_s_sleep(1);
        if ((++sp & 255u) == 0u) { if (xb_ld(&bar[XB_TMO])) break; if (sp > XB_SPIN_CAP) { atomicAdd(&bar[XB_TMO], 1u); break; } }
    }
    nloc = mine > 0u ? mine : 1u; nx = cnt > 0u ? cnt : 1u;
}

template <bool FIRST> __device__ __forceinline__ void xcd_barrier(const XcdBarrier& b) {
    asm volatile("s_waitcnt vmcnt(0)" ::: "memory");
    __syncthreads();
    if (threadIdx.x == 0) {
        unsigned* bar = b.bar;
        __builtin_amdgcn_s_waitcnt(0);
        unsigned nloc = b.st[0], nx = b.st[1];
        if (FIRST) { if (nloc == 0u) { xcd_barrier_complete(bar, b.x, nloc, nx); b.st[0] = nloc; b.st[1] = nx; } }
        const unsigned old = xb_add(&bar[XB_XSUB(b.x)], 1u);
        const unsigned gen = old / nloc;
        if (old + 1u == (gen + 1u) * nloc) {
            __builtin_amdgcn_fence(__ATOMIC_RELEASE, "agent");
            asm volatile("s_waitcnt vmcnt(0)" ::: "memory");
            const unsigned og = xb_add(&bar[XB_TOP], 1u);
            const unsigned tg = og / nx;
            if (og + 1u == (tg + 1u) * nx) xb_add(&bar[XB_TOPGEN], 1u);
            else XB_SPIN(xb_ld(&bar[XB_TOPGEN]) == tg, bar);
            __builtin_amdgcn_fence(__ATOMIC_ACQUIRE, "agent");
            xb_add(&bar[XB_XGEN(b.x)], 1u);
            asm volatile("s_waitcnt vmcnt(0)" ::: "memory");
        } else {
            XB_SPIN(xb_ld(&bar[XB_XGEN(b.x)]) == gen, bar);
            __builtin_amdgcn_fence(__ATOMIC_ACQUIRE, "agent");
            asm volatile("s_waitcnt vmcnt(0)" ::: "memory");
        }
    }
    __syncthreads();
}

__device__ __forceinline__ void transpose_item(const float* W, int K, int N, bf16_t* WT, int drow0, int k0, int n0, LAS float* scr, int lane) {
#pragma unroll 8
    for (int i = 0; i < 32; ++i) { const int kk = 2 * i + (lane >> 5); scr[kk * 33 + (lane & 31)] = W[(size_t)(k0 + kk) * N + n0 + (lane & 31)]; }
    LDS_WAIT(); asm volatile("" ::: "memory");
    const int c = lane & 7;
#pragma unroll
    for (int j = 0; j < 4; ++j) { const int n = (lane >> 3) + 8 * j; const LAS float* s = scr + (8 * c) * 33 + n;
        u32x4 o; o.x = cvt_pk_bf16(s[0 * 33], s[1 * 33]); o.y = cvt_pk_bf16(s[2 * 33], s[3 * 33]); o.z = cvt_pk_bf16(s[4 * 33], s[5 * 33]); o.w = cvt_pk_bf16(s[6 * 33], s[7 * 33]);
        *(u32x4*)(WT + (size_t)(drow0 + n) * K + k0 + 8 * c) = o; }
    LDS_WAIT(); asm volatile("" ::: "memory");
}
__device__ __forceinline__ float rms_row(const float* xrow, const float* g, bf16_t* orow, int lane) {
    const f32x4* xr = (const f32x4*)xrow + lane; const f32x4* gr = (const f32x4*)g + lane;
    f32x4 v[8]; float s = 0.f;
#pragma unroll
    for (int j = 0; j < 8; ++j) { v[j] = xr[64 * j]; s += (v[j].x * v[j].x + v[j].y * v[j].y) + (v[j].z * v[j].z + v[j].w * v[j].w); }
    const float rstd = 1.0f / sqrtf(wave_sum(s) * (1.0f / DM) + EPS);
    u32x2* o8 = (u32x2*)orow + lane;
#pragma unroll
    for (int j = 0; j < 8; ++j) { const f32x4 gg = gr[64 * j]; const f32x4 y = v[j] * rstd * gg; u32x2 w; w.x = cvt_pk_bf16(y.x, y.y); w.y = cvt_pk_bf16(y.z, y.w); o8[64 * j] = w; }
    return rstd;
}

struct Args { const void* in[20]; float* out; unsigned char* ws; };

__global__ void __launch_bounds__(512, 2) hybrid_fwd(Args args) {
    extern __shared__ __attribute__((aligned(16))) unsigned char lds_raw[];
    LAS unsigned char* lds = (LAS unsigned char*)lds_raw;
    volatile LAS unsigned* LW = (volatile LAS unsigned*)(lds + LDSCTL_OFF);
    const int tid = threadIdx.x, lane = tid & 63, wave = __builtin_amdgcn_readfirstlane(tid >> 6);
    const int G = gridDim.x, bx = blockIdx.x;
    const int gw = bx * 8 + wave, NGW = G * 8;
    for (int u = tid; u < (LDS_BYTES - LDSCTL_OFF) / 4; u += 512) LW[u] = 0u;
    __syncthreads();
    if (tid < 22) { const unsigned long long pv = tid < 20 ? (unsigned long long)args.in[tid] : (tid == 20 ? (unsigned long long)args.out : (unsigned long long)args.ws);
        LW[64 + 2 * tid] = (unsigned)pv; LW[64 + 2 * tid + 1] = (unsigned)(pv >> 32); }
    __syncthreads();
#define PTR(i) ((unsigned long long)(unsigned)__builtin_amdgcn_readfirstlane((int)LW[64 + 2 * (i)]) | ((unsigned long long)(unsigned)__builtin_amdgcn_readfirstlane((int)LW[64 + 2 * (i) + 1]) << 32))
#define INF(i) ((const float*)PTR(i))
#define WSP(T, off) ((T*)((unsigned char*)PTR(21) + (off)))
#define OUTP ((float*)PTR(20))
    { const XcdBarrier b0 = xcd_barrier_post(WSP(unsigned, WS_CTL) + CW_BAR, LW); if (threadIdx.x == 0) LW[2] = b0.x; }
    __syncthreads();
#define GRID_BAR_T(F) do { XcdBarrier b_; b_.bar = WSP(unsigned, WS_CTL) + CW_BAR; b_.x = (unsigned)__builtin_amdgcn_readfirstlane((int)LW[2]); b_.st = LW; xcd_barrier<F>(b_); } while (0)
#define GRID_BAR() GRID_BAR_T(false)

    if (PH_MASK & (1 << 0)) {
        LAS float* scr = (LAS float*)(lds + wave * 16384);
        constexpr int I_IN = 32 * 160, I_OUT = 32 * 64, I_DG = 32 * 176, I_DD = 88 * 64, I_MG = 32 * 224, I_MD = 112 * 64;
        constexpr int NITEMS = 2 * I_IN + 2 * I_OUT + 2 * I_DG + I_DD + 16 * I_MG + 8 * I_MD;
        unsigned char* ws = WSP(unsigned char, 0);
        for (int it = gw; it < NITEMS; it += NGW) {
            int r = it; const float* W; bf16_t* WT; int K, N, mode = 0;
            if (r < 2 * I_IN) { const int l = r / I_IN; r -= l * I_IN; W = INF(3) + (size_t)l * DM * INW; WT = (bf16_t*)(ws + WS_WIN) + (size_t)l * INW * DM; K = DM; N = INW; }
            else if ((r -= 2 * I_IN) < 2 * I_OUT) { const int l = r / I_OUT; r -= l * I_OUT; W = INF(11) + (size_t)l * DM * DM; WT = (bf16_t*)(ws + WS_WOUT) + (size_t)l * DM * DM; K = DM; N = DM; }
            else if ((r -= 2 * I_OUT) < I_DG) { W = INF(13); WT = (bf16_t*)(ws + WS_WDGU); K = DM; N = FFD; mode = 1; }
            else if ((r -= I_DG) < I_DG) { W = INF(14); WT = (bf16_t*)(ws + WS_WDGU); K = DM; N = FFD; mode = 2; }
            else if ((r -= I_DG) < I_DD) { W = INF(15); WT = (bf16_t*)(ws + WS_WDD); K = FFD; N = DM; }
            else if ((r -= I_DD) < 8 * I_MG) { const int e = r / I_MG; r -= e * I_MG; W = INF(17) + (size_t)e * DM * FFE; WT = (bf16_t*)(ws + WS_WMGU) + (size_t)e * 2 * FFE * DM; K = DM; N = FFE; mode = 1; }
            else if ((r -= 8 * I_MG) < 8 * I_MG) { const int e = r / I_MG; r -= e * I_MG; W = INF(18) + (size_t)e * DM * FFE; WT = (bf16_t*)(ws + WS_WMGU) + (size_t)e * 2 * FFE * DM; K = DM; N = FFE; mode = 2; }
            else { r -= 8 * I_MG; const int e = r / I_MD; r -= e * I_MD; W = INF(19) + (size_t)e * FFE * DM; WT = (bf16_t*)(ws + WS_WMD) + (size_t)e * DM * FFE; K = FFE; N = DM; }
            const int nblk = N / 32, kb = r / nblk, nb = r - kb * nblk, k0 = 64 * kb, n0 = 32 * nb;
            const int drow0 = mode == 0 ? n0 : (256 * (n0 >> 7) + (mode - 1) * 128 + (n0 & 127));
            transpose_item(W, K, N, WT, drow0, k0, n0, scr, lane);
        }
        {
            const int* positions = (const int*)PTR(1); float* cosT = (float*)(ws + WS_COS); float* sinT = (float*)(ws + WS_SIN);
            for (int idx = (bx * 512 + tid); idx < NTOK * 64; idx += G * 512) {
                const int t = idx >> 6, i = idx & 63;
                const float inv = 1.0f / powf(10000.0f, (float)(2 * i) / 128.0f);
                const float ang = (float)positions[t] * inv;
                double rev = (double)ang * 0.15915494309189535; rev -= rint(rev);
                const float rf = (float)rev;
                cosT[idx] = __builtin_amdgcn_cosf(rf); sinT[idx] = __builtin_amdgcn_sinf(rf);
            }
        }
        {
            const float* w_pool = INF(8); bf16_t* wpt = (bf16_t*)(ws + WS_WPT);
            for (int idx = (bx * 512 + tid); idx < 2 * 4 * 128 * 128; idx += G * 512) {
                const int c = idx & 127, d = (idx >> 7) & 127, lg = idx >> 14;
                const float v = w_pool[((size_t)lg * 128 + c) * 128 + d];
                wpt[idx] = (bf16_t)(cvt_pk_bf16(v, 0.f) & 0xffffu);
            }
        }
        {
            const float* x_in = INF(0); const float* gn = INF(2); bf16_t* xn = (bf16_t*)(ws + WS_XN);
            for (int m = gw; m < NTOK; m += NGW) (void)rms_row(x_in + (size_t)m * DM, gn, xn + (size_t)m * DM, lane);
        }
    }
    GRID_BAR_T(true);

    for (int l = 0; l < DEPTH; ++l) {
#define PHASE_IDS() const int tid = ltid(), lane = tid & 63, wave = __builtin_amdgcn_readfirstlane(tid >> 6), gw = bx * 8 + wave; (void)tid; (void)lane; (void)wave; (void)gw
        if (PH_MASK & (1 << 1)) {
            pg8::Gemm g{WSP(bf16_t, WS_XN), WSP(bf16_t, WS_WIN) + (size_t)l * INW * DM, DM, 0};
            pg8::StaticOrder S; S.init(NTOK / 256, INW / 256, G, bx);
            pg8::EpiBf16 E{WSP(bf16_t, WS_Z), INW};
            pg8::gemm_phase<pg8::EpiBf16, pg8::StaticOrder>(lds, g, S, E);
        }
        GRID_BAR();
        if (PH_MASK & (1 << 2)) {
            PHASE_IDS();
            bf16_t* zb = WSP(bf16_t, WS_Z); bf16_t* mix = WSP(bf16_t, WS_MIX);
            {
            const float* qg = INF(4) + l * 128; const float* kg = INF(5) + l * 128;
            const float* cw = INF(10) + (size_t)l * 3 * 512;
            const float* cosT = WSP(float, WS_COS); const float* sinT = WSP(float, WS_SIN);
            for (int t = gw; t < NTOK; t += NGW) {
                bf16_t* zr = zb + (size_t)t * INW;
                {
                    const int c = lane >> 2, sub = lane & 3;
                    bf16_t* p = zr + c * 128 + 16 * sub;
                    const u32x4 a0 = *(const u32x4*)p, a1 = *(const u32x4*)(p + 8), b0 = *(const u32x4*)(p + 64), b1 = *(const u32x4*)(p + 72);
                    float xa[16], xb[16];
#pragma unroll
                    for (int j = 0; j < 4; ++j) { xa[2 * j] = bflo(a0[j]); xa[2 * j + 1] = bfhi(a0[j]); xa[8 + 2 * j] = bflo(a1[j]); xa[8 + 2 * j + 1] = bfhi(a1[j]);
                                                  xb[2 * j] = bflo(b0[j]); xb[2 * j + 1] = bfhi(b0[j]); xb[8 + 2 * j] = bflo(b1[j]); xb[8 + 2 * j + 1] = bfhi(b1[j]); }
                    float ss = 0.f;
#pragma unroll
                    for (int j = 0; j < 16; ++j) ss += xa[j] * xa[j] + xb[j] * xb[j];
                    ss += __shfl_xor(ss, 1); ss += __shfl_xor(ss, 2);
                    const float rstd = 1.0f / sqrtf(ss * (1.0f / 128.0f) + EPS);
                    const float* gp = (c < 8 ? qg : kg) + 16 * sub;
                    const float* cp = cosT + (size_t)t * 64 + 16 * sub; const float* sp = sinT + (size_t)t * 64 + 16 * sub;
                    float oa[16], ob[16];
#pragma unroll
                    for (int j = 0; j < 16; ++j) { const float x1 = xa[j] * rstd * gp[j], x2 = xb[j] * rstd * gp[64 + j]; const float cs = cp[j], sn = sp[j];
                        oa[j] = x1 * cs - x2 * sn; ob[j] = x1 * sn + x2 * cs; }
                    u32x4 w0, w1, w2, w3;
#pragma unroll
                    for (int j = 0; j < 4; ++j) { w0[j] = cvt_pk_bf16(oa[2 * j], oa[2 * j + 1]); w1[j] = cvt_pk_bf16(oa[8 + 2 * j], oa[8 + 2 * j + 1]);
                                                  w2[j] = cvt_pk_bf16(ob[2 * j], ob[2 * j + 1]); w3[j] = cvt_pk_bf16(ob[8 + 2 * j], ob[8 + 2 * j + 1]); }
                    *(u32x4*)p = w0; *(u32x4*)(p + 8) = w1; *(u32x4*)(p + 64) = w2; *(u32x4*)(p + 72) = w3;
                }
                {
                    const int tb = t & (SEQ - 1), ch = 8 * lane;
                    const u32x4 gb = *(const u32x4*)(zr + ZGB + ch);
                    float y[8];
#pragma unroll
                    for (int j = 0; j < 8; ++j) y[j] = 0.f;
#pragma unroll
                    for (int d = 0; d < 3; ++d) {
                        if (tb >= d) {
                            const bf16_t* zd = zr - (size_t)d * INW;
                            const u32x4 gc = *(const u32x4*)(zd + ZGC + ch), hc = *(const u32x4*)(zd + ZH + ch);
                            const f32x4 wa = *(const f32x4*)(cw + (2 - d) * 512 + ch), wb = *(const f32x4*)(cw + (2 - d) * 512 + ch + 4);
#pragma unroll
                            for (int j = 0; j < 4; ++j) { const float u0 = bflo(gc[j]) * bflo(hc[j]), u1 = bfhi(gc[j]) * bfhi(hc[j]);
                                const float k0_ = (j < 2) ? wa[2 * j] : wb[2 * j - 4], k1_ = (j < 2) ? wa[2 * j + 1] : wb[2 * j - 3];
                                y[2 * j] += k0_ * u0; y[2 * j + 1] += k1_ * u1; }
                        }
                    }
                    u32x4 w;
#pragma unroll
                    for (int j = 0; j < 4; ++j) w[j] = cvt_pk_bf16(bflo(gb[j]) * y[2 * j], bfhi(gb[j]) * y[2 * j + 1]);
                    *(u32x4*)(mix + (size_t)t * DM + 1536 + ch) = w;
                }
            }
            }
            {
            const bf16_t* wpt = WSP(bf16_t, WS_WPT); const float* pool_scale = INF(9) + l * 512;
            for (int it = gw; it < (NTOK / 32) * 4; it += NGW) {
                const int T = it >> 2, gi = it & 3, wn = 2 << gi, t0 = T * 32;
                const int r32 = lane & 31, hi = lane >> 5, t = t0 + r32, tb = t & (SEQ - 1);
                const float inv = 1.0f / (float)((tb + 1) < wn ? (tb + 1) : wn);
                const bf16_t* zp = zb + (size_t)t * INW + ZP + gi * 128;
                const bf16_t* wp = wpt + ((size_t)(l * 4 + gi) * 128) * 128;
                f32x16 acc[4];
#pragma unroll
                for (int nb = 0; nb < 4; ++nb) acc[nb] = f32x16{};
#pragma unroll 1
                for (int s = 0; s < 8; ++s) {
                    const int cb = 16 * s + 8 * hi;
                    float sum[8], self[8];
#pragma unroll
                    for (int j = 0; j < 8; ++j) { sum[j] = 0.f; self[j] = 0.f; }
#pragma unroll 1
                    for (int d = 0; d < wn; ++d) {
                        if (d <= tb) { const u32x4 v = *(const u32x4*)(zp - (size_t)d * INW + cb);
#pragma unroll
                            for (int j = 0; j < 4; ++j) { const float a = bflo(v[j]), b = bfhi(v[j]); sum[2 * j] += a; sum[2 * j + 1] += b; if (d == 0) { self[2 * j] = a; self[2 * j + 1] = b; } } }
                    }
                    u32x4 aw;
#pragma unroll
                    for (int j = 0; j < 4; ++j) aw[j] = cvt_pk_bf16(sum[2 * j] * inv - self[2 * j], sum[2 * j + 1] * inv - self[2 * j + 1]);
                    const bf16x8 af = __builtin_bit_cast(bf16x8, aw);
#pragma unroll
                    for (int nb = 0; nb < 4; ++nb) { const bf16x8 bfr = *(const bf16x8*)(wp + (size_t)(nb * 32 + r32) * 128 + cb);
                        acc[nb] = __builtin_amdgcn_mfma_f32_32x32x16_bf16(af, bfr, acc[nb], 0, 0, 0); }
                }
#pragma unroll
                for (int nb = 0; nb < 4; ++nb) { const int col = gi * 128 + nb * 32 + r32; const float ps = pool_scale[col];
#pragma unroll
                    for (int r = 0; r < 16; ++r) { const int row = (r & 3) + 8 * (r >> 2) + 4 * hi;
                        mix[(size_t)(t0 + row) * DM + 1024 + col] = (bf16_t)(cvt_pk_bf16(acc[nb][r] * ps, 0.f) & 0xffffu); } }
            }
            }
        }
        GRID_BAR();
        if (PH_MASK & (1 << 3)) {
            constexpr int NITEM = 512;
            char* alds = (char*)lds_raw;
            int L = bx;
            if (L < NITEM) {
                const bf16_t* zb = WSP(bf16_t, WS_Z); float* ao = WSP(float, WS_AO);
#define ATT_REF(ref, LL, pass) do { const int xcd_ = (LL) & 7, k_ = (LL) >> 3, bh_ = (k_ >> 4) * 8 + xcd_, b_ = bh_ >> 2, h_ = bh_ & 3, vh_ = (k_ & 15) >> 2, mp_ = vh_ >> 1, vj_ = vh_ & 1, x_ = k_ & 3; \
                    const int qb_ = (pass) ? 7 - x_ : x_; const bf16_t* zb_ = zb + (size_t)b_ * SEQ * INW; \
                    (ref).Q = zb_ + (size_t)qb_ * 256 * INW + ZQ + h_ * 256 + mp_ * 128; (ref).K = zb_ + ZK + h_ * 256 + mp_ * 128; (ref).V = zb_ + ZV + h_ * 256 + vj_ * 128; \
                    (ref).O = ao + ((size_t)b_ * SEQ + (size_t)qb_ * 256) * DM + h_ * 512 + mp_ * 256 + vj_ * 128; (ref).P0 = qb_ * 256; } while (0)
                att::BlockRef cur, nxt; int pass = 0;
                ATT_REF(cur, L, 0);
                att::Seam S;
                att::causal_prime(cur, alds, S);
                for (;;) {
                    const bool more_pass = pass == 0, more_item = L + G < NITEM, last = !more_pass && !more_item;
                    int passn = pass + 1, Ln = L;
                    if (!more_pass) { passn = 0; Ln = more_item ? L + G : L; }
                    if (last) nxt = cur; else ATT_REF(nxt, Ln, passn);
                    att::causal_block(cur, nxt, SEQ, alds, S);
                    if (last) break;
                    cur = nxt; pass = passn; L = Ln;
                }
#undef ATT_REF
            }
        }
        GRID_BAR();
        if (PH_MASK & (1 << 4)) {
            PHASE_IDS();
            const float lam_init = (l == 0) ? 0.2f : 0.35550906759096926f;
            const float* lv = INF(6) + (size_t)l * 512;
            const float d01 = wave_sum(lv[lane] * lv[128 + lane] + lv[64 + lane] * lv[192 + lane]);
            const float d23 = wave_sum(lv[256 + lane] * lv[384 + lane] + lv[320 + lane] * lv[448 + lane]);
            const float lam = expf(d01) - expf(d23) + lam_init;
            const float oscale = 1.0f - lam_init;
            const int h = lane >> 4, e0 = (lane & 15) * 16;
            const float* sg = INF(7) + l * 256 + e0;
            const float* ao = WSP(float, WS_AO); bf16_t* mix = WSP(bf16_t, WS_MIX);
            for (int t = gw; t < NTOK; t += NGW) {
                const float* o0 = ao + (size_t)t * DM + h * 512 + e0; const float* o1 = o0 + 256;
                float dv[16]; float ss = 0.f;
#pragma unroll
                for (int j = 0; j < 4; ++j) { const f32x4 a = *(const f32x4*)(o0 + 4 * j), b = *(const f32x4*)(o1 + 4 * j);
#pragma unroll
                    for (int q = 0; q < 4; ++q) { const float d = a[q] - lam * b[q]; dv[4 * j + q] = d; ss += d * d; } }
                ss += __shfl_xor(ss, 1); ss += __shfl_xor(ss, 2); ss += __shfl_xor(ss, 4); ss += __shfl_xor(ss, 8);
                const float rstd = 1.0f / sqrtf(ss * (1.0f / 256.0f) + EPS);
                u32x4 w0, w1;
#pragma unroll
                for (int j = 0; j < 4; ++j) { w0[j] = cvt_pk_bf16(dv[2 * j] * rstd * sg[2 * j] * oscale, dv[2 * j + 1] * rstd * sg[2 * j + 1] * oscale);
                                              w1[j] = cvt_pk_bf16(dv[8 + 2 * j] * rstd * sg[8 + 2 * j] * oscale, dv[8 + 2 * j + 1] * rstd * sg[8 + 2 * j + 1] * oscale); }
                bf16_t* mp = mix + (size_t)t * DM + h * 256 + e0;
                *(u32x4*)mp = w0; *(u32x4*)(mp + 8) = w1;
            }
        }
        GRID_BAR();
        if (PH_MASK & (1 << 5)) {
            pg8::Gemm g{WSP(bf16_t, WS_MIX), WSP(bf16_t, WS_WOUT) + (size_t)l * DM * DM, DM, 0};
            pg8::StaticOrder S; S.init(NTOK / 256, DM / 256, G, bx);
            float* out = OUTP;
            pg8::EpiResF32 E{l == 0 ? INF(0) : (const float*)out, out, DM};
            pg8::gemm_phase<pg8::EpiResF32, pg8::StaticOrder>(lds, g, S, E);
        }
        GRID_BAR();
        if (l == 0 && (PH_MASK & (1 << 6))) {
            {
                PHASE_IDS();
                const float* out = OUTP; const float* gn = INF(12); bf16_t* xn = WSP(bf16_t, WS_XN);
                for (int m = gw; m < NTOK; m += NGW) (void)rms_row(out + (size_t)m * DM, gn, xn + (size_t)m * DM, lane);
            }
            GRID_BAR();
            {
                pg8::Gemm g{WSP(bf16_t, WS_XN), WSP(bf16_t, WS_WDGU), DM, 0};
                pg8::StaticOrder S; S.init(NTOK / 256, 2 * FFD / 256, G, bx);
                pg8::EpiSwiglu E{WSP(bf16_t, WS_ACTD), FFD};
                pg8::gemm_phase<pg8::EpiSwiglu, pg8::StaticOrder>(lds, g, S, E);
            }
            GRID_BAR();
            {
                pg8::Gemm g{WSP(bf16_t, WS_ACTD), WSP(bf16_t, WS_WDD), FFD, 0};
                pg8::StaticOrder S; S.init(NTOK / 256, DM / 256, G, bx);
                float* out = OUTP;
                pg8::EpiResF32 E{out, out, DM};
                pg8::gemm_phase<pg8::EpiResF32, pg8::StaticOrder>(lds, g, S, E);
            }
            GRID_BAR();
            {
                PHASE_IDS();
                const float* out = OUTP; const float* gn = INF(2) + DM; bf16_t* xn = WSP(bf16_t, WS_XN);
                for (int m = gw; m < NTOK; m += NGW) (void)rms_row(out + (size_t)m * DM, gn, xn + (size_t)m * DM, lane);
            }
            GRID_BAR();
        } else if (PH_MASK & (1 << 7)) {
            const int TPW = (NTOK + G - 1) / G;
            {
                PHASE_IDS();
                if (tid < 8) LW[LW_CNT + tid] = 0u;
                __syncthreads();
                const float* out = OUTP; const float* gn = INF(12) + DM; bf16_t* xn = WSP(bf16_t, WS_XN); const float* router_w = INF(16);
                int* tokE = WSP(int, WS_TOKE); int* tokR = WSP(int, WS_TOKR); float* tokG = WSP(float, WS_TOKG);
                const int tlo = bx * TPW, thi = (tlo + TPW) < NTOK ? (tlo + TPW) : NTOK;
                for (int t = tlo + wave; t < thi; t += 8) {
                    const float rstd = rms_row(out + (size_t)t * DM, gn, xn + (size_t)t * DM, lane);
                    float lg[8];
#pragma unroll
                    for (int e = 0; e < 8; ++e) lg[e] = 0.f;
#pragma unroll 1
                    for (int j = 0; j < 8; ++j) {
                        const f32x4 xv = *((const f32x4*)(out + (size_t)t * DM) + 64 * j + lane), gv = *((const f32x4*)gn + 64 * j + lane);
#pragma unroll
                        for (int q = 0; q < 4; ++q) { const int k = 256 * j + 4 * lane + q; const f32x4 ra = *(const f32x4*)(router_w + (size_t)k * 8), rb = *(const f32x4*)(router_w + (size_t)k * 8 + 4); const float hv = xv[q] * rstd * gv[q];
                            lg[0] += hv * ra[0]; lg[1] += hv * ra[1]; lg[2] += hv * ra[2]; lg[3] += hv * ra[3]; lg[4] += hv * rb[0]; lg[5] += hv * rb[1]; lg[6] += hv * rb[2]; lg[7] += hv * rb[3]; }
                    }
#pragma unroll
                    for (int e = 0; e < 8; ++e) lg[e] = wave_sum(lg[e]);
                    if (lane == 0) {
                        int e0 = 0; float v0 = lg[0];
#pragma unroll
                        for (int e = 1; e < 8; ++e) if (lg[e] > v0) { v0 = lg[e]; e0 = e; }
                        int e1 = -1; float v1 = -3.0e38f;
#pragma unroll
                        for (int e = 0; e < 8; ++e) if (e != e0 && lg[e] > v1) { v1 = lg[e]; e1 = e; }
                        const float ex = expf(v1 - v0), g0 = 1.0f / (1.0f + ex), g1 = ex / (1.0f + ex);
                        const int r0 = (int)atomicAdd((unsigned*)(lds_raw + LDSCTL_OFF) + LW_CNT + e0, 1u);
                        const int r1 = (int)atomicAdd((unsigned*)(lds_raw + LDSCTL_OFF) + LW_CNT + e1, 1u);
                        tokE[2 * t] = e0; tokE[2 * t + 1] = e1; tokR[2 * t] = r0; tokR[2 * t + 1] = r1; tokG[2 * t] = g0; tokG[2 * t + 1] = g1;
                    }
                }
                __syncthreads();
                if (tid < 8) WSP(int, WS_CNTWG)[bx * 8 + tid] = (int)LW[LW_CNT + tid];
            }
            GRID_BAR();
            {
                PHASE_IDS();
                if (tid < 8) { LW[LW_TOT + tid] = 0u; LW[LW_PRE + tid] = 0u; }
                __syncthreads();
                {
                const int* cntWG = WSP(int, WS_CNTWG);
                for (int j = tid; j < G; j += 512) {
                    const i32x4 ca = *(const i32x4*)(cntWG + j * 8), cb = *(const i32x4*)(cntWG + j * 8 + 4);
                    unsigned* lw = (unsigned*)(lds_raw + LDSCTL_OFF);
#pragma unroll
                    for (int e = 0; e < 4; ++e) { atomicAdd(lw + LW_TOT + e, (unsigned)ca[e]); atomicAdd(lw + LW_TOT + 4 + e, (unsigned)cb[e]);
                        if (j < bx) { atomicAdd(lw + LW_PRE + e, (unsigned)ca[e]); atomicAdd(lw + LW_PRE + 4 + e, (unsigned)cb[e]); } }
                }
                }
                __syncthreads();
                if (tid == 0) { unsigned base = 0;
                    for (int e = 0; e < 8; ++e) { const unsigned tot = LW[LW_TOT + e]; LW[LW_BP + e] = base + LW[LW_PRE + e]; LW[LW_TOFF + e] = base >> 8; base += (tot + 255u) & ~255u; }
                    LW[LW_TOFF + 8] = base >> 8; }
                __syncthreads();
                const int* tokE = WSP(int, WS_TOKE); const int* tokR = WSP(int, WS_TOKR); int* tokS = WSP(int, WS_TOKS);
                const bf16_t* xn = WSP(bf16_t, WS_XN); bf16_t* hp = WSP(bf16_t, WS_HP);
                const int tlo = bx * TPW, thi = (tlo + TPW) < NTOK ? (tlo + TPW) : NTOK;
                for (int t = tlo + wave; t < thi; t += 8) {
                    const int e0 = tokE[2 * t], e1 = tokE[2 * t + 1];
                    const int s0 = (int)LW[LW_BP + e0] + tokR[2 * t], s1 = (int)LW[LW_BP + e1] + tokR[2 * t + 1];
                    if (lane == 0) { tokS[2 * t] = s0; tokS[2 * t + 1] = s1; }
                    const u32x4* src = (const u32x4*)(xn + (size_t)t * DM) + lane; u32x4* d0 = (u32x4*)(hp + (size_t)s0 * DM) + lane; u32x4* d1 = (u32x4*)(hp + (size_t)s1 * DM) + lane;
#pragma unroll
                    for (int j = 0; j < 4; ++j) { const u32x4 v = src[64 * j]; d0[64 * j] = v; d1[64 * j] = v; }
                }
                for (int e = 0; e < 8; ++e) {
                    const int rlo = (int)LW[LW_TOFF + e] * 256 + (int)LW[LW_TOT + e], rhi = (int)LW[LW_TOFF + e + 1] * 256;
                    for (int r = rlo + gw; r < rhi; r += NGW) { u32x4* d0 = (u32x4*)(hp + (size_t)r * DM) + lane;
#pragma unroll
                        for (int j = 0; j < 4; ++j) d0[64 * j] = (u32x4){0u, 0u, 0u, 0u}; }
                }
            }
            GRID_BAR();
#define RFL(i) __builtin_amdgcn_readfirstlane((int)LW[LW_TOFF + (i)])
            {
                pg8::Gemm g{WSP(bf16_t, WS_HP), WSP(bf16_t, WS_WMGU), DM, (size_t)2 * FFE * DM * 2};
                pg8::MoeOrder S; S.S.init(RFL(8), 2 * FFE / 256, G, bx);
                S.t1 = RFL(1); S.t2 = RFL(2); S.t3 = RFL(3); S.t4 = RFL(4); S.t5 = RFL(5); S.t6 = RFL(6); S.t7 = RFL(7);
                pg8::EpiSwiglu E{WSP(bf16_t, WS_ACTM), FFE};
                pg8::gemm_phase<pg8::EpiSwiglu, pg8::MoeOrder>(lds, g, S, E);
            }
            GRID_BAR();
            {
                pg8::Gemm g{WSP(bf16_t, WS_ACTM), WSP(bf16_t, WS_WMD), FFE, (size_t)DM * FFE * 2};
                pg8::MoeOrder S; S.S.init(RFL(8), DM / 256, G, bx);
                S.t1 = RFL(1); S.t2 = RFL(2); S.t3 = RFL(3); S.t4 = RFL(4); S.t5 = RFL(5); S.t6 = RFL(6); S.t7 = RFL(7);
                pg8::EpiF32 E{WSP(float, WS_Y), DM};
                pg8::gemm_phase<pg8::EpiF32, pg8::MoeOrder>(lds, g, S, E);
            }
#undef RFL
            GRID_BAR();
            {
                PHASE_IDS();
                const int* tokS = WSP(int, WS_TOKS); const float* tokG = WSP(float, WS_TOKG); float* out = OUTP; const float* yb = WSP(float, WS_Y);
                for (int t = gw; t < NTOK; t += NGW) {
                    const int s0 = tokS[2 * t], s1 = tokS[2 * t + 1]; const float g0 = tokG[2 * t], g1 = tokG[2 * t + 1];
                    f32x4* o = (f32x4*)(out + (size_t)t * DM) + lane; const f32x4* y0 = (const f32x4*)(yb + (size_t)s0 * DM) + lane; const f32x4* y1 = (const f32x4*)(yb + (size_t)s1 * DM) + lane;
#pragma unroll
                    for (int j = 0; j < 8; ++j) o[64 * j] = o[64 * j] + (y0[64 * j] * g0 + y1[64 * j] * g1);
                }
            }
        }
    }
}

extern "C" void kernel_launch(void* const* d_in, const int* in_sizes, int n_in, void* d_out, int out_size, void* d_ws, size_t ws_size, hipStream_t stream) {
    static int grid = 0;
    if (grid == 0) {
        if (n_in != 20 || in_sizes[0] != NTOK * DM || out_size != NTOK * DM || ws_size < WS_END) {
            fprintf(stderr, "kernel_launch: unexpected shapes (n_in %d, in0 %d, out %d, ws %zu < %zu); nothing launched\n", n_in, n_in > 0 ? in_sizes[0] : -1, out_size, ws_size, (size_t)WS_END); grid = -1; return; }
        int dev = 0, cus = 0, per_cu = 0;
        if (hipGetDevice(&dev) != hipSuccess || hipDeviceGetAttribute(&cus, hipDeviceAttributeMultiprocessorCount, dev) != hipSuccess) { grid = -1; return; }
        if (hipFuncSetAttribute((const void*)hybrid_fwd, hipFuncAttributeMaxDynamicSharedMemorySize, LDS_BYTES) != hipSuccess) { fprintf(stderr, "kernel_launch: hipFuncSetAttribute failed\n"); grid = -1; return; }
        if (hipOccupancyMaxActiveBlocksPerMultiprocessor(&per_cu, (const void*)hybrid_fwd, 512, LDS_BYTES) != hipSuccess || per_cu < 1)
            fprintf(stderr, "kernel_launch: note: occupancy query reports %d workgroups per CU\n", per_cu);
        (void)hipGetLastError();
        grid = cus > 512 ? 512 : cus;
    }
    if (grid < 0) return;
    if (hipMemsetAsync((char*)d_ws + WS_CTL, 0, CTL_ZERO_BYTES, stream) != hipSuccess) { fprintf(stderr, "kernel_launch: memset failed\n"); return; }
    Args a{};
    for (int i = 0; i < 20; ++i) a.in[i] = d_in[i];
    a.out = (float*)d_out; a.ws = (unsigned char*)d_ws;
    hipLaunchKernelGGL(hybrid_fwd, dim3(grid), dim3(512), LDS_BYTES, stream, a);
    const hipError_t le = hipPeekAtLastError();
    if (le != hipSuccess) fprintf(stderr, "kernel_launch: launch failed: %s\n", hipGetErrorName(le));
}
```

```cpp
#include <hip/hip_runtime.h>
#include <hip/hip_bf16.h>
#include <cstdio>
#include <cstdint>

#define LAS __attribute__((address_space(3)))
#define GAS __attribute__((address_space(1)))
typedef unsigned short bf16_t;
typedef short bf16x8 __attribute__((ext_vector_type(8)));
typedef short s16x4 __attribute__((ext_vector_type(4)));
typedef float f32x4 __attribute__((ext_vector_type(4)));
typedef float f32x2 __attribute__((ext_vector_type(2)));
typedef float f32x16 __attribute__((ext_vector_type(16)));
typedef unsigned u32x4 __attribute__((ext_vector_type(4)));
typedef unsigned u32x2 __attribute__((ext_vector_type(2)));
typedef int i32x4 __attribute__((ext_vector_type(4)));

constexpr int DM = 2048, NB = 8, SEQ = 2048, NTOK = NB * SEQ, DEPTH = 2;
constexpr int INW = 5120, FFD = 5632, NEXP = 8, FFE = 7168;
constexpr int ZQ = 0, ZK = 1024, ZV = 2048, ZP = 3072, ZGB = 3584, ZGC = 4096, ZH = 4608;
constexpr int MOE_ROWS = NTOK * 2 + NEXP * 256;
constexpr float EPS = 1e-6f;

constexpr size_t MiB = 1u << 20;
constexpr size_t WS_CTL = 0, CTL_ZERO_BYTES = 1 * MiB;
constexpr size_t WS_COS = 1 * MiB, WS_SIN = 5 * MiB;
constexpr size_t WS_WPT = 9 * MiB;
constexpr size_t WS_TOKE = 10 * MiB;
constexpr size_t WS_TOKR = WS_TOKE + 128 * 1024;
constexpr size_t WS_TOKG = WS_TOKR + 128 * 1024;
constexpr size_t WS_TOKS = WS_TOKG + 128 * 1024;
constexpr size_t WS_CNTWG = WS_TOKS + 128 * 1024;
constexpr size_t WS_WIN = 16 * MiB;
constexpr size_t WS_WOUT = WS_WIN + 40 * MiB;
constexpr size_t WS_WDGU = WS_WOUT + 16 * MiB;
constexpr size_t WS_WDD = WS_WDGU + 44 * MiB;
constexpr size_t WS_WMGU = WS_WDD + 22 * MiB;
constexpr size_t WS_WMD = WS_WMGU + 448 * MiB;
constexpr size_t WS_ACT0 = WS_WMD + 224 * MiB;
constexpr size_t WS_Z = WS_ACT0;
constexpr size_t WS_AO = WS_ACT0 + 160 * MiB;
constexpr size_t WS_MIX = WS_ACT0 + 288 * MiB;
constexpr size_t WS_XN = WS_ACT0 + 352 * MiB;
constexpr size_t WS_ACTM = WS_ACT0;
constexpr size_t WS_HP = WS_ACT0 + 476 * MiB;
constexpr size_t WS_Y = WS_ACT0 + 612 * MiB;
constexpr size_t WS_ACTD = WS_ACT0 + 476 * MiB;
constexpr size_t WS_END = WS_ACT0 + 884 * MiB;
static_assert(WS_ACT0 == 810 * MiB, "map");
static_assert((size_t)MOE_ROWS * FFE * 2 <= 476 * MiB && (size_t)MOE_ROWS * DM * 2 <= 136 * MiB && (size_t)MOE_ROWS * DM * 4 <= 272 * MiB, "map");

#ifndef PH_MASK
#define PH_MASK 0xffff
#endif
#define REP_P0 1
#define REP_P1 1
#define REP_P3 1
#define REP_P7 1
constexpr int CW_TMO = 0, CW_CODE = 1, CW_BAR = 4096;

constexpr int RING_BYTES = 131072;
constexpr int LDSCTL_OFF = RING_BYTES;
constexpr int LDS_BYTES = 147456;
constexpr int LW_CNT = 16, LW_TOT = 24, LW_PRE = 32, LW_BP = 40, LW_TOFF = 48;

#define LDS_WAIT() asm volatile("s_waitcnt lgkmcnt(0)" ::: "memory")
#define VM_WAIT() asm volatile("s_waitcnt vmcnt(0)" ::: "memory")

__device__ __forceinline__ unsigned cvt_pk_bf16(float lo, float hi) { unsigned r; asm volatile("v_cvt_pk_bf16_f32 %0, %1, %2" : "=v"(r) : "v"(lo), "v"(hi)); return r; }
__device__ __forceinline__ float bflo(unsigned w) { return __uint_as_float(w << 16); }
__device__ __forceinline__ float bfhi(unsigned w) { return __uint_as_float(w & 0xffff0000u); }
__device__ __forceinline__ float wave_sum(float v) {
#pragma unroll
    for (int o = 1; o < 64; o <<= 1) v += __shfl_xor(v, o);
    return v;
}

__device__ __forceinline__ int ltid() { int t = threadIdx.x; asm volatile("" : "+v"(t)); return t; }

namespace pg8 {
constexpr int BM = 256, BK = 64, HALF = 128, HTB = HALF * BK * 2, STAGE_BYTES = 8 * HTB, NXCD = 8, WGM = 8;
__host__ __device__ __forceinline__ int lds_byte(int r, int c) { const int st = (r >> 4) * 2 + (c >> 5), rr = r & 15, cc = c & 31, ob = rr * 64 + cc * 2; return st * 1024 + (ob ^ (((ob >> 9) & 1) << 5)); }
__host__ __device__ __forceinline__ void stage_rc(int b, int& R, int& C) { const int st = b / 1024, sb = b % 1024, swz = sb ^ (((sb >> 9) & 1) << 5); R = (st >> 1) * 16 + swz / 64; C = (st & 1) * 32 + (swz % 64) / 2; }
__host__ __device__ __forceinline__ int perm32(int rho) { const int n = rho >> 4, i = rho & 15; return 8 * (i >> 2) + 4 * n + (i & 3); }

struct Unit { int pm, pn, e; };
struct Gemm { const bf16_t* A; const bf16_t* Bt; int K; size_t estride; };

struct StaticOrder {
    int nM, nN, nwg, G, c;
    __device__ __forceinline__ void init(int nM_, int nN_, int G_, int c_) { nM = nM_; nN = nN_; nwg = nM * nN; G = G_; c = c_; }
    __device__ __forceinline__ bool next(int i, Unit& u) const {
        const long L = (long)i * G + c; if (L >= nwg) return false;
        int wgid = (int)L; { const int q = nwg / NXCD, r = nwg % NXCD, xcd = wgid % NXCD, off = wgid / NXCD; wgid = (xcd < r ? xcd * (q + 1) : r * (q + 1) + (xcd - r) * q) + off; }
        const int nig = WGM * nN, gid = wgid / nig, fm = gid * WGM, gsz = (nM - fm) < WGM ? (nM - fm) : WGM;
        u.pm = fm + ((wgid % nig) % gsz); u.pn = (wgid % nig) / gsz; u.e = 0; return true;
    }
};
struct MoeOrder {
    StaticOrder S; int t1, t2, t3, t4, t5, t6, t7;
    __device__ __forceinline__ bool next(int i, Unit& u) const {
        if (!S.next(i, u)) return false;
        const int p = u.pm; u.e = __builtin_amdgcn_readfirstlane((p >= t1) + (p >= t2) + (p >= t3) + (p >= t4) + (p >= t5) + (p >= t6) + (p >= t7)); return true;
    }
};

struct EpiBf16 {
    static constexpr bool PERM = true;
    bf16_t* O; int ldc;
    __device__ __forceinline__ void operator()(const f32x4 (&acc)[2][2][4][2], const Unit& u, int wr, int wc, int fr, int fq) const {
        const int row0 = u.pm * BM + wr * 64 + fr, col0 = u.pn * BM + wc * 32 + 8 * fq;
#pragma unroll
        for (int ai = 0; ai < 2; ++ai)
#pragma unroll
            for (int m = 0; m < 4; ++m) { bf16_t* rowp = O + (size_t)(row0 + ai * HALF + m * 16) * ldc + col0;
#pragma unroll
                for (int bj = 0; bj < 2; ++bj) { const f32x4 v0 = acc[ai][bj][m][0], v1 = acc[ai][bj][m][1];
                    u32x4 w; w.x = cvt_pk_bf16(v0[0], v0[1]); w.y = cvt_pk_bf16(v0[2], v0[3]); w.z = cvt_pk_bf16(v1[0], v1[1]); w.w = cvt_pk_bf16(v1[2], v1[3]);
                    *(u32x4*)(rowp + bj * HALF) = w; } }
    }
};
__device__ __forceinline__ float silu_mul(float g, float u) { return g * __builtin_amdgcn_rcpf(1.0f + __builtin_amdgcn_exp2f(-1.4426950408889634f * g)) * u; }
struct EpiSwiglu {
    static constexpr bool PERM = true;
    bf16_t* O; int ldc;
    __device__ __forceinline__ void operator()(const f32x4 (&acc)[2][2][4][2], const Unit& u, int wr, int wc, int fr, int fq) const {
        const int row0 = u.pm * BM + wr * 64 + fr, col0 = u.pn * HALF + wc * 32 + 8 * fq;
#pragma unroll
        for (int ai = 0; ai < 2; ++ai)
#pragma unroll
            for (int m = 0; m < 4; ++m) { bf16_t* rowp = O + (size_t)(row0 + ai * HALF + m * 16) * ldc + col0;
                const f32x4 g0 = acc[ai][0][m][0], g1 = acc[ai][0][m][1], u0 = acc[ai][1][m][0], u1 = acc[ai][1][m][1];
                u32x4 w;
                w.x = cvt_pk_bf16(silu_mul(g0[0], u0[0]), silu_mul(g0[1], u0[1])); w.y = cvt_pk_bf16(silu_mul(g0[2], u0[2]), silu_mul(g0[3], u0[3]));
                w.z = cvt_pk_bf16(silu_mul(g1[0], u1[0]), silu_mul(g1[1], u1[1])); w.w = cvt_pk_bf16(silu_mul(g1[2], u1[2]), silu_mul(g1[3], u1[3]));
                *(u32x4*)rowp = w; }
    }
};
struct EpiResF32 {
    static constexpr bool PERM = false;
    const float* R; float* O; int ldc;
    __device__ __forceinline__ void operator()(const f32x4 (&acc)[2][2][4][2], const Unit& u, int wr, int wc, int fr, int fq) const {
        const int col0 = u.pn * BM + wc * 32 + 4 * fq;
#pragma unroll
        for (int ai = 0; ai < 2; ++ai)
#pragma unroll
            for (int m = 0; m < 4; ++m) { const size_t off = (size_t)(u.pm * BM + ai * HALF + wr * 64 + m * 16 + fr) * ldc + col0;
#pragma unroll
                for (int bj = 0; bj < 2; ++bj)
#pragma unroll
                    for (int n = 0; n < 2; ++n) { const f32x4 bs = *(const f32x4*)(R + off + bj * HALF + n * 16); *(f32x4*)(O + off + bj * HALF + n * 16) = bs + acc[ai][bj][m][n]; }
                asm volatile("" ::: "memory"); }
    }
};
struct EpiF32 {
    static constexpr bool PERM = false;
    float* O; int ldc;
    __device__ __forceinline__ void operator()(const f32x4 (&acc)[2][2][4][2], const Unit& u, int wr, int wc, int fr, int fq) const {
        const int col0 = u.pn * BM + wc * 32 + 4 * fq;
#pragma unroll
        for (int ai = 0; ai < 2; ++ai)
#pragma unroll
            for (int m = 0; m < 4; ++m) { const size_t off = (size_t)(u.pm * BM + ai * HALF + wr * 64 + m * 16 + fr) * ldc + col0;
#pragma unroll
                for (int bj = 0; bj < 2; ++bj)
#pragma unroll
                    for (int n = 0; n < 2; ++n) *(f32x4*)(O + off + bj * HALF + n * 16) = acc[ai][bj][m][n]; }
    }
};

__device__ __forceinline__ void glds16s(unsigned voff, const char* sbase, unsigned lds_dst) { unsigned keep;
    asm volatile("s_mov_b32 %0, m0\n\ts_mov_b32 m0, %3\n\ts_nop 0\n\tglobal_load_lds_dwordx4 %1, %2\n\ts_mov_b32 m0, %0" : "=&s"(keep) : "v"(voff), "s"(sbase), "s"(lds_dst) : "memory"); }
template <class Epi, class Sched>
__device__ __forceinline__ void gemm_phase(LAS unsigned char* lds, const Gemm g, const Sched& S, const Epi& E) {
    const int tid = ltid(), wid = __builtin_amdgcn_readfirstlane(tid >> 6), lane = tid & 63, wr = wid >> 2, wc = wid & 3, fr = lane & 15, fq = lane >> 4;
    const int K = g.K, nt = K / BK;
    unsigned voffA[2], voffB[2];
#pragma unroll
    for (int i = 0; i < 2; ++i) { int R, C; stage_rc(tid * 16 + i * 8192, R, C); const int Rb = Epi::PERM ? ((R & ~31) + perm32(R & 31)) : R;
        voffA[i] = (unsigned)(R * K + C) * 2u; voffB[i] = (unsigned)(Rb * K + C) * 2u; }
    const size_t kstep = (size_t)(BK * 2);
    const size_t hstep = (size_t)HALF * K * 2;
    const size_t tstep = 2 * hstep;
    const unsigned ldsb = (unsigned)(uintptr_t)lds + (unsigned)wid * 1024u;
    const int aoff = lds_byte(wr * 64 + fr, fq * 8), boff = lds_byte(wc * 32 + fr, fq * 8);
#define PG8_SA(b, h) (((b) * 2 + (h)) * HTB)
#define PG8_SB(b, h) ((4 + (b) * 2 + (h)) * HTB)
#define PG8_STAGE(bufoff, gbase, voff) do { _Pragma("unroll") for (int _i = 0; _i < 2; ++_i) \
        glds16s((voff)[_i], (const char*)(gbase), ldsb + (unsigned)((bufoff) + _i * 8192)); } while (0)
#define PG8_LDA(dst, b, h) do { _Pragma("unroll") for (int m = 0; m < 4; ++m) _Pragma("unroll") for (int k = 0; k < 2; ++k) dst[m][k] = *(const LAS bf16x8*)(lds + PG8_SA(b, h) + aoff + m * 2048 + k * 1024); } while (0)
#define PG8_LDB(dst, b, h) do { _Pragma("unroll") for (int n = 0; n < 2; ++n) _Pragma("unroll") for (int k = 0; k < 2; ++k) dst[n][k] = *(const LAS bf16x8*)(lds + PG8_SB(b, h) + boff + n * 2048 + k * 1024); } while (0)
#define PG8_MMA(ai, bj, At, Bt) do { __builtin_amdgcn_s_setprio(1); _Pragma("unroll") for (int m = 0; m < 4; ++m) _Pragma("unroll") for (int n = 0; n < 2; ++n) _Pragma("unroll") for (int k = 0; k < 2; ++k) \
        acc[ai][bj][m][n] = __builtin_amdgcn_mfma_f32_16x16x32_bf16(Bt[n][k], At[m][k], acc[ai][bj][m][n], 0, 0, 0); __builtin_amdgcn_s_setprio(0); } while (0)
#define PG8_WAIT_V(n) asm volatile("s_waitcnt vmcnt(" #n ")" ::: "memory")
#define PG8_WAIT_L(n) asm volatile("s_waitcnt lgkmcnt(" #n ")" ::: "memory")
#define PG8_BAR __builtin_amdgcn_s_barrier()
#define PG8_SCHED __builtin_amdgcn_sched_barrier(0)
    Unit cur, nxt; int ui = 0;
    if (!S.next(0, cur)) return;
    f32x4 acc[2][2][4][2];
#pragma unroll
    for (int a = 0; a < 2; ++a)
#pragma unroll
        for (int b = 0; b < 2; ++b)
#pragma unroll
            for (int m = 0; m < 4; ++m)
#pragma unroll
                for (int n = 0; n < 2; ++n) acc[a][b][m][n] = (f32x4){0.f, 0.f, 0.f, 0.f};
    bf16x8 At[4][2], B0[2][2], B1[2][2];
    const char* cA = (const char*)g.A + (size_t)cur.pm * tstep; const char* cB = (const char*)g.Bt + (size_t)cur.e * g.estride + (size_t)cur.pn * tstep;
    PG8_STAGE(PG8_SB(0, 0), cB, voffB); PG8_STAGE(PG8_SB(0, 1), cB + hstep, voffB); PG8_STAGE(PG8_SA(0, 0), cA, voffA); PG8_STAGE(PG8_SA(0, 1), cA + hstep, voffA);
    if (wr == 1) PG8_BAR;
    PG8_WAIT_V(2); PG8_BAR;
    PG8_STAGE(PG8_SB(1, 0), cB + kstep, voffB); PG8_STAGE(PG8_SA(1, 0), cA + kstep, voffA); PG8_STAGE(PG8_SB(1, 1), cB + hstep + kstep, voffB);
    PG8_WAIT_V(6); PG8_BAR;
    for (;;) {
        const bool has_next = S.next(ui + 1, nxt);
        const char* nA = has_next ? (const char*)g.A + (size_t)nxt.pm * tstep : cA; const char* nB = has_next ? (const char*)g.Bt + (size_t)nxt.e * g.estride + (size_t)nxt.pn * tstep : cB;
        for (int t = 0; t < nt; t += 2) {
            const bool last = (t == nt - 2);
            const char* a1 = cA + (size_t)(t + 1) * kstep;
            const char* a2 = last ? nA : cA + (size_t)(t + 2) * kstep; const char* b2 = last ? nB : cB + (size_t)(t + 2) * kstep;
            const char* a3 = a2 + kstep; const char* b3 = b2 + kstep;
            PG8_LDB(B0, 0, 0); PG8_LDB(B1, 0, 1); PG8_SCHED; PG8_LDA(At, 0, 0); PG8_STAGE(PG8_SA(1, 1), a1 + hstep, voffA);
            PG8_WAIT_V(8); PG8_WAIT_L(0); PG8_BAR; PG8_MMA(0, 0, At, B0); PG8_MMA(0, 1, At, B1); PG8_BAR; PG8_SCHED;
            PG8_LDA(At, 0, 1); PG8_STAGE(PG8_SB(0, 0), b2, voffB); PG8_STAGE(PG8_SB(0, 1), b2 + hstep, voffB); PG8_STAGE(PG8_SA(0, 0), a2, voffA);
            PG8_WAIT_V(8); PG8_WAIT_L(0); PG8_BAR; PG8_MMA(1, 0, At, B0); PG8_MMA(1, 1, At, B1); PG8_BAR; PG8_SCHED;
            PG8_LDB(B0, 1, 0); PG8_LDB(B1, 1, 1); PG8_SCHED; PG8_LDA(At, 1, 0); PG8_STAGE(PG8_SA(0, 1), a2 + hstep, voffA);
            PG8_WAIT_V(8); PG8_WAIT_L(0); PG8_BAR; PG8_MMA(0, 0, At, B0); PG8_MMA(0, 1, At, B1); PG8_BAR; PG8_SCHED;
            PG8_LDA(At, 1, 1); PG8_STAGE(PG8_SB(1, 0), b3, voffB); PG8_STAGE(PG8_SB(1, 1), b3 + hstep, voffB); PG8_STAGE(PG8_SA(1, 0), a3, voffA);
            PG8_WAIT_V(8); PG8_WAIT_L(0); PG8_BAR; PG8_MMA(1, 0, At, B0); PG8_MMA(1, 1, At, B1); PG8_BAR; PG8_SCHED;
        }
        if (wr == 0) PG8_BAR;
        E(acc, cur, wr, wc, fr, fq);
        if (!has_next) break;
#pragma unroll
        for (int a = 0; a < 2; ++a)
#pragma unroll
            for (int b = 0; b < 2; ++b)
#pragma unroll
                for (int m = 0; m < 4; ++m)
#pragma unroll
                    for (int n = 0; n < 2; ++n) acc[a][b][m][n] = (f32x4){0.f, 0.f, 0.f, 0.f};
        cur = nxt; cA = nA; cB = nB; ++ui;
        if (wr == 1) PG8_BAR;
    }
    PG8_WAIT_V(0);
    PG8_BAR;
#undef PG8_SA
#undef PG8_SB
#undef PG8_STAGE
#undef PG8_LDA
#undef PG8_LDB
#undef PG8_MMA
#undef PG8_WAIT_V
#undef PG8_WAIT_L
#undef PG8_BAR
#undef PG8_SCHED
}
}

namespace att {
constexpr int D = 128, LDZ = INW, LDO = DM;
constexpr float SCALE = 0.08838834764831845f;
constexpr float THR = 8.f;
constexpr int NW = 8, QBLK = 32, KVBLK = 64, QB = NW * QBLK;
constexpr int SHM_V = KVBLK * D * 2, SHM_K = KVBLK * D * 2;
constexpr int ATT_LDS_BYTES = 2 * SHM_V + 2 * SHM_K + NW * 64 * 4;
#define KSWZ(row, colB) ((row) * 256 + ((colB) ^ (((row) & 7) << 4)))
#define SBAR() __builtin_amdgcn_sched_barrier(0)
__device__ __forceinline__ int v_st(int k, int c) { const int kk = (k & ~0xC) | ((k & 4) << 1) | ((k & 8) >> 1); return ((kk >> 3) * 4 + (c >> 5)) * 512 + ((kk & 7) * 32 + (c & 31)) * 2; }
__device__ __forceinline__ int v_rd_base(int lane) { return ((lane & 3) << 3) | (((lane >> 2) & 3) << 6) | (((lane >> 4) & 1) << 5) | (((lane >> 5) & 1) << 8); }
constexpr int v_rd_off(int d0, int ks, int half) { return d0 * 512 + ks * 4096 + half * 2048; }
__device__ __forceinline__ int crow(int r, int hi) { return (r & 3) + 8 * (r >> 2) + 4 * hi; }
__device__ __forceinline__ bf16x8 load8(const bf16_t* p) { return *reinterpret_cast<const bf16x8*>(p); }
__device__ __forceinline__ void mask_tile(f32x16& p0, f32x16& p1, int dq, unsigned W) {
    const float NEG = -__builtin_inff();
#pragma unroll
    for (int r = 0; r < 16; ++r) {
        const int c = (r & 3) + 8 * (r >> 2);
        if ((unsigned)(dq - c) >= W) p0[r] = NEG;
        if ((unsigned)(dq - c - 32) >= W) p1[r] = NEG;
    }
}
__device__ __forceinline__ void partialSM(f32x16& p0, f32x16& p1, float& m_reg, float& mn, float& alpha) {
    float pmax = p0[0];
#pragma unroll
    for (int r = 1; r < 16; ++r) pmax = fmaxf(pmax, p0[r]);
#pragma unroll
    for (int r = 0; r < 16; ++r) pmax = fmaxf(pmax, p1[r]);
    { auto rr = __builtin_amdgcn_permlane32_swap(__float_as_uint(pmax), __float_as_uint(pmax), false, false);
      pmax = fmaxf(__uint_as_float(rr[0]), __uint_as_float(rr[1])); }
    constexpr float C2 = 1.4426950408889634f * SCALE;
    if (__builtin_expect(__all((pmax - m_reg) * SCALE <= THR), 1)) { mn = m_reg; alpha = 1.f; }
    else { mn = fmaxf(m_reg, pmax); alpha = __builtin_amdgcn_exp2f((m_reg - mn) * C2); m_reg = mn; }
    const float mnL = -mn * C2;
#pragma unroll
    for (int r = 0; r < 16; ++r) p0[r] = fmaf(p0[r], C2, mnL);
#pragma unroll
    for (int r = 0; r < 16; ++r) p1[r] = fmaf(p1[r], C2, mnL);
#pragma unroll
    for (int r = 0; r < 16; ++r) p0[r] = __builtin_amdgcn_exp2f(p0[r]);
}
__device__ __forceinline__ void finishSM(f32x16& p0, f32x16& p1, float alpha, float& l_reg, bf16x8& pa0, bf16x8& pa1, bf16x8& pa2, bf16x8& pa3) {
#pragma unroll
    for (int r = 0; r < 16; ++r) p1[r] = __builtin_amdgcn_exp2f(p1[r]);
    float ps = 0;
#pragma unroll
    for (int r = 0; r < 16; ++r) ps += p0[r];
#pragma unroll
    for (int r = 0; r < 16; ++r) ps += p1[r];
    { auto rr = __builtin_amdgcn_permlane32_swap(__float_as_uint(ps), __float_as_uint(ps), false, false);
      ps = __uint_as_float(rr[0]) + __uint_as_float(rr[1]); }
    l_reg = l_reg * alpha + ps;
#define PK4(P, B_, OUT) do { unsigned a0 = cvt_pk_bf16(P[B_+0], P[B_+1]), a1 = cvt_pk_bf16(P[B_+2], P[B_+3]);                          \
        unsigned b0 = cvt_pk_bf16(P[B_+4], P[B_+5]), b1 = cvt_pk_bf16(P[B_+6], P[B_+7]);                                             \
        auto r0 = __builtin_amdgcn_permlane32_swap(a0, b0, false, false); auto r1 = __builtin_amdgcn_permlane32_swap(a1, b1, false, false); \
        u32x4 w = {r0[0], r1[0], r0[1], r1[1]}; OUT = *reinterpret_cast<bf16x8*>(&w); } while (0)
    PK4(p0, 0, pa0); PK4(p0, 8, pa1); PK4(p1, 0, pa2); PK4(p1, 8, pa3);
#undef PK4
}
template <int KB>
__device__ __forceinline__ void qkt(f32x16& p0, f32x16& p1, const char* K_lds, int r32, int hi, const bf16x8* qr) {
    p0 = f32x16{}; p1 = f32x16{};
    const char* kb[4];
#pragma unroll
    for (int dd = 0; dd < 4; ++dd) kb[dd] = K_lds + KB * SHM_K + KSWZ(r32, (dd * 16 + hi * 8) * 2);
#pragma unroll
    for (int d0 = 0; d0 < 8; ++d0) { const char* a = kb[d0 & 3] + (d0 >> 2) * 128;
        bf16x8 b0 = *reinterpret_cast<const bf16x8*>(a);
        bf16x8 b1 = *reinterpret_cast<const bf16x8*>(a + 32 * 256);
        p0 = __builtin_amdgcn_mfma_f32_32x32x16_bf16(b0, qr[d0], p0, 0, 0, 0);
        p1 = __builtin_amdgcn_mfma_f32_32x32x16_bf16(b1, qr[d0], p1, 0, 0, 0); }
}
template <int VB>
__device__ __forceinline__ void pv_tile(f32x16* o, int vb0, bf16x8 pa0, bf16x8 pa1, bf16x8 pa2, bf16x8 pa3) {
#define TRRD(dst, off) asm volatile("ds_read_b64_tr_b16 %0, %1 offset:%2" : "=&v"(dst) : "v"(vb0), "i"(off) : "memory")
#define PV_D0(d0) do { s16x4 l0, l1, l2, l3, h0, h1, h2, h3; constexpr int b_ = VB * SHM_V + v_rd_off(d0, 0, 0); \
        TRRD(l0, b_); TRRD(h0, b_ + 2048); TRRD(l1, b_ + 4096); TRRD(h1, b_ + 6144); TRRD(l2, b_ + 8192); TRRD(h2, b_ + 10240); TRRD(l3, b_ + 12288); TRRD(h3, b_ + 14336); \
        asm volatile("s_waitcnt lgkmcnt(0)" ::: "memory"); SBAR();   \
        o[d0] = __builtin_amdgcn_mfma_f32_32x32x16_bf16(pa0, (bf16x8){l0[0], l0[1], l0[2], l0[3], h0[0], h0[1], h0[2], h0[3]}, o[d0], 0, 0, 0);   \
        o[d0] = __builtin_amdgcn_mfma_f32_32x32x16_bf16(pa1, (bf16x8){l1[0], l1[1], l1[2], l1[3], h1[0], h1[1], h1[2], h1[3]}, o[d0], 0, 0, 0);   \
        o[d0] = __builtin_amdgcn_mfma_f32_32x32x16_bf16(pa2, (bf16x8){l2[0], l2[1], l2[2], l2[3], h2[0], h2[1], h2[2], h2[3]}, o[d0], 0, 0, 0);   \
        o[d0] = __builtin_amdgcn_mfma_f32_32x32x16_bf16(pa3, (bf16x8){l3[0], l3[1], l3[2], l3[3], h3[0], h3[1], h3[2], h3[3]}, o[d0], 0, 0, 0); } while (0)
    PV_D0(0); PV_D0(1); PV_D0(2); PV_D0(3);
#undef PV_D0
#undef TRRD
}
struct BlockRef { const bf16_t* Q; const bf16_t* K; const bf16_t* V; float* O; int P0; };
struct Seam { bf16x8 qr[8]; bf16x8 st_v0, st_v1, st_k0, st_k1; };
#define ROW(p, k0, rr) ((p) + (size_t)((k0) + (rr)) * LDZ + sc)
#define VMW() asm volatile("s_waitcnt vmcnt(0)" ::: "memory")
#define VMWN(n) asm volatile("s_waitcnt vmcnt(%0)" :: "i"(n) : "memory")
#define SLOAD_H(Kp, Vp, k0) do { S.st_v0 = load8(ROW(Vp, k0, sr)); S.st_v1 = load8(ROW(Vp, k0, 32 + sr));              \
                         S.st_k0 = load8(ROW(Kp, k0, sr)); S.st_k1 = load8(ROW(Kp, k0, 32 + sr)); } while (0)
#define SWRITE_HK(bf) do { *(bf16x8*)(K_lds + (bf) * SHM_K + kws) = S.st_k0; *(bf16x8*)(K_lds + (bf) * SHM_K + kws + 32 * 256) = S.st_k1; } while (0)
#define SWRITE_HV(bf) do { *(bf16x8*)(V_lds + (bf) * SHM_V + vst0) = S.st_v0; *(bf16x8*)(V_lds + (bf) * SHM_V + vst1) = S.st_v1; } while (0)
#define SWRITE_H(bf) do { SWRITE_HV(bf); SWRITE_HK(bf); } while (0)
__device__ __forceinline__ void causal_prime(const BlockRef& cur, char* lds, Seam& S) {
    const int tid = ltid(), wid = __builtin_amdgcn_readfirstlane(tid >> 6), lane = tid & 63, r32 = lane & 31, hi = lane >> 5;
    const int sr = tid >> 4, sc = (tid & 15) * 8, kws = KSWZ(sr, sc * 2); char* K_lds = lds + 2 * SHM_V;
    const int kb0 = 0;
#pragma unroll
    for (int d0 = 0; d0 < 8; ++d0) S.qr[d0] = load8(cur.Q + (size_t)(wid * QBLK + r32) * LDZ + d0 * 16 + hi * 8);
    SLOAD_H(cur.K, cur.V, kb0); VMW(); SWRITE_HK(0);
    __syncthreads();
}
__device__ __forceinline__ void causal_block(const BlockRef& cur, const BlockRef& nxt, int skv, char* lds, Seam& S) {
    const int tid = ltid(), wid = __builtin_amdgcn_readfirstlane(tid >> 6), lane = tid & 63, r32 = lane & 31, hi = lane >> 5;
    const int W = 1 << 30;
    const int j_lo = 0;
    int j_hi = (cur.P0 + QB - 1) / KVBLK + 1; if (j_hi > skv / KVBLK) j_hi = skv / KVBLK;
    const int NT = j_hi - j_lo;
    const int kbn = 0;
    const int qlo = cur.P0 + wid * QBLK, qm = qlo + r32 - 4 * hi;
    char* V_lds = lds; char* K_lds = lds + 2 * SHM_V;
    float* ws = (float*)(lds + 2 * SHM_V + 2 * SHM_K) + wid * 64; float* li_l = ws, * al_l = ws + 32;
    float m_reg = -1e30f, l_reg = 0; f32x16 o[4] = {};
    const int sr = tid >> 4, sc = (tid & 15) * 8, vst0 = v_st(sr, sc), vst1 = v_st(32 + sr, sc), kws = KSWZ(sr, sc * 2);
    const int vb0 = (int)(uintptr_t)V_lds + v_rd_base(lane);
    const bf16_t* Kh = cur.K; const bf16_t* Vh = cur.V;
#define RESC(a) do { if (__any((a) < 1.f)) { if (hi == 0) al_l[r32] = (a); asm volatile("s_waitcnt lgkmcnt(0)" ::: "memory");              \
                     _Pragma("unroll") for (int d_ = 0; d_ < 4; ++d_) _Pragma("unroll") for (int r = 0; r < 16; ++r) o[d_][r] *= al_l[crow(r, hi)]; } } while (0)
#define KBASE(t) ((j_lo + (t)) * KVBLK)
#define MASKT(P0_, P1_, t) do { const int kb_ = KBASE(t); if (kb_ + KVBLK - 1 > qlo) mask_tile(P0_, P1_, qm - kb_, (unsigned)W); } while (0)
    constexpr int NQL = 8;
#define SEAM_K0() do { VMWN(NQL); SWRITE_HK(0); SBAR(); } while (0)
    f32x16 pA0, pA1, pB0, pB1; float mnA, mnB, alA, alB; bf16x8 pa0, pa1, pa2, pa3;
    SWRITE_HV(0); SBAR();
    if (NT > 1) { SLOAD_H(Kh, Vh, KBASE(1)); }
    SBAR(); qkt<0>(pA0, pA1, K_lds, r32, hi, S.qr);
    MASKT(pA0, pA1, 0); partialSM(pA0, pA1, m_reg, mnA, alA);
    if (NT > 1) { VMW(); SWRITE_H(1); }
    __syncthreads();
#define HALF_STEP(PX0, PX1, mnX, alX, PY0, PY1, alY, t, KB, VB, SB) do {                                                      \
        SBAR(); qkt<KB>(PX0, PX1, K_lds, r32, hi, S.qr);                                                                      \
        finishSM(PY0, PY1, alY, l_reg, pa0, pa1, pa2, pa3); SBAR();                                                           \
        if ((t) + 1 < NT) { SLOAD_H(Kh, Vh, KBASE((t) + 1)); SBAR(); }                                                        \
        pv_tile<VB>(o, vb0, pa0, pa1, pa2, pa3); MASKT(PX0, PX1, (t)); partialSM(PX0, PX1, m_reg, mnX, alX);                  \
        __syncthreads();                                                                                                      \
        if ((t) + 1 < NT) { VMW(); SWRITE_H(SB); }                                                                            \
        RESC(alX); __syncthreads(); } while (0)
    for (int t = 1; t + 1 < NT; t += 2) {
        HALF_STEP(pB0, pB1, mnB, alB, pA0, pA1, alA, t, 1, 0, 0);
        HALF_STEP(pA0, pA1, mnA, alA, pB0, pB1, alB, t + 1, 0, 1, 1);
    }
    const bool even = (NT & 1) == 0;
    if (even) { SBAR(); qkt<1>(pB0, pB1, K_lds, r32, hi, S.qr); SBAR(); }
    SLOAD_H(nxt.K, nxt.V, kbn); SBAR();
#pragma unroll
    for (int d0 = 0; d0 < 8; ++d0) S.qr[d0] = load8(nxt.Q + (size_t)(wid * QBLK + r32) * LDZ + d0 * 16 + hi * 8);
    SBAR();
    finishSM(pA0, pA1, alA, l_reg, pa0, pa1, pa2, pa3); SBAR();
    pv_tile<0>(o, vb0, pa0, pa1, pa2, pa3);
    if (even) { MASKT(pB0, pB1, NT - 1); partialSM(pB0, pB1, m_reg, mnB, alB); __syncthreads(); RESC(alB);
        finishSM(pB0, pB1, alB, l_reg, pa0, pa1, pa2, pa3); SBAR(); pv_tile<1>(o, vb0, pa0, pa1, pa2, pa3); }
    SBAR(); SEAM_K0();
    if (hi == 0) li_l[r32] = l_reg; asm volatile("s_waitcnt lgkmcnt(0)" ::: "memory");
    float rli[16];
#pragma unroll
    for (int r = 0; r < 16; ++r) rli[r] = __builtin_amdgcn_rcpf(li_l[crow(r, hi)]);
    float* Ow = cur.O + (size_t)(wid * QBLK) * LDO;
#pragma unroll
    for (int r = 0; r < 16; ++r) { const int orow = crow(r, hi);
#pragma unroll
        for (int d0 = 0; d0 < 4; ++d0) { const float v = o[d0][r] * rli[r]; Ow[(size_t)orow * LDO + d0 * 32 + r32] = v; } }
    __syncthreads();
#undef RESC
#undef KBASE
#undef MASKT
#undef SEAM_K0
#undef HALF_STEP
}
#undef ROW
#undef VMW
#undef VMWN
#undef SLOAD_H
#undef SWRITE_HK
#undef SWRITE_HV
#undef SWRITE_H
#undef KSWZ
#undef SBAR
}

#define XB_TMO      128
#define XB_XCNT(j)  (256  + 64 * (j))
#define XB_XSUB(j)  (1280 + 64 * (j))
#define XB_XGEN(j)  (2304 + 64 * (j))
#define XB_TOP      3328
#define XB_TOPGEN   3392
#define XCD_BAR_WORDS 3456
#define XB_SPIN_CAP (1u << 18)

__device__ __forceinline__ unsigned xb_ld(unsigned* p)              { return __hip_atomic_load(p, __ATOMIC_RELAXED, __HIP_MEMORY_SCOPE_AGENT); }
__device__ __forceinline__ unsigned xb_add(unsigned* p, unsigned v) { return __hip_atomic_fetch_add(p, v, __ATOMIC_RELAXED, __HIP_MEMORY_SCOPE_AGENT); }
__device__ __forceinline__ unsigned xb_xcc_id() { return (unsigned)__builtin_amdgcn_s_getreg((3 << 11) | 20) & 0xFu; }
#define XB_SPIN(cond, bar) do { unsigned _sp = 0; while (cond) { __builtin_amdgcn_s_sleep(1); \
    if ((++_sp & 255u) == 0u) { if (xb_ld(&(bar)[XB_TMO])) break; if (_sp > XB_SPIN_CAP) { atomicAdd(&(bar)[XB_TMO], 1u); break; } } } } while (0)

struct XcdBarrier {
    unsigned* bar; unsigned x;
    volatile LAS unsigned* st;
};

__device__ __forceinline__ XcdBarrier xcd_barrier_post(unsigned* bar, volatile LAS unsigned* st) {
    XcdBarrier b; b.bar = bar; b.x = xb_xcc_id(); b.st = st;
    if (threadIdx.x == 0) (void)xb_add(&bar[XB_XCNT(b.x)], 1u);
    return b;
}
__device__ __forceinline__ void xcd_barrier_complete(unsigned* bar, unsigned x, unsigned& nloc, unsigned& nx) {
    const unsigned G = gridDim.x * gridDim.y * gridDim.z;
    unsigned sum, cnt, mine, sp = 0u;
    for (;;) {
        sum = 0u; cnt = 0u; mine = 0u;
#pragma unroll
        for (unsigned j = 0; j < 16; ++j) { const unsigned c = xb_ld(&bar[XB_XCNT(j)]); sum += c; cnt += (c > 0u) ? 1u : 0u; mine = (j == x) ? c : mine; }
        if (sum == G) break;
        __builtin_amdgcn_s_sleep(1);
        if ((++sp & 255u) == 0u) { if (xb_ld(&bar[XB_TMO])) break; if (sp > XB_SPIN_CAP) { atomicAdd(&bar[XB_TMO], 1u); break; } }
    }
    nloc = mine > 0u ? mine : 1u; nx = cnt > 0u ? cnt : 1u;
}

template <bool FIRST> __device__ __forceinline__ void xcd_barrier(const XcdBarrier& b) {
    asm volatile("s_waitcnt vmcnt(0)" ::: "memory");
    __syncthreads();
    if (threadIdx.x == 0) {
        unsigned* bar = b.bar;
        __builtin_amdgcn_s_waitcnt(0);
        unsigned nloc = b.st[0], nx = b.st[1];
        if (FIRST) { if (nloc == 0u) { xcd_barrier_complete(bar, b.x, nloc, nx); b.st[0] = nloc; b.st[1] = nx; } }
        const unsigned old = xb_add(&bar[XB_XSUB(b.x)], 1u);
        const unsigned gen = old / nloc;
        if (old + 1u == (gen + 1u) * nloc) {
            __builtin_amdgcn_fence(__ATOMIC_RELEASE, "agent");
            asm volatile("s_waitcnt vmcnt(0)" ::: "memory");
            const unsigned og = xb_add(&bar[XB_TOP], 1u);
            const unsigned tg = og / nx;
            if (og + 1u == (tg + 1u) * nx) xb_add(&bar[XB_TOPGEN], 1u);
            else XB_SPIN(xb_ld(&bar[XB_TOPGEN]) == tg, bar);
            __builtin_amdgcn_fence(__ATOMIC_ACQUIRE, "agent");
            xb_add(&bar[XB_XGEN(b.x)], 1u);
            asm volatile("s_waitcnt vmcnt(0)" ::: "memory");
        } else {
            XB_SPIN(xb_ld(&bar[XB_XGEN(b.x)]) == gen, bar);
            __builtin_amdgcn_fence(__ATOMIC_ACQUIRE, "agent");
            asm volatile("s_waitcnt vmcnt(0)" ::: "memory");
        }
    }
    __syncthreads();
}

__device__ __forceinline__ void transpose_item(const float* W, int K, int N, bf16_t* WT, int drow0, int k0, int n0, LAS float* scr, int lane) {
#pragma unroll 8
    for (int i = 0; i < 32; ++i) { const int kk = 2 * i + (lane >> 5); scr[kk * 33 + (lane & 31)] = W[(size_t)(k0 + kk) * N + n0 + (lane & 31)]; }
    LDS_WAIT(); asm volatile("" ::: "memory");
    const int c = lane & 7;
#pragma unroll
    for (int j = 0; j < 4; ++j) { const int n = (lane >> 3) + 8 * j; const LAS float* s = scr + (8 * c) * 33 + n;
        u32x4 o; o.x = cvt_pk_bf16(s[0 * 33], s[1 * 33]); o.y = cvt_pk_bf16(s[2 * 33], s[3 * 33]); o.z = cvt_pk_bf16(s[4 * 33], s[5 * 33]); o.w = cvt_pk_bf16(s[6 * 33], s[7 * 33]);
        *(u32x4*)(WT + (size_t)(drow0 + n) * K + k0 + 8 * c) = o; }
    LDS_WAIT(); asm volatile("" ::: "memory");
}
__device__ __forceinline__ float rms_row(const float* xrow, const float* g, bf16_t* orow, int lane) {
    const f32x4* xr = (const f32x4*)xrow + lane; const f32x4* gr = (const f32x4*)g + lane;
    f32x4 v[8]; float s = 0.f;
#pragma unroll
    for (int j = 0; j < 8; ++j) { v[j] = xr[64 * j]; s += (v[j].x * v[j].x + v[j].y * v[j].y) + (v[j].z * v[j].z + v[j].w * v[j].w); }
    const float rstd = 1.0f / sqrtf(wave_sum(s) * (1.0f / DM) + EPS);
    u32x2* o8 = (u32x2*)orow + lane;
#pragma unroll
    for (int j = 0; j < 8; ++j) { const f32x4 gg = gr[64 * j]; const f32x4 y = v[j] * rstd * gg; u32x2 w; w.x = cvt_pk_bf16(y.x, y.y); w.y = cvt_pk_bf16(y.z, y.w); o8[64 * j] = w; }
    return rstd;
}

struct Args { const void* in[20]; float* out; unsigned char* ws; };

__global__ void __launch_bounds__(512, 2) hybrid_fwd(Args args) {
    extern __shared__ __attribute__((aligned(16))) unsigned char lds_raw[];
    LAS unsigned char* lds = (LAS unsigned char*)lds_raw;
    volatile LAS unsigned* LW = (volatile LAS unsigned*)(lds + LDSCTL_OFF);
    const int tid = threadIdx.x, lane = tid & 63, wave = __builtin_amdgcn_readfirstlane(tid >> 6);
    const int G = gridDim.x, bx = blockIdx.x;
    const int gw = bx * 8 + wave, NGW = G * 8;
    for (int u = tid; u < (LDS_BYTES - LDSCTL_OFF) / 4; u += 512) LW[u] = 0u;
    __syncthreads();
    if (tid < 22) { const unsigned long long pv = tid < 20 ? (unsigned long long)args.in[tid] : (tid == 20 ? (unsigned long long)args.out : (unsigned long long)args.ws);
        LW[64 + 2 * tid] = (unsigned)pv; LW[64 + 2 * tid + 1] = (unsigned)(pv >> 32); }
    __syncthreads();
#define PTR(i) ((unsigned long long)(unsigned)__builtin_amdgcn_readfirstlane((int)LW[64 + 2 * (i)]) | ((unsigned long long)(unsigned)__builtin_amdgcn_readfirstlane((int)LW[64 + 2 * (i) + 1]) << 32))
#define INF(i) ((const float*)(GAS const float*)PTR(i))
#define WSP(T, off) ((T*)(GAS T*)(PTR(21) + (unsigned long long)(off)))
#define OUTP ((float*)(GAS float*)PTR(20))
    { const XcdBarrier b0 = xcd_barrier_post(WSP(unsigned, WS_CTL) + CW_BAR, LW); if (threadIdx.x == 0) LW[2] = b0.x; }
    __syncthreads();
#define GRID_BAR_T(F) do { XcdBarrier b_; b_.bar = WSP(unsigned, WS_CTL) + CW_BAR; b_.x = (unsigned)__builtin_amdgcn_readfirstlane((int)LW[2]); b_.st = LW; xcd_barrier<F>(b_); } while (0)
#define GRID_BAR() GRID_BAR_T(false)

    for (int rep_ = 0; rep_ < REP_P0; ++rep_) {
        LAS float* scr = (LAS float*)(lds + wave * 16384);
        constexpr int I_IN = 32 * 160, I_OUT = 32 * 64, I_DG = 32 * 176, I_DD = 88 * 64, I_MG = 32 * 224, I_MD = 112 * 64;
        constexpr int NITEMS = 2 * I_IN + 2 * I_OUT + 2 * I_DG + I_DD + 16 * I_MG + 8 * I_MD;
        unsigned char* ws = WSP(unsigned char, 0);
        for (int it = gw; it < NITEMS; it += NGW) {
            int r = it; const float* W; bf16_t* WT; int K, N, mode = 0;
            if (r < 2 * I_IN) { const int l = r / I_IN; r -= l * I_IN; W = INF(3) + (size_t)l * DM * INW; WT = (bf16_t*)(ws + WS_WIN) + (size_t)l * INW * DM; K = DM; N = INW; }
            else if ((r -= 2 * I_IN) < 2 * I_OUT) { const int l = r / I_OUT; r -= l * I_OUT; W = INF(11) + (size_t)l * DM * DM; WT = (bf16_t*)(ws + WS_WOUT) + (size_t)l * DM * DM; K = DM; N = DM; }
            else if ((r -= 2 * I_OUT) < I_DG) { W = INF(13); WT = (bf16_t*)(ws + WS_WDGU); K = DM; N = FFD; mode = 1; }
            else if ((r -= I_DG) < I_DG) { W = INF(14); WT = (bf16_t*)(ws + WS_WDGU); K = DM; N = FFD; mode = 2; }
            else if ((r -= I_DG) < I_DD) { W = INF(15); WT = (bf16_t*)(ws + WS_WDD); K = FFD; N = DM; }
            else if ((r -= I_DD) < 8 * I_MG) { const int e = r / I_MG; r -= e * I_MG; W = INF(17) + (size_t)e * DM * FFE; WT = (bf16_t*)(ws + WS_WMGU) + (size_t)e * 2 * FFE * DM; K = DM; N = FFE; mode = 1; }
            else if ((r -= 8 * I_MG) < 8 * I_MG) { const int e = r / I_MG; r -= e * I_MG; W = INF(18) + (size_t)e * DM * FFE; WT = (bf16_t*)(ws + WS_WMGU) + (size_t)e * 2 * FFE * DM; K = DM; N = FFE; mode = 2; }
            else { r -= 8 * I_MG; const int e = r / I_MD; r -= e * I_MD; W = INF(19) + (size_t)e * FFE * DM; WT = (bf16_t*)(ws + WS_WMD) + (size_t)e * DM * FFE; K = FFE; N = DM; }
            const int nblk = N / 32, kb = r / nblk, nb = r - kb * nblk, k0 = 64 * kb, n0 = 32 * nb;
            const int drow0 = mode == 0 ? n0 : (256 * (n0 >> 7) + (mode - 1) * 128 + (n0 & 127));
            transpose_item(W, K, N, WT, drow0, k0, n0, scr, lane);
        }
        {
            const int* positions = (const int*)(GAS const int*)PTR(1); float* cosT = (float*)(ws + WS_COS); float* sinT = (float*)(ws + WS_SIN);
            for (int idx = (bx * 512 + tid); idx < NTOK * 64; idx += G * 512) {
                const int t = idx >> 6, i = idx & 63;
                const float inv = 1.0f / powf(10000.0f, (float)(2 * i) / 128.0f);
                const float ang = (float)positions[t] * inv;
                double rev = (double)ang * 0.15915494309189535; rev -= rint(rev);
                const float rf = (float)rev;
                cosT[idx] = __builtin_amdgcn_cosf(rf); sinT[idx] = __builtin_amdgcn_sinf(rf);
            }
        }
        {
            const float* w_pool = INF(8); bf16_t* wpt = (bf16_t*)(ws + WS_WPT);
            for (int idx = (bx * 512 + tid); idx < 2 * 4 * 128 * 128; idx += G * 512) {
                const int c = idx & 127, d = (idx >> 7) & 127, lg = idx >> 14;
                const float v = w_pool[((size_t)lg * 128 + c) * 128 + d];
                wpt[idx] = (bf16_t)(cvt_pk_bf16(v, 0.f) & 0xffffu);
            }
        }
        {
            const float* x_in = INF(0); const float* gn = INF(2); bf16_t* xn = (bf16_t*)(ws + WS_XN);
            for (int m = gw; m < NTOK; m += NGW) (void)rms_row(x_in + (size_t)m * DM, gn, xn + (size_t)m * DM, lane);
        }
    }
    GRID_BAR_T(true);

    for (int l = 0; l < DEPTH; ++l) {
#define PHASE_IDS() const int tid = ltid(), lane = tid & 63, wave = __builtin_amdgcn_readfirstlane(tid >> 6), gw = bx * 8 + wave; (void)tid; (void)lane; (void)wave; (void)gw
        for (int rep_ = 0; rep_ < REP_P1; ++rep_) {
            pg8::Gemm g{WSP(bf16_t, WS_XN), WSP(bf16_t, WS_WIN) + (size_t)l * INW * DM, DM, 0};
            pg8::StaticOrder S; S.init(NTOK / 256, INW / 256, G, bx);
            pg8::EpiBf16 E{WSP(bf16_t, WS_Z), INW};
            pg8::gemm_phase<pg8::EpiBf16, pg8::StaticOrder>(lds, g, S, E);
        }
        GRID_BAR();
        if (PH_MASK & (1 << 2)) {
            PHASE_IDS();
            bf16_t* zb = WSP(bf16_t, WS_Z); bf16_t* mix = WSP(bf16_t, WS_MIX);
            {
            const float* qg = INF(4) + l * 128; const float* kg = INF(5) + l * 128;
            const float* cw = INF(10) + (size_t)l * 3 * 512;
            const float* cosT = WSP(float, WS_COS); const float* sinT = WSP(float, WS_SIN);
            for (int t = gw; t < NTOK; t += NGW) {
                bf16_t* zr = zb + (size_t)t * INW;
                {
                    const int c = lane >> 2, sub = lane & 3;
                    bf16_t* p = zr + c * 128 + 16 * sub;
                    const u32x4 a0 = *(const u32x4*)p, a1 = *(const u32x4*)(p + 8), b0 = *(const u32x4*)(p + 64), b1 = *(const u32x4*)(p + 72);
                    float xa[16], xb[16];
#pragma unroll
                    for (int j = 0; j < 4; ++j) { xa[2 * j] = bflo(a0[j]); xa[2 * j + 1] = bfhi(a0[j]); xa[8 + 2 * j] = bflo(a1[j]); xa[8 + 2 * j + 1] = bfhi(a1[j]);
                                                  xb[2 * j] = bflo(b0[j]); xb[2 * j + 1] = bfhi(b0[j]); xb[8 + 2 * j] = bflo(b1[j]); xb[8 + 2 * j + 1] = bfhi(b1[j]); }
                    float ss = 0.f;
#pragma unroll
                    for (int j = 0; j < 16; ++j) ss += xa[j] * xa[j] + xb[j] * xb[j];
                    ss += __shfl_xor(ss, 1); ss += __shfl_xor(ss, 2);
                    const float rstd = 1.0f / sqrtf(ss * (1.0f / 128.0f) + EPS);
                    const float* gp = (c < 8 ? qg : kg) + 16 * sub;
                    const float* cp = cosT + (size_t)t * 64 + 16 * sub; const float* sp = sinT + (size_t)t * 64 + 16 * sub;
                    float oa[16], ob[16];
#pragma unroll
                    for (int j = 0; j < 16; ++j) { const float x1 = xa[j] * rstd * gp[j], x2 = xb[j] * rstd * gp[64 + j]; const float cs = cp[j], sn = sp[j];
                        oa[j] = x1 * cs - x2 * sn; ob[j] = x1 * sn + x2 * cs; }
                    u32x4 w0, w1, w2, w3;
#pragma unroll
                    for (int j = 0; j < 4; ++j) { w0[j] = cvt_pk_bf16(oa[2 * j], oa[2 * j + 1]); w1[j] = cvt_pk_bf16(oa[8 + 2 * j], oa[8 + 2 * j + 1]);
                                                  w2[j] = cvt_pk_bf16(ob[2 * j], ob[2 * j + 1]); w3[j] = cvt_pk_bf16(ob[8 + 2 * j], ob[8 + 2 * j + 1]); }
                    *(u32x4*)p = w0; *(u32x4*)(p + 8) = w1; *(u32x4*)(p + 64) = w2; *(u32x4*)(p + 72) = w3;
                }
                {
                    const int tb = t & (SEQ - 1), ch = 8 * lane;
                    const u32x4 gb = *(const u32x4*)(zr + ZGB + ch);
                    float y[8];
#pragma unroll
                    for (int j = 0; j < 8; ++j) y[j] = 0.f;
#pragma unroll
                    for (int d = 0; d < 3; ++d) {
                        if (tb >= d) {
                            const bf16_t* zd = zr - (size_t)d * INW;
                            const u32x4 gc = *(const u32x4*)(zd + ZGC + ch), hc = *(const u32x4*)(zd + ZH + ch);
                            const f32x4 wa = *(const f32x4*)(cw + (2 - d) * 512 + ch), wb = *(const f32x4*)(cw + (2 - d) * 512 + ch + 4);
#pragma unroll
                            for (int j = 0; j < 4; ++j) { const float u0 = bflo(gc[j]) * bflo(hc[j]), u1 = bfhi(gc[j]) * bfhi(hc[j]);
                                const float k0_ = (j < 2) ? wa[2 * j] : wb[2 * j - 4], k1_ = (j < 2) ? wa[2 * j + 1] : wb[2 * j - 3];
                                y[2 * j] += k0_ * u0; y[2 * j + 1] += k1_ * u1; }
                        }
                    }
                    u32x4 w;
#pragma unroll
                    for (int j = 0; j < 4; ++j) w[j] = cvt_pk_bf16(bflo(gb[j]) * y[2 * j], bfhi(gb[j]) * y[2 * j + 1]);
                    *(u32x4*)(mix + (size_t)t * DM + 1536 + ch) = w;
                }
            }
            }
            {
            const bf16_t* wpt = WSP(bf16_t, WS_WPT); const float* pool_scale = INF(9) + l * 512;
            for (int it = gw; it < (NTOK / 32) * 4; it += NGW) {
                const int T = it >> 2, gi = it & 3, wn = 2 << gi, t0 = T * 32;
                const int r32 = lane & 31, hi = lane >> 5, t = t0 + r32, tb = t & (SEQ - 1);
                const float inv = 1.0f / (float)((tb + 1) < wn ? (tb + 1) : wn);
                const bf16_t* zp = zb + (size_t)t * INW + ZP + gi * 128;
                const bf16_t* wp = wpt + ((size_t)(l * 4 + gi) * 128) * 128;
                f32x16 acc[4];
#pragma unroll
                for (int nb = 0; nb < 4; ++nb) acc[nb] = f32x16{};
#pragma unroll 1
                for (int s = 0; s < 8; ++s) {
                    const int cb = 16 * s + 8 * hi;
                    float sum[8], self[8];
#pragma unroll
                    for (int j = 0; j < 8; ++j) { sum[j] = 0.f; self[j] = 0.f; }
#pragma unroll 1
                    for (int d = 0; d < wn; ++d) {
                        if (d <= tb) { const u32x4 v = *(const u32x4*)(zp - (size_t)d * INW + cb);
#pragma unroll
                            for (int j = 0; j < 4; ++j) { const float a = bflo(v[j]), b = bfhi(v[j]); sum[2 * j] += a; sum[2 * j + 1] += b; if (d == 0) { self[2 * j] = a; self[2 * j + 1] = b; } } }
                    }
                    u32x4 aw;
#pragma unroll
                    for (int j = 0; j < 4; ++j) aw[j] = cvt_pk_bf16(sum[2 * j] * inv - self[2 * j], sum[2 * j + 1] * inv - self[2 * j + 1]);
                    const bf16x8 af = __builtin_bit_cast(bf16x8, aw);
#pragma unroll
                    for (int nb = 0; nb < 4; ++nb) { const bf16x8 bfr = *(const bf16x8*)(wp + (size_t)(nb * 32 + r32) * 128 + cb);
                        acc[nb] = __builtin_amdgcn_mfma_f32_32x32x16_bf16(af, bfr, acc[nb], 0, 0, 0); }
                }
#pragma unroll
                for (int nb = 0; nb < 4; ++nb) { const int col = gi * 128 + nb * 32 + r32; const float ps = pool_scale[col];
#pragma unroll
                    for (int r = 0; r < 16; ++r) { const int row = (r & 3) + 8 * (r >> 2) + 4 * hi;
                        mix[(size_t)(t0 + row) * DM + 1024 + col] = (bf16_t)(cvt_pk_bf16(acc[nb][r] * ps, 0.f) & 0xffffu); } }
            }
            }
        }
        GRID_BAR();
        for (int rep_ = 0; rep_ < REP_P3; ++rep_) {
            constexpr int NITEM = 512;
            char* alds = (char*)lds_raw;
            int L = bx;
            if (L < NITEM) {
                const bf16_t* zb = WSP(bf16_t, WS_Z); float* ao = WSP(float, WS_AO);
#define ATT_REF(ref, LL, pass) do { const int xcd_ = (LL) & 7, k_ = (LL) >> 3, bh_ = (k_ >> 4) * 8 + xcd_, b_ = bh_ >> 2, h_ = bh_ & 3, vh_ = (k_ & 15) >> 2, mp_ = vh_ >> 1, vj_ = vh_ & 1, x_ = k_ & 3; \
                    const int qb_ = (pass) ? 7 - x_ : x_; const bf16_t* zb_ = zb + (size_t)b_ * SEQ * INW; \
                    (ref).Q = zb_ + (size_t)qb_ * 256 * INW + ZQ + h_ * 256 + mp_ * 128; (ref).K = zb_ + ZK + h_ * 256 + mp_ * 128; (ref).V = zb_ + ZV + h_ * 256 + vj_ * 128; \
                    (ref).O = ao + ((size_t)b_ * SEQ + (size_t)qb_ * 256) * DM + h_ * 512 + mp_ * 256 + vj_ * 128; (ref).P0 = qb_ * 256; } while (0)
                att::BlockRef cur, nxt; int pass = 0;
                ATT_REF(cur, L, 0);
                att::Seam S;
                att::causal_prime(cur, alds, S);
                for (;;) {
                    const bool more_pass = pass == 0, more_item = L + G < NITEM, last = !more_pass && !more_item;
                    int passn = pass + 1, Ln = L;
                    if (!more_pass) { passn = 0; Ln = more_item ? L + G : L; }
                    if (last) nxt = cur; else ATT_REF(nxt, Ln, passn);
                    att::causal_block(cur, nxt, SEQ, alds, S);
                    if (last) break;
                    cur = nxt; pass = passn; L = Ln;
                }
#undef ATT_REF
            }
        }
        GRID_BAR();
        if (PH_MASK & (1 << 4)) {
            PHASE_IDS();
            const float lam_init = (l == 0) ? 0.2f : 0.35550906759096926f;
            const float* lv = INF(6) + (size_t)l * 512;
            const float d01 = wave_sum(lv[lane] * lv[128 + lane] + lv[64 + lane] * lv[192 + lane]);
            const float d23 = wave_sum(lv[256 + lane] * lv[384 + lane] + lv[320 + lane] * lv[448 + lane]);
            const float lam = expf(d01) - expf(d23) + lam_init;
            const float oscale = 1.0f - lam_init;
            const int h = lane >> 4, e0 = (lane & 15) * 16;
            const float* sg = INF(7) + l * 256 + e0;
            const float* ao = WSP(float, WS_AO); bf16_t* mix = WSP(bf16_t, WS_MIX);
            for (int t = gw; t < NTOK; t += NGW) {
                const float* o0 = ao + (size_t)t * DM + h * 512 + e0; const float* o1 = o0 + 256;
                float dv[16]; float ss = 0.f;
#pragma unroll
                for (int j = 0; j < 4; ++j) { const f32x4 a = *(const f32x4*)(o0 + 4 * j), b = *(const f32x4*)(o1 + 4 * j);
#pragma unroll
                    for (int q = 0; q < 4; ++q) { const float d = a[q] - lam * b[q]; dv[4 * j + q] = d; ss += d * d; } }
                ss += __shfl_xor(ss, 1); ss += __shfl_xor(ss, 2); ss += __shfl_xor(ss, 4); ss += __shfl_xor(ss, 8);
                const float rstd = 1.0f / sqrtf(ss * (1.0f / 256.0f) + EPS);
                u32x4 w0, w1;
#pragma unroll
                for (int j = 0; j < 4; ++j) { w0[j] = cvt_pk_bf16(dv[2 * j] * rstd * sg[2 * j] * oscale, dv[2 * j + 1] * rstd * sg[2 * j + 1] * oscale);
                                              w1[j] = cvt_pk_bf16(dv[8 + 2 * j] * rstd * sg[8 + 2 * j] * oscale, dv[8 + 2 * j + 1] * rstd * sg[8 + 2 * j + 1] * oscale); }
                bf16_t* mp = mix + (size_t)t * DM + h * 256 + e0;
                *(u32x4*)mp = w0; *(u32x4*)(mp + 8) = w1;
            }
        }
        GRID_BAR();
        if (PH_MASK & (1 << 5)) {
            pg8::Gemm g{WSP(bf16_t, WS_MIX), WSP(bf16_t, WS_WOUT) + (size_t)l * DM * DM, DM, 0};
            pg8::StaticOrder S; S.init(NTOK / 256, DM / 256, G, bx);
            float* out = OUTP;
            pg8::EpiResF32 E{l == 0 ? INF(0) : (const float*)out, out, DM};
            pg8::gemm_phase<pg8::EpiResF32, pg8::StaticOrder>(lds, g, S, E);
        }
        GRID_BAR();
        if (l == 0 && (PH_MASK & (1 << 6))) {
            {
                PHASE_IDS();
                const float* out = OUTP; const float* gn = INF(12); bf16_t* xn = WSP(bf16_t, WS_XN);
                for (int m = gw; m < NTOK; m += NGW) (void)rms_row(out + (size_t)m * DM, gn, xn + (size_t)m * DM, lane);
            }
            GRID_BAR();
            {
                pg8::Gemm g{WSP(bf16_t, WS_XN), WSP(bf16_t, WS_WDGU), DM, 0};
                pg8::StaticOrder S; S.init(NTOK / 256, 2 * FFD / 256, G, bx);
                pg8::EpiSwiglu E{WSP(bf16_t, WS_ACTD), FFD};
                pg8::gemm_phase<pg8::EpiSwiglu, pg8::StaticOrder>(lds, g, S, E);
            }
            GRID_BAR();
            {
                pg8::Gemm g{WSP(bf16_t, WS_ACTD), WSP(bf16_t, WS_WDD), FFD, 0};
                pg8::StaticOrder S; S.init(NTOK / 256, DM / 256, G, bx);
                float* out = OUTP;
                pg8::EpiResF32 E{out, out, DM};
                pg8::gemm_phase<pg8::EpiResF32, pg8::StaticOrder>(lds, g, S, E);
            }
            GRID_BAR();
            {
                PHASE_IDS();
                const float* out = OUTP; const float* gn = INF(2) + DM; bf16_t* xn = WSP(bf16_t, WS_XN);
                for (int m = gw; m < NTOK; m += NGW) (void)rms_row(out + (size_t)m * DM, gn, xn + (size_t)m * DM, lane);
            }
            GRID_BAR();
        } else if (PH_MASK & (1 << 7)) {
            const int TPW = (NTOK + G - 1) / G;
            {
                PHASE_IDS();
                if (tid < 8) LW[LW_CNT + tid] = 0u;
                __syncthreads();
                const float* out = OUTP; const float* gn = INF(12) + DM; bf16_t* xn = WSP(bf16_t, WS_XN); const float* router_w = INF(16);
                int* tokE = WSP(int, WS_TOKE); int* tokR = WSP(int, WS_TOKR); float* tokG = WSP(float, WS_TOKG);
                const int tlo = bx * TPW, thi = (tlo + TPW) < NTOK ? (tlo + TPW) : NTOK;
                for (int t = tlo + wave; t < thi; t += 8) {
                    const float rstd = rms_row(out + (size_t)t * DM, gn, xn + (size_t)t * DM, lane);
                    float lg[8];
#pragma unroll
                    for (int e = 0; e < 8; ++e) lg[e] = 0.f;
#pragma unroll 1
                    for (int j = 0; j < 8; ++j) {
                        const f32x4 xv = *((const f32x4*)(out + (size_t)t * DM) + 64 * j + lane), gv = *((const f32x4*)gn + 64 * j + lane);
#pragma unroll
                        for (int q = 0; q < 4; ++q) { const int k = 256 * j + 4 * lane + q; const f32x4 ra = *(const f32x4*)(router_w + (size_t)k * 8), rb = *(const f32x4*)(router_w + (size_t)k * 8 + 4); const float hv = xv[q] * rstd * gv[q];
                            lg[0] += hv * ra[0]; lg[1] += hv * ra[1]; lg[2] += hv * ra[2]; lg[3] += hv * ra[3]; lg[4] += hv * rb[0]; lg[5] += hv * rb[1]; lg[6] += hv * rb[2]; lg[7] += hv * rb[3]; }
                    }
#pragma unroll
                    for (int e = 0; e < 8; ++e) lg[e] = wave_sum(lg[e]);
                    if (lane == 0) {
                        int e0 = 0; float v0 = lg[0];
#pragma unroll
                        for (int e = 1; e < 8; ++e) if (lg[e] > v0) { v0 = lg[e]; e0 = e; }
                        int e1 = -1; float v1 = -3.0e38f;
#pragma unroll
                        for (int e = 0; e < 8; ++e) if (e != e0 && lg[e] > v1) { v1 = lg[e]; e1 = e; }
                        const float ex = expf(v1 - v0), g0 = 1.0f / (1.0f + ex), g1 = ex / (1.0f + ex);
                        const int r0 = (int)atomicAdd((unsigned*)(lds_raw + LDSCTL_OFF) + LW_CNT + e0, 1u);
                        const int r1 = (int)atomicAdd((unsigned*)(lds_raw + LDSCTL_OFF) + LW_CNT + e1, 1u);
                        tokE[2 * t] = e0; tokE[2 * t + 1] = e1; tokR[2 * t] = r0; tokR[2 * t + 1] = r1; tokG[2 * t] = g0; tokG[2 * t + 1] = g1;
                    }
                }
                __syncthreads();
                if (tid < 8) WSP(int, WS_CNTWG)[bx * 8 + tid] = (int)LW[LW_CNT + tid];
            }
            GRID_BAR();
            {
                PHASE_IDS();
                if (tid < 8) { LW[LW_TOT + tid] = 0u; LW[LW_PRE + tid] = 0u; }
                __syncthreads();
                {
                const int* cntWG = WSP(int, WS_CNTWG);
                for (int j = tid; j < G; j += 512) {
                    const i32x4 ca = *(const i32x4*)(cntWG + j * 8), cb = *(const i32x4*)(cntWG + j * 8 + 4);
                    unsigned* lw = (unsigned*)(lds_raw + LDSCTL_OFF);
#pragma unroll
                    for (int e = 0; e < 4; ++e) { atomicAdd(lw + LW_TOT + e, (unsigned)ca[e]); atomicAdd(lw + LW_TOT + 4 + e, (unsigned)cb[e]);
                        if (j < bx) { atomicAdd(lw + LW_PRE + e, (unsigned)ca[e]); atomicAdd(lw + LW_PRE + 4 + e, (unsigned)cb[e]); } }
                }
                }
                __syncthreads();
                if (tid == 0) { unsigned base = 0;
                    for (int e = 0; e < 8; ++e) { const unsigned tot = LW[LW_TOT + e]; LW[LW_BP + e] = base + LW[LW_PRE + e]; LW[LW_TOFF + e] = base >> 8; base += (tot + 255u) & ~255u; }
                    LW[LW_TOFF + 8] = base >> 8; }
                __syncthreads();
                const int* tokE = WSP(int, WS_TOKE); const int* tokR = WSP(int, WS_TOKR); int* tokS = WSP(int, WS_TOKS);
                const bf16_t* xn = WSP(bf16_t, WS_XN); bf16_t* hp = WSP(bf16_t, WS_HP);
                const int tlo = bx * TPW, thi = (tlo + TPW) < NTOK ? (tlo + TPW) : NTOK;
                for (int t = tlo + wave; t < thi; t += 8) {
                    const int e0 = tokE[2 * t], e1 = tokE[2 * t + 1];
                    const int s0 = (int)LW[LW_BP + e0] + tokR[2 * t], s1 = (int)LW[LW_BP + e1] + tokR[2 * t + 1];
                    if (lane == 0) { tokS[2 * t] = s0; tokS[2 * t + 1] = s1; }
                    const u32x4* src = (const u32x4*)(xn + (size_t)t * DM) + lane; u32x4* d0 = (u32x4*)(hp + (size_t)s0 * DM) + lane; u32x4* d1 = (u32x4*)(hp + (size_t)s1 * DM) + lane;
#pragma unroll
                    for (int j = 0; j < 4; ++j) { const u32x4 v = src[64 * j]; d0[64 * j] = v; d1[64 * j] = v; }
                }
                for (int e = 0; e < 8; ++e) {
                    const int rlo = (int)LW[LW_TOFF + e] * 256 + (int)LW[LW_TOT + e], rhi = (int)LW[LW_TOFF + e + 1] * 256;
                    for (int r = rlo + gw; r < rhi; r += NGW) { u32x4* d0 = (u32x4*)(hp + (size_t)r * DM) + lane;
#pragma unroll
                        for (int j = 0; j < 4; ++j) d0[64 * j] = (u32x4){0u, 0u, 0u, 0u}; }
                }
            }
            GRID_BAR();
#define RFL(i) __builtin_amdgcn_readfirstlane((int)LW[LW_TOFF + (i)])
            for (int rep_ = 0; rep_ < REP_P7; ++rep_) {
                pg8::Gemm g{WSP(bf16_t, WS_HP), WSP(bf16_t, WS_WMGU), DM, (size_t)2 * FFE * DM * 2};
                pg8::MoeOrder S; S.S.init(RFL(8), 2 * FFE / 256, G, bx);
                S.t1 = RFL(1); S.t2 = RFL(2); S.t3 = RFL(3); S.t4 = RFL(4); S.t5 = RFL(5); S.t6 = RFL(6); S.t7 = RFL(7);
                pg8::EpiSwiglu E{WSP(bf16_t, WS_ACTM), FFE};
                pg8::gemm_phase<pg8::EpiSwiglu, pg8::MoeOrder>(lds, g, S, E);
            }
            GRID_BAR();
            {
                pg8::Gemm g{WSP(bf16_t, WS_ACTM), WSP(bf16_t, WS_WMD), FFE, (size_t)DM * FFE * 2};
                pg8::MoeOrder S; S.S.init(RFL(8), DM / 256, G, bx);
                S.t1 = RFL(1); S.t2 = RFL(2); S.t3 = RFL(3); S.t4 = RFL(4); S.t5 = RFL(5); S.t6 = RFL(6); S.t7 = RFL(7);
                pg8::EpiF32 E{WSP(float, WS_Y), DM};
                pg8::gemm_phase<pg8::EpiF32, pg8::MoeOrder>(lds, g, S, E);
            }
#undef RFL
            GRID_BAR();
            {
                PHASE_IDS();
                const int* tokS = WSP(int, WS_TOKS); const float* tokG = WSP(float, WS_TOKG); float* out = OUTP; const float* yb = WSP(float, WS_Y);
                for (int t = gw; t < NTOK; t += NGW) {
                    const int s0 = tokS[2 * t], s1 = tokS[2 * t + 1]; const float g0 = tokG[2 * t], g1 = tokG[2 * t + 1];
                    f32x4* o = (f32x4*)(out + (size_t)t * DM) + lane; const f32x4* y0 = (const f32x4*)(yb + (size_t)s0 * DM) + lane; const f32x4* y1 = (const f32x4*)(yb + (size_t)s1 * DM) + lane;
#pragma unroll
                    for (int j = 0; j < 8; ++j) o[64 * j] = o[64 * j] + (y0[64 * j] * g0 + y1[64 * j] * g1);
                }
            }
        }
    }
}

extern "C" void kernel_launch(void* const* d_in, const int* in_sizes, int n_in, void* d_out, int out_size, void* d_ws, size_t ws_size, hipStream_t stream) {
    static int grid = 0;
    if (grid == 0) {
        if (n_in != 20 || in_sizes[0] != NTOK * DM || out_size != NTOK * DM || ws_size < WS_END) {
            fprintf(stderr, "kernel_launch: unexpected shapes (n_in %d, in0 %d, out %d, ws %zu < %zu); nothing launched\n", n_in, n_in > 0 ? in_sizes[0] : -1, out_size, ws_size, (size_t)WS_END); grid = -1; return; }
        int dev = 0, cus = 0, per_cu = 0;
        if (hipGetDevice(&dev) != hipSuccess || hipDeviceGetAttribute(&cus, hipDeviceAttributeMultiprocessorCount, dev) != hipSuccess) { grid = -1; return; }
        if (hipFuncSetAttribute((const void*)hybrid_fwd, hipFuncAttributeMaxDynamicSharedMemorySize, LDS_BYTES) != hipSuccess) { fprintf(stderr, "kernel_launch: hipFuncSetAttribute failed\n"); grid = -1; return; }
        if (hipOccupancyMaxActiveBlocksPerMultiprocessor(&per_cu, (const void*)hybrid_fwd, 512, LDS_BYTES) != hipSuccess || per_cu < 1)
            fprintf(stderr, "kernel_launch: note: occupancy query reports %d workgroups per CU\n", per_cu);
        (void)hipGetLastError();
        grid = cus > 512 ? 512 : cus;
    }
    if (grid < 0) return;
    if (hipMemsetAsync((char*)d_ws + WS_CTL, 0, CTL_ZERO_BYTES, stream) != hipSuccess) { fprintf(stderr, "kernel_launch: memset failed\n"); return; }
    Args a{};
    for (int i = 0; i < 20; ++i) a.in[i] = d_in[i];
    a.out = (float*)d_out; a.ws = (unsigned char*)d_ws;
    hipLaunchKernelGGL(hybrid_fwd, dim3(grid), dim3(512), LDS_BYTES, stream, a);
    const hipError_t le = hipPeekAtLastError();
    if (le != hipSuccess) fprintf(stderr, "kernel_launch: launch failed: %s\n", hipGetErrorName(le));
}
```

```cpp
#include <hip/hip_runtime.h>
#include <hip/hip_bf16.h>
#include <cstdio>
#include <cstdint>

#define LAS __attribute__((address_space(3)))
#define GAS __attribute__((address_space(1)))
typedef unsigned short bf16_t;
typedef short bf16x8 __attribute__((ext_vector_type(8)));
typedef short s16x4 __attribute__((ext_vector_type(4)));
typedef float f32x4 __attribute__((ext_vector_type(4)));
typedef float f32x2 __attribute__((ext_vector_type(2)));
typedef float f32x16 __attribute__((ext_vector_type(16)));
typedef unsigned u32x4 __attribute__((ext_vector_type(4)));
typedef unsigned u32x2 __attribute__((ext_vector_type(2)));
typedef int i32x4 __attribute__((ext_vector_type(4)));
typedef int i32x8 __attribute__((ext_vector_type(8)));

constexpr int DM = 2048, NB = 8, SEQ = 2048, NTOK = NB * SEQ, DEPTH = 2;
constexpr int INW = 5120, FFD = 5632, NEXP = 8, FFE = 7168;
constexpr int ZQ = 0, ZK = 1024, ZV = 2048, ZP = 3072, ZGB = 3584, ZGC = 4096, ZH = 4608;
constexpr int MOE_ROWS = NTOK * 2 + NEXP * 256;
constexpr float EPS = 1e-6f;

constexpr size_t MiB = 1u << 20;
constexpr size_t WS_CTL = 0, CTL_ZERO_BYTES = 1 * MiB;
constexpr size_t WS_COS = 1 * MiB, WS_SIN = 5 * MiB;
constexpr size_t WS_WPT = 9 * MiB;
constexpr size_t WS_TOKE = 10 * MiB;
constexpr size_t WS_TOKR = WS_TOKE + 128 * 1024;
constexpr size_t WS_TOKG = WS_TOKR + 128 * 1024;
constexpr size_t WS_TOKS = WS_TOKG + 128 * 1024;
constexpr size_t WS_CNTWG = WS_TOKS + 128 * 1024;
constexpr size_t WS_WIN = 16 * MiB;
constexpr size_t WS_WOUT = WS_WIN + 40 * MiB;
constexpr size_t WS_WDGU = WS_WOUT + 16 * MiB;
constexpr size_t WS_WDD = WS_WDGU + 44 * MiB;
constexpr size_t WS_WMGU = WS_WDD + 22 * MiB;
constexpr size_t WS_WMD = WS_WMGU + 448 * MiB;
constexpr size_t WS_ACT0 = WS_WMD + 224 * MiB;
constexpr size_t WS_Z = WS_ACT0;
constexpr size_t WS_AO = WS_ACT0 + 160 * MiB;
constexpr size_t WS_MIX = WS_ACT0 + 288 * MiB;
constexpr size_t WS_XN = WS_ACT0 + 352 * MiB;
constexpr size_t WS_ACTM = WS_ACT0;
constexpr size_t WS_HP = WS_ACT0 + 476 * MiB;
constexpr size_t WS_Y = WS_ACT0 + 612 * MiB;
constexpr size_t WS_ACTD = WS_ACT0 + 476 * MiB;
constexpr size_t WS_END = WS_ACT0 + 884 * MiB;
static_assert(WS_ACT0 == 810 * MiB, "map");
static_assert((size_t)MOE_ROWS * FFE * 2 <= 476 * MiB && (size_t)MOE_ROWS * DM * 2 <= 136 * MiB && (size_t)MOE_ROWS * DM * 4 <= 272 * MiB, "map");

#ifndef PH_MASK
#define PH_MASK 0xffff
#endif
#define REP_P0 1
#define REP_P1 1
#define REP_P3 1
#define REP_P7 1
constexpr int CW_TMO = 0, CW_CODE = 1, CW_BAR = 4096;

constexpr int LDSCTL_OFF = 0, LDSCTL_BYTES = 1024;
constexpr int RING_OFF = 16384, RING_BYTES = 131072;
constexpr int LDS_BYTES = 147456;
constexpr int LW_CNT = 16, LW_TOT = 24, LW_PRE = 32, LW_BP = 40, LW_TOFF = 48;

#define LDS_WAIT() asm volatile("s_waitcnt lgkmcnt(0)" ::: "memory")
#define VM_WAIT() asm volatile("s_waitcnt vmcnt(0)" ::: "memory")

__device__ __forceinline__ unsigned cvt_pk_bf16(float lo, float hi) { unsigned r; asm volatile("v_cvt_pk_bf16_f32 %0, %1, %2" : "=v"(r) : "v"(lo), "v"(hi)); return r; }
__device__ __forceinline__ unsigned pk4_fp8(float a, float b, float c, float d) {
    a = __builtin_amdgcn_fmed3f(a, -448.f, 448.f); b = __builtin_amdgcn_fmed3f(b, -448.f, 448.f); c = __builtin_amdgcn_fmed3f(c, -448.f, 448.f); d = __builtin_amdgcn_fmed3f(d, -448.f, 448.f);
    int w = __builtin_amdgcn_cvt_pk_fp8_f32(a, b, 0, false); w = __builtin_amdgcn_cvt_pk_fp8_f32(c, d, w, true); return (unsigned)w; }
constexpr float W8_SCALE = 64.f, A8_SCALE = 8.f;
constexpr int SC_ONE = 0x7f7f7f7f, SC_W = 0x79797979  , SC_A = 0x7c7c7c7c  ;
__device__ __forceinline__ float bflo(unsigned w) { return __uint_as_float(w << 16); }
__device__ __forceinline__ float bfhi(unsigned w) { return __uint_as_float(w & 0xffff0000u); }
__device__ __forceinline__ float wave_sum(float v) {
#pragma unroll
    for (int o = 1; o < 64; o <<= 1) v += __shfl_xor(v, o);
    return v;
}

__device__ __forceinline__ int ltid() { int t = threadIdx.x; asm volatile("" : "+v"(t)); return t; }

namespace pg8 {
constexpr int BM = 256, BK = 64, HALF = 128, HTB = HALF * BK * 2, STAGE_BYTES = 8 * HTB, NXCD = 8, WGM = 8;
__host__ __device__ __forceinline__ int lds_byte(int r, int c) { const int st = (r >> 4) * 2 + (c >> 5), rr = r & 15, cc = c & 31, ob = rr * 64 + cc * 2; return st * 1024 + (ob ^ (((ob >> 9) & 1) << 5)); }
__host__ __device__ __forceinline__ void stage_rc(int b, int& R, int& C) { const int st = b / 1024, sb = b % 1024, swz = sb ^ (((sb >> 9) & 1) << 5); R = (st >> 1) * 16 + swz / 64; C = (st & 1) * 32 + (swz % 64) / 2; }
__host__ __device__ __forceinline__ int perm32(int rho) { const int n = rho >> 4, i = rho & 15; return 8 * (i >> 2) + 4 * n + (i & 3); }

struct Unit { int pm, pn, e; };
struct Gemm { const void* A; const void* Bt; int KB; size_t estride; };

struct StaticOrder {
    int nM, nN, nwg, G, c;
    __device__ __forceinline__ void init(int nM_, int nN_, int G_, int c_) { nM = nM_; nN = nN_; nwg = nM * nN; G = G_; c = c_; }
    __device__ __forceinline__ bool next(int i, Unit& u) const {
        const long L = (long)i * G + c; if (L >= nwg) return false;
        int wgid = (int)L; { const int q = nwg / NXCD, r = nwg % NXCD, xcd = wgid % NXCD, off = wgid / NXCD; wgid = (xcd < r ? xcd * (q + 1) : r * (q + 1) + (xcd - r) * q) + off; }
        const int nig = WGM * nN, gid = wgid / nig, fm = gid * WGM, gsz = (nM - fm) < WGM ? (nM - fm) : WGM;
        u.pm = fm + ((wgid % nig) % gsz); u.pn = (wgid % nig) / gsz; u.e = 0; return true;
    }
};
struct MoeOrder {
    StaticOrder S; int t1, t2, t3, t4, t5, t6, t7;
    __device__ __forceinline__ bool next(int i, Unit& u) const {
        if (!S.next(i, u)) return false;
        const int p = u.pm; u.e = __builtin_amdgcn_readfirstlane((p >= t1) + (p >= t2) + (p >= t3) + (p >= t4) + (p >= t5) + (p >= t6) + (p >= t7)); return true;
    }
};

struct EpiBf16 {
    static constexpr bool PERM = true;
    bf16_t* O; int ldc;
    __device__ __forceinline__ void operator()(const f32x4 (&acc)[2][2][4][2], const Unit& u, int wr, int wc, int fr, int fq) const {
        const int row0 = u.pm * BM + wr * 64 + fr, col0 = u.pn * BM + wc * 32 + 8 * fq;
#pragma unroll
        for (int ai = 0; ai < 2; ++ai)
#pragma unroll
            for (int m = 0; m < 4; ++m) { bf16_t* rowp = O + (size_t)(row0 + ai * HALF + m * 16) * ldc + col0;
#pragma unroll
                for (int bj = 0; bj < 2; ++bj) { const f32x4 v0 = acc[ai][bj][m][0], v1 = acc[ai][bj][m][1];
                    u32x4 w; w.x = cvt_pk_bf16(v0[0], v0[1]); w.y = cvt_pk_bf16(v0[2], v0[3]); w.z = cvt_pk_bf16(v1[0], v1[1]); w.w = cvt_pk_bf16(v1[2], v1[3]);
                    *(u32x4*)(rowp + bj * HALF) = w; } }
    }
};
__device__ __forceinline__ float silu_mul(float g, float u) { return g * __builtin_amdgcn_rcpf(1.0f + __builtin_amdgcn_exp2f(-1.4426950408889634f * g)) * u; }
struct EpiSwiglu {
    static constexpr bool PERM = true;
    bf16_t* O; int ldc;
    __device__ __forceinline__ void operator()(const f32x4 (&acc)[2][2][4][2], const Unit& u, int wr, int wc, int fr, int fq) const {
        const int row0 = u.pm * BM + wr * 64 + fr, col0 = u.pn * HALF + wc * 32 + 8 * fq;
#pragma unroll
        for (int ai = 0; ai < 2; ++ai)
#pragma unroll
            for (int m = 0; m < 4; ++m) { bf16_t* rowp = O + (size_t)(row0 + ai * HALF + m * 16) * ldc + col0;
                const f32x4 g0 = acc[ai][0][m][0], g1 = acc[ai][0][m][1], u0 = acc[ai][1][m][0], u1 = acc[ai][1][m][1];
                u32x4 w;
                w.x = cvt_pk_bf16(silu_mul(g0[0], u0[0]), silu_mul(g0[1], u0[1])); w.y = cvt_pk_bf16(silu_mul(g0[2], u0[2]), silu_mul(g0[3], u0[3]));
                w.z = cvt_pk_bf16(silu_mul(g1[0], u1[0]), silu_mul(g1[1], u1[1])); w.w = cvt_pk_bf16(silu_mul(g1[2], u1[2]), silu_mul(g1[3], u1[3]));
                *(u32x4*)rowp = w; }
    }
};
struct EpiSwigluF8 {
    static constexpr bool PERM = true;
    unsigned char* O; int ldc;
    __device__ __forceinline__ void operator()(const f32x4 (&acc)[2][2][4][2], const Unit& u, int wr, int wc, int fr, int fq) const {
        const int row0 = u.pm * BM + wr * 64 + fr, col0 = u.pn * HALF + wc * 32 + 8 * fq;
#pragma unroll
        for (int ai = 0; ai < 2; ++ai)
#pragma unroll
            for (int m = 0; m < 4; ++m) { unsigned char* rowp = O + (size_t)(row0 + ai * HALF + m * 16) * ldc + col0;
                const f32x4 g0 = acc[ai][0][m][0], g1 = acc[ai][0][m][1], u0 = acc[ai][1][m][0], u1 = acc[ai][1][m][1];
                u32x2 w;
                w.x = pk4_fp8(silu_mul(g0[0], u0[0]) * A8_SCALE, silu_mul(g0[1], u0[1]) * A8_SCALE, silu_mul(g0[2], u0[2]) * A8_SCALE, silu_mul(g0[3], u0[3]) * A8_SCALE);
                w.y = pk4_fp8(silu_mul(g1[0], u1[0]) * A8_SCALE, silu_mul(g1[1], u1[1]) * A8_SCALE, silu_mul(g1[2], u1[2]) * A8_SCALE, silu_mul(g1[3], u1[3]) * A8_SCALE);
                *(u32x2*)rowp = w; }
    }
};
struct EpiResF32 {
    static constexpr bool PERM = false;
    const float* R; float* O; int ldc;
    __device__ __forceinline__ void operator()(const f32x4 (&acc)[2][2][4][2], const Unit& u, int wr, int wc, int fr, int fq) const {
        const int col0 = u.pn * BM + wc * 32 + 4 * fq;
#pragma unroll
        for (int ai = 0; ai < 2; ++ai)
#pragma unroll
            for (int m = 0; m < 4; ++m) { const size_t off = (size_t)(u.pm * BM + ai * HALF + wr * 64 + m * 16 + fr) * ldc + col0;
#pragma unroll
                for (int bj = 0; bj < 2; ++bj)
#pragma unroll
                    for (int n = 0; n < 2; ++n) { const f32x4 bs = *(const f32x4*)(R + off + bj * HALF + n * 16); *(f32x4*)(O + off + bj * HALF + n * 16) = bs + acc[ai][bj][m][n]; }
                asm volatile("" ::: "memory"); }
    }
};
struct EpiF32 {
    static constexpr bool PERM = false;
    float* O; int ldc;
    __device__ __forceinline__ void operator()(const f32x4 (&acc)[2][2][4][2], const Unit& u, int wr, int wc, int fr, int fq) const {
        const int col0 = u.pn * BM + wc * 32 + 4 * fq;
#pragma unroll
        for (int ai = 0; ai < 2; ++ai)
#pragma unroll
            for (int m = 0; m < 4; ++m) { const size_t off = (size_t)(u.pm * BM + ai * HALF + wr * 64 + m * 16 + fr) * ldc + col0;
#pragma unroll
                for (int bj = 0; bj < 2; ++bj)
#pragma unroll
                    for (int n = 0; n < 2; ++n) *(f32x4*)(O + off + bj * HALF + n * 16) = acc[ai][bj][m][n]; }
    }
};

__device__ __forceinline__ void mfma_f8_tied(f32x4& c, i32x8 a, i32x8 b, int sa, int sb) {
    asm volatile("v_mfma_scale_f32_16x16x128_f8f6f4 %0, %1, %2, %0, %3, %4 op_sel_hi:[0,0,0]" : "+v"(c) : "v"(a), "v"(b), "v"(sa), "v"(sb)); }
__device__ __forceinline__ void mfma_f8_drain() { asm volatile("s_nop 15\n\ts_nop 15" ::: "memory"); }
__device__ __forceinline__ void glds16s(unsigned voff, const char* sbase, unsigned lds_dst) { unsigned keep;
    asm volatile("s_mov_b32 %0, m0\n\ts_mov_b32 m0, %3\n\ts_nop 0\n\tglobal_load_lds_dwordx4 %1, %2\n\ts_mov_b32 m0, %0" : "=&s"(keep) : "v"(voff), "s"(sbase), "s"(lds_dst) : "memory"); }
template <class Epi, class Sched, bool F8 = false, int SCW = SC_ONE, int SCX = SC_ONE>
__device__ __forceinline__ void gemm_phase(LAS unsigned char* lds, const Gemm g, const Sched& S, const Epi& E) {
    const int tid = ltid(), wid = __builtin_amdgcn_readfirstlane(tid >> 6), lane = tid & 63, wr = wid >> 2, wc = wid & 3, fr = lane & 15, fq = lane >> 4;
    const int KB = g.KB, nt = KB / 128;
    int scw_ = SCW, scx_ = SCX; if constexpr (F8) { asm volatile("" : "+v"(scw_), "+v"(scx_)); }
    unsigned voffA[2], voffB[2];
#pragma unroll
    for (int i = 0; i < 2; ++i) { int R, C; stage_rc(tid * 16 + i * 8192, R, C); const int Rb = Epi::PERM ? ((R & ~31) + perm32(R & 31)) : R;
        voffA[i] = (unsigned)(R * KB + C * 2); voffB[i] = (unsigned)(Rb * KB + C * 2); }
    const size_t kstep = (size_t)128;
    const size_t hstep = (size_t)HALF * KB;
    const size_t tstep = 2 * hstep;
    const unsigned ldsb = (unsigned)(uintptr_t)lds + (unsigned)wid * 1024u;
    const int aoff = lds_byte(wr * 64 + fr, fq * 8), boff = lds_byte(wc * 32 + fr, fq * 8);
#define PG8_SA(b, h) (((b) * 2 + (h)) * HTB)
#define PG8_SB(b, h) ((4 + (b) * 2 + (h)) * HTB)
#define PG8_STAGE(bufoff, gbase, voff) do { _Pragma("unroll") for (int _i = 0; _i < 2; ++_i) \
        glds16s((voff)[_i], (const char*)(gbase), ldsb + (unsigned)((bufoff) + _i * 8192)); } while (0)
#define PG8_LDA(dst, b, h) do { _Pragma("unroll") for (int m = 0; m < 4; ++m) _Pragma("unroll") for (int k = 0; k < 2; ++k) dst[m][k] = *(const LAS bf16x8*)(lds + PG8_SA(b, h) + aoff + m * 2048 + k * 1024); } while (0)
#define PG8_LDB(dst, b, h) do { _Pragma("unroll") for (int n = 0; n < 2; ++n) _Pragma("unroll") for (int k = 0; k < 2; ++k) dst[n][k] = *(const LAS bf16x8*)(lds + PG8_SB(b, h) + boff + n * 2048 + k * 1024); } while (0)
#define PG8_CAT8(x) __builtin_shufflevector(__builtin_bit_cast(i32x4, (x)[0]), __builtin_bit_cast(i32x4, (x)[1]), 0, 1, 2, 3, 4, 5, 6, 7)
#define PG8_MMA(ai, bj, At, Bt) do { __builtin_amdgcn_s_setprio(1); \
        if constexpr (F8) { _Pragma("unroll") for (int m = 0; m < 4; ++m) _Pragma("unroll") for (int n = 0; n < 2; ++n) \
            mfma_f8_tied(acc[ai][bj][m][n], PG8_CAT8(Bt[n]), PG8_CAT8(At[m]), scw_, scx_); } \
        else { _Pragma("unroll") for (int m = 0; m < 4; ++m) _Pragma("unroll") for (int n = 0; n < 2; ++n) _Pragma("unroll") for (int k = 0; k < 2; ++k) \
            acc[ai][bj][m][n] = __builtin_amdgcn_mfma_f32_16x16x32_bf16(Bt[n][k], At[m][k], acc[ai][bj][m][n], 0, 0, 0); } \
        __builtin_amdgcn_s_setprio(0); } while (0)
#define PG8_WAIT_V(n) asm volatile("s_waitcnt vmcnt(" #n ")" ::: "memory")
#define PG8_WAIT_L(n) asm volatile("s_waitcnt lgkmcnt(" #n ")" ::: "memory")
#define PG8_BAR __builtin_amdgcn_s_barrier()
#define PG8_SCHED __builtin_amdgcn_sched_barrier(0)
    Unit cur, nxt; int ui = 0;
    if (!S.next(0, cur)) return;
    f32x4 acc[2][2][4][2];
#pragma unroll
    for (int a = 0; a < 2; ++a)
#pragma unroll
        for (int b = 0; b < 2; ++b)
#pragma unroll
            for (int m = 0; m < 4; ++m)
#pragma unroll
                for (int n = 0; n < 2; ++n) acc[a][b][m][n] = (f32x4){0.f, 0.f, 0.f, 0.f};
    bf16x8 At[4][2], B0[2][2], B1[2][2];
    const char* cA = (const char*)g.A + (size_t)cur.pm * tstep; const char* cB = (const char*)g.Bt + (size_t)cur.e * g.estride + (size_t)cur.pn * tstep;
    PG8_STAGE(PG8_SB(0, 0), cB, voffB); PG8_STAGE(PG8_SB(0, 1), cB + hstep, voffB); PG8_STAGE(PG8_SA(0, 0), cA, voffA); PG8_STAGE(PG8_SA(0, 1), cA + hstep, voffA);
    if (wr == 1) PG8_BAR;
    PG8_WAIT_V(2); PG8_BAR;
    PG8_STAGE(PG8_SB(1, 0), cB + kstep, voffB); PG8_STAGE(PG8_SA(1, 0), cA + kstep, voffA); PG8_STAGE(PG8_SB(1, 1), cB + hstep + kstep, voffB);
    PG8_WAIT_V(6); PG8_BAR;
    for (;;) {
        const bool has_next = S.next(ui + 1, nxt);
        const char* nA = has_next ? (const char*)g.A + (size_t)nxt.pm * tstep : cA; const char* nB = has_next ? (const char*)g.Bt + (size_t)nxt.e * g.estride + (size_t)nxt.pn * tstep : cB;
        for (int t = 0; t < nt; t += 2) {
            const bool last = (t == nt - 2);
            const char* a1 = cA + (size_t)(t + 1) * kstep;
            const char* a2 = last ? nA : cA + (size_t)(t + 2) * kstep; const char* b2 = last ? nB : cB + (size_t)(t + 2) * kstep;
            const char* a3 = a2 + kstep; const char* b3 = b2 + kstep;
            PG8_LDB(B0, 0, 0); PG8_LDB(B1, 0, 1); PG8_SCHED; PG8_LDA(At, 0, 0); PG8_STAGE(PG8_SA(1, 1), a1 + hstep, voffA);
            PG8_WAIT_V(8); PG8_WAIT_L(0); PG8_BAR; PG8_MMA(0, 0, At, B0); PG8_MMA(0, 1, At, B1); PG8_BAR; PG8_SCHED;
            PG8_LDA(At, 0, 1); PG8_STAGE(PG8_SB(0, 0), b2, voffB); PG8_STAGE(PG8_SB(0, 1), b2 + hstep, voffB); PG8_STAGE(PG8_SA(0, 0), a2, voffA);
            PG8_WAIT_V(8); PG8_WAIT_L(0); PG8_BAR; PG8_MMA(1, 0, At, B0); PG8_MMA(1, 1, At, B1); PG8_BAR; PG8_SCHED;
            PG8_LDB(B0, 1, 0); PG8_LDB(B1, 1, 1); PG8_SCHED; PG8_LDA(At, 1, 0); PG8_STAGE(PG8_SA(0, 1), a2 + hstep, voffA);
            PG8_WAIT_V(8); PG8_WAIT_L(0); PG8_BAR; PG8_MMA(0, 0, At, B0); PG8_MMA(0, 1, At, B1); PG8_BAR; PG8_SCHED;
            PG8_LDA(At, 1, 1); PG8_STAGE(PG8_SB(1, 0), b3, voffB); PG8_STAGE(PG8_SB(1, 1), b3 + hstep, voffB); PG8_STAGE(PG8_SA(1, 0), a3, voffA);
            PG8_WAIT_V(8); PG8_WAIT_L(0); PG8_BAR; PG8_MMA(1, 0, At, B0); PG8_MMA(1, 1, At, B1); PG8_BAR; PG8_SCHED;
        }
        if (wr == 0) PG8_BAR;
        if constexpr (F8) mfma_f8_drain();
        E(acc, cur, wr, wc, fr, fq);
        if (!has_next) break;
#pragma unroll
        for (int a = 0; a < 2; ++a)
#pragma unroll
            for (int b = 0; b < 2; ++b)
#pragma unroll
                for (int m = 0; m < 4; ++m)
#pragma unroll
                    for (int n = 0; n < 2; ++n) acc[a][b][m][n] = (f32x4){0.f, 0.f, 0.f, 0.f};
        cur = nxt; cA = nA; cB = nB; ++ui;
        if (wr == 1) PG8_BAR;
    }
    PG8_WAIT_V(0);
    PG8_BAR;
#undef PG8_SA
#undef PG8_SB
#undef PG8_STAGE
#undef PG8_LDA
#undef PG8_LDB
#undef PG8_MMA
#undef PG8_CAT8
#undef PG8_WAIT_V
#undef PG8_WAIT_L
#undef PG8_BAR
#undef PG8_SCHED
}
}

namespace att {
constexpr int D = 128, LDZ = INW, LDO = DM;
constexpr float SCALE = 0.08838834764831845f;
constexpr float THR = 8.f;
constexpr int NW = 8, QBLK = 32, KVBLK = 64, QB = NW * QBLK;
constexpr int SHM_V = KVBLK * D * 2, SHM_K = KVBLK * D * 2;
constexpr int ATT_LDS_BYTES = 2 * SHM_V + 2 * SHM_K + NW * 64 * 4;
#define KSWZ(row, colB) ((row) * 256 + ((colB) ^ (((row) & 7) << 4)))
#define SBAR() __builtin_amdgcn_sched_barrier(0)
__device__ __forceinline__ int v_st(int k, int c) { const int kk = (k & ~0xC) | ((k & 4) << 1) | ((k & 8) >> 1); return ((kk >> 3) * 4 + (c >> 5)) * 512 + ((kk & 7) * 32 + (c & 31)) * 2; }
__device__ __forceinline__ int v_rd_base(int lane) { return ((lane & 3) << 3) | (((lane >> 2) & 3) << 6) | (((lane >> 4) & 1) << 5) | (((lane >> 5) & 1) << 8); }
constexpr int v_rd_off(int d0, int ks, int half) { return d0 * 512 + ks * 4096 + half * 2048; }
__device__ __forceinline__ int crow(int r, int hi) { return (r & 3) + 8 * (r >> 2) + 4 * hi; }
__device__ __forceinline__ bf16x8 load8(const bf16_t* p) { return *reinterpret_cast<const bf16x8*>(p); }
__device__ __forceinline__ void mask_tile(f32x16& p0, f32x16& p1, int dq, unsigned W) {
    const float NEG = -__builtin_inff();
#pragma unroll
    for (int r = 0; r < 16; ++r) {
        const int c = (r & 3) + 8 * (r >> 2);
        if ((unsigned)(dq - c) >= W) p0[r] = NEG;
        if ((unsigned)(dq - c - 32) >= W) p1[r] = NEG;
    }
}
__device__ __forceinline__ void partialSM(f32x16& p0, f32x16& p1, float& m_reg, float& mn, float& alpha) {
    float pmax = p0[0];
#pragma unroll
    for (int r = 1; r < 16; ++r) pmax = fmaxf(pmax, p0[r]);
#pragma unroll
    for (int r = 0; r < 16; ++r) pmax = fmaxf(pmax, p1[r]);
    { auto rr = __builtin_amdgcn_permlane32_swap(__float_as_uint(pmax), __float_as_uint(pmax), false, false);
      pmax = fmaxf(__uint_as_float(rr[0]), __uint_as_float(rr[1])); }
    constexpr float C2 = 1.4426950408889634f * SCALE;
    if (__builtin_expect(__all((pmax - m_reg) * SCALE <= THR), 1)) { mn = m_reg; alpha = 1.f; }
    else { mn = fmaxf(m_reg, pmax); alpha = __builtin_amdgcn_exp2f((m_reg - mn) * C2); m_reg = mn; }
    const float mnL = -mn * C2;
#pragma unroll
    for (int r = 0; r < 16; ++r) p0[r] = fmaf(p0[r], C2, mnL);
#pragma unroll
    for (int r = 0; r < 16; ++r) p1[r] = fmaf(p1[r], C2, mnL);
#pragma unroll
    for (int r = 0; r < 16; ++r) p0[r] = __builtin_amdgcn_exp2f(p0[r]);
}
__device__ __forceinline__ void finishSM(f32x16& p0, f32x16& p1, float alpha, float& l_reg, bf16x8& pa0, bf16x8& pa1, bf16x8& pa2, bf16x8& pa3) {
#pragma unroll
    for (int r = 0; r < 16; ++r) p1[r] = __builtin_amdgcn_exp2f(p1[r]);
    float ps = 0;
#pragma unroll
    for (int r = 0; r < 16; ++r) ps += p0[r];
#pragma unroll
    for (int r = 0; r < 16; ++r) ps += p1[r];
    { auto rr = __builtin_amdgcn_permlane32_swap(__float_as_uint(ps), __float_as_uint(ps), false, false);
      ps = __uint_as_float(rr[0]) + __uint_as_float(rr[1]); }
    l_reg = l_reg * alpha + ps;
#define PK4(P, B_, OUT) do { unsigned a0 = cvt_pk_bf16(P[B_+0], P[B_+1]), a1 = cvt_pk_bf16(P[B_+2], P[B_+3]);                          \
        unsigned b0 = cvt_pk_bf16(P[B_+4], P[B_+5]), b1 = cvt_pk_bf16(P[B_+6], P[B_+7]);                                             \
        auto r0 = __builtin_amdgcn_permlane32_swap(a0, b0, false, false); auto r1 = __builtin_amdgcn_permlane32_swap(a1, b1, false, false); \
        u32x4 w = {r0[0], r1[0], r0[1], r1[1]}; OUT = *reinterpret_cast<bf16x8*>(&w); } while (0)
    PK4(p0, 0, pa0); PK4(p0, 8, pa1); PK4(p1, 0, pa2); PK4(p1, 8, pa3);
#undef PK4
}
template <int KB>
__device__ __forceinline__ void qkt(f32x16& p0, f32x16& p1, const char* K_lds, int r32, int hi, const bf16x8* qr) {
    p0 = f32x16{}; p1 = f32x16{};
    const char* kb[4];
#pragma unroll
    for (int dd = 0; dd < 4; ++dd) kb[dd] = K_lds + KB * SHM_K + KSWZ(r32, (dd * 16 + hi * 8) * 2);
#pragma unroll
    for (int d0 = 0; d0 < 8; ++d0) { const char* a = kb[d0 & 3] + (d0 >> 2) * 128;
        bf16x8 b0 = *reinterpret_cast<const bf16x8*>(a);
        bf16x8 b1 = *reinterpret_cast<const bf16x8*>(a + 32 * 256);
        p0 = __builtin_amdgcn_mfma_f32_32x32x16_bf16(b0, qr[d0], p0, 0, 0, 0);
        p1 = __builtin_amdgcn_mfma_f32_32x32x16_bf16(b1, qr[d0], p1, 0, 0, 0); }
}
template <int VB>
__device__ __forceinline__ void pv_tile(f32x16* o, int vb0, bf16x8 pa0, bf16x8 pa1, bf16x8 pa2, bf16x8 pa3) {
#define TRRD(dst, off) asm volatile("ds_read_b64_tr_b16 %0, %1 offset:%2" : "=&v"(dst) : "v"(vb0), "i"(off) : "memory")
#define PV_D0(d0) do { s16x4 l0, l1, l2, l3, h0, h1, h2, h3; constexpr int b_ = VB * SHM_V + v_rd_off(d0, 0, 0); \
        TRRD(l0, b_); TRRD(h0, b_ + 2048); TRRD(l1, b_ + 4096); TRRD(h1, b_ + 6144); TRRD(l2, b_ + 8192); TRRD(h2, b_ + 10240); TRRD(l3, b_ + 12288); TRRD(h3, b_ + 14336); \
        asm volatile("s_waitcnt lgkmcnt(0)" ::: "memory"); SBAR();   \
        o[d0] = __builtin_amdgcn_mfma_f32_32x32x16_bf16(pa0, (bf16x8){l0[0], l0[1], l0[2], l0[3], h0[0], h0[1], h0[2], h0[3]}, o[d0], 0, 0, 0);   \
        o[d0] = __builtin_amdgcn_mfma_f32_32x32x16_bf16(pa1, (bf16x8){l1[0], l1[1], l1[2], l1[3], h1[0], h1[1], h1[2], h1[3]}, o[d0], 0, 0, 0);   \
        o[d0] = __builtin_amdgcn_mfma_f32_32x32x16_bf16(pa2, (bf16x8){l2[0], l2[1], l2[2], l2[3], h2[0], h2[1], h2[2], h2[3]}, o[d0], 0, 0, 0);   \
        o[d0] = __builtin_amdgcn_mfma_f32_32x32x16_bf16(pa3, (bf16x8){l3[0], l3[1], l3[2], l3[3], h3[0], h3[1], h3[2], h3[3]}, o[d0], 0, 0, 0); } while (0)
    PV_D0(0); PV_D0(1); PV_D0(2); PV_D0(3);
#undef PV_D0
#undef TRRD
}
struct BlockRef { const bf16_t* Q; const bf16_t* K; const bf16_t* V; float* O; int P0; };
struct Seam { bf16x8 qr[8]; bf16x8 st_v0, st_v1, st_k0, st_k1; };
#define ROW(p, k0, rr) ((p) + (size_t)((k0) + (rr)) * LDZ + sc)
#define VMW() asm volatile("s_waitcnt vmcnt(0)" ::: "memory")
#define VMWN(n) asm volatile("s_waitcnt vmcnt(%0)" :: "i"(n) : "memory")
#define SLOAD_H(Kp, Vp, k0) do { S.st_v0 = load8(ROW(Vp, k0, sr)); S.st_v1 = load8(ROW(Vp, k0, 32 + sr));              \
                         S.st_k0 = load8(ROW(Kp, k0, sr)); S.st_k1 = load8(ROW(Kp, k0, 32 + sr)); } while (0)
#define SWRITE_HK(bf) do { *(bf16x8*)(K_lds + (bf) * SHM_K + kws) = S.st_k0; *(bf16x8*)(K_lds + (bf) * SHM_K + kws + 32 * 256) = S.st_k1; } while (0)
#define SWRITE_HV(bf) do { *(bf16x8*)(V_lds + (bf) * SHM_V + vst0) = S.st_v0; *(bf16x8*)(V_lds + (bf) * SHM_V + vst1) = S.st_v1; } while (0)
#define SWRITE_H(bf) do { SWRITE_HV(bf); SWRITE_HK(bf); } while (0)
__device__ __forceinline__ void causal_prime(const BlockRef& cur, char* lds, Seam& S) {
    const int tid = ltid(), wid = __builtin_amdgcn_readfirstlane(tid >> 6), lane = tid & 63, r32 = lane & 31, hi = lane >> 5;
    const int sr = tid >> 4, sc = (tid & 15) * 8, kws = KSWZ(sr, sc * 2); char* K_lds = lds + 2 * SHM_V;
    const int kb0 = 0;
#pragma unroll
    for (int d0 = 0; d0 < 8; ++d0) S.qr[d0] = load8(cur.Q + (size_t)(wid * QBLK + r32) * LDZ + d0 * 16 + hi * 8);
    SLOAD_H(cur.K, cur.V, kb0); VMW(); SWRITE_HK(0);
    __syncthreads();
}
__device__ __forceinline__ void causal_block(const BlockRef& cur, const BlockRef& nxt, int skv, char* lds, Seam& S) {
    const int tid = ltid(), wid = __builtin_amdgcn_readfirstlane(tid >> 6), lane = tid & 63, r32 = lane & 31, hi = lane >> 5;
    const int W = 1 << 30;
    const int j_lo = 0;
    int j_hi = (cur.P0 + QB - 1) / KVBLK + 1; if (j_hi > skv / KVBLK) j_hi = skv / KVBLK;
    const int NT = j_hi - j_lo;
    const int kbn = 0;
    const int qlo = cur.P0 + wid * QBLK, qm = qlo + r32 - 4 * hi;
    char* V_lds = lds; char* K_lds = lds + 2 * SHM_V;
    float* ws = (float*)(lds + 2 * SHM_V + 2 * SHM_K) + wid * 64; float* li_l = ws, * al_l = ws + 32;
    float m_reg = -1e30f, l_reg = 0; f32x16 o[4];
    { float z_ = 0.f; asm volatile("" : "+v"(z_));
#pragma unroll
      for (int d_ = 0; d_ < 4; ++d_)
#pragma unroll
          for (int r = 0; r < 16; ++r) o[d_][r] = z_; }
    const int sr = tid >> 4, sc = (tid & 15) * 8, vst0 = v_st(sr, sc), vst1 = v_st(32 + sr, sc), kws = KSWZ(sr, sc * 2);
    const int vb0 = (int)(uintptr_t)V_lds + v_rd_base(lane);
    const bf16_t* Kh = cur.K; const bf16_t* Vh = cur.V;
#define RESC(a) do { if (__any((a) < 1.f)) { if (hi == 0) al_l[r32] = (a); asm volatile("s_waitcnt lgkmcnt(0)" ::: "memory");              \
                     _Pragma("unroll") for (int d_ = 0; d_ < 4; ++d_) _Pragma("unroll") for (int r = 0; r < 16; ++r) o[d_][r] *= al_l[crow(r, hi)]; } } while (0)
#define KBASE(t) ((j_lo + (t)) * KVBLK)
#define MASKT(P0_, P1_, t) do { const int kb_ = KBASE(t); if (kb_ + KVBLK - 1 > qlo) mask_tile(P0_, P1_, qm - kb_, (unsigned)W); } while (0)
    constexpr int NQL = 8;
#define SEAM_K0() do { VMWN(NQL); SWRITE_HK(0); SBAR(); } while (0)
    f32x16 pA0, pA1, pB0, pB1; float mnA, mnB, alA, alB; bf16x8 pa0, pa1, pa2, pa3;
    SWRITE_HV(0); SBAR();
    if (NT > 1) { SLOAD_H(Kh, Vh, KBASE(1)); }
    SBAR(); qkt<0>(pA0, pA1, K_lds, r32, hi, S.qr);
    MASKT(pA0, pA1, 0); partialSM(pA0, pA1, m_reg, mnA, alA);
    if (NT > 1) { VMW(); SWRITE_H(1); }
    __syncthreads();
#define HALF_STEP(PX0, PX1, mnX, alX, PY0, PY1, alY, t, KB, VB, SB) do {                                                      \
        SBAR(); qkt<KB>(PX0, PX1, K_lds, r32, hi, S.qr);                                                                      \
        finishSM(PY0, PY1, alY, l_reg, pa0, pa1, pa2, pa3); SBAR();                                                           \
        if ((t) + 1 < NT) { SLOAD_H(Kh, Vh, KBASE((t) + 1)); SBAR(); }                                                        \
        pv_tile<VB>(o, vb0, pa0, pa1, pa2, pa3); MASKT(PX0, PX1, (t)); partialSM(PX0, PX1, m_reg, mnX, alX);                  \
        __syncthreads();                                                                                                      \
        if ((t) + 1 < NT) { VMW(); SWRITE_H(SB); }                                                                            \
        RESC(alX); __syncthreads(); } while (0)
    for (int t = 1; t + 1 < NT; t += 2) {
        HALF_STEP(pB0, pB1, mnB, alB, pA0, pA1, alA, t, 1, 0, 0);
        HALF_STEP(pA0, pA1, mnA, alA, pB0, pB1, alB, t + 1, 0, 1, 1);
    }
    const bool even = (NT & 1) == 0;
    if (even) { SBAR(); qkt<1>(pB0, pB1, K_lds, r32, hi, S.qr); SBAR(); }
    SLOAD_H(nxt.K, nxt.V, kbn); SBAR();
#pragma unroll
    for (int d0 = 0; d0 < 8; ++d0) S.qr[d0] = load8(nxt.Q + (size_t)(wid * QBLK + r32) * LDZ + d0 * 16 + hi * 8);
    SBAR();
    finishSM(pA0, pA1, alA, l_reg, pa0, pa1, pa2, pa3); SBAR();
    pv_tile<0>(o, vb0, pa0, pa1, pa2, pa3);
    if (even) { MASKT(pB0, pB1, NT - 1); partialSM(pB0, pB1, m_reg, mnB, alB); __syncthreads(); RESC(alB);
        finishSM(pB0, pB1, alB, l_reg, pa0, pa1, pa2, pa3); SBAR(); pv_tile<1>(o, vb0, pa0, pa1, pa2, pa3); }
    SBAR(); SEAM_K0();
    if (hi == 0) li_l[r32] = l_reg; asm volatile("s_waitcnt lgkmcnt(0)" ::: "memory");
    float rli[16];
#pragma unroll
    for (int r = 0; r < 16; ++r) rli[r] = __builtin_amdgcn_rcpf(li_l[crow(r, hi)]);
    float* Ow = cur.O + (size_t)(wid * QBLK) * LDO;
#pragma unroll
    for (int r = 0; r < 16; ++r) { const int orow = crow(r, hi);
#pragma unroll
        for (int d0 = 0; d0 < 4; ++d0) { const float v = o[d0][r] * rli[r]; Ow[(size_t)orow * LDO + d0 * 32 + r32] = v; } }
    __syncthreads();
#undef RESC
#undef KBASE
#undef MASKT
#undef SEAM_K0
#undef HALF_STEP
}
#undef ROW
#undef VMW
#undef VMWN
#undef SLOAD_H
#undef SWRITE_HK
#undef SWRITE_HV
#undef SWRITE_H
#undef KSWZ
#undef SBAR
}

#define XB_TMO      128
#define XB_XCNT(j)  (256  + 64 * (j))
#define XB_XSUB(j)  (1280 + 64 * (j))
#define XB_XGEN(j)  (2304 + 64 * (j))
#define XB_TOP      3328
#define XB_TOPGEN   3392
#define XCD_BAR_WORDS 3456
#define XB_SPIN_CAP (1u << 18)

__device__ __forceinline__ unsigned xb_ld(unsigned* p)              { return __hip_atomic_load(p, __ATOMIC_RELAXED, __HIP_MEMORY_SCOPE_AGENT); }
__device__ __forceinline__ unsigned xb_add(unsigned* p, unsigned v) { return __hip_atomic_fetch_add(p, v, __ATOMIC_RELAXED, __HIP_MEMORY_SCOPE_AGENT); }
__device__ __forceinline__ unsigned xb_xcc_id() { return (unsigned)__builtin_amdgcn_s_getreg((3 << 11) | 20) & 0xFu; }
#define XB_SPIN(cond, bar) do { unsigned _sp = 0; while (cond) { __builtin_amdgcn_s_sleep(1); \
    if ((++_sp & 255u) == 0u) { if (xb_ld(&(bar)[XB_TMO])) break; if (_sp > XB_SPIN_CAP) { atomicAdd(&(bar)[XB_TMO], 1u); break; } } } } while (0)

struct XcdBarrier {
    unsigned* bar; unsigned x;
    volatile LAS unsigned* st;
};

__device__ __forceinline__ XcdBarrier xcd_barrier_post(unsigned* bar, volatile LAS unsigned* st) {
    XcdBarrier b; b.bar = bar; b.x = xb_xcc_id(); b.st = st;
    if (threadIdx.x == 0) (void)xb_add(&bar[XB_XCNT(b.x)], 1u);
    return b;
}
__device__ __forceinline__ void xcd_barrier_complete(unsigned* bar, unsigned x, unsigned& nloc, unsigned& nx) {
    const unsigned G = gridDim.x * gridDim.y * gridDim.z;
    unsigned sum, cnt, mine, sp = 0u;
    for (;;) {
        sum = 0u; cnt = 0u; mine = 0u;
#pragma unroll
        for (unsigned j = 0; j < 16; ++j) { const unsigned c = xb_ld(&bar[XB_XCNT(j)]); sum += c; cnt += (c > 0u) ? 1u : 0u; mine = (j == x) ? c : mine; }
        if (sum == G) break;
        __builtin_amdgcn_s_sleep(1);
        if ((++sp & 255u) == 0u) { if (xb_ld(&bar[XB_TMO])) break; if (sp > XB_SPIN_CAP) { atomicAdd(&bar[XB_TMO], 1u); break; } }
    }
    nloc = mine > 0u ? mine : 1u; nx = cnt > 0u ? cnt : 1u;
}

template <bool FIRST> __device__ __forceinline__ void xcd_barrier(const XcdBarrier& b) {
    asm volatile("s_waitcnt vmcnt(0)" ::: "memory");
    __syncthreads();
    if (threadIdx.x == 0) {
        unsigned* bar = b.bar;
        __builtin_amdgcn_s_waitcnt(0);
        unsigned nloc = b.st[0], nx = b.st[1];
        if (FIRST) { if (nloc == 0u) { xcd_barrier_complete(bar, b.x, nloc, nx); b.st[0] = nloc; b.st[1] = nx; } }
        const unsigned old = xb_add(&bar[XB_XSUB(b.x)], 1u);
        const unsigned gen = old / nloc;
        if (old + 1u == (gen + 1u) * nloc) {
            __builtin_amdgcn_fence(__ATOMIC_RELEASE, "agent");
            asm volatile("s_waitcnt vmcnt(0)" ::: "memory");
            const unsigned og = xb_add(&bar[XB_TOP], 1u);
            const unsigned tg = og / nx;
            if (og + 1u == (tg + 1u) * nx) xb_add(&bar[XB_TOPGEN], 1u);
            else XB_SPIN(xb_ld(&bar[XB_TOPGEN]) == tg, bar);
            __builtin_amdgcn_fence(__ATOMIC_ACQUIRE, "agent");
            xb_add(&bar[XB_XGEN(b.x)], 1u);
            asm volatile("s_waitcnt vmcnt(0)" ::: "memory");
        } else {
            XB_SPIN(xb_ld(&bar[XB_XGEN(b.x)]) == gen, bar);
            __builtin_amdgcn_fence(__ATOMIC_ACQUIRE, "agent");
            asm volatile("s_waitcnt vmcnt(0)" ::: "memory");
        }
    }
    __syncthreads();
}

template <int KT, bool F8>
__device__ __forceinline__ void transpose_item(const float* W, int K, int N, void* WT, int drow0, int k0, int n0, LAS float* scr, int lane) {
    const int kr = lane >> 3, n4 = 4 * (lane & 7);
    f32x4 v[KT / 8];
#pragma unroll
    for (int i = 0; i < KT / 8; ++i) v[i] = *(const f32x4*)(W + (size_t)(k0 + kr + 8 * i) * N + n0 + n4);
#pragma unroll
    for (int i = 0; i < KT / 8; ++i) { LAS float* s = scr + (kr + 8 * i) * 33 + n4; s[0] = v[i][0]; s[1] = v[i][1]; s[2] = v[i][2]; s[3] = v[i][3]; }
    LDS_WAIT(); asm volatile("" ::: "memory");
    const int c = lane & 7;
#pragma unroll
    for (int j = 0; j < 4; ++j) { const int n = (lane >> 3) + 8 * j;
        if constexpr (!F8) { static_assert(F8 || KT == 64, "bf16 item is 64 k");
            const LAS float* s = scr + (8 * c) * 33 + n;
            u32x4 o; o.x = cvt_pk_bf16(s[0 * 33], s[1 * 33]); o.y = cvt_pk_bf16(s[2 * 33], s[3 * 33]); o.z = cvt_pk_bf16(s[4 * 33], s[5 * 33]); o.w = cvt_pk_bf16(s[6 * 33], s[7 * 33]);
            *(u32x4*)((bf16_t*)WT + (size_t)(drow0 + n) * K + k0 + 8 * c) = o;
        } else { static_assert(!F8 || KT == 128, "fp8 item is 128 k");
            const LAS float* s = scr + (16 * c) * 33 + n;
            u32x4 o;
            o.x = pk4_fp8(s[0 * 33] * W8_SCALE, s[1 * 33] * W8_SCALE, s[2 * 33] * W8_SCALE, s[3 * 33] * W8_SCALE);
            o.y = pk4_fp8(s[4 * 33] * W8_SCALE, s[5 * 33] * W8_SCALE, s[6 * 33] * W8_SCALE, s[7 * 33] * W8_SCALE);
            o.z = pk4_fp8(s[8 * 33] * W8_SCALE, s[9 * 33] * W8_SCALE, s[10 * 33] * W8_SCALE, s[11 * 33] * W8_SCALE);
            o.w = pk4_fp8(s[12 * 33] * W8_SCALE, s[13 * 33] * W8_SCALE, s[14 * 33] * W8_SCALE, s[15 * 33] * W8_SCALE);
            *(u32x4*)((unsigned char*)WT + (size_t)(drow0 + n) * K + k0 + 16 * c) = o;
        } }
    LDS_WAIT(); asm volatile("" ::: "memory");
}
__device__ __forceinline__ float rms_row(const float* xrow, const float* g, bf16_t* orow, int lane) {
    const f32x4* xr = (const f32x4*)xrow + lane; const f32x4* gr = (const f32x4*)g + lane;
    f32x4 v[8]; float s = 0.f;
#pragma unroll
    for (int j = 0; j < 8; ++j) { v[j] = xr[64 * j]; s += (v[j].x * v[j].x + v[j].y * v[j].y) + (v[j].z * v[j].z + v[j].w * v[j].w); }
    const float rstd = 1.0f / sqrtf(wave_sum(s) * (1.0f / DM) + EPS);
    u32x2* o8 = (u32x2*)orow + lane;
#pragma unroll
    for (int j = 0; j < 8; ++j) { const f32x4 gg = gr[64 * j]; const f32x4 y = v[j] * rstd * gg; u32x2 w; w.x = cvt_pk_bf16(y.x, y.y); w.y = cvt_pk_bf16(y.z, y.w); o8[64 * j] = w; }
    return rstd;
}

__device__ __forceinline__ float rms_row_f8(const float* xrow, const float* g, unsigned char* orow, int lane) {
    const f32x4* xr = (const f32x4*)xrow + lane; const f32x4* gr = (const f32x4*)g + lane;
    f32x4 v[8]; float s = 0.f;
#pragma unroll
    for (int j = 0; j < 8; ++j) { v[j] = xr[64 * j]; s += (v[j].x * v[j].x + v[j].y * v[j].y) + (v[j].z * v[j].z + v[j].w * v[j].w); }
    const float rstd = 1.0f / sqrtf(wave_sum(s) * (1.0f / DM) + EPS);
    unsigned* o4 = (unsigned*)orow + lane;
#pragma unroll
    for (int j = 0; j < 8; ++j) { const f32x4 gg = gr[64 * j]; const f32x4 y = v[j] * rstd * gg; o4[64 * j] = pk4_fp8(y.x, y.y, y.z, y.w); }
    return rstd;
}

struct Args { const void* in[20]; float* out; unsigned char* ws; };

__global__ void __launch_bounds__(512, 2) hybrid_fwd(Args args) {
    extern __shared__ __attribute__((aligned(16))) unsigned char lds_raw[];
    LAS unsigned char* lds = (LAS unsigned char*)lds_raw;
    volatile LAS unsigned* LW = (volatile LAS unsigned*)(lds + LDSCTL_OFF);
    const int tid = threadIdx.x, lane = tid & 63, wave = __builtin_amdgcn_readfirstlane(tid >> 6);
    const int G = gridDim.x, bx = blockIdx.x;
    const int gw = bx * 8 + wave, NGW = G * 8;
    for (int u = tid; u < LDSCTL_BYTES / 4; u += 512) LW[u] = 0u;
    __syncthreads();
    if (tid < 22) { const unsigned long long pv = tid < 20 ? (unsigned long long)args.in[tid] : (tid == 20 ? (unsigned long long)args.out : (unsigned long long)args.ws);
        LW[64 + 2 * tid] = (unsigned)pv; LW[64 + 2 * tid + 1] = (unsigned)(pv >> 32); }
    __syncthreads();
#define PTR(i) ((unsigned long long)(unsigned)__builtin_amdgcn_readfirstlane((int)LW[64 + 2 * (i)]) | ((unsigned long long)(unsigned)__builtin_amdgcn_readfirstlane((int)LW[64 + 2 * (i) + 1]) << 32))
#define INF(i) ((const float*)(GAS const float*)PTR(i))
#define WSP(T, off) ((T*)(GAS T*)(PTR(21) + (unsigned long long)(off)))
#define OUTP ((float*)(GAS float*)PTR(20))
    { const XcdBarrier b0 = xcd_barrier_post(WSP(unsigned, WS_CTL) + CW_BAR, LW); if (threadIdx.x == 0) LW[2] = b0.x; }
    __syncthreads();
#define GRID_BAR_T(F) do { XcdBarrier b_; b_.bar = WSP(unsigned, WS_CTL) + CW_BAR; b_.x = (unsigned)__builtin_amdgcn_readfirstlane((int)LW[2]); b_.st = LW; xcd_barrier<F>(b_); } while (0)
#define GRID_BAR() GRID_BAR_T(false)

    for (int rep_ = 0; rep_ < REP_P0; ++rep_) {
        LAS float* scr = (LAS float*)(lds + 1024 + wave * 16896);
        constexpr int I_IN = 32 * 160, I_OUT = 32 * 64;
        constexpr int J_DG = 16 * 176, J_DD = 44 * 64, J_MG = 16 * 224, J_MD = 56 * 64;
        constexpr int N16 = 2 * I_IN + 2 * I_OUT, N8 = 2 * J_DG + J_DD + 16 * J_MG + 8 * J_MD;
        unsigned char* ws = WSP(unsigned char, 0);
        for (int it = gw; it < N16 + N8; it += NGW) {
            if (it < N16) {
                int r = it; const float* W; bf16_t* WT; int N;
                if (r < 2 * I_IN) { const int l = r / I_IN; r -= l * I_IN; W = INF(3) + (size_t)l * DM * INW; WT = (bf16_t*)(ws + WS_WIN) + (size_t)l * INW * DM; N = INW; }
                else { r -= 2 * I_IN; const int l = r / I_OUT; r -= l * I_OUT; W = INF(11) + (size_t)l * DM * DM; WT = (bf16_t*)(ws + WS_WOUT) + (size_t)l * DM * DM; N = DM; }
                const int nblk = N / 32, kb = r / nblk, nb = r - kb * nblk;
                transpose_item<64, false>(W, DM, N, WT, 32 * nb, 64 * kb, 32 * nb, scr, lane);
            } else {
                int r = it - N16; const float* W; unsigned char* WT; int K, N, mode = 0;
                if (r < J_DG) { W = INF(13); WT = ws + WS_WDGU; K = DM; N = FFD; mode = 1; }
                else if ((r -= J_DG) < J_DG) { W = INF(14); WT = ws + WS_WDGU; K = DM; N = FFD; mode = 2; }
                else if ((r -= J_DG) < J_DD) { W = INF(15); WT = ws + WS_WDD; K = FFD; N = DM; }
                else if ((r -= J_DD) < 8 * J_MG) { const int e = r / J_MG; r -= e * J_MG; W = INF(17) + (size_t)e * DM * FFE; WT = ws + WS_WMGU + (size_t)e * 2 * FFE * DM; K = DM; N = FFE; mode = 1; }
                else if ((r -= 8 * J_MG) < 8 * J_MG) { const int e = r / J_MG; r -= e * J_MG; W = INF(18) + (size_t)e * DM * FFE; WT = ws + WS_WMGU + (size_t)e * 2 * FFE * DM; K = DM; N = FFE; mode = 2; }
                else { r -= 8 * J_MG; const int e = r / J_MD; r -= e * J_MD; W = INF(19) + (size_t)e * FFE * DM; WT = ws + WS_WMD + (size_t)e * DM * FFE; K = FFE; N = DM; }
                const int nblk = N / 32, kb = r / nblk, nb = r - kb * nblk, n0 = 32 * nb;
                const int drow0 = mode == 0 ? n0 : (256 * (n0 >> 7) + (mode - 1) * 128 + (n0 & 127));
                transpose_item<128, true>(W, K, N, WT, drow0, 128 * kb, n0, scr, lane);
            }
        }
        {
            const int* positions = (const int*)(GAS const int*)PTR(1); float* cosT = (float*)(ws + WS_COS); float* sinT = (float*)(ws + WS_SIN);
            for (int idx = (bx * 512 + tid); idx < NTOK * 64; idx += G * 512) {
                const int t = idx >> 6, i = idx & 63;
                const float inv = 1.0f / powf(10000.0f, (float)(2 * i) / 128.0f);
                const float ang = (float)positions[t] * inv;
                double rev = (double)ang * 0.15915494309189535; rev -= rint(rev);
                const float rf = (float)rev;
                cosT[idx] = __builtin_amdgcn_cosf(rf); sinT[idx] = __builtin_amdgcn_sinf(rf);
            }
        }
        {
            const float* w_pool = INF(8); bf16_t* wpt = (bf16_t*)(ws + WS_WPT);
            for (int idx = (bx * 512 + tid); idx < 2 * 4 * 128 * 128; idx += G * 512) {
                const int c = idx & 127, d = (idx >> 7) & 127, lg = idx >> 14;
                const float v = w_pool[((size_t)lg * 128 + c) * 128 + d];
                wpt[idx] = (bf16_t)(cvt_pk_bf16(v, 0.f) & 0xffffu);
            }
        }
        {
            const float* x_in = INF(0); const float* gn = INF(2); bf16_t* xn = (bf16_t*)(ws + WS_XN);
            for (int m = gw; m < NTOK; m += NGW) (void)rms_row(x_in + (size_t)m * DM, gn, xn + (size_t)m * DM, lane);
        }
    }
    GRID_BAR_T(true);

    for (int l = 0; l < DEPTH; ++l) {
#define PHASE_IDS() const int tid = ltid(), lane = tid & 63, wave = __builtin_amdgcn_readfirstlane(tid >> 6), gw = bx * 8 + wave; (void)tid; (void)lane; (void)wave; (void)gw
        for (int rep_ = 0; rep_ < REP_P1; ++rep_) {
            pg8::Gemm g{WSP(bf16_t, WS_XN), WSP(bf16_t, WS_WIN) + (size_t)l * INW * DM, DM * 2, 0};
            pg8::StaticOrder S; S.init(NTOK / 256, INW / 256, G, bx);
            pg8::EpiBf16 E{WSP(bf16_t, WS_Z), INW};
            pg8::gemm_phase<pg8::EpiBf16, pg8::StaticOrder>(lds + RING_OFF, g, S, E);
        }
        GRID_BAR();
        if (PH_MASK & (1 << 2)) {
            PHASE_IDS();
            bf16_t* zb = WSP(bf16_t, WS_Z); bf16_t* mix = WSP(bf16_t, WS_MIX);
            {
            const float* qg = INF(4) + l * 128; const float* kg = INF(5) + l * 128;
            const float* cw = INF(10) + (size_t)l * 3 * 512;
            const float* cosT = WSP(float, WS_COS); const float* sinT = WSP(float, WS_SIN);
            for (int t = gw; t < NTOK; t += NGW) {
                bf16_t* zr = zb + (size_t)t * INW;
                {
                    const int c = lane >> 2, sub = lane & 3;
                    bf16_t* p = zr + c * 128 + 16 * sub;
                    const u32x4 a0 = *(const u32x4*)p, a1 = *(const u32x4*)(p + 8), b0 = *(const u32x4*)(p + 64), b1 = *(const u32x4*)(p + 72);
                    float xa[16], xb[16];
#pragma unroll
                    for (int j = 0; j < 4; ++j) { xa[2 * j] = bflo(a0[j]); xa[2 * j + 1] = bfhi(a0[j]); xa[8 + 2 * j] = bflo(a1[j]); xa[8 + 2 * j + 1] = bfhi(a1[j]);
                                                  xb[2 * j] = bflo(b0[j]); xb[2 * j + 1] = bfhi(b0[j]); xb[8 + 2 * j] = bflo(b1[j]); xb[8 + 2 * j + 1] = bfhi(b1[j]); }
                    float ss = 0.f;
#pragma unroll
                    for (int j = 0; j < 16; ++j) ss += xa[j] * xa[j] + xb[j] * xb[j];
                    ss += __shfl_xor(ss, 1); ss += __shfl_xor(ss, 2);
                    const float rstd = 1.0f / sqrtf(ss * (1.0f / 128.0f) + EPS);
                    const float* gp = (c < 8 ? qg : kg) + 16 * sub;
                    const float* cp = cosT + (size_t)t * 64 + 16 * sub; const float* sp = sinT + (size_t)t * 64 + 16 * sub;
                    float oa[16], ob[16];
#pragma unroll
                    for (int j = 0; j < 16; ++j) { const float x1 = xa[j] * rstd * gp[j], x2 = xb[j] * rstd * gp[64 + j]; const float cs = cp[j], sn = sp[j];
                        oa[j] = x1 * cs - x2 * sn; ob[j] = x1 * sn + x2 * cs; }
                    u32x4 w0, w1, w2, w3;
#pragma unroll
                    for (int j = 0; j < 4; ++j) { w0[j] = cvt_pk_bf16(oa[2 * j], oa[2 * j + 1]); w1[j] = cvt_pk_bf16(oa[8 + 2 * j], oa[8 + 2 * j + 1]);
                                                  w2[j] = cvt_pk_bf16(ob[2 * j], ob[2 * j + 1]); w3[j] = cvt_pk_bf16(ob[8 + 2 * j], ob[8 + 2 * j + 1]); }
                    *(u32x4*)p = w0; *(u32x4*)(p + 8) = w1; *(u32x4*)(p + 64) = w2; *(u32x4*)(p + 72) = w3;
                }
                {
                    const int tb = t & (SEQ - 1), ch = 8 * lane;
                    const u32x4 gb = *(const u32x4*)(zr + ZGB + ch);
                    float y[8];
#pragma unroll
                    for (int j = 0; j < 8; ++j) y[j] = 0.f;
#pragma unroll
                    for (int d = 0; d < 3; ++d) {
                        if (tb >= d) {
                            const bf16_t* zd = zr - (size_t)d * INW;
                            const u32x4 gc = *(const u32x4*)(zd + ZGC + ch), hc = *(const u32x4*)(zd + ZH + ch);
                            const f32x4 wa = *(const f32x4*)(cw + (2 - d) * 512 + ch), wb = *(const f32x4*)(cw + (2 - d) * 512 + ch + 4);
#pragma unroll
                            for (int j = 0; j < 4; ++j) { const float u0 = bflo(gc[j]) * bflo(hc[j]), u1 = bfhi(gc[j]) * bfhi(hc[j]);
                                const float k0_ = (j < 2) ? wa[2 * j] : wb[2 * j - 4], k1_ = (j < 2) ? wa[2 * j + 1] : wb[2 * j - 3];
                                y[2 * j] += k0_ * u0; y[2 * j + 1] += k1_ * u1; }
                        }
                    }
                    u32x4 w;
#pragma unroll
                    for (int j = 0; j < 4; ++j) w[j] = cvt_pk_bf16(bflo(gb[j]) * y[2 * j], bfhi(gb[j]) * y[2 * j + 1]);
                    *(u32x4*)(mix + (size_t)t * DM + 1536 + ch) = w;
                }
            }
            }
            {
            const bf16_t* wpt = WSP(bf16_t, WS_WPT); const float* pool_scale = INF(9) + l * 512;
            for (int it = gw; it < (NTOK / 32) * 4; it += NGW) {
                const int T = it >> 2, gi = it & 3, wn = 2 << gi, t0 = T * 32;
                const int r32 = lane & 31, hi = lane >> 5, t = t0 + r32, tb = t & (SEQ - 1);
                const float inv = 1.0f / (float)((tb + 1) < wn ? (tb + 1) : wn);
                const bf16_t* zp = zb + (size_t)t * INW + ZP + gi * 128;
                const bf16_t* wp = wpt + ((size_t)(l * 4 + gi) * 128) * 128;
                f32x16 acc[4];
#pragma unroll
                for (int nb = 0; nb < 4; ++nb) acc[nb] = f32x16{};
#pragma unroll 1
                for (int s = 0; s < 8; ++s) {
                    const int cb = 16 * s + 8 * hi;
                    float sum[8], self[8];
#pragma unroll
                    for (int j = 0; j < 8; ++j) { sum[j] = 0.f; self[j] = 0.f; }
#pragma unroll 1
                    for (int d = 0; d < wn; ++d) {
                        if (d <= tb) { const u32x4 v = *(const u32x4*)(zp - (size_t)d * INW + cb);
#pragma unroll
                            for (int j = 0; j < 4; ++j) { const float a = bflo(v[j]), b = bfhi(v[j]); sum[2 * j] += a; sum[2 * j + 1] += b; if (d == 0) { self[2 * j] = a; self[2 * j + 1] = b; } } }
                    }
                    u32x4 aw;
#pragma unroll
                    for (int j = 0; j < 4; ++j) aw[j] = cvt_pk_bf16(sum[2 * j] * inv - self[2 * j], sum[2 * j + 1] * inv - self[2 * j + 1]);
                    const bf16x8 af = __builtin_bit_cast(bf16x8, aw);
#pragma unroll
                    for (int nb = 0; nb < 4; ++nb) { const bf16x8 bfr = *(const bf16x8*)(wp + (size_t)(nb * 32 + r32) * 128 + cb);
                        acc[nb] = __builtin_amdgcn_mfma_f32_32x32x16_bf16(af, bfr, acc[nb], 0, 0, 0); }
                }
#pragma unroll
                for (int nb = 0; nb < 4; ++nb) { const int col = gi * 128 + nb * 32 + r32; const float ps = pool_scale[col];
#pragma unroll
                    for (int r = 0; r < 16; ++r) { const int row = (r & 3) + 8 * (r >> 2) + 4 * hi;
                        mix[(size_t)(t0 + row) * DM + 1024 + col] = (bf16_t)(cvt_pk_bf16(acc[nb][r] * ps, 0.f) & 0xffffu); } }
            }
            }
        }
        GRID_BAR();
        for (int rep_ = 0; rep_ < REP_P3; ++rep_) {
            constexpr int NITEM = 512;
            char* alds = (char*)lds_raw + RING_OFF;
            int L = bx;
            if (L < NITEM) {
                const bf16_t* zb = WSP(bf16_t, WS_Z); float* ao = WSP(float, WS_AO);
#define ATT_REF(ref, LL, pass) do { const int xcd_ = (LL) & 7, k_ = (LL) >> 3, bh_ = (k_ >> 4) * 8 + xcd_, b_ = bh_ >> 2, h_ = bh_ & 3, vh_ = (k_ & 15) >> 2, mp_ = vh_ >> 1, vj_ = vh_ & 1, x_ = k_ & 3; \
                    const int qb_ = (pass) ? 7 - x_ : x_; const bf16_t* zb_ = zb + (size_t)b_ * SEQ * INW; \
                    (ref).Q = zb_ + (size_t)qb_ * 256 * INW + ZQ + h_ * 256 + mp_ * 128; (ref).K = zb_ + ZK + h_ * 256 + mp_ * 128; (ref).V = zb_ + ZV + h_ * 256 + vj_ * 128; \
                    (ref).O = ao + ((size_t)b_ * SEQ + (size_t)qb_ * 256) * DM + h_ * 512 + mp_ * 256 + vj_ * 128; (ref).P0 = qb_ * 256; } while (0)
                att::BlockRef cur, nxt; int pass = 0;
                ATT_REF(cur, L, 0);
                att::Seam S;
                att::causal_prime(cur, alds, S);
                for (;;) {
                    const bool more_pass = pass == 0, more_item = L + G < NITEM, last = !more_pass && !more_item;
                    int passn = pass + 1, Ln = L;
                    if (!more_pass) { passn = 0; Ln = more_item ? L + G : L; }
                    if (last) nxt = cur; else ATT_REF(nxt, Ln, passn);
                    att::causal_block(cur, nxt, SEQ, alds, S);
                    if (last) break;
                    cur = nxt; pass = passn; L = Ln;
                }
#undef ATT_REF
            }
        }
        GRID_BAR();
        if (PH_MASK & (1 << 4)) {
            PHASE_IDS();
            const float lam_init = (l == 0) ? 0.2f : 0.35550906759096926f;
            const float* lv = INF(6) + (size_t)l * 512;
            const float d01 = wave_sum(lv[lane] * lv[128 + lane] + lv[64 + lane] * lv[192 + lane]);
            const float d23 = wave_sum(lv[256 + lane] * lv[384 + lane] + lv[320 + lane] * lv[448 + lane]);
            const float lam = expf(d01) - expf(d23) + lam_init;
            const float oscale = 1.0f - lam_init;
            const int h = lane >> 4, e0 = (lane & 15) * 16;
            const float* sg = INF(7) + l * 256 + e0;
            const float* ao = WSP(float, WS_AO); bf16_t* mix = WSP(bf16_t, WS_MIX);
            for (int t = gw; t < NTOK; t += NGW) {
                const float* o0 = ao + (size_t)t * DM + h * 512 + e0; const float* o1 = o0 + 256;
                float dv[16]; float ss = 0.f;
#pragma unroll
                for (int j = 0; j < 4; ++j) { const f32x4 a = *(const f32x4*)(o0 + 4 * j), b = *(const f32x4*)(o1 + 4 * j);
#pragma unroll
                    for (int q = 0; q < 4; ++q) { const float d = a[q] - lam * b[q]; dv[4 * j + q] = d; ss += d * d; } }
                ss += __shfl_xor(ss, 1); ss += __shfl_xor(ss, 2); ss += __shfl_xor(ss, 4); ss += __shfl_xor(ss, 8);
                const float rstd = 1.0f / sqrtf(ss * (1.0f / 256.0f) + EPS);
                u32x4 w0, w1;
#pragma unroll
                for (int j = 0; j < 4; ++j) { w0[j] = cvt_pk_bf16(dv[2 * j] * rstd * sg[2 * j] * oscale, dv[2 * j + 1] * rstd * sg[2 * j + 1] * oscale);
                                              w1[j] = cvt_pk_bf16(dv[8 + 2 * j] * rstd * sg[8 + 2 * j] * oscale, dv[8 + 2 * j + 1] * rstd * sg[8 + 2 * j + 1] * oscale); }
                bf16_t* mp = mix + (size_t)t * DM + h * 256 + e0;
                *(u32x4*)mp = w0; *(u32x4*)(mp + 8) = w1;
            }
        }
        GRID_BAR();
        if (PH_MASK & (1 << 5)) {
            pg8::Gemm g{WSP(bf16_t, WS_MIX), WSP(bf16_t, WS_WOUT) + (size_t)l * DM * DM, DM * 2, 0};
            pg8::StaticOrder S; S.init(NTOK / 256, DM / 256, G, bx);
            float* out = OUTP;
            pg8::EpiResF32 E{l == 0 ? INF(0) : (const float*)out, out, DM};
            pg8::gemm_phase<pg8::EpiResF32, pg8::StaticOrder>(lds + RING_OFF, g, S, E);
        }
        GRID_BAR();
        if (l == 0 && (PH_MASK & (1 << 6))) {
            {
                PHASE_IDS();
                const float* out = OUTP; const float* gn = INF(12); unsigned char* xn8 = WSP(unsigned char, WS_XN);
                for (int m = gw; m < NTOK; m += NGW) (void)rms_row_f8(out + (size_t)m * DM, gn, xn8 + (size_t)m * DM, lane);
            }
            GRID_BAR();
            {
                pg8::Gemm g{WSP(unsigned char, WS_XN), WSP(unsigned char, WS_WDGU), DM, 0};
                pg8::StaticOrder S; S.init(NTOK / 256, 2 * FFD / 256, G, bx);
                pg8::EpiSwigluF8 E{WSP(unsigned char, WS_ACTD), FFD};
                pg8::gemm_phase<pg8::EpiSwigluF8, pg8::StaticOrder, true, SC_W, SC_ONE>(lds + RING_OFF, g, S, E);
            }
            GRID_BAR();
            {
                pg8::Gemm g{WSP(unsigned char, WS_ACTD), WSP(unsigned char, WS_WDD), FFD, 0};
                pg8::StaticOrder S; S.init(NTOK / 256, DM / 256, G, bx);
                float* out = OUTP;
                pg8::EpiResF32 E{out, out, DM};
                pg8::gemm_phase<pg8::EpiResF32, pg8::StaticOrder, true, SC_W, SC_A>(lds + RING_OFF, g, S, E);
            }
            GRID_BAR();
            {
                PHASE_IDS();
                const float* out = OUTP; const float* gn = INF(2) + DM; bf16_t* xn = WSP(bf16_t, WS_XN);
                for (int m = gw; m < NTOK; m += NGW) (void)rms_row(out + (size_t)m * DM, gn, xn + (size_t)m * DM, lane);
            }
            GRID_BAR();
        } else if (PH_MASK & (1 << 7)) {
            const int TPW = (NTOK + G - 1) / G;
            {
                PHASE_IDS();
                if (tid < 8) LW[LW_CNT + tid] = 0u;
                __syncthreads();
                const float* out = OUTP; const float* gn = INF(12) + DM; unsigned char* xn8 = WSP(unsigned char, WS_XN); const float* router_w = INF(16);
                int* tokE = WSP(int, WS_TOKE); int* tokR = WSP(int, WS_TOKR); float* tokG = WSP(float, WS_TOKG);
                const int tlo = bx * TPW, thi = (tlo + TPW) < NTOK ? (tlo + TPW) : NTOK;
                for (int t = tlo + wave; t < thi; t += 8) {
                    const float rstd = rms_row_f8(out + (size_t)t * DM, gn, xn8 + (size_t)t * DM, lane);
                    float lg[8];
#pragma unroll
                    for (int e = 0; e < 8; ++e) lg[e] = 0.f;
#pragma unroll 1
                    for (int j = 0; j < 8; ++j) {
                        const f32x4 xv = *((const f32x4*)(out + (size_t)t * DM) + 64 * j + lane), gv = *((const f32x4*)gn + 64 * j + lane);
#pragma unroll
                        for (int q = 0; q < 4; ++q) { const int k = 256 * j + 4 * lane + q; const f32x4 ra = *(const f32x4*)(router_w + (size_t)k * 8), rb = *(const f32x4*)(router_w + (size_t)k * 8 + 4); const float hv = xv[q] * rstd * gv[q];
                            lg[0] += hv * ra[0]; lg[1] += hv * ra[1]; lg[2] += hv * ra[2]; lg[3] += hv * ra[3]; lg[4] += hv * rb[0]; lg[5] += hv * rb[1]; lg[6] += hv * rb[2]; lg[7] += hv * rb[3]; }
                    }
#pragma unroll
                    for (int e = 0; e < 8; ++e) lg[e] = wave_sum(lg[e]);
                    if (lane == 0) {
                        int e0 = 0; float v0 = lg[0];
#pragma unroll
                        for (int e = 1; e < 8; ++e) if (lg[e] > v0) { v0 = lg[e]; e0 = e; }
                        int e1 = -1; float v1 = -3.0e38f;
#pragma unroll
                        for (int e = 0; e < 8; ++e) if (e != e0 && lg[e] > v1) { v1 = lg[e]; e1 = e; }
                        const float ex = expf(v1 - v0), g0 = 1.0f / (1.0f + ex), g1 = ex / (1.0f + ex);
                        const int r0 = (int)atomicAdd((unsigned*)(lds_raw + LDSCTL_OFF) + LW_CNT + e0, 1u);
                        const int r1 = (int)atomicAdd((unsigned*)(lds_raw + LDSCTL_OFF) + LW_CNT + e1, 1u);
                        tokE[2 * t] = e0; tokE[2 * t + 1] = e1; tokR[2 * t] = r0; tokR[2 * t + 1] = r1; tokG[2 * t] = g0; tokG[2 * t + 1] = g1;
                    }
                }
                __syncthreads();
                if (tid < 8) WSP(int, WS_CNTWG)[bx * 8 + tid] = (int)LW[LW_CNT + tid];
            }
            GRID_BAR();
            {
                PHASE_IDS();
                if (tid < 8) { LW[LW_TOT + tid] = 0u; LW[LW_PRE + tid] = 0u; }
                __syncthreads();
                {
                const int* cntWG = WSP(int, WS_CNTWG);
                for (int j = tid; j < G; j += 512) {
                    const i32x4 ca = *(const i32x4*)(cntWG + j * 8), cb = *(const i32x4*)(cntWG + j * 8 + 4);
                    unsigned* lw = (unsigned*)(lds_raw + LDSCTL_OFF);
#pragma unroll
                    for (int e = 0; e < 4; ++e) { atomicAdd(lw + LW_TOT + e, (unsigned)ca[e]); atomicAdd(lw + LW_TOT + 4 + e, (unsigned)cb[e]);
                        if (j < bx) { atomicAdd(lw + LW_PRE + e, (unsigned)ca[e]); atomicAdd(lw + LW_PRE + 4 + e, (unsigned)cb[e]); } }
                }
                }
                __syncthreads();
                if (tid == 0) { unsigned base = 0;
                    for (int e = 0; e < 8; ++e) { const unsigned tot = LW[LW_TOT + e]; LW[LW_BP + e] = base + LW[LW_PRE + e]; LW[LW_TOFF + e] = base >> 8; base += (tot + 255u) & ~255u; }
                    LW[LW_TOFF + 8] = base >> 8; }
                __syncthreads();
                const int* tokE = WSP(int, WS_TOKE); const int* tokR = WSP(int, WS_TOKR); int* tokS = WSP(int, WS_TOKS);
                const unsigned char* xn8 = WSP(unsigned char, WS_XN); unsigned char* hp = WSP(unsigned char, WS_HP);
                const int tlo = bx * TPW, thi = (tlo + TPW) < NTOK ? (tlo + TPW) : NTOK;
                for (int t = tlo + wave; t < thi; t += 8) {
                    const int e0 = tokE[2 * t], e1 = tokE[2 * t + 1];
                    const int s0 = (int)LW[LW_BP + e0] + tokR[2 * t], s1 = (int)LW[LW_BP + e1] + tokR[2 * t + 1];
                    if (lane == 0) { tokS[2 * t] = s0; tokS[2 * t + 1] = s1; }
                    const u32x4* src = (const u32x4*)(xn8 + (size_t)t * DM) + lane; u32x4* d0 = (u32x4*)(hp + (size_t)s0 * DM) + lane; u32x4* d1 = (u32x4*)(hp + (size_t)s1 * DM) + lane;
#pragma unroll
                    for (int j = 0; j < 2; ++j) { const u32x4 v = src[64 * j]; d0[64 * j] = v; d1[64 * j] = v; }
                }
                for (int e = 0; e < 8; ++e) {
                    const int rlo = (int)LW[LW_TOFF + e] * 256 + (int)LW[LW_TOT + e], rhi = (int)LW[LW_TOFF + e + 1] * 256;
                    for (int r = rlo + gw; r < rhi; r += NGW) { u32x4* d0 = (u32x4*)(hp + (size_t)r * DM) + lane;
#pragma unroll
                        for (int j = 0; j < 2; ++j) d0[64 * j] = (u32x4){0u, 0u, 0u, 0u}; }
                }
            }
            GRID_BAR();
#define RFL(i) __builtin_amdgcn_readfirstlane((int)LW[LW_TOFF + (i)])
            for (int rep_ = 0; rep_ < REP_P7; ++rep_) {
                pg8::Gemm g{WSP(unsigned char, WS_HP), WSP(unsigned char, WS_WMGU), DM, (size_t)2 * FFE * DM};
                pg8::MoeOrder S; S.S.init(RFL(8), 2 * FFE / 256, G, bx);
                S.t1 = RFL(1); S.t2 = RFL(2); S.t3 = RFL(3); S.t4 = RFL(4); S.t5 = RFL(5); S.t6 = RFL(6); S.t7 = RFL(7);
                pg8::EpiSwigluF8 E{WSP(unsigned char, WS_ACTM), FFE};
                pg8::gemm_phase<pg8::EpiSwigluF8, pg8::MoeOrder, true, SC_W, SC_ONE>(lds + RING_OFF, g, S, E);
            }
            GRID_BAR();
            {
                pg8::Gemm g{WSP(unsigned char, WS_ACTM), WSP(unsigned char, WS_WMD), FFE, (size_t)DM * FFE};
                pg8::MoeOrder S; S.S.init(RFL(8), DM / 256, G, bx);
                S.t1 = RFL(1); S.t2 = RFL(2); S.t3 = RFL(3); S.t4 = RFL(4); S.t5 = RFL(5); S.t6 = RFL(6); S.t7 = RFL(7);
                pg8::EpiF32 E{WSP(float, WS_Y), DM};
                pg8::gemm_phase<pg8::EpiF32, pg8::MoeOrder, true, SC_W, SC_A>(lds + RING_OFF, g, S, E);
            }
#undef RFL
            GRID_BAR();
            {
                PHASE_IDS();
                const int* tokS = WSP(int, WS_TOKS); const float* tokG = WSP(float, WS_TOKG); float* out = OUTP; const float* yb = WSP(float, WS_Y);
                for (int t = gw; t < NTOK; t += NGW) {
                    const int s0 = tokS[2 * t], s1 = tokS[2 * t + 1]; const float g0 = tokG[2 * t], g1 = tokG[2 * t + 1];
                    f32x4* o = (f32x4*)(out + (size_t)t * DM) + lane; const f32x4* y0 = (const f32x4*)(yb + (size_t)s0 * DM) + lane; const f32x4* y1 = (const f32x4*)(yb + (size_t)s1 * DM) + lane;
#pragma unroll
                    for (int j = 0; j < 8; ++j) o[64 * j] = o[64 * j] + (y0[64 * j] * g0 + y1[64 * j] * g1);
                }
            }
        }
    }
}

extern "C" void kernel_launch(void* const* d_in, const int* in_sizes, int n_in, void* d_out, int out_size, void* d_ws, size_t ws_size, hipStream_t stream) {
    static int grid = 0;
    if (grid == 0) {
        if (n_in != 20 || in_sizes[0] != NTOK * DM || out_size != NTOK * DM || ws_size < WS_END) {
            fprintf(stderr, "kernel_launch: unexpected shapes (n_in %d, in0 %d, out %d, ws %zu < %zu); nothing launched\n", n_in, n_in > 0 ? in_sizes[0] : -1, out_size, ws_size, (size_t)WS_END); grid = -1; return; }
        int dev = 0, cus = 0, per_cu = 0;
        if (hipGetDevice(&dev) != hipSuccess || hipDeviceGetAttribute(&cus, hipDeviceAttributeMultiprocessorCount, dev) != hipSuccess) { grid = -1; return; }
        if (hipFuncSetAttribute((const void*)hybrid_fwd, hipFuncAttributeMaxDynamicSharedMemorySize, LDS_BYTES) != hipSuccess) { fprintf(stderr, "kernel_launch: hipFuncSetAttribute failed\n"); grid = -1; return; }
        if (hipOccupancyMaxActiveBlocksPerMultiprocessor(&per_cu, (const void*)hybrid_fwd, 512, LDS_BYTES) != hipSuccess || per_cu < 1)
            fprintf(stderr, "kernel_launch: note: occupancy query reports %d workgroups per CU\n", per_cu);
        (void)hipGetLastError();
        grid = cus > 512 ? 512 : cus;
    }
    if (grid < 0) return;
    if (hipMemsetAsync((char*)d_ws + WS_CTL, 0, CTL_ZERO_BYTES, stream) != hipSuccess) { fprintf(stderr, "kernel_launch: memset failed\n"); return; }
    Args a{};
    for (int i = 0; i < 20; ++i) a.in[i] = d_in[i];
    a.out = (float*)d_out; a.ws = (unsigned char*)d_ws;
    hipLaunchKernelGGL(hybrid_fwd, dim3(grid), dim3(512), LDS_BYTES, stream, a);
    const hipError_t le = hipPeekAtLastError();
    if (le != hipSuccess) fprintf(stderr, "kernel_launch: launch failed: %s\n", hipGetErrorName(le));
}
```

```cpp
#include <hip/hip_runtime.h>
#include <hip/hip_bf16.h>
#include <cstdio>
#include <cstdint>

#define LAS __attribute__((address_space(3)))
#define GAS __attribute__((address_space(1)))
typedef unsigned short bf16_t;
typedef short bf16x8 __attribute__((ext_vector_type(8)));
typedef short s16x4 __attribute__((ext_vector_type(4)));
typedef float f32x4 __attribute__((ext_vector_type(4)));
typedef float f32x2 __attribute__((ext_vector_type(2)));
typedef float f32x16 __attribute__((ext_vector_type(16)));
typedef unsigned u32x4 __attribute__((ext_vector_type(4)));
typedef unsigned u32x2 __attribute__((ext_vector_type(2)));
typedef int i32x4 __attribute__((ext_vector_type(4)));
typedef int i32x8 __attribute__((ext_vector_type(8)));

constexpr int DM = 2048, NB = 8, SEQ = 2048, NTOK = NB * SEQ, DEPTH = 2;
constexpr int INW = 5120, FFD = 5632, NEXP = 8, FFE = 7168;
constexpr int ZQ = 0, ZK = 1024, ZV = 2048, ZP = 3072, ZGB = 3584, ZGC = 4096, ZH = 4608;
constexpr int MOE_ROWS = NTOK * 2 + NEXP * 256;
constexpr float EPS = 1e-6f;

constexpr size_t MiB = 1u << 20;
constexpr size_t WS_CTL = 0, CTL_ZERO_BYTES = 1 * MiB;
constexpr size_t WS_COS = 1 * MiB, WS_SIN = 5 * MiB;
constexpr size_t WS_WPT = 9 * MiB;
constexpr size_t WS_TOKE = 10 * MiB;
constexpr size_t WS_TOKR = WS_TOKE + 128 * 1024;
constexpr size_t WS_TOKG = WS_TOKR + 128 * 1024;
constexpr size_t WS_TOKS = WS_TOKG + 128 * 1024;
constexpr size_t WS_CNTWG = WS_TOKS + 128 * 1024;
constexpr size_t WS_WIN = 16 * MiB;
constexpr size_t WS_WOUT = WS_WIN + 40 * MiB;
constexpr size_t WS_WDGU = WS_WOUT + 16 * MiB;
constexpr size_t WS_WDD = WS_WDGU + 44 * MiB;
constexpr size_t WS_WMGU = WS_WDD + 22 * MiB;
constexpr size_t WS_WMD = WS_WMGU + 448 * MiB;
constexpr size_t WS_ACT0 = WS_WMD + 224 * MiB;
constexpr size_t WS_Z = WS_ACT0;
constexpr size_t WS_AO = WS_ACT0 + 160 * MiB;
constexpr size_t WS_MIX = WS_ACT0 + 288 * MiB;
constexpr size_t WS_XN = WS_ACT0 + 352 * MiB;
constexpr size_t WS_ACTM = WS_ACT0;
constexpr size_t WS_HP = WS_ACT0 + 476 * MiB;
constexpr size_t WS_Y = WS_ACT0 + 612 * MiB;
constexpr size_t WS_ACTD = WS_ACT0 + 476 * MiB;
constexpr size_t WS_END = WS_ACT0 + 884 * MiB;
static_assert(WS_ACT0 == 810 * MiB, "map");
static_assert((size_t)MOE_ROWS * FFE * 2 <= 476 * MiB && (size_t)MOE_ROWS * DM * 2 <= 136 * MiB && (size_t)MOE_ROWS * DM * 4 <= 272 * MiB, "map");

#ifndef PH_MASK
#define PH_MASK 0xffff
#endif
#define REP_P0 1
#ifndef DUP8
#define DUP8 0
#endif
#ifndef DDN8
#define DDN8 0
#endif
#define REP_P1 1
#define REP_P3 1
#define REP_P7 1
constexpr int CW_TMO = 0, CW_CODE = 1, CW_BAR = 4096;
constexpr size_t WS_SS = WS_CTL + 256 * 1024;
typedef unsigned long long u64_t;
constexpr float SS_FIX = 16777216.0f, SS_UNFIX = 1.0f / 16777216.0f;
__device__ __forceinline__ u64_t ss_fix(float s) { return (u64_t)__float2ll_rn(s * SS_FIX); }
__device__ __forceinline__ float ss_rstd(u64_t v) { return 1.0f / sqrtf((float)(long long)v * (SS_UNFIX / DM) + EPS); }
constexpr size_t WS_RSLOT = 12 * MiB;

constexpr int LDSCTL_OFF = 0, LDSCTL_BYTES = 1024;
constexpr int RING_OFF = 16384, RING_BYTES = 131072;
constexpr int LDS_BYTES = 147456;
constexpr int LW_CNT = 16, LW_TOT = 24, LW_PRE = 32, LW_BP = 40, LW_TOFF = 48;

#define LDS_WAIT() asm volatile("s_waitcnt lgkmcnt(0)" ::: "memory")
#define VM_WAIT() asm volatile("s_waitcnt vmcnt(0)" ::: "memory")

__device__ __forceinline__ unsigned cvt_pk_bf16(float lo, float hi) { unsigned r; asm volatile("v_cvt_pk_bf16_f32 %0, %1, %2" : "=v"(r) : "v"(lo), "v"(hi)); return r; }
__device__ __forceinline__ unsigned pk4_fp8(float a, float b, float c, float d) {
    a = __builtin_amdgcn_fmed3f(a, -448.f, 448.f); b = __builtin_amdgcn_fmed3f(b, -448.f, 448.f); c = __builtin_amdgcn_fmed3f(c, -448.f, 448.f); d = __builtin_amdgcn_fmed3f(d, -448.f, 448.f);
    int w = __builtin_amdgcn_cvt_pk_fp8_f32(a, b, 0, false); w = __builtin_amdgcn_cvt_pk_fp8_f32(c, d, w, true); return (unsigned)w; }
constexpr float W8_SCALE = 64.f, A8_SCALE = 8.f;
constexpr int SC_ONE = 0x7f7f7f7f, SC_W = 0x79797979  , SC_A = 0x7c7c7c7c  ;
__device__ __forceinline__ float bflo(unsigned w) { return __uint_as_float(w << 16); }
__device__ __forceinline__ float bfhi(unsigned w) { return __uint_as_float(w & 0xffff0000u); }
__device__ __forceinline__ float wave_sum(float v) {
#pragma unroll
    for (int o = 1; o < 64; o <<= 1) v += __shfl_xor(v, o);
    return v;
}

__device__ __forceinline__ int ltid() { int t = threadIdx.x; asm volatile("" : "+v"(t)); return t; }

namespace pg8 {
constexpr int BM = 256, BK = 64, HALF = 128, HTB = HALF * BK * 2, STAGE_BYTES = 8 * HTB, NXCD = 8, WGM = 8;
__host__ __device__ __forceinline__ int lds_byte(int r, int c) { const int st = (r >> 4) * 2 + (c >> 5), rr = r & 15, cc = c & 31, ob = rr * 64 + cc * 2; return st * 1024 + (ob ^ (((ob >> 9) & 1) << 5)); }
__host__ __device__ __forceinline__ void stage_rc(int b, int& R, int& C) { const int st = b / 1024, sb = b % 1024, swz = sb ^ (((sb >> 9) & 1) << 5); R = (st >> 1) * 16 + swz / 64; C = (st & 1) * 32 + (swz % 64) / 2; }
__host__ __device__ __forceinline__ int perm32(int rho) { const int n = rho >> 4, i = rho & 15; return 8 * (i >> 2) + 4 * n + (i & 3); }

struct Unit { int pm, pn, e; };
struct Gemm { const void* A; const void* Bt; int KB; size_t estride; };

struct StaticOrder {
    int nM, nN, nwg, G, c;
    __device__ __forceinline__ void init(int nM_, int nN_, int G_, int c_) { nM = nM_; nN = nN_; nwg = nM * nN; G = G_; c = c_; }
    __device__ __forceinline__ bool next(int i, Unit& u) const {
        const long L = (long)i * G + c; if (L >= nwg) return false;
        int wgid = (int)L; { const int q = nwg / NXCD, r = nwg % NXCD, xcd = wgid % NXCD, off = wgid / NXCD; wgid = (xcd < r ? xcd * (q + 1) : r * (q + 1) + (xcd - r) * q) + off; }
        const int nig = WGM * nN, gid = wgid / nig, fm = gid * WGM, gsz = (nM - fm) < WGM ? (nM - fm) : WGM;
        u.pm = fm + ((wgid % nig) % gsz); u.pn = (wgid % nig) / gsz; u.e = 0; return true;
    }
};
struct MoeOrder {
    StaticOrder S; int t1, t2, t3, t4, t5, t6, t7;
    __device__ __forceinline__ bool next(int i, Unit& u) const {
        if (!S.next(i, u)) return false;
        const int p = u.pm; u.e = __builtin_amdgcn_readfirstlane((p >= t1) + (p >= t2) + (p >= t3) + (p >= t4) + (p >= t5) + (p >= t6) + (p >= t7)); return true;
    }
};

template <int RS> __device__ __forceinline__ void row_scales(float (&sc)[2][4], const void* p, int row0) {
#pragma unroll
    for (int ai = 0; ai < 2; ++ai)
#pragma unroll
        for (int m = 0; m < 4; ++m) { if constexpr (RS == 0) sc[ai][m] = 1.0f; else if constexpr (RS == 1) sc[ai][m] = ss_rstd(((const u64_t*)p)[row0 + ai * HALF + m * 16]); else sc[ai][m] = ((const float*)p)[row0 + ai * HALF + m * 16]; }
}
template <int RS> struct EpiBf16 {
    static constexpr bool PERM = true;
    bf16_t* O; int ldc; const void* rsp;
    __device__ __forceinline__ void operator()(const f32x4 (&acc)[2][2][4][2], const Unit& u, int wr, int wc, int fr, int fq) const {
        const int row0 = u.pm * BM + wr * 64 + fr, col0 = u.pn * BM + wc * 32 + 8 * fq;
        float sc[2][4]; row_scales<RS>(sc, rsp, row0);
#pragma unroll
        for (int ai = 0; ai < 2; ++ai)
#pragma unroll
            for (int m = 0; m < 4; ++m) { bf16_t* rowp = O + (size_t)(row0 + ai * HALF + m * 16) * ldc + col0;
#pragma unroll
                for (int bj = 0; bj < 2; ++bj) { const f32x4 v0 = acc[ai][bj][m][0] * sc[ai][m], v1 = acc[ai][bj][m][1] * sc[ai][m];
                    u32x4 w; w.x = cvt_pk_bf16(v0[0], v0[1]); w.y = cvt_pk_bf16(v0[2], v0[3]); w.z = cvt_pk_bf16(v1[0], v1[1]); w.w = cvt_pk_bf16(v1[2], v1[3]);
                    *(u32x4*)(rowp + bj * HALF) = w; } }
    }
};
__device__ __forceinline__ float silu_mul(float g, float u) { return g * __builtin_amdgcn_rcpf(1.0f + __builtin_amdgcn_exp2f(-1.4426950408889634f * g)) * u; }
template <int RS> struct EpiSwiglu {
    static constexpr bool PERM = true;
    bf16_t* O; int ldc; const void* rsp;
    __device__ __forceinline__ void operator()(const f32x4 (&acc)[2][2][4][2], const Unit& u, int wr, int wc, int fr, int fq) const {
        const int row0 = u.pm * BM + wr * 64 + fr, col0 = u.pn * HALF + wc * 32 + 8 * fq;
        float sc[2][4]; row_scales<RS>(sc, rsp, row0);
#pragma unroll
        for (int ai = 0; ai < 2; ++ai)
#pragma unroll
            for (int m = 0; m < 4; ++m) { bf16_t* rowp = O + (size_t)(row0 + ai * HALF + m * 16) * ldc + col0;
                const f32x4 g0 = acc[ai][0][m][0] * sc[ai][m], g1 = acc[ai][0][m][1] * sc[ai][m], u0 = acc[ai][1][m][0] * sc[ai][m], u1 = acc[ai][1][m][1] * sc[ai][m];
                u32x4 w;
                w.x = cvt_pk_bf16(silu_mul(g0[0], u0[0]), silu_mul(g0[1], u0[1])); w.y = cvt_pk_bf16(silu_mul(g0[2], u0[2]), silu_mul(g0[3], u0[3]));
                w.z = cvt_pk_bf16(silu_mul(g1[0], u1[0]), silu_mul(g1[1], u1[1])); w.w = cvt_pk_bf16(silu_mul(g1[2], u1[2]), silu_mul(g1[3], u1[3]));
                *(u32x4*)rowp = w; }
    }
};
template <int RS> struct EpiSwigluF8 {
    static constexpr bool PERM = true;
    unsigned char* O; int ldc; const void* rsp;
    __device__ __forceinline__ void operator()(const f32x4 (&acc)[2][2][4][2], const Unit& u, int wr, int wc, int fr, int fq) const {
        const int row0 = u.pm * BM + wr * 64 + fr, col0 = u.pn * HALF + wc * 32 + 8 * fq;
        float sc[2][4]; row_scales<RS>(sc, rsp, row0);
#pragma unroll
        for (int ai = 0; ai < 2; ++ai)
#pragma unroll
            for (int m = 0; m < 4; ++m) { unsigned char* rowp = O + (size_t)(row0 + ai * HALF + m * 16) * ldc + col0;
                const f32x4 g0 = acc[ai][0][m][0] * sc[ai][m], g1 = acc[ai][0][m][1] * sc[ai][m], u0 = acc[ai][1][m][0] * sc[ai][m], u1 = acc[ai][1][m][1] * sc[ai][m];
                u32x2 w;
                w.x = pk4_fp8(silu_mul(g0[0], u0[0]) * A8_SCALE, silu_mul(g0[1], u0[1]) * A8_SCALE, silu_mul(g0[2], u0[2]) * A8_SCALE, silu_mul(g0[3], u0[3]) * A8_SCALE);
                w.y = pk4_fp8(silu_mul(g1[0], u1[0]) * A8_SCALE, silu_mul(g1[1], u1[1]) * A8_SCALE, silu_mul(g1[2], u1[2]) * A8_SCALE, silu_mul(g1[3], u1[3]) * A8_SCALE);
                *(u32x2*)rowp = w; }
    }
};
struct EpiResF32 {
    static constexpr bool PERM = true;
    const float* R; float* O; int ldc; void* XB; u64_t* ss; int f8out;
    __device__ __forceinline__ void operator()(const f32x4 (&acc)[2][2][4][2], const Unit& u, int wr, int wc, int fr, int fq) const {
        const int col0 = u.pn * BM + wc * 32 + 8 * fq;
#pragma unroll
        for (int ai = 0; ai < 2; ++ai)
#pragma unroll
            for (int m = 0; m < 4; ++m) { const int r = u.pm * BM + ai * HALF + wr * 64 + m * 16 + fr; const size_t off = (size_t)r * ldc + col0;
                float ssp = 0.f;
#pragma unroll
                for (int bj = 0; bj < 2; ++bj) {
                    const f32x4 v0 = *(const f32x4*)(R + off + bj * HALF) + acc[ai][bj][m][0], v1 = *(const f32x4*)(R + off + bj * HALF + 4) + acc[ai][bj][m][1];
                    *(f32x4*)(O + off + bj * HALF) = v0; *(f32x4*)(O + off + bj * HALF + 4) = v1;
                    ssp += (v0[0] * v0[0] + v0[1] * v0[1]) + (v0[2] * v0[2] + v0[3] * v0[3]) + (v1[0] * v1[0] + v1[1] * v1[1]) + (v1[2] * v1[2] + v1[3] * v1[3]);
                    if (f8out) { u32x2 w; w.x = pk4_fp8(v0[0], v0[1], v0[2], v0[3]); w.y = pk4_fp8(v1[0], v1[1], v1[2], v1[3]); *(u32x2*)((unsigned char*)XB + off + bj * HALF) = w; }
                    else { u32x4 w; w.x = cvt_pk_bf16(v0[0], v0[1]); w.y = cvt_pk_bf16(v0[2], v0[3]); w.z = cvt_pk_bf16(v1[0], v1[1]); w.w = cvt_pk_bf16(v1[2], v1[3]); *(u32x4*)((bf16_t*)XB + off + bj * HALF) = w; }
                }
                ssp += __shfl_xor(ssp, 16); ssp += __shfl_xor(ssp, 32);
                if (fq == 0) (void)__hip_atomic_fetch_add(ss + r, ss_fix(ssp), __ATOMIC_RELAXED, __HIP_MEMORY_SCOPE_AGENT);
                asm volatile("" ::: "memory"); }
    }
};
struct EpiF32 {
    static constexpr bool PERM = false;
    float* O; int ldc;
    __device__ __forceinline__ void operator()(const f32x4 (&acc)[2][2][4][2], const Unit& u, int wr, int wc, int fr, int fq) const {
        const int col0 = u.pn * BM + wc * 32 + 4 * fq;
#pragma unroll
        for (int ai = 0; ai < 2; ++ai)
#pragma unroll
            for (int m = 0; m < 4; ++m) { const size_t off = (size_t)(u.pm * BM + ai * HALF + wr * 64 + m * 16 + fr) * ldc + col0;
#pragma unroll
                for (int bj = 0; bj < 2; ++bj)
#pragma unroll
                    for (int n = 0; n < 2; ++n) *(f32x4*)(O + off + bj * HALF + n * 16) = acc[ai][bj][m][n]; }
    }
};

__device__ __forceinline__ void mfma_f8_tied(f32x4& c, i32x8 a, i32x8 b, int sa, int sb) {
    asm volatile("v_mfma_scale_f32_16x16x128_f8f6f4 %0, %1, %2, %0, %3, %4 op_sel_hi:[0,0,0]" : "+v"(c) : "v"(a), "v"(b), "v"(sa), "v"(sb)); }
__device__ __forceinline__ void mfma_f8_drain() { asm volatile("s_nop 15\n\ts_nop 15" ::: "memory"); }
__device__ __forceinline__ void glds16s(unsigned voff, const char* sbase, unsigned lds_dst) { unsigned keep;
    asm volatile("s_mov_b32 %0, m0\n\ts_mov_b32 m0, %3\n\ts_nop 0\n\tglobal_load_lds_dwordx4 %1, %2\n\ts_mov_b32 m0, %0" : "=&s"(keep) : "v"(voff), "s"(sbase), "s"(lds_dst) : "memory"); }
template <class Epi, class Sched, bool F8 = false, int SCW = SC_ONE, int SCX = SC_ONE>
__device__ __forceinline__ void gemm_phase(LAS unsigned char* lds, const Gemm g, const Sched& S, const Epi& E) {
    const int tid = ltid(), wid = __builtin_amdgcn_readfirstlane(tid >> 6), lane = tid & 63, wr = wid >> 2, wc = wid & 3, fr = lane & 15, fq = lane >> 4;
    const int KB = g.KB, nt = KB / 128;
    int scw_ = SCW, scx_ = SCX; if constexpr (F8) { asm volatile("" : "+v"(scw_), "+v"(scx_)); }
    unsigned voffA[2], voffB[2];
#pragma unroll
    for (int i = 0; i < 2; ++i) { int R, C; stage_rc(tid * 16 + i * 8192, R, C); const int Rb = Epi::PERM ? ((R & ~31) + perm32(R & 31)) : R;
        voffA[i] = (unsigned)(R * KB + C * 2); voffB[i] = (unsigned)(Rb * KB + C * 2); }
    const size_t kstep = (size_t)128;
    const size_t hstep = (size_t)HALF * KB;
    const size_t tstep = 2 * hstep;
    const unsigned ldsb = (unsigned)(uintptr_t)lds + (unsigned)wid * 1024u;
    const int aoff = lds_byte(wr * 64 + fr, fq * 8), boff = lds_byte(wc * 32 + fr, fq * 8);
#define PG8_SA(b, h) (((b) * 2 + (h)) * HTB)
#define PG8_SB(b, h) ((4 + (b) * 2 + (h)) * HTB)
#define PG8_STAGE(bufoff, gbase, voff) do { _Pragma("unroll") for (int _i = 0; _i < 2; ++_i) \
        glds16s((voff)[_i], (const char*)(gbase), ldsb + (unsigned)((bufoff) + _i * 8192)); } while (0)
#define PG8_LDA(dst, b, h) do { _Pragma("unroll") for (int m = 0; m < 4; ++m) _Pragma("unroll") for (int k = 0; k < 2; ++k) dst[m][k] = *(const LAS bf16x8*)(lds + PG8_SA(b, h) + aoff + m * 2048 + k * 1024); } while (0)
#define PG8_LDB(dst, b, h) do { _Pragma("unroll") for (int n = 0; n < 2; ++n) _Pragma("unroll") for (int k = 0; k < 2; ++k) dst[n][k] = *(const LAS bf16x8*)(lds + PG8_SB(b, h) + boff + n * 2048 + k * 1024); } while (0)
#define PG8_CAT8(x) __builtin_shufflevector(__builtin_bit_cast(i32x4, (x)[0]), __builtin_bit_cast(i32x4, (x)[1]), 0, 1, 2, 3, 4, 5, 6, 7)
#define PG8_MMA(ai, bj, At, Bt) do { __builtin_amdgcn_s_setprio(1); \
        if constexpr (F8) { _Pragma("unroll") for (int m = 0; m < 4; ++m) _Pragma("unroll") for (int n = 0; n < 2; ++n) \
            mfma_f8_tied(acc[ai][bj][m][n], PG8_CAT8(Bt[n]), PG8_CAT8(At[m]), scw_, scx_); } \
        else { _Pragma("unroll") for (int m = 0; m < 4; ++m) _Pragma("unroll") for (int n = 0; n < 2; ++n) _Pragma("unroll") for (int k = 0; k < 2; ++k) \
            acc[ai][bj][m][n] = __builtin_amdgcn_mfma_f32_16x16x32_bf16(Bt[n][k], At[m][k], acc[ai][bj][m][n], 0, 0, 0); } \
        __builtin_amdgcn_s_setprio(0); } while (0)
#define PG8_WAIT_V(n) asm volatile("s_waitcnt vmcnt(" #n ")" ::: "memory")
#define PG8_WAIT_L(n) asm volatile("s_waitcnt lgkmcnt(" #n ")" ::: "memory")
#define PG8_BAR __builtin_amdgcn_s_barrier()
#define PG8_SCHED __builtin_amdgcn_sched_barrier(0)
    Unit cur, nxt; int ui = 0;
    if (!S.next(0, cur)) return;
    f32x4 acc[2][2][4][2];
#pragma unroll
    for (int a = 0; a < 2; ++a)
#pragma unroll
        for (int b = 0; b < 2; ++b)
#pragma unroll
            for (int m = 0; m < 4; ++m)
#pragma unroll
                for (int n = 0; n < 2; ++n) acc[a][b][m][n] = (f32x4){0.f, 0.f, 0.f, 0.f};
    bf16x8 At[4][2], B0[2][2], B1[2][2];
    const char* cA = (const char*)g.A + (size_t)cur.pm * tstep; const char* cB = (const char*)g.Bt + (size_t)cur.e * g.estride + (size_t)cur.pn * tstep;
    PG8_STAGE(PG8_SB(0, 0), cB, voffB); PG8_STAGE(PG8_SB(0, 1), cB + hstep, voffB); PG8_STAGE(PG8_SA(0, 0), cA, voffA); PG8_STAGE(PG8_SA(0, 1), cA + hstep, voffA);
    if (wr == 1) PG8_BAR;
    PG8_WAIT_V(2); PG8_BAR;
    PG8_STAGE(PG8_SB(1, 0), cB + kstep, voffB); PG8_STAGE(PG8_SA(1, 0), cA + kstep, voffA); PG8_STAGE(PG8_SB(1, 1), cB + hstep + kstep, voffB);
    PG8_WAIT_V(6); PG8_BAR;
    for (;;) {
        const bool has_next = S.next(ui + 1, nxt);
        const char* nA = has_next ? (const char*)g.A + (size_t)nxt.pm * tstep : cA; const char* nB = has_next ? (const char*)g.Bt + (size_t)nxt.e * g.estride + (size_t)nxt.pn * tstep : cB;
        for (int t = 0; t < nt; t += 2) {
            const bool last = (t == nt - 2);
            const char* a1 = cA + (size_t)(t + 1) * kstep;
            const char* a2 = last ? nA : cA + (size_t)(t + 2) * kstep; const char* b2 = last ? nB : cB + (size_t)(t + 2) * kstep;
            const char* a3 = a2 + kstep; const char* b3 = b2 + kstep;
            PG8_LDB(B0, 0, 0); PG8_LDB(B1, 0, 1); PG8_SCHED; PG8_LDA(At, 0, 0); PG8_STAGE(PG8_SA(1, 1), a1 + hstep, voffA);
            PG8_WAIT_V(8); PG8_WAIT_L(0); PG8_BAR; PG8_MMA(0, 0, At, B0); PG8_MMA(0, 1, At, B1); PG8_BAR; PG8_SCHED;
            PG8_LDA(At, 0, 1); PG8_STAGE(PG8_SB(0, 0), b2, voffB); PG8_STAGE(PG8_SB(0, 1), b2 + hstep, voffB); PG8_STAGE(PG8_SA(0, 0), a2, voffA);
            PG8_WAIT_V(8); PG8_WAIT_L(0); PG8_BAR; PG8_MMA(1, 0, At, B0); PG8_MMA(1, 1, At, B1); PG8_BAR; PG8_SCHED;
            PG8_LDB(B0, 1, 0); PG8_LDB(B1, 1, 1); PG8_SCHED; PG8_LDA(At, 1, 0); PG8_STAGE(PG8_SA(0, 1), a2 + hstep, voffA);
            PG8_WAIT_V(8); PG8_WAIT_L(0); PG8_BAR; PG8_MMA(0, 0, At, B0); PG8_MMA(0, 1, At, B1); PG8_BAR; PG8_SCHED;
            PG8_LDA(At, 1, 1); PG8_STAGE(PG8_SB(1, 0), b3, voffB); PG8_STAGE(PG8_SB(1, 1), b3 + hstep, voffB); PG8_STAGE(PG8_SA(1, 0), a3, voffA);
            PG8_WAIT_V(8); PG8_WAIT_L(0); PG8_BAR; PG8_MMA(1, 0, At, B0); PG8_MMA(1, 1, At, B1); PG8_BAR; PG8_SCHED;
        }
        if (wr == 0) PG8_BAR;
        if constexpr (F8) mfma_f8_drain();
        E(acc, cur, wr, wc, fr, fq);
        if (!has_next) break;
#pragma unroll
        for (int a = 0; a < 2; ++a)
#pragma unroll
            for (int b = 0; b < 2; ++b)
#pragma unroll
                for (int m = 0; m < 4; ++m)
#pragma unroll
                    for (int n = 0; n < 2; ++n) acc[a][b][m][n] = (f32x4){0.f, 0.f, 0.f, 0.f};
        cur = nxt; cA = nA; cB = nB; ++ui;
        if (wr == 1) PG8_BAR;
    }
    PG8_WAIT_V(0);
    PG8_BAR;
#undef PG8_SA
#undef PG8_SB
#undef PG8_STAGE
#undef PG8_LDA
#undef PG8_LDB
#undef PG8_MMA
#undef PG8_CAT8
#undef PG8_WAIT_V
#undef PG8_WAIT_L
#undef PG8_BAR
#undef PG8_SCHED
}
}

namespace att {
constexpr int D = 128, LDZ = INW, LDO = DM;
constexpr float SCALE = 0.08838834764831845f;
constexpr float THR = 8.f;
constexpr int NW = 8, QBLK = 32, KVBLK = 64, QB = NW * QBLK;
constexpr int SHM_V = KVBLK * D * 2, SHM_K = KVBLK * D * 2;
constexpr int ATT_LDS_BYTES = 2 * SHM_V + 2 * SHM_K + NW * 64 * 4;
#define KSWZ(row, colB) ((row) * 256 + ((colB) ^ (((row) & 7) << 4)))
#define SBAR() __builtin_amdgcn_sched_barrier(0)
__device__ __forceinline__ int v_st(int k, int c) { const int kk = (k & ~0xC) | ((k & 4) << 1) | ((k & 8) >> 1); return ((kk >> 3) * 4 + (c >> 5)) * 512 + ((kk & 7) * 32 + (c & 31)) * 2; }
__device__ __forceinline__ int v_rd_base(int lane) { return ((lane & 3) << 3) | (((lane >> 2) & 3) << 6) | (((lane >> 4) & 1) << 5) | (((lane >> 5) & 1) << 8); }
constexpr int v_rd_off(int d0, int ks, int half) { return d0 * 512 + ks * 4096 + half * 2048; }
__device__ __forceinline__ int crow(int r, int hi) { return (r & 3) + 8 * (r >> 2) + 4 * hi; }
__device__ __forceinline__ bf16x8 load8(const bf16_t* p) { return *reinterpret_cast<const bf16x8*>(p); }
__device__ __forceinline__ void mask_tile(f32x16& p0, f32x16& p1, int dq, unsigned W) {
    const float NEG = -__builtin_inff();
#pragma unroll
    for (int r = 0; r < 16; ++r) {
        const int c = (r & 3) + 8 * (r >> 2);
        if ((unsigned)(dq - c) >= W) p0[r] = NEG;
        if ((unsigned)(dq - c - 32) >= W) p1[r] = NEG;
    }
}
__device__ __forceinline__ void partialSM(f32x16& p0, f32x16& p1, float& m_reg, float& mn, float& alpha) {
    float pmax = p0[0];
#pragma unroll
    for (int r = 1; r < 16; ++r) pmax = fmaxf(pmax, p0[r]);
#pragma unroll
    for (int r = 0; r < 16; ++r) pmax = fmaxf(pmax, p1[r]);
    { auto rr = __builtin_amdgcn_permlane32_swap(__float_as_uint(pmax), __float_as_uint(pmax), false, false);
      pmax = fmaxf(__uint_as_float(rr[0]), __uint_as_float(rr[1])); }
    constexpr float C2 = 1.4426950408889634f * SCALE;
    if (__builtin_expect(__all((pmax - m_reg) * SCALE <= THR), 1)) { mn = m_reg; alpha = 1.f; }
    else { mn = fmaxf(m_reg, pmax); alpha = __builtin_amdgcn_exp2f((m_reg - mn) * C2); m_reg = mn; }
    const float mnL = -mn * C2;
#pragma unroll
    for (int r = 0; r < 16; ++r) p0[r] = fmaf(p0[r], C2, mnL);
#pragma unroll
    for (int r = 0; r < 16; ++r) p1[r] = fmaf(p1[r], C2, mnL);
#pragma unroll
    for (int r = 0; r < 16; ++r) p0[r] = __builtin_amdgcn_exp2f(p0[r]);
}
__device__ __forceinline__ void finishSM(f32x16& p0, f32x16& p1, float alpha, float& l_reg, bf16x8& pa0, bf16x8& pa1, bf16x8& pa2, bf16x8& pa3) {
#pragma unroll
    for (int r = 0; r < 16; ++r) p1[r] = __builtin_amdgcn_exp2f(p1[r]);
    float ps = 0;
#pragma unroll
    for (int r = 0; r < 16; ++r) ps += p0[r];
#pragma unroll
    for (int r = 0; r < 16; ++r) ps += p1[r];
    { auto rr = __builtin_amdgcn_permlane32_swap(__float_as_uint(ps), __float_as_uint(ps), false, false);
      ps = __uint_as_float(rr[0]) + __uint_as_float(rr[1]); }
    l_reg = l_reg * alpha + ps;
#define PK4(P, B_, OUT) do { unsigned a0 = cvt_pk_bf16(P[B_+0], P[B_+1]), a1 = cvt_pk_bf16(P[B_+2], P[B_+3]);                          \
        unsigned b0 = cvt_pk_bf16(P[B_+4], P[B_+5]), b1 = cvt_pk_bf16(P[B_+6], P[B_+7]);                                             \
        auto r0 = __builtin_amdgcn_permlane32_swap(a0, b0, false, false); auto r1 = __builtin_amdgcn_permlane32_swap(a1, b1, false, false); \
        u32x4 w = {r0[0], r1[0], r0[1], r1[1]}; OUT = *reinterpret_cast<bf16x8*>(&w); } while (0)
    PK4(p0, 0, pa0); PK4(p0, 8, pa1); PK4(p1, 0, pa2); PK4(p1, 8, pa3);
#undef PK4
}
template <int KB>
__device__ __forceinline__ void qkt(f32x16& p0, f32x16& p1, const char* K_lds, int r32, int hi, const bf16x8* qr) {
    p0 = f32x16{}; p1 = f32x16{};
    const char* kb[4];
#pragma unroll
    for (int dd = 0; dd < 4; ++dd) kb[dd] = K_lds + KB * SHM_K + KSWZ(r32, (dd * 16 + hi * 8) * 2);
#pragma unroll
    for (int d0 = 0; d0 < 8; ++d0) { const char* a = kb[d0 & 3] + (d0 >> 2) * 128;
        bf16x8 b0 = *reinterpret_cast<const bf16x8*>(a);
        bf16x8 b1 = *reinterpret_cast<const bf16x8*>(a + 32 * 256);
        p0 = __builtin_amdgcn_mfma_f32_32x32x16_bf16(b0, qr[d0], p0, 0, 0, 0);
        p1 = __builtin_amdgcn_mfma_f32_32x32x16_bf16(b1, qr[d0], p1, 0, 0, 0); }
}
template <int VB>
__device__ __forceinline__ void pv_tile(f32x16* o, int vb0, bf16x8 pa0, bf16x8 pa1, bf16x8 pa2, bf16x8 pa3) {
#define TRRD(dst, off) asm volatile("ds_read_b64_tr_b16 %0, %1 offset:%2" : "=&v"(dst) : "v"(vb0), "i"(off) : "memory")
#define PV_D0(d0) do { s16x4 l0, l1, l2, l3, h0, h1, h2, h3; constexpr int b_ = VB * SHM_V + v_rd_off(d0, 0, 0); \
        TRRD(l0, b_); TRRD(h0, b_ + 2048); TRRD(l1, b_ + 4096); TRRD(h1, b_ + 6144); TRRD(l2, b_ + 8192); TRRD(h2, b_ + 10240); TRRD(l3, b_ + 12288); TRRD(h3, b_ + 14336); \
        asm volatile("s_waitcnt lgkmcnt(0)" ::: "memory"); SBAR();   \
        o[d0] = __builtin_amdgcn_mfma_f32_32x32x16_bf16(pa0, (bf16x8){l0[0], l0[1], l0[2], l0[3], h0[0], h0[1], h0[2], h0[3]}, o[d0], 0, 0, 0);   \
        o[d0] = __builtin_amdgcn_mfma_f32_32x32x16_bf16(pa1, (bf16x8){l1[0], l1[1], l1[2], l1[3], h1[0], h1[1], h1[2], h1[3]}, o[d0], 0, 0, 0);   \
        o[d0] = __builtin_amdgcn_mfma_f32_32x32x16_bf16(pa2, (bf16x8){l2[0], l2[1], l2[2], l2[3], h2[0], h2[1], h2[2], h2[3]}, o[d0], 0, 0, 0);   \
        o[d0] = __builtin_amdgcn_mfma_f32_32x32x16_bf16(pa3, (bf16x8){l3[0], l3[1], l3[2], l3[3], h3[0], h3[1], h3[2], h3[3]}, o[d0], 0, 0, 0); } while (0)
    PV_D0(0); PV_D0(1); PV_D0(2); PV_D0(3);
#undef PV_D0
#undef TRRD
}
struct BlockRef { const bf16_t* Q; const bf16_t* K; const bf16_t* V; float* O; int P0; };
struct Seam { bf16x8 qr[8]; bf16x8 st_v0, st_v1, st_k0, st_k1; };
#define ROW(p, k0, rr) ((p) + (size_t)((k0) + (rr)) * LDZ + sc)
#define VMW() asm volatile("s_waitcnt vmcnt(0)" ::: "memory")
#define VMWN(n) asm volatile("s_waitcnt vmcnt(%0)" :: "i"(n) : "memory")
#define SLOAD_H(Kp, Vp, k0) do { S.st_v0 = load8(ROW(Vp, k0, sr)); S.st_v1 = load8(ROW(Vp, k0, 32 + sr));              \
                         S.st_k0 = load8(ROW(Kp, k0, sr)); S.st_k1 = load8(ROW(Kp, k0, 32 + sr)); } while (0)
#define SWRITE_HK(bf) do { *(bf16x8*)(K_lds + (bf) * SHM_K + kws) = S.st_k0; *(bf16x8*)(K_lds + (bf) * SHM_K + kws + 32 * 256) = S.st_k1; } while (0)
#define SWRITE_HV(bf) do { *(bf16x8*)(V_lds + (bf) * SHM_V + vst0) = S.st_v0; *(bf16x8*)(V_lds + (bf) * SHM_V + vst1) = S.st_v1; } while (0)
#define SWRITE_H(bf) do { SWRITE_HV(bf); SWRITE_HK(bf); } while (0)
__device__ __forceinline__ void causal_prime(const BlockRef& cur, char* lds, Seam& S) {
    const int tid = ltid(), wid = __builtin_amdgcn_readfirstlane(tid >> 6), lane = tid & 63, r32 = lane & 31, hi = lane >> 5;
    const int sr = tid >> 4, sc = (tid & 15) * 8, kws = KSWZ(sr, sc * 2); char* K_lds = lds + 2 * SHM_V;
    const int kb0 = 0;
#pragma unroll
    for (int d0 = 0; d0 < 8; ++d0) S.qr[d0] = load8(cur.Q + (size_t)(wid * QBLK + r32) * LDZ + d0 * 16 + hi * 8);
    SLOAD_H(cur.K, cur.V, kb0); VMW(); SWRITE_HK(0);
    __syncthreads();
}
__device__ __forceinline__ void causal_block(const BlockRef& cur, const BlockRef& nxt, int skv, char* lds, Seam& S) {
    const int tid = ltid(), wid = __builtin_amdgcn_readfirstlane(tid >> 6), lane = tid & 63, r32 = lane & 31, hi = lane >> 5;
    const int W = 1 << 30;
    const int j_lo = 0;
    int j_hi = (cur.P0 + QB - 1) / KVBLK + 1; if (j_hi > skv / KVBLK) j_hi = skv / KVBLK;
    const int NT = j_hi - j_lo;
    const int kbn = 0;
    const int qlo = cur.P0 + wid * QBLK, qm = qlo + r32 - 4 * hi;
    char* V_lds = lds; char* K_lds = lds + 2 * SHM_V;
    float* ws = (float*)(lds + 2 * SHM_V + 2 * SHM_K) + wid * 64; float* li_l = ws, * al_l = ws + 32;
    float m_reg = -1e30f, l_reg = 0; f32x16 o[4];
    { float z_ = 0.f; asm volatile("" : "+v"(z_));
#pragma unroll
      for (int d_ = 0; d_ < 4; ++d_)
#pragma unroll
          for (int r = 0; r < 16; ++r) o[d_][r] = z_; }
    const int sr = tid >> 4, sc = (tid & 15) * 8, vst0 = v_st(sr, sc), vst1 = v_st(32 + sr, sc), kws = KSWZ(sr, sc * 2);
    const int vb0 = (int)(uintptr_t)V_lds + v_rd_base(lane);
    const bf16_t* Kh = cur.K; const bf16_t* Vh = cur.V;
#define RESC(a) do { if (__any((a) < 1.f)) { if (hi == 0) al_l[r32] = (a); asm volatile("s_waitcnt lgkmcnt(0)" ::: "memory");              \
                     _Pragma("unroll") for (int d_ = 0; d_ < 4; ++d_) _Pragma("unroll") for (int r = 0; r < 16; ++r) o[d_][r] *= al_l[crow(r, hi)]; } } while (0)
#define KBASE(t) ((j_lo + (t)) * KVBLK)
#define MASKT(P0_, P1_, t) do { const int kb_ = KBASE(t); if (kb_ + KVBLK - 1 > qlo) mask_tile(P0_, P1_, qm - kb_, (unsigned)W); } while (0)
    constexpr int NQL = 8;
#define SEAM_K0() do { VMWN(NQL); SWRITE_HK(0); SBAR(); } while (0)
    f32x16 pA0, pA1, pB0, pB1; float mnA, mnB, alA, alB; bf16x8 pa0, pa1, pa2, pa3;
    SWRITE_HV(0); SBAR();
    if (NT > 1) { SLOAD_H(Kh, Vh, KBASE(1)); }
    SBAR(); qkt<0>(pA0, pA1, K_lds, r32, hi, S.qr);
    MASKT(pA0, pA1, 0); partialSM(pA0, pA1, m_reg, mnA, alA);
    if (NT > 1) { VMW(); SWRITE_H(1); }
    __syncthreads();
#define HALF_STEP(PX0, PX1, mnX, alX, PY0, PY1, alY, t, KB, VB, SB) do {                                                      \
        SBAR(); qkt<KB>(PX0, PX1, K_lds, r32, hi, S.qr);                                                                      \
        finishSM(PY0, PY1, alY, l_reg, pa0, pa1, pa2, pa3); SBAR();                                                           \
        if ((t) + 1 < NT) { SLOAD_H(Kh, Vh, KBASE((t) + 1)); SBAR(); }                                                        \
        pv_tile<VB>(o, vb0, pa0, pa1, pa2, pa3); MASKT(PX0, PX1, (t)); partialSM(PX0, PX1, m_reg, mnX, alX);                  \
        __syncthreads();                                                                                                      \
        if ((t) + 1 < NT) { VMW(); SWRITE_H(SB); }                                                                            \
        RESC(alX); __syncthreads(); } while (0)
    for (int t = 1; t + 1 < NT; t += 2) {
        HALF_STEP(pB0, pB1, mnB, alB, pA0, pA1, alA, t, 1, 0, 0);
        HALF_STEP(pA0, pA1, mnA, alA, pB0, pB1, alB, t + 1, 0, 1, 1);
    }
    const bool even = (NT & 1) == 0;
    if (even) { SBAR(); qkt<1>(pB0, pB1, K_lds, r32, hi, S.qr); SBAR(); }
    SLOAD_H(nxt.K, nxt.V, kbn); SBAR();
#pragma unroll
    for (int d0 = 0; d0 < 8; ++d0) S.qr[d0] = load8(nxt.Q + (size_t)(wid * QBLK + r32) * LDZ + d0 * 16 + hi * 8);
    SBAR();
    finishSM(pA0, pA1, alA, l_reg, pa0, pa1, pa2, pa3); SBAR();
    pv_tile<0>(o, vb0, pa0, pa1, pa2, pa3);
    if (even) { MASKT(pB0, pB1, NT - 1); partialSM(pB0, pB1, m_reg, mnB, alB); __syncthreads(); RESC(alB);
        finishSM(pB0, pB1, alB, l_reg, pa0, pa1, pa2, pa3); SBAR(); pv_tile<1>(o, vb0, pa0, pa1, pa2, pa3); }
    SBAR(); SEAM_K0();
    if (hi == 0) li_l[r32] = l_reg; asm volatile("s_waitcnt lgkmcnt(0)" ::: "memory");
    float rli[16];
#pragma unroll
    for (int r = 0; r < 16; ++r) rli[r] = __builtin_amdgcn_rcpf(li_l[crow(r, hi)]);
    float* Ow = cur.O + (size_t)(wid * QBLK) * LDO;
#pragma unroll
    for (int r = 0; r < 16; ++r) { const int orow = crow(r, hi);
#pragma unroll
        for (int d0 = 0; d0 < 4; ++d0) { const float v = o[d0][r] * rli[r]; Ow[(size_t)orow * LDO + d0 * 32 + r32] = v; } }
    __syncthreads();
#undef RESC
#undef KBASE
#undef MASKT
#undef SEAM_K0
#undef HALF_STEP
}
#undef ROW
#undef VMW
#undef VMWN
#undef SLOAD_H
#undef SWRITE_HK
#undef SWRITE_HV
#undef SWRITE_H
#undef KSWZ
#undef SBAR
}

#define XB_TMO      128
#define XB_XCNT(j)  (256  + 64 * (j))
#define XB_XSUB(j)  (1280 + 64 * (j))
#define XB_XGEN(j)  (2304 + 64 * (j))
#define XB_TOP      3328
#define XB_TOPGEN   3392
#define XCD_BAR_WORDS 3456
#define XB_SPIN_CAP (1u << 18)

__device__ __forceinline__ unsigned xb_ld(unsigned* p)              { return __hip_atomic_load(p, __ATOMIC_RELAXED, __HIP_MEMORY_SCOPE_AGENT); }
__device__ __forceinline__ unsigned xb_add(unsigned* p, unsigned v) { return __hip_atomic_fetch_add(p, v, __ATOMIC_RELAXED, __HIP_MEMORY_SCOPE_AGENT); }
__device__ __forceinline__ unsigned xb_xcc_id() { return (unsigned)__builtin_amdgcn_s_getreg((3 << 11) | 20) & 0xFu; }
#define XB_SPIN(cond, bar) do { unsigned _sp = 0; while (cond) { __builtin_amdgcn_s_sleep(1); \
    if ((++_sp & 255u) == 0u) { if (xb_ld(&(bar)[XB_TMO])) break; if (_sp > XB_SPIN_CAP) { atomicAdd(&(bar)[XB_TMO], 1u); break; } } } } while (0)

struct XcdBarrier {
    unsigned* bar; unsigned x;
    volatile LAS unsigned* st;
};

__device__ __forceinline__ XcdBarrier xcd_barrier_post(unsigned* bar, volatile LAS unsigned* st) {
    XcdBarrier b; b.bar = bar; b.x = xb_xcc_id(); b.st = st;
    if (threadIdx.x == 0) (void)xb_add(&bar[XB_XCNT(b.x)], 1u);
    return b;
}
__device__ __forceinline__ void xcd_barrier_complete(unsigned* bar, unsigned x, unsigned& nloc, unsigned& nx) {
    const unsigned G = gridDim.x * gridDim.y * gridDim.z;
    unsigned sum, cnt, mine, sp = 0u;
    for (;;) {
        sum = 0u; cnt = 0u; mine = 0u;
#pragma unroll
        for (unsigned j = 0; j < 16; ++j) { const unsigned c = xb_ld(&bar[XB_XCNT(j)]); sum += c; cnt += (c > 0u) ? 1u : 0u; mine = (j == x) ? c : mine; }
        if (sum == G) break;
        __builtin_amdgcn_s_sleep(1);
        if ((++sp & 255u) == 0u) { if (xb_ld(&bar[XB_TMO])) break; if (sp > XB_SPIN_CAP) { atomicAdd(&bar[XB_TMO], 1u); break; } }
    }
    nloc = mine > 0u ? mine : 1u; nx = cnt > 0u ? cnt : 1u;
}

template <bool FIRST> __device__ __forceinline__ void xcd_barrier(const XcdBarrier& b) {
    asm volatile("s_waitcnt vmcnt(0)" ::: "memory");
    __syncthreads();
    if (threadIdx.x == 0) {
        unsigned* bar = b.bar;
        __builtin_amdgcn_s_waitcnt(0);
        unsigned nloc = b.st[0], nx = b.st[1];
        if (FIRST) { if (nloc == 0u) { xcd_barrier_complete(bar, b.x, nloc, nx); b.st[0] = nloc; b.st[1] = nx; } }
        const unsigned old = xb_add(&bar[XB_XSUB(b.x)], 1u);
        const unsigned gen = old / nloc;
        if (old + 1u == (gen + 1u) * nloc) {
            __builtin_amdgcn_fence(__ATOMIC_RELEASE, "agent");
            asm volatile("s_waitcnt vmcnt(0)" ::: "memory");
            const unsigned og = xb_add(&bar[XB_TOP], 1u);
            const unsigned tg = og / nx;
            if (og + 1u == (tg + 1u) * nx) xb_add(&bar[XB_TOPGEN], 1u);
            else XB_SPIN(xb_ld(&bar[XB_TOPGEN]) == tg, bar);
            __builtin_amdgcn_fence(__ATOMIC_ACQUIRE, "agent");
            xb_add(&bar[XB_XGEN(b.x)], 1u);
            asm volatile("s_waitcnt vmcnt(0)" ::: "memory");
        } else {
            XB_SPIN(xb_ld(&bar[XB_XGEN(b.x)]) == gen, bar);
            __builtin_amdgcn_fence(__ATOMIC_ACQUIRE, "agent");
            asm volatile("s_waitcnt vmcnt(0)" ::: "memory");
        }
    }
    __syncthreads();
}

template <int KT, bool F8>
__device__ __forceinline__ void transpose_item(const float* W, int K, int N, void* WT, int drow0, int k0, int n0, LAS float* scr, int lane, const float* gk) {
    const int kr = lane >> 3, n4 = 4 * (lane & 7);
    f32x4 v[KT / 8];
#pragma unroll
    for (int i = 0; i < KT / 8; ++i) v[i] = *(const f32x4*)(W + (size_t)(k0 + kr + 8 * i) * N + n0 + n4);
    if (gk) {
#pragma unroll
        for (int i = 0; i < KT / 8; ++i) v[i] = v[i] * gk[k0 + kr + 8 * i]; }
#pragma unroll
    for (int i = 0; i < KT / 8; ++i) { LAS float* s = scr + (kr + 8 * i) * 33 + n4; s[0] = v[i][0]; s[1] = v[i][1]; s[2] = v[i][2]; s[3] = v[i][3]; }
    LDS_WAIT(); asm volatile("" ::: "memory");
    const int c = lane & 7;
#pragma unroll
    for (int j = 0; j < 4; ++j) { const int n = (lane >> 3) + 8 * j;
        if constexpr (!F8) { static_assert(F8 || KT == 64, "bf16 item is 64 k");
            const LAS float* s = scr + (8 * c) * 33 + n;
            u32x4 o; o.x = cvt_pk_bf16(s[0 * 33], s[1 * 33]); o.y = cvt_pk_bf16(s[2 * 33], s[3 * 33]); o.z = cvt_pk_bf16(s[4 * 33], s[5 * 33]); o.w = cvt_pk_bf16(s[6 * 33], s[7 * 33]);
            *(u32x4*)((bf16_t*)WT + (size_t)(drow0 + n) * K + k0 + 8 * c) = o;
        } else { static_assert(!F8 || KT == 128, "fp8 item is 128 k");
            const LAS float* s = scr + (16 * c) * 33 + n;
            u32x4 o;
            o.x = pk4_fp8(s[0 * 33] * W8_SCALE, s[1 * 33] * W8_SCALE, s[2 * 33] * W8_SCALE, s[3 * 33] * W8_SCALE);
            o.y = pk4_fp8(s[4 * 33] * W8_SCALE, s[5 * 33] * W8_SCALE, s[6 * 33] * W8_SCALE, s[7 * 33] * W8_SCALE);
            o.z = pk4_fp8(s[8 * 33] * W8_SCALE, s[9 * 33] * W8_SCALE, s[10 * 33] * W8_SCALE, s[11 * 33] * W8_SCALE);
            o.w = pk4_fp8(s[12 * 33] * W8_SCALE, s[13 * 33] * W8_SCALE, s[14 * 33] * W8_SCALE, s[15 * 33] * W8_SCALE);
            *(u32x4*)((unsigned char*)WT + (size_t)(drow0 + n) * K + k0 + 16 * c) = o;
        } }
    LDS_WAIT(); asm volatile("" ::: "memory");
}
__device__ __forceinline__ float row_copy_ss(const float* xrow, bf16_t* orow, int lane) {
    const f32x4* xr = (const f32x4*)xrow + lane; u32x2* o8 = (u32x2*)orow + lane;
    float s = 0.f;
#pragma unroll
    for (int j = 0; j < 8; ++j) { const f32x4 v = xr[64 * j]; s += (v.x * v.x + v.y * v.y) + (v.z * v.z + v.w * v.w); u32x2 w; w.x = cvt_pk_bf16(v.x, v.y); w.y = cvt_pk_bf16(v.z, v.w); o8[64 * j] = w; }
    return wave_sum(s);
}

struct Args { const void* in[20]; float* out; unsigned char* ws; };

__global__ void __launch_bounds__(512, 2) hybrid_fwd(Args args) {
    extern __shared__ __attribute__((aligned(16))) unsigned char lds_raw[];
    LAS unsigned char* lds = (LAS unsigned char*)lds_raw;
    volatile LAS unsigned* LW = (volatile LAS unsigned*)(lds + LDSCTL_OFF);
    const int tid = threadIdx.x, lane = tid & 63, wave = __builtin_amdgcn_readfirstlane(tid >> 6);
    const int G = gridDim.x, bx = blockIdx.x;
    const int gw = bx * 8 + wave, NGW = G * 8;
    for (int u = tid; u < LDSCTL_BYTES / 4; u += 512) LW[u] = 0u;
    __syncthreads();
    if (tid < 22) { const unsigned long long pv = tid < 20 ? (unsigned long long)args.in[tid] : (tid == 20 ? (unsigned long long)args.out : (unsigned long long)args.ws);
        LW[64 + 2 * tid] = (unsigned)pv; LW[64 + 2 * tid + 1] = (unsigned)(pv >> 32); }
    __syncthreads();
#define PTR(i) ((unsigned long long)(unsigned)__builtin_amdgcn_readfirstlane((int)LW[64 + 2 * (i)]) | ((unsigned long long)(unsigned)__builtin_amdgcn_readfirstlane((int)LW[64 + 2 * (i) + 1]) << 32))
#define INF(i) ((const float*)(GAS const float*)PTR(i))
#define WSP(T, off) ((T*)(GAS T*)(PTR(21) + (unsigned long long)(off)))
#define OUTP ((float*)(GAS float*)PTR(20))
    { const XcdBarrier b0 = xcd_barrier_post(WSP(unsigned, WS_CTL) + CW_BAR, LW); if (threadIdx.x == 0) LW[2] = b0.x; }
    __syncthreads();
#define GRID_BAR_T(F) do { XcdBarrier b_; b_.bar = WSP(unsigned, WS_CTL) + CW_BAR; b_.x = (unsigned)__builtin_amdgcn_readfirstlane((int)LW[2]); b_.st = LW; xcd_barrier<F>(b_); } while (0)
#define GRID_BAR() GRID_BAR_T(false)

    for (int rep_ = 0; rep_ < REP_P0; ++rep_) {
        LAS float* scr = (LAS float*)(lds + 1024 + wave * 16896);
        constexpr int I_IN = 32 * 160, I_OUT = 32 * 64, I_DG = 32 * 176, I_DD = 88 * 64;
        constexpr int J_DG = 16 * 176, J_DD = 44 * 64, J_MG = 16 * 224, J_MD = 56 * 64;
        constexpr int N16A = 2 * I_IN + 2 * I_OUT, N16B = N16A + (DUP8 ? 0 : 2 * I_DG), N16 = N16B + (DDN8 ? 0 : I_DD);
        constexpr int N8A = DUP8 ? 2 * J_DG : 0, N8B = N8A + (DDN8 ? J_DD : 0), N8 = N8B + 16 * J_MG + 8 * J_MD;
        unsigned char* ws = WSP(unsigned char, 0);
        for (int it = gw; it < N16 + N8; it += NGW) {
            if (it < N16) {
                int r = it; const float* W; bf16_t* WT; int K = DM, N, mode = 0; const float* gk = nullptr;
                if (r < 2 * I_IN) { const int l = r / I_IN; r -= l * I_IN; W = INF(3) + (size_t)l * DM * INW; WT = (bf16_t*)(ws + WS_WIN) + (size_t)l * INW * DM; N = INW; gk = INF(2) + l * DM; }
                else if (r < N16A) { r -= 2 * I_IN; const int l = r / I_OUT; r -= l * I_OUT; W = INF(11) + (size_t)l * DM * DM; WT = (bf16_t*)(ws + WS_WOUT) + (size_t)l * DM * DM; N = DM; }
                else if (r < N16B) { r -= N16A; mode = 1 + r / I_DG; r -= (mode - 1) * I_DG; W = mode == 1 ? INF(13) : INF(14); WT = (bf16_t*)(ws + WS_WDGU); N = FFD; gk = INF(12); }
                else { r -= N16B; W = INF(15); WT = (bf16_t*)(ws + WS_WDD); K = FFD; N = DM; }
                const int nblk = N / 32, kb = r / nblk, nb = r - kb * nblk, n0 = 32 * nb;
                const int drow0 = mode == 0 ? n0 : (256 * (n0 >> 7) + (mode - 1) * 128 + (n0 & 127));
                transpose_item<64, false>(W, K, N, WT, drow0, 64 * kb, n0, scr, lane, gk);
            } else {
                int r = it - N16; const float* W; unsigned char* WT; int K, N, mode = 0; const float* gk = nullptr;
                if (r < N8A) { mode = 1 + r / J_DG; r -= (mode - 1) * J_DG; W = mode == 1 ? INF(13) : INF(14); WT = ws + WS_WDGU; K = DM; N = FFD; gk = INF(12); }
                else if (r < N8B) { r -= N8A; W = INF(15); WT = ws + WS_WDD; K = FFD; N = DM; }
                else if ((r -= N8B) < 8 * J_MG) { const int e = r / J_MG; r -= e * J_MG; W = INF(17) + (size_t)e * DM * FFE; WT = ws + WS_WMGU + (size_t)e * 2 * FFE * DM; K = DM; N = FFE; mode = 1; gk = INF(12) + DM; }
                else if ((r -= 8 * J_MG) < 8 * J_MG) { const int e = r / J_MG; r -= e * J_MG; W = INF(18) + (size_t)e * DM * FFE; WT = ws + WS_WMGU + (size_t)e * 2 * FFE * DM; K = DM; N = FFE; mode = 2; gk = INF(12) + DM; }
                else { r -= 8 * J_MG; const int e = r / J_MD; r -= e * J_MD; W = INF(19) + (size_t)e * FFE * DM; WT = ws + WS_WMD + (size_t)e * DM * FFE; K = FFE; N = DM; }
                const int nblk = N / 32, kb = r / nblk, nb = r - kb * nblk, n0 = 32 * nb;
                const int drow0 = mode == 0 ? n0 : (256 * (n0 >> 7) + (mode - 1) * 128 + (n0 & 127));
                transpose_item<128, true>(W, K, N, WT, drow0, 128 * kb, n0, scr, lane, gk);
            }
        }
        {
            const int* positions = (const int*)(GAS const int*)PTR(1); float* cosT = (float*)(ws + WS_COS); float* sinT = (float*)(ws + WS_SIN);
            for (int idx = (bx * 512 + tid); idx < NTOK * 64; idx += G * 512) {
                const int t = idx >> 6, i = idx & 63;
                const float inv = 1.0f / powf(10000.0f, (float)(2 * i) / 128.0f);
                const float ang = (float)positions[t] * inv;
                double rev = (double)ang * 0.15915494309189535; rev -= rint(rev);
                const float rf = (float)rev;
                cosT[idx] = __builtin_amdgcn_cosf(rf); sinT[idx] = __builtin_amdgcn_sinf(rf);
            }
        }
        {
            const float* w_pool = INF(8); bf16_t* wpt = (bf16_t*)(ws + WS_WPT);
            for (int idx = (bx * 512 + tid); idx < 2 * 4 * 128 * 128; idx += G * 512) {
                const int c = idx & 127, d = (idx >> 7) & 127, lg = idx >> 14;
                const float v = w_pool[((size_t)lg * 128 + c) * 128 + d];
                wpt[idx] = (bf16_t)(cvt_pk_bf16(v, 0.f) & 0xffffu);
            }
        }
        {
            const float* x_in = INF(0); bf16_t* xb = (bf16_t*)(ws + WS_XN); u64_t* ss0 = (u64_t*)(ws + WS_SS);
            for (int m = gw; m < NTOK; m += NGW) { const float s = row_copy_ss(x_in + (size_t)m * DM, xb + (size_t)m * DM, lane); if (lane == 0) ss0[m] = ss_fix(s); }
        }
    }
    GRID_BAR_T(true);

    for (int l = 0; l < DEPTH; ++l) {
#define PHASE_IDS() const int tid = ltid(), lane = tid & 63, wave = __builtin_amdgcn_readfirstlane(tid >> 6), gw = bx * 8 + wave; (void)tid; (void)lane; (void)wave; (void)gw
        for (int rep_ = 0; rep_ < REP_P1; ++rep_) {
            pg8::Gemm g{WSP(bf16_t, WS_XN), WSP(bf16_t, WS_WIN) + (size_t)l * INW * DM, DM * 2, 0};
            pg8::StaticOrder S; S.init(NTOK / 256, INW / 256, G, bx);
            pg8::EpiBf16<1> E{WSP(bf16_t, WS_Z), INW, WSP(u64_t, WS_SS) + (l == 0 ? 0 : 2 * NTOK)};
            pg8::gemm_phase<pg8::EpiBf16<1>, pg8::StaticOrder>(lds + RING_OFF, g, S, E);
        }
        GRID_BAR();
        if (PH_MASK & (1 << 2)) {
            PHASE_IDS();
            bf16_t* zb = WSP(bf16_t, WS_Z); bf16_t* mix = WSP(bf16_t, WS_MIX);
            {
            const float* qg = INF(4) + l * 128; const float* kg = INF(5) + l * 128;
            const float* cw = INF(10) + (size_t)l * 3 * 512;
            const float* cosT = WSP(float, WS_COS); const float* sinT = WSP(float, WS_SIN);
            for (int t = gw; t < NTOK; t += NGW) {
                bf16_t* zr = zb + (size_t)t * INW;
                {
                    const int c = lane >> 2, sub = lane & 3;
                    bf16_t* p = zr + c * 128 + 16 * sub;
                    const u32x4 a0 = *(const u32x4*)p, a1 = *(const u32x4*)(p + 8), b0 = *(const u32x4*)(p + 64), b1 = *(const u32x4*)(p + 72);
                    float xa[16], xb[16];
#pragma unroll
                    for (int j = 0; j < 4; ++j) { xa[2 * j] = bflo(a0[j]); xa[2 * j + 1] = bfhi(a0[j]); xa[8 + 2 * j] = bflo(a1[j]); xa[8 + 2 * j + 1] = bfhi(a1[j]);
                                                  xb[2 * j] = bflo(b0[j]); xb[2 * j + 1] = bfhi(b0[j]); xb[8 + 2 * j] = bflo(b1[j]); xb[8 + 2 * j + 1] = bfhi(b1[j]); }
                    float ss = 0.f;
#pragma unroll
                    for (int j = 0; j < 16; ++j) ss += xa[j] * xa[j] + xb[j] * xb[j];
                    ss += __shfl_xor(ss, 1); ss += __shfl_xor(ss, 2);
                    const float rstd = 1.0f / sqrtf(ss * (1.0f / 128.0f) + EPS);
                    const float* gp = (c < 8 ? qg : kg) + 16 * sub;
                    const float* cp = cosT + (size_t)t * 64 + 16 * sub; const float* sp = sinT + (size_t)t * 64 + 16 * sub;
                    float oa[16], ob[16];
#pragma unroll
                    for (int j = 0; j < 16; ++j) { const float x1 = xa[j] * rstd * gp[j], x2 = xb[j] * rstd * gp[64 + j]; const float cs = cp[j], sn = sp[j];
                        oa[j] = x1 * cs - x2 * sn; ob[j] = x1 * sn + x2 * cs; }
                    u32x4 w0, w1, w2, w3;
#pragma unroll
                    for (int j = 0; j < 4; ++j) { w0[j] = cvt_pk_bf16(oa[2 * j], oa[2 * j + 1]); w1[j] = cvt_pk_bf16(oa[8 + 2 * j], oa[8 + 2 * j + 1]);
                                                  w2[j] = cvt_pk_bf16(ob[2 * j], ob[2 * j + 1]); w3[j] = cvt_pk_bf16(ob[8 + 2 * j], ob[8 + 2 * j + 1]); }
                    *(u32x4*)p = w0; *(u32x4*)(p + 8) = w1; *(u32x4*)(p + 64) = w2; *(u32x4*)(p + 72) = w3;
                }
                {
                    const int tb = t & (SEQ - 1), ch = 8 * lane;
                    const u32x4 gb = *(const u32x4*)(zr + ZGB + ch);
                    float y[8];
#pragma unroll
                    for (int j = 0; j < 8; ++j) y[j] = 0.f;
#pragma unroll
                    for (int d = 0; d < 3; ++d) {
                        if (tb >= d) {
                            const bf16_t* zd = zr - (size_t)d * INW;
                            const u32x4 gc = *(const u32x4*)(zd + ZGC + ch), hc = *(const u32x4*)(zd + ZH + ch);
                            const f32x4 wa = *(const f32x4*)(cw + (2 - d) * 512 + ch), wb = *(const f32x4*)(cw + (2 - d) * 512 + ch + 4);
#pragma unroll
                            for (int j = 0; j < 4; ++j) { const float u0 = bflo(gc[j]) * bflo(hc[j]), u1 = bfhi(gc[j]) * bfhi(hc[j]);
                                const float k0_ = (j < 2) ? wa[2 * j] : wb[2 * j - 4], k1_ = (j < 2) ? wa[2 * j + 1] : wb[2 * j - 3];
                                y[2 * j] += k0_ * u0; y[2 * j + 1] += k1_ * u1; }
                        }
                    }
                    u32x4 w;
#pragma unroll
                    for (int j = 0; j < 4; ++j) w[j] = cvt_pk_bf16(bflo(gb[j]) * y[2 * j], bfhi(gb[j]) * y[2 * j + 1]);
                    *(u32x4*)(mix + (size_t)t * DM + 1536 + ch) = w;
                }
            }
            }
            {
            const bf16_t* wpt = WSP(bf16_t, WS_WPT); const float* pool_scale = INF(9) + l * 512;
            for (int it = gw; it < (NTOK / 32) * 4; it += NGW) {
                const int T = it >> 2, gi = it & 3, wn = 2 << gi, t0 = T * 32;
                const int r32 = lane & 31, hi = lane >> 5, t = t0 + r32, tb = t & (SEQ - 1);
                const float inv = 1.0f / (float)((tb + 1) < wn ? (tb + 1) : wn);
                const bf16_t* zp = zb + (size_t)t * INW + ZP + gi * 128;
                const bf16_t* wp = wpt + ((size_t)(l * 4 + gi) * 128) * 128;
                f32x16 acc[4];
#pragma unroll
                for (int nb = 0; nb < 4; ++nb) acc[nb] = f32x16{};
#pragma unroll 1
                for (int s = 0; s < 8; ++s) {
                    const int cb = 16 * s + 8 * hi;
                    float sum[8], self[8];
#pragma unroll
                    for (int j = 0; j < 8; ++j) { sum[j] = 0.f; self[j] = 0.f; }
                    u32x4 rv[16];
#pragma unroll
                    for (int d = 0; d < 16; ++d) { rv[d] = (u32x4){0u, 0u, 0u, 0u}; if (d < wn) { if (d <= tb) rv[d] = *(const u32x4*)(zp - (size_t)d * INW + cb); } }
#pragma unroll
                    for (int d = 0; d < 16; ++d) {
#pragma unroll
                        for (int j = 0; j < 4; ++j) { const float a = bflo(rv[d][j]), b = bfhi(rv[d][j]); sum[2 * j] += a; sum[2 * j + 1] += b; if (d == 0) { self[2 * j] = a; self[2 * j + 1] = b; } }
                    }
                    u32x4 aw;
#pragma unroll
                    for (int j = 0; j < 4; ++j) aw[j] = cvt_pk_bf16(sum[2 * j] * inv - self[2 * j], sum[2 * j + 1] * inv - self[2 * j + 1]);
                    const bf16x8 af = __builtin_bit_cast(bf16x8, aw);
#pragma unroll
                    for (int nb = 0; nb < 4; ++nb) { const bf16x8 bfr = *(const bf16x8*)(wp + (size_t)(nb * 32 + r32) * 128 + cb);
                        acc[nb] = __builtin_amdgcn_mfma_f32_32x32x16_bf16(af, bfr, acc[nb], 0, 0, 0); }
                }
#pragma unroll
                for (int nb = 0; nb < 4; ++nb) { const int col = gi * 128 + nb * 32 + r32; const float ps = pool_scale[col];
#pragma unroll
                    for (int r = 0; r < 16; ++r) { const int row = (r & 3) + 8 * (r >> 2) + 4 * hi;
                        mix[(size_t)(t0 + row) * DM + 1024 + col] = (bf16_t)(cvt_pk_bf16(acc[nb][r] * ps, 0.f) & 0xffffu); } }
            }
            }
        }
        GRID_BAR();
        for (int rep_ = 0; rep_ < REP_P3; ++rep_) {
            constexpr int NITEM = 512;
            char* alds = (char*)lds_raw + RING_OFF;
            int L = bx;
            if (L < NITEM) {
                const bf16_t* zb = WSP(bf16_t, WS_Z); float* ao = WSP(float, WS_AO);
#define ATT_REF(ref, LL, pass) do { const int xcd_ = (LL) & 7, k_ = (LL) >> 3, bh_ = (k_ >> 4) * 8 + xcd_, b_ = bh_ >> 2, h_ = bh_ & 3, vh_ = (k_ & 15) >> 2, mp_ = vh_ >> 1, vj_ = vh_ & 1, x_ = k_ & 3; \
                    const int qb_ = (pass) ? 7 - x_ : x_; const bf16_t* zb_ = zb + (size_t)b_ * SEQ * INW; \
                    (ref).Q = zb_ + (size_t)qb_ * 256 * INW + ZQ + h_ * 256 + mp_ * 128; (ref).K = zb_ + ZK + h_ * 256 + mp_ * 128; (ref).V = zb_ + ZV + h_ * 256 + vj_ * 128; \
                    (ref).O = ao + ((size_t)b_ * SEQ + (size_t)qb_ * 256) * DM + h_ * 512 + mp_ * 256 + vj_ * 128; (ref).P0 = qb_ * 256; } while (0)
                att::BlockRef cur, nxt; int pass = 0;
                ATT_REF(cur, L, 0);
                att::Seam S;
                att::causal_prime(cur, alds, S);
                for (;;) {
                    const bool more_pass = pass == 0, more_item = L + G < NITEM, last = !more_pass && !more_item;
                    int passn = pass + 1, Ln = L;
                    if (!more_pass) { passn = 0; Ln = more_item ? L + G : L; }
                    if (last) nxt = cur; else ATT_REF(nxt, Ln, passn);
                    att::causal_block(cur, nxt, SEQ, alds, S);
                    if (last) break;
                    cur = nxt; pass = passn; L = Ln;
                }
#undef ATT_REF
            }
        }
        GRID_BAR();
        if (PH_MASK & (1 << 4)) {
            PHASE_IDS();
            const float lam_init = (l == 0) ? 0.2f : 0.35550906759096926f;
            const float* lv = INF(6) + (size_t)l * 512;
            const float d01 = wave_sum(lv[lane] * lv[128 + lane] + lv[64 + lane] * lv[192 + lane]);
            const float d23 = wave_sum(lv[256 + lane] * lv[384 + lane] + lv[320 + lane] * lv[448 + lane]);
            const float lam = expf(d01) - expf(d23) + lam_init;
            const float oscale = 1.0f - lam_init;
            const int h = lane >> 4, e0 = (lane & 15) * 16;
            const float* sg = INF(7) + l * 256 + e0;
            const float* ao = WSP(float, WS_AO); bf16_t* mix = WSP(bf16_t, WS_MIX);
            for (int t = gw; t < NTOK; t += NGW) {
                const float* o0 = ao + (size_t)t * DM + h * 512 + e0; const float* o1 = o0 + 256;
                float dv[16]; float ss = 0.f;
#pragma unroll
                for (int j = 0; j < 4; ++j) { const f32x4 a = *(const f32x4*)(o0 + 4 * j), b = *(const f32x4*)(o1 + 4 * j);
#pragma unroll
                    for (int q = 0; q < 4; ++q) { const float d = a[q] - lam * b[q]; dv[4 * j + q] = d; ss += d * d; } }
                ss += __shfl_xor(ss, 1); ss += __shfl_xor(ss, 2); ss += __shfl_xor(ss, 4); ss += __shfl_xor(ss, 8);
                const float rstd = 1.0f / sqrtf(ss * (1.0f / 256.0f) + EPS);
                u32x4 w0, w1;
#pragma unroll
                for (int j = 0; j < 4; ++j) { w0[j] = cvt_pk_bf16(dv[2 * j] * rstd * sg[2 * j] * oscale, dv[2 * j + 1] * rstd * sg[2 * j + 1] * oscale);
                                              w1[j] = cvt_pk_bf16(dv[8 + 2 * j] * rstd * sg[8 + 2 * j] * oscale, dv[8 + 2 * j + 1] * rstd * sg[8 + 2 * j + 1] * oscale); }
                bf16_t* mp = mix + (size_t)t * DM + h * 256 + e0;
                *(u32x4*)mp = w0; *(u32x4*)(mp + 8) = w1;
            }
        }
        GRID_BAR();
        if (PH_MASK & (1 << 5)) {
            pg8::Gemm g{WSP(bf16_t, WS_MIX), WSP(bf16_t, WS_WOUT) + (size_t)l * DM * DM, DM * 2, 0};
            pg8::StaticOrder S; S.init(NTOK / 256, DM / 256, G, bx);
            float* out = OUTP;
            pg8::EpiResF32 E{l == 0 ? INF(0) : (const float*)out, out, DM, WSP(void, WS_XN), WSP(u64_t, WS_SS) + (l == 0 ? 1 : 3) * NTOK, l == 0 ? (int)DUP8 : 1};
            pg8::gemm_phase<pg8::EpiResF32, pg8::StaticOrder>(lds + RING_OFF, g, S, E);
        }
        GRID_BAR();
        if (l == 0 && (PH_MASK & (1 << 6))) {
            {
                pg8::Gemm g{WSP(unsigned char, WS_XN), WSP(unsigned char, WS_WDGU), DUP8 ? DM : 2 * DM, 0};
                pg8::StaticOrder S; S.init(NTOK / 256, 2 * FFD / 256, G, bx);
                const u64_t* ss1 = WSP(u64_t, WS_SS) + NTOK;
                if constexpr (DDN8) { pg8::EpiSwigluF8<1> E{WSP(unsigned char, WS_ACTD), FFD, ss1};
                    pg8::gemm_phase<pg8::EpiSwigluF8<1>, pg8::StaticOrder, (bool)DUP8, DUP8 ? SC_W : SC_ONE, SC_ONE>(lds + RING_OFF, g, S, E); }
                else { pg8::EpiSwiglu<1> E{WSP(bf16_t, WS_ACTD), FFD, ss1};
                    pg8::gemm_phase<pg8::EpiSwiglu<1>, pg8::StaticOrder, (bool)DUP8, DUP8 ? SC_W : SC_ONE, SC_ONE>(lds + RING_OFF, g, S, E); }
            }
            GRID_BAR();
            {
                pg8::Gemm g{WSP(unsigned char, WS_ACTD), WSP(unsigned char, WS_WDD), DDN8 ? FFD : 2 * FFD, 0};
                pg8::StaticOrder S; S.init(NTOK / 256, DM / 256, G, bx);
                float* out = OUTP;
                pg8::EpiResF32 E{out, out, DM, WSP(void, WS_XN), WSP(u64_t, WS_SS) + 2 * NTOK, 0};
                pg8::gemm_phase<pg8::EpiResF32, pg8::StaticOrder, (bool)DDN8, DDN8 ? SC_W : SC_ONE, DDN8 ? SC_A : SC_ONE>(lds + RING_OFF, g, S, E);
            }
            GRID_BAR();
        } else if (PH_MASK & (1 << 7)) {
            const int TPW = (NTOK + G - 1) / G;
            {
                PHASE_IDS();
                if (tid < 8) LW[LW_CNT + tid] = 0u;
                LAS float* RT = (LAS float*)(lds + RING_OFF);
                { const float* router_w = INF(16); const float* gn = INF(12) + DM;
                  for (int k = tid; k < DM; k += 512) { const f32x4 ra = *(const f32x4*)(router_w + (size_t)k * 8), rb = *(const f32x4*)(router_w + (size_t)k * 8 + 4); const float gk = gn[k];
                      RT[0 * DM + k] = ra[0] * gk; RT[1 * DM + k] = ra[1] * gk; RT[2 * DM + k] = ra[2] * gk; RT[3 * DM + k] = ra[3] * gk;
                      RT[4 * DM + k] = rb[0] * gk; RT[5 * DM + k] = rb[1] * gk; RT[6 * DM + k] = rb[2] * gk; RT[7 * DM + k] = rb[3] * gk; } }
                __syncthreads();
                const float* out = OUTP; const u64_t* ss3 = WSP(u64_t, WS_SS) + 3 * NTOK;
                int* tokE = WSP(int, WS_TOKE); int* tokR = WSP(int, WS_TOKR); float* tokG = WSP(float, WS_TOKG);
                const int tlo = bx * TPW, thi = (tlo + TPW) < NTOK ? (tlo + TPW) : NTOK;
                for (int t = tlo + wave; t < thi; t += 8) {
                    const float rstd = ss_rstd(ss3[t]);
                    const f32x4* xr = (const f32x4*)(out + (size_t)t * DM) + lane;
                    f32x4 xv[8];
#pragma unroll
                    for (int j = 0; j < 8; ++j) xv[j] = xr[64 * j];
                    float lg[8];
#pragma unroll
                    for (int e = 0; e < 8; ++e) { float a = 0.f;
#pragma unroll
                        for (int j = 0; j < 8; ++j) { const f32x4 rv = *(const LAS f32x4*)(RT + e * DM + 256 * j + 4 * lane); a += (xv[j][0] * rv[0] + xv[j][1] * rv[1]) + (xv[j][2] * rv[2] + xv[j][3] * rv[3]); }
                        lg[e] = wave_sum(a) * rstd; }
                    if (lane == 0) {
                        int e0 = 0; float v0 = lg[0];
#pragma unroll
                        for (int e = 1; e < 8; ++e) if (lg[e] > v0) { v0 = lg[e]; e0 = e; }
                        int e1 = -1; float v1 = -3.0e38f;
#pragma unroll
                        for (int e = 0; e < 8; ++e) if (e != e0 && lg[e] > v1) { v1 = lg[e]; e1 = e; }
                        const float ex = expf(v1 - v0), g0 = 1.0f / (1.0f + ex), g1 = ex / (1.0f + ex);
                        const int r0 = (int)atomicAdd((unsigned*)(lds_raw + LDSCTL_OFF) + LW_CNT + e0, 1u);
                        const int r1 = (int)atomicAdd((unsigned*)(lds_raw + LDSCTL_OFF) + LW_CNT + e1, 1u);
                        tokE[2 * t] = e0; tokE[2 * t + 1] = e1; tokR[2 * t] = r0; tokR[2 * t + 1] = r1; tokG[2 * t] = g0; tokG[2 * t + 1] = g1;
                    }
                }
                __syncthreads();
                if (tid < 8) WSP(int, WS_CNTWG)[bx * 8 + tid] = (int)LW[LW_CNT + tid];
            }
            GRID_BAR();
            {
                PHASE_IDS();
                if (tid < 8) { LW[LW_TOT + tid] = 0u; LW[LW_PRE + tid] = 0u; }
                __syncthreads();
                {
                const int* cntWG = WSP(int, WS_CNTWG);
                for (int j = tid; j < G; j += 512) {
                    const i32x4 ca = *(const i32x4*)(cntWG + j * 8), cb = *(const i32x4*)(cntWG + j * 8 + 4);
                    unsigned* lw = (unsigned*)(lds_raw + LDSCTL_OFF);
#pragma unroll
                    for (int e = 0; e < 4; ++e) { atomicAdd(lw + LW_TOT + e, (unsigned)ca[e]); atomicAdd(lw + LW_TOT + 4 + e, (unsigned)cb[e]);
                        if (j < bx) { atomicAdd(lw + LW_PRE + e, (unsigned)ca[e]); atomicAdd(lw + LW_PRE + 4 + e, (unsigned)cb[e]); } }
                }
                }
                __syncthreads();
                if (tid == 0) { unsigned base = 0;
                    for (int e = 0; e < 8; ++e) { const unsigned tot = LW[LW_TOT + e]; LW[LW_BP + e] = base + LW[LW_PRE + e]; LW[LW_TOFF + e] = base >> 8; base += (tot + 255u) & ~255u; }
                    LW[LW_TOFF + 8] = base >> 8; }
                __syncthreads();
                const int* tokE = WSP(int, WS_TOKE); const int* tokR = WSP(int, WS_TOKR); int* tokS = WSP(int, WS_TOKS);
                const u64_t* ss3 = WSP(u64_t, WS_SS) + 3 * NTOK; float* rslot = WSP(float, WS_RSLOT);
                const unsigned char* xn8 = WSP(unsigned char, WS_XN); unsigned char* hp = WSP(unsigned char, WS_HP);
                const int tlo = bx * TPW, thi = (tlo + TPW) < NTOK ? (tlo + TPW) : NTOK;
                for (int t = tlo + wave; t < thi; t += 8) {
                    const int e0 = tokE[2 * t], e1 = tokE[2 * t + 1];
                    const int s0 = (int)LW[LW_BP + e0] + tokR[2 * t], s1 = (int)LW[LW_BP + e1] + tokR[2 * t + 1];
                    if (lane == 0) { tokS[2 * t] = s0; tokS[2 * t + 1] = s1; const float rstd = ss_rstd(ss3[t]); rslot[s0] = rstd; rslot[s1] = rstd; }
                    const u32x4* src = (const u32x4*)(xn8 + (size_t)t * DM) + lane; u32x4* d0 = (u32x4*)(hp + (size_t)s0 * DM) + lane; u32x4* d1 = (u32x4*)(hp + (size_t)s1 * DM) + lane;
#pragma unroll
                    for (int j = 0; j < 2; ++j) { const u32x4 v = src[64 * j]; d0[64 * j] = v; d1[64 * j] = v; }
                }
                for (int e = 0; e < 8; ++e) {
                    const int rlo = (int)LW[LW_TOFF + e] * 256 + (int)LW[LW_TOT + e], rhi = (int)LW[LW_TOFF + e + 1] * 256;
                    for (int r = rlo + gw; r < rhi; r += NGW) { if (lane == 0) rslot[r] = 0.f; u32x4* d0 = (u32x4*)(hp + (size_t)r * DM) + lane;
#pragma unroll
                        for (int j = 0; j < 2; ++j) d0[64 * j] = (u32x4){0u, 0u, 0u, 0u}; }
                }
            }
            GRID_BAR();
#define RFL(i) __builtin_amdgcn_readfirstlane((int)LW[LW_TOFF + (i)])
            for (int rep_ = 0; rep_ < REP_P7; ++rep_) {
                pg8::Gemm g{WSP(unsigned char, WS_HP), WSP(unsigned char, WS_WMGU), DM, (size_t)2 * FFE * DM};
                pg8::MoeOrder S; S.S.init(RFL(8), 2 * FFE / 256, G, bx);
                S.t1 = RFL(1); S.t2 = RFL(2); S.t3 = RFL(3); S.t4 = RFL(4); S.t5 = RFL(5); S.t6 = RFL(6); S.t7 = RFL(7);
                pg8::EpiSwigluF8<2> E{WSP(unsigned char, WS_ACTM), FFE, WSP(float, WS_RSLOT)};
                pg8::gemm_phase<pg8::EpiSwigluF8<2>, pg8::MoeOrder, true, SC_W, SC_ONE>(lds + RING_OFF, g, S, E);
            }
            GRID_BAR();
            {
                pg8::Gemm g{WSP(unsigned char, WS_ACTM), WSP(unsigned char, WS_WMD), FFE, (size_t)DM * FFE};
                pg8::MoeOrder S; S.S.init(RFL(8), DM / 256, G, bx);
                S.t1 = RFL(1); S.t2 = RFL(2); S.t3 = RFL(3); S.t4 = RFL(4); S.t5 = RFL(5); S.t6 = RFL(6); S.t7 = RFL(7);
                pg8::EpiBf16<0> E{WSP(bf16_t, WS_Y), DM, nullptr};
                pg8::gemm_phase<pg8::EpiBf16<0>, pg8::MoeOrder, true, SC_W, SC_A>(lds + RING_OFF, g, S, E);
            }
#undef RFL
            GRID_BAR();
            {
                PHASE_IDS();
                const int* tokS = WSP(int, WS_TOKS); const float* tokG = WSP(float, WS_TOKG); float* out = OUTP; const bf16_t* yb = WSP(bf16_t, WS_Y);
                for (int t = gw; t < NTOK; t += NGW) {
                    const int s0 = tokS[2 * t], s1 = tokS[2 * t + 1]; const float g0 = tokG[2 * t], g1 = tokG[2 * t + 1];
                    f32x4* o = (f32x4*)(out + (size_t)t * DM) + 2 * lane; const u32x4* y0 = (const u32x4*)(yb + (size_t)s0 * DM) + lane; const u32x4* y1 = (const u32x4*)(yb + (size_t)s1 * DM) + lane;
#pragma unroll
                    for (int j = 0; j < 4; ++j) { const u32x4 a = y0[64 * j], b = y1[64 * j]; f32x4 o0 = o[128 * j], o1 = o[128 * j + 1];
                        o0[0] += bflo(a[0]) * g0 + bflo(b[0]) * g1; o0[1] += bfhi(a[0]) * g0 + bfhi(b[0]) * g1; o0[2] += bflo(a[1]) * g0 + bflo(b[1]) * g1; o0[3] += bfhi(a[1]) * g0 + bfhi(b[1]) * g1;
                        o1[0] += bflo(a[2]) * g0 + bflo(b[2]) * g1; o1[1] += bfhi(a[2]) * g0 + bfhi(b[2]) * g1; o1[2] += bflo(a[3]) * g0 + bflo(b[3]) * g1; o1[3] += bfhi(a[3]) * g0 + bfhi(b[3]) * g1;
                        o[128 * j] = o0; o[128 * j + 1] = o1; }
                }
            }
        }
    }
}

extern "C" void kernel_launch(void* const* d_in, const int* in_sizes, int n_in, void* d_out, int out_size, void* d_ws, size_t ws_size, hipStream_t stream) {
    static int grid = 0;
    if (grid == 0) {
        if (n_in != 20 || in_sizes[0] != NTOK * DM || out_size != NTOK * DM || ws_size < WS_END) {
            fprintf(stderr, "kernel_launch: unexpected shapes (n_in %d, in0 %d, out %d, ws %zu < %zu); nothing launched\n", n_in, n_in > 0 ? in_sizes[0] : -1, out_size, ws_size, (size_t)WS_END); grid = -1; return; }
        int dev = 0, cus = 0, per_cu = 0;
        if (hipGetDevice(&dev) != hipSuccess || hipDeviceGetAttribute(&cus, hipDeviceAttributeMultiprocessorCount, dev) != hipSuccess) { grid = -1; return; }
        if (hipFuncSetAttribute((const void*)hybrid_fwd, hipFuncAttributeMaxDynamicSharedMemorySize, LDS_BYTES) != hipSuccess) { fprintf(stderr, "kernel_launch: hipFuncSetAttribute failed\n"); grid = -1; return; }
        if (hipOccupancyMaxActiveBlocksPerMultiprocessor(&per_cu, (const void*)hybrid_fwd, 512, LDS_BYTES) != hipSuccess || per_cu < 1)
            fprintf(stderr, "kernel_launch: note: occupancy query reports %d workgroups per CU\n", per_cu);
        (void)hipGetLastError();
        grid = cus > 512 ? 512 : cus;
    }
    if (grid < 0) return;
    if (hipMemsetAsync((char*)d_ws + WS_CTL, 0, CTL_ZERO_BYTES, stream) != hipSuccess) { fprintf(stderr, "kernel_launch: memset failed\n"); return; }
    Args a{};
    for (int i = 0; i < 20; ++i) a.in[i] = d_in[i];
    a.out = (float*)d_out; a.ws = (unsigned char*)d_ws;
    hipLaunchKernelGGL(hybrid_fwd, dim3(grid), dim3(512), LDS_BYTES, stream, a);
    const hipError_t le = hipPeekAtLastError();
    if (le != hipSuccess) fprintf(stderr, "kernel_launch: launch failed: %s\n", hipGetErrorName(le));
}
```

```cpp
#include <hip/hip_runtime.h>
#include <hip/hip_bf16.h>
#include <cstdio>
#include <cstdint>

#define LAS __attribute__((address_space(3)))
#define GAS __attribute__((address_space(1)))
typedef unsigned short bf16_t;
typedef short bf16x8 __attribute__((ext_vector_type(8)));
typedef short s16x4 __attribute__((ext_vector_type(4)));
typedef float f32x4 __attribute__((ext_vector_type(4)));
typedef float f32x2 __attribute__((ext_vector_type(2)));
typedef float f32x16 __attribute__((ext_vector_type(16)));
typedef unsigned u32x4 __attribute__((ext_vector_type(4)));
typedef unsigned u32x2 __attribute__((ext_vector_type(2)));
typedef int i32x4 __attribute__((ext_vector_type(4)));
typedef int i32x8 __attribute__((ext_vector_type(8)));

constexpr int DM = 2048, NB = 8, SEQ = 2048, NTOK = NB * SEQ, DEPTH = 2;
constexpr int INW = 5120, FFD = 5632, NEXP = 8, FFE = 7168;
constexpr int ZQ = 0, ZK = 1024, ZV = 2048, ZP = 3072, ZGB = 3584, ZGC = 4096, ZH = 4608;
constexpr int MOE_ROWS = NTOK * 2 + NEXP * 256;
constexpr float EPS = 1e-6f;

constexpr size_t MiB = 1u << 20;
constexpr size_t WS_CTL = 0, CTL_ZERO_BYTES = 1 * MiB;
constexpr size_t WS_COS = 1 * MiB, WS_SIN = 5 * MiB;
constexpr size_t WS_WPT = 9 * MiB;
constexpr size_t WS_TOKE = 10 * MiB;
constexpr size_t WS_TOKR = WS_TOKE + 128 * 1024;
constexpr size_t WS_TOKG = WS_TOKR + 128 * 1024;
constexpr size_t WS_TOKS = WS_TOKG + 128 * 1024;
constexpr size_t WS_CNTWG = WS_TOKS + 128 * 1024;
constexpr size_t WS_WIN = 16 * MiB;
constexpr size_t WS_WOUT = WS_WIN + 40 * MiB;
constexpr size_t WS_WDGU = WS_WOUT + 16 * MiB;
constexpr size_t WS_WDD = WS_WDGU + 44 * MiB;
constexpr size_t WS_WMGU = WS_WDD + 22 * MiB;
constexpr size_t WS_WMD = WS_WMGU + 448 * MiB;
constexpr size_t WS_ACT0 = WS_WMD + 224 * MiB;
constexpr size_t WS_Z = WS_ACT0;
constexpr size_t WS_AO = WS_ACT0 + 160 * MiB;
constexpr size_t WS_MIX = WS_ACT0 + 288 * MiB;
constexpr size_t WS_XN = WS_ACT0 + 352 * MiB;
constexpr size_t WS_ACTM = WS_ACT0;
constexpr size_t WS_HP = WS_ACT0 + 476 * MiB;
constexpr size_t WS_Y = WS_ACT0 + 612 * MiB;
constexpr size_t WS_ACTD = WS_ACT0 + 476 * MiB;
constexpr size_t WS_XR = WS_ACT0 + 884 * MiB;
constexpr size_t WS_END = WS_ACT0 + 948 * MiB;
static_assert(WS_ACT0 == 810 * MiB, "map");
static_assert((size_t)MOE_ROWS * FFE * 2 <= 476 * MiB && (size_t)MOE_ROWS * DM * 2 <= 136 * MiB && (size_t)MOE_ROWS * DM * 4 <= 272 * MiB, "map");

#ifndef PH_MASK
#define PH_MASK 0xffff
#endif
#define REP_P0 1
#ifndef BG_SPLIT
#define BG_SPLIT 0
#endif
#ifndef BG_NQ
#define BG_NQ 2
#endif
#ifndef BG_NREP
#define BG_NREP 1
#endif
#ifndef PROBE_MASK
#define PROBE_MASK 0u
#endif
#ifndef DUP8
#define DUP8 1
#endif
#ifndef DDN8
#define DDN8 1
#endif
#define REP_P1 1
#define REP_P3 1
#define REP_P7 1
constexpr int CW_TMO = 0, CW_CODE = 1, CW_BAR = 4096;
constexpr size_t WS_SS = 14 * MiB;
typedef unsigned long long u64_t;
typedef float ssrow_t[8];
__device__ __forceinline__ float ss_rstd(const float* p) { const f32x4 a = *(const f32x4*)p, b = *(const f32x4*)(p + 4); return 1.0f / sqrtf((((a[0] + a[1]) + (a[2] + a[3])) + ((b[0] + b[1]) + (b[2] + b[3]))) * (1.0f / DM) + EPS); }
constexpr size_t WS_TMAP = WS_CTL + 768 * 1024;
constexpr size_t WS_PB = WS_ACT0 + 612 * MiB + 136 * MiB;
constexpr size_t WS_RSLOT = 12 * MiB;

constexpr int LDSCTL_OFF = 0, LDSCTL_BYTES = 1024;
constexpr int RING_OFF = 16384, RING_BYTES = 131072;
constexpr int LDS_BYTES = 147456;
constexpr int LW_CNT = 16, LW_TOT = 24, LW_PRE = 32, LW_BP = 40, LW_TOFF = 48;

#define LDS_WAIT() asm volatile("s_waitcnt lgkmcnt(0)" ::: "memory")
#define VM_WAIT() asm volatile("s_waitcnt vmcnt(0)" ::: "memory")

__device__ __forceinline__ unsigned cvt_pk_bf16(float lo, float hi) { unsigned r; asm volatile("v_cvt_pk_bf16_f32 %0, %1, %2" : "=v"(r) : "v"(lo), "v"(hi)); return r; }
__device__ __forceinline__ unsigned pk4_fp8(float a, float b, float c, float d) {
    a = __builtin_amdgcn_fmed3f(a, -448.f, 448.f); b = __builtin_amdgcn_fmed3f(b, -448.f, 448.f); c = __builtin_amdgcn_fmed3f(c, -448.f, 448.f); d = __builtin_amdgcn_fmed3f(d, -448.f, 448.f);
    int w = __builtin_amdgcn_cvt_pk_fp8_f32(a, b, 0, false); w = __builtin_amdgcn_cvt_pk_fp8_f32(c, d, w, true); return (unsigned)w; }
constexpr float W8_SCALE = 64.f, A8_SCALE = 8.f;
constexpr int SC_ONE = 0x7f7f7f7f, SC_W = 0x79797979  , SC_A = 0x7c7c7c7c  ;
__device__ __forceinline__ float bflo(unsigned w) { return __uint_as_float(w << 16); }
__device__ __forceinline__ float bfhi(unsigned w) { return __uint_as_float(w & 0xffff0000u); }
template <int CTRL> __device__ __forceinline__ float dppf(float v) { return __int_as_float(__builtin_amdgcn_update_dpp(0, __float_as_int(v), CTRL, 0xf, 0xf, true)); }
__device__ __forceinline__ float lx1(float v) { return dppf<0xB1>(v); }
__device__ __forceinline__ float lx2(float v) { return dppf<0x4E>(v); }
__device__ __forceinline__ float lhm(float v) { return dppf<0x141>(v); }
__device__ __forceinline__ float lrm(float v) { return dppf<0x140>(v); }
__device__ __forceinline__ float lx16(float v) { return __int_as_float(__builtin_amdgcn_ds_swizzle(__float_as_int(v), 0x401F)); }
__device__ __forceinline__ float sum_halves(float v) { const auto r = __builtin_amdgcn_permlane32_swap(__float_as_uint(v), __float_as_uint(v), false, false); return __uint_as_float(r[0]) + __uint_as_float(r[1]); }
__device__ __forceinline__ float row16_sum(float v) { v += lx1(v); v += lx2(v); v += lhm(v); v += lrm(v); return v; }
__device__ __forceinline__ float wave_sum(float v) { v = row16_sum(v); v += lx16(v); return sum_halves(v); }

__device__ __forceinline__ int ltid() {
    const unsigned key = (unsigned)__builtin_amdgcn_s_getreg((5 << 11) | 4) & 63u;
    const int wv = __builtin_amdgcn_readfirstlane((int)((volatile LAS unsigned*)(LDSCTL_OFF + 4 * 128))[key]);
    int ln; asm volatile("v_mbcnt_lo_u32_b32 %0, -1, 0\n\tv_mbcnt_hi_u32_b32 %0, -1, %0" : "=&v"(ln));
    return (wv << 6) | ln; }

__device__ __forceinline__ void st16_wt(void* p, u32x4 v) { asm volatile("global_store_dwordx4 %0, %1, off sc1\n\ts_nop 1" :: "v"(p), "v"(v) : "memory"); }
__device__ __forceinline__ void st8_wt(void* p, u32x2 v) { asm volatile("global_store_dwordx2 %0, %1, off sc1\n\ts_nop 1" :: "v"(p), "v"(v) : "memory"); }
namespace pg8 {
constexpr int BM = 256, BK = 64, HALF = 128, HTB = HALF * BK * 2, STAGE_BYTES = 8 * HTB, NXCD = 8, WGM = 8;
__host__ __device__ __forceinline__ int lds_byte(int r, int c) { const int st = (r >> 4) * 2 + (c >> 5), rr = r & 15, cc = c & 31, ob = rr * 64 + cc * 2; return st * 1024 + (ob ^ (((ob >> 9) & 1) << 5)); }
__host__ __device__ __forceinline__ void stage_rc(int b, int& R, int& C) { const int st = b / 1024, sb = b % 1024, swz = sb ^ (((sb >> 9) & 1) << 5); R = (st >> 1) * 16 + swz / 64; C = (st & 1) * 32 + (swz % 64) / 2; }
__host__ __device__ __forceinline__ int perm32(int rho) { const int n = rho >> 4, i = rho & 15; return 8 * (i >> 2) + 4 * n + (i & 3); }

struct Unit { int pm, pn, e, kb0, ntu, part; };
struct Gemm { const void* A; const void* Bt; int KB; size_t estride; };

struct StaticOrder {
    int nM, nN, nwg, G, c, i0, cnt;
    __device__ __forceinline__ void init(int nM_, int nN_, int G_, int c_, int i0_ = 0, int cnt_ = 1 << 30) { nM = nM_; nN = nN_; nwg = nM * nN; G = G_; c = c_; i0 = i0_; cnt = cnt_; }
    __device__ __forceinline__ void unit_of(int L, Unit& u) const {
        int wgid = L; { const int q = nwg / NXCD, r = nwg % NXCD, xcd = wgid % NXCD, off = wgid / NXCD; wgid = (xcd < r ? xcd * (q + 1) : r * (q + 1) + (xcd - r) * q) + off; }
        const int nig = WGM * nN, gid = wgid / nig, fm = gid * WGM, gsz = (nM - fm) < WGM ? (nM - fm) : WGM;
        u.pm = fm + ((wgid % nig) % gsz); u.pn = (wgid % nig) / gsz; u.e = 0; u.kb0 = 0; u.ntu = 0; u.part = -1;
    }
    __device__ __forceinline__ bool next(int i, Unit& u) const {
        if (i >= cnt) return false;
        const long L = (long)(i + i0) * G + c; if (L >= nwg) return false;
        unit_of((int)L, u); return true;
    }
};
struct MoeOrder {
    StaticOrder S; int t1, t2, t3, t4, t5, t6, t7; int SP, nfull, R, ntp, kbs; int rev = 0;
    __device__ __forceinline__ bool next(int i, Unit& u) const {
        if (SP > 1) {
            if (i < nfull) S.unit_of(i * S.G + S.c, u);
            else if (i == nfull && S.c < R * SP) { S.unit_of(nfull * S.G + S.c / SP, u); const int p = S.c % SP; u.kb0 = p * kbs; u.ntu = ntp; u.part = S.c; }
            else return false;
        } else if (!S.next(i, u)) return false;
        if (rev) u.pm = S.nM - 1 - u.pm;
        const int p = u.pm; u.e = __builtin_amdgcn_readfirstlane((p >= t1) + (p >= t2) + (p >= t3) + (p >= t4) + (p >= t5) + (p >= t6) + (p >= t7)); return true;
    }
};

template <int RS> __device__ __forceinline__ void row_scales(float (&sc)[2][4], const void* p, int row0) {
#pragma unroll
    for (int ai = 0; ai < 2; ++ai)
#pragma unroll
        for (int m = 0; m < 4; ++m) { if constexpr (RS == 0) sc[ai][m] = 1.0f; else if constexpr (RS == 1) sc[ai][m] = ss_rstd((const float*)p + (size_t)(row0 + ai * HALF + m * 16) * 8); else sc[ai][m] = ((const float*)p)[row0 + ai * HALF + m * 16]; }
}
template <int RS> struct EpiBf16 {
    static constexpr bool PERM = true;
    bf16_t* O; int ldc; const void* rsp;
    __device__ __forceinline__ void operator()(const f32x4 (&acc)[2][2][4][2], const Unit& u, int wr, int wc, int fr, int fq) const {
        const int row0 = u.pm * BM + wr * 64 + fr, col0 = u.pn * BM + wc * 32 + 8 * fq;
        float sc[2][4]; row_scales<RS>(sc, rsp, row0);
#pragma unroll
        for (int ai = 0; ai < 2; ++ai)
#pragma unroll
            for (int m = 0; m < 4; ++m) { bf16_t* rowp = O + (size_t)(row0 + ai * HALF + m * 16) * ldc + col0;
#pragma unroll
                for (int bj = 0; bj < 2; ++bj) { const f32x4 v0 = acc[ai][bj][m][0] * sc[ai][m], v1 = acc[ai][bj][m][1] * sc[ai][m];
                    u32x4 w; w.x = cvt_pk_bf16(v0[0], v0[1]); w.y = cvt_pk_bf16(v0[2], v0[3]); w.z = cvt_pk_bf16(v1[0], v1[1]); w.w = cvt_pk_bf16(v1[2], v1[3]);
                    st16_wt(rowp + bj * HALF, w); } }
    }
};
struct EpiZ {
    static constexpr bool PERM = true;
    bf16_t* O; int ldc; const void* rsp; const float* qg; const float* kg; const float* cosT; const float* sinT; LAS float* part;
    __device__ __forceinline__ void operator()(const f32x4 (&acc)[2][2][4][2], const Unit& u, int wr, int wc, int fr, int fq) const {
        const int row0 = u.pm * BM + wr * 64 + fr, col0 = u.pn * BM + wc * 32 + 8 * fq;
        float sc[2][4]; row_scales<1>(sc, rsp, row0);
        if (u.pn >= 8) {
#pragma unroll
            for (int ai = 0; ai < 2; ++ai)
#pragma unroll
                for (int m = 0; m < 4; ++m) { bf16_t* rowp = O + (size_t)(row0 + ai * HALF + m * 16) * ldc + col0;
#pragma unroll
                    for (int bj = 0; bj < 2; ++bj) { const f32x4 v0 = acc[ai][bj][m][0] * sc[ai][m], v1 = acc[ai][bj][m][1] * sc[ai][m];
                        u32x4 w; w.x = cvt_pk_bf16(v0[0], v0[1]); w.y = cvt_pk_bf16(v0[2], v0[3]); w.z = cvt_pk_bf16(v1[0], v1[1]); w.w = cvt_pk_bf16(v1[2], v1[3]);
                        st16_wt(rowp + bj * HALF, w); } }
            return;
        }
        LAS float* pw = part + ((wr * 4 + wc) * 16) * 16 + fr;
#pragma unroll
        for (int ai = 0; ai < 2; ++ai)
#pragma unroll
            for (int m = 0; m < 4; ++m)
#pragma unroll
                for (int bj = 0; bj < 2; ++bj) { const f32x4 v0 = acc[ai][bj][m][0] * sc[ai][m], v1 = acc[ai][bj][m][1] * sc[ai][m];
                    float p = (v0[0] * v0[0] + v0[1] * v0[1]) + (v0[2] * v0[2] + v0[3] * v0[3]) + (v1[0] * v1[0] + v1[1] * v1[1]) + (v1[2] * v1[2] + v1[3] * v1[3]);
                    p += lx16(p); p = sum_halves(p);
                    if (fq == 0) pw[((ai * 4 + m) * 2 + bj) * 16] = p; }
        asm volatile("s_waitcnt lgkmcnt(0)" ::: "memory"); __builtin_amdgcn_s_barrier(); asm volatile("" ::: "memory");
        const int i0 = 16 * wc + 4 * fq;
        const float* gp = (u.pn < 4 ? qg : kg) + i0;
        const f32x4 ga = *(const f32x4*)gp, gb = *(const f32x4*)(gp + 64);
        const LAS float* pr = part + (wr * 4 * 16) * 16 + fr;
#pragma unroll
        for (int ai = 0; ai < 2; ++ai)
#pragma unroll
            for (int m = 0; m < 4; ++m) { const int r = row0 + ai * HALF + m * 16; bf16_t* rowp = O + (size_t)r * ldc + col0;
                const f32x4 cs = *(const f32x4*)(cosT + (size_t)r * 64 + i0), sn = *(const f32x4*)(sinT + (size_t)r * 64 + i0);
#pragma unroll
                for (int bj = 0; bj < 2; ++bj) { const int pi = ((ai * 4 + m) * 2 + bj) * 16;
                    const float tot = (pr[pi] + pr[pi + 256]) + (pr[pi + 512] + pr[pi + 768]);
                    const float f = sc[ai][m] / sqrtf(tot * (1.0f / 128.0f) + EPS);
                    const f32x4 v0 = acc[ai][bj][m][0] * f, v1 = acc[ai][bj][m][1] * f;
                    const float a0 = v0[0] * ga[0], b0 = v0[1] * gb[0], a1 = v0[2] * ga[1], b1 = v0[3] * gb[1], a2 = v1[0] * ga[2], b2 = v1[1] * gb[2], a3 = v1[2] * ga[3], b3 = v1[3] * gb[3];
                    u32x4 w;
                    w.x = cvt_pk_bf16(a0 * cs[0] - b0 * sn[0], a0 * sn[0] + b0 * cs[0]); w.y = cvt_pk_bf16(a1 * cs[1] - b1 * sn[1], a1 * sn[1] + b1 * cs[1]);
                    w.z = cvt_pk_bf16(a2 * cs[2] - b2 * sn[2], a2 * sn[2] + b2 * cs[2]); w.w = cvt_pk_bf16(a3 * cs[3] - b3 * sn[3], a3 * sn[3] + b3 * cs[3]);
                    st16_wt(rowp + bj * HALF, w); } }
        asm volatile("s_waitcnt lgkmcnt(0)" ::: "memory"); __builtin_amdgcn_s_barrier(); asm volatile("" ::: "memory");
    }
};
__device__ __forceinline__ float silu_mul(float g, float u) { return g * __builtin_amdgcn_rcpf(1.0f + __builtin_amdgcn_exp2f(-1.4426950408889634f * g)) * u; }
__device__ __forceinline__ f32x2 silu_mul2(f32x2 g, f32x2 u, float sg, float su) {
    const f32x2 t = g * sg, a = t * (-1.4426950408889634f);
    f32x2 e; e.x = __builtin_amdgcn_exp2f(a.x); e.y = __builtin_amdgcn_exp2f(a.y);
    const f32x2 d = e + 1.0f;
    f32x2 r; r.x = __builtin_amdgcn_rcpf(d.x); r.y = __builtin_amdgcn_rcpf(d.y);
    return (t * r) * (u * su);
}
template <int RS> struct EpiSwiglu {
    static constexpr bool PERM = true;
    bf16_t* O; int ldc; const void* rsp;
    __device__ __forceinline__ void operator()(const f32x4 (&acc)[2][2][4][2], const Unit& u, int wr, int wc, int fr, int fq) const {
        const int row0 = u.pm * BM + wr * 64 + fr, col0 = u.pn * HALF + wc * 32 + 8 * fq;
        float sc[2][4]; row_scales<RS>(sc, rsp, row0);
#pragma unroll
        for (int ai = 0; ai < 2; ++ai)
#pragma unroll
            for (int m = 0; m < 4; ++m) { bf16_t* rowp = O + (size_t)(row0 + ai * HALF + m * 16) * ldc + col0;
                const f32x4 g0 = acc[ai][0][m][0], g1 = acc[ai][0][m][1], u0 = acc[ai][1][m][0], u1 = acc[ai][1][m][1]; const float s = sc[ai][m];
                const f32x2 o0 = silu_mul2((f32x2){g0[0], g0[1]}, (f32x2){u0[0], u0[1]}, s, s), o1 = silu_mul2((f32x2){g0[2], g0[3]}, (f32x2){u0[2], u0[3]}, s, s);
                const f32x2 o2 = silu_mul2((f32x2){g1[0], g1[1]}, (f32x2){u1[0], u1[1]}, s, s), o3 = silu_mul2((f32x2){g1[2], g1[3]}, (f32x2){u1[2], u1[3]}, s, s);
                u32x4 w; w.x = cvt_pk_bf16(o0.x, o0.y); w.y = cvt_pk_bf16(o1.x, o1.y); w.z = cvt_pk_bf16(o2.x, o2.y); w.w = cvt_pk_bf16(o3.x, o3.y);
                *(u32x4*)rowp = w; }
    }
};
template <int RS> struct EpiSwigluF8 {
    static constexpr bool PERM = true;
    unsigned char* O; int ldc; const void* rsp;
    __device__ __forceinline__ void operator()(const f32x4 (&acc)[2][2][4][2], const Unit& u, int wr, int wc, int fr, int fq) const {
        const int row0 = u.pm * BM + wr * 64 + fr, col0 = u.pn * HALF + wc * 32 + 8 * fq;
        float sc[2][4]; row_scales<RS>(sc, rsp, row0);
#pragma unroll
        for (int ai = 0; ai < 2; ++ai)
#pragma unroll
            for (int m = 0; m < 4; ++m) { unsigned char* rowp = O + (size_t)(row0 + ai * HALF + m * 16) * ldc + col0;
                const f32x4 g0 = acc[ai][0][m][0], g1 = acc[ai][0][m][1], u0 = acc[ai][1][m][0], u1 = acc[ai][1][m][1]; const float s = sc[ai][m], s8 = s * A8_SCALE;
                const f32x2 o0 = silu_mul2((f32x2){g0[0], g0[1]}, (f32x2){u0[0], u0[1]}, s, s8), o1 = silu_mul2((f32x2){g0[2], g0[3]}, (f32x2){u0[2], u0[3]}, s, s8);
                const f32x2 o2 = silu_mul2((f32x2){g1[0], g1[1]}, (f32x2){u1[0], u1[1]}, s, s8), o3 = silu_mul2((f32x2){g1[2], g1[3]}, (f32x2){u1[2], u1[3]}, s, s8);
                u32x2 w; w.x = pk4_fp8(o0.x, o0.y, o1.x, o1.y); w.y = pk4_fp8(o2.x, o2.y, o3.x, o3.y);
                st8_wt(rowp, w); }
    }
};
struct EpiResF32 {
    static constexpr bool PERM = true;
    const float* R32; bf16_t* XR; int ldc; unsigned char* XB8; float* ss; int rf32; int f8out; LAS float* part;
    __device__ __forceinline__ void operator()(const f32x4 (&acc)[2][2][4][2], const Unit& u, int wr, int wc, int fr, int fq) const {
        const int col0 = u.pn * BM + wc * 32 + 8 * fq;
        float ssw[2][4];
#pragma unroll
        for (int ai = 0; ai < 2; ++ai) {
            f32x4 rv[4][2][2];
            if (rf32) {
#pragma unroll
                for (int m = 0; m < 4; ++m) { const size_t off = (size_t)(u.pm * BM + ai * HALF + wr * 64 + m * 16 + fr) * ldc + col0;
#pragma unroll
                    for (int bj = 0; bj < 2; ++bj) { rv[m][bj][0] = *(const f32x4*)(R32 + off + bj * HALF); rv[m][bj][1] = *(const f32x4*)(R32 + off + bj * HALF + 4); } }
            } else {
                u32x4 rb[4][2];
#pragma unroll
                for (int m = 0; m < 4; ++m) { const size_t off = (size_t)(u.pm * BM + ai * HALF + wr * 64 + m * 16 + fr) * ldc + col0;
#pragma unroll
                    for (int bj = 0; bj < 2; ++bj) rb[m][bj] = *(const u32x4*)(XR + off + bj * HALF); }
#pragma unroll
                for (int m = 0; m < 4; ++m)
#pragma unroll
                    for (int bj = 0; bj < 2; ++bj) { rv[m][bj][0] = (f32x4){bflo(rb[m][bj][0]), bfhi(rb[m][bj][0]), bflo(rb[m][bj][1]), bfhi(rb[m][bj][1])};
                                                     rv[m][bj][1] = (f32x4){bflo(rb[m][bj][2]), bfhi(rb[m][bj][2]), bflo(rb[m][bj][3]), bfhi(rb[m][bj][3])}; }
            }
#pragma unroll
            for (int m = 0; m < 4; ++m) { const int r = u.pm * BM + ai * HALF + wr * 64 + m * 16 + fr; const size_t off = (size_t)r * ldc + col0;
                float ssp = 0.f;
#pragma unroll
                for (int bj = 0; bj < 2; ++bj) {
                    const f32x4 v0 = rv[m][bj][0] + acc[ai][bj][m][0], v1 = rv[m][bj][1] + acc[ai][bj][m][1];
                    ssp += (v0[0] * v0[0] + v0[1] * v0[1]) + (v0[2] * v0[2] + v0[3] * v0[3]) + (v1[0] * v1[0] + v1[1] * v1[1]) + (v1[2] * v1[2] + v1[3] * v1[3]);
                    { u32x4 w; w.x = cvt_pk_bf16(v0[0], v0[1]); w.y = cvt_pk_bf16(v0[2], v0[3]); w.z = cvt_pk_bf16(v1[0], v1[1]); w.w = cvt_pk_bf16(v1[2], v1[3]); st16_wt(XR + off + bj * HALF, w); }
                    if (f8out) { u32x2 w; w.x = pk4_fp8(v0[0], v0[1], v0[2], v0[3]); w.y = pk4_fp8(v1[0], v1[1], v1[2], v1[3]); st8_wt(XB8 + off + bj * HALF, w); }
                }
                ssp += lx16(ssp); ssw[ai][m] = sum_halves(ssp);
            }
            asm volatile("" ::: "memory");
        }
        if (fq == 0) {
#pragma unroll
            for (int ai = 0; ai < 2; ++ai)
#pragma unroll
                for (int m = 0; m < 4; ++m) part[((wr * 4 + wc) * 8 + ai * 4 + m) * 16 + fr] = ssw[ai][m]; }
        asm volatile("s_waitcnt lgkmcnt(0)" ::: "memory"); __builtin_amdgcn_s_barrier(); asm volatile("" ::: "memory");
        if (wc == 0 && fq == 0) {
#pragma unroll
            for (int ai = 0; ai < 2; ++ai)
#pragma unroll
                for (int m = 0; m < 4; ++m) { const LAS float* p = part + (wr * 4 * 8 + ai * 4 + m) * 16 + fr;
                    ss[(size_t)(u.pm * BM + ai * HALF + wr * 64 + m * 16 + fr) * 8 + u.pn] = (p[0] + p[128]) + (p[256] + p[384]); } }
        asm volatile("s_waitcnt lgkmcnt(0)" ::: "memory"); __builtin_amdgcn_s_barrier(); asm volatile("" ::: "memory");
    }
};
struct EpiMoeDown {
    static constexpr bool PERM = true;
    bf16_t* O; int ldc; float* PB; int* tmap; int SP;
    __device__ __forceinline__ void operator()(const f32x4 (&acc)[2][2][4][2], const Unit& u, int wr, int wc, int fr, int fq) const {
        if (u.part < 0) {
            const int row0 = u.pm * BM + wr * 64 + fr, col0 = u.pn * BM + wc * 32 + 8 * fq;
#pragma unroll
            for (int ai = 0; ai < 2; ++ai)
#pragma unroll
                for (int m = 0; m < 4; ++m) { bf16_t* rowp = O + (size_t)(row0 + ai * HALF + m * 16) * ldc + col0;
#pragma unroll
                    for (int bj = 0; bj < 2; ++bj) { const f32x4 v0 = acc[ai][bj][m][0], v1 = acc[ai][bj][m][1];
                        u32x4 w; w.x = cvt_pk_bf16(v0[0], v0[1]); w.y = cvt_pk_bf16(v0[2], v0[3]); w.z = cvt_pk_bf16(v1[0], v1[1]); w.w = cvt_pk_bf16(v1[2], v1[3]);
                        st16_wt(rowp + bj * HALF, w); } }
        } else {
            float* slab = PB + (size_t)u.part * (BM * BM);
            if ((u.part % SP) == 0 && wr == 0 && wc == 0 && fr == 0 && fq == 0) tmap[u.pm * 8 + u.pn] = 1 + u.part / SP;
#pragma unroll
            for (int ai = 0; ai < 2; ++ai)
#pragma unroll
                for (int m = 0; m < 4; ++m) { float* rowp = slab + (ai * HALF + wr * 64 + m * 16 + fr) * BM + wc * 32 + 8 * fq;
#pragma unroll
                    for (int bj = 0; bj < 2; ++bj) { *(f32x4*)(rowp + bj * HALF) = acc[ai][bj][m][0]; *(f32x4*)(rowp + bj * HALF + 4) = acc[ai][bj][m][1]; } }
        }
    }
};
struct EpiF32 {
    static constexpr bool PERM = false;
    float* O; int ldc;
    __device__ __forceinline__ void operator()(const f32x4 (&acc)[2][2][4][2], const Unit& u, int wr, int wc, int fr, int fq) const {
        const int col0 = u.pn * BM + wc * 32 + 4 * fq;
#pragma unroll
        for (int ai = 0; ai < 2; ++ai)
#pragma unroll
            for (int m = 0; m < 4; ++m) { const size_t off = (size_t)(u.pm * BM + ai * HALF + wr * 64 + m * 16 + fr) * ldc + col0;
#pragma unroll
                for (int bj = 0; bj < 2; ++bj)
#pragma unroll
                    for (int n = 0; n < 2; ++n) *(f32x4*)(O + off + bj * HALF + n * 16) = acc[ai][bj][m][n]; }
    }
};

struct NoBG { static constexpr int nslots = 0; __device__ __forceinline__ void operator()(int) const {} };
struct MoeConv {
    volatile LAS unsigned* LW; int slot0, nslots, bx8, NGW;
    static constexpr int PER = 3584, NITEMS = 24 * PER, NQ = BG_NQ;
    __device__ __forceinline__ unsigned long long ptr(int i) const { return (unsigned long long)(unsigned)__builtin_amdgcn_readfirstlane((int)LW[64 + 2 * i]) | ((unsigned long long)(unsigned)__builtin_amdgcn_readfirstlane((int)LW[64 + 2 * i + 1]) << 32); }
    __device__ __forceinline__ void operator()(int s) const {
        if (s >= nslots) return;
        const int tid_ = ltid(), lane = tid_ & 63, c = lane & 31, h = lane >> 5, gw = bx8 + __builtin_amdgcn_readfirstlane(tid_ >> 6);
#pragma unroll 1
        for (int rp = 0; rp < BG_NREP; ++rp) {
        const int it0 = (((slot0 + s) * BG_NREP + rp) * NGW + gw) * NQ; if (it0 >= NITEMS) return;
        f32x4 v[NQ][4][2][2]; float sc[NQ][4]; unsigned char* dst[NQ];
#pragma unroll
        for (int q2 = 0; q2 < NQ; ++q2) {
            int it = it0 + q2; it = it < NITEMS ? it : it0;
            const int mat = it / PER, r = it - mat * PER, e = mat & 7, kind = mat >> 3;
            const bool up_ = kind < 2;
            const int K = up_ ? DM : FFE, N = up_ ? FFE : DM, nblk = up_ ? 224 : 64, kb = r / nblk, nb = r - kb * nblk, k0 = 128 * kb, n0 = 32 * nb;
            const int drow0 = up_ ? (256 * (n0 >> 7) + kind * 128 + (n0 & 127)) : n0;
            const float* W = (const float*)(GAS const float*)ptr(kind == 0 ? 17 : (kind == 1 ? 18 : 19)) + (size_t)e * DM * FFE;
            const float* gk = (const float*)(GAS const float*)ptr(12) + DM;
            dst[q2] = (unsigned char*)(GAS unsigned char*)(ptr(21) + (up_ ? WS_WMGU : WS_WMD)) + (size_t)e * (up_ ? 2 : 1) * FFE * DM + (size_t)(drow0 + c) * K + k0 + 16 * h;
#pragma unroll
            for (int kb4 = 0; kb4 < 4; ++kb4) {
                const unsigned off = (unsigned)(((k0 + 32 * kb4 + c) * N + n0 + 8 * h) * 4);
                const char* row = (const char*)W + off;
                const float gv = gk[(k0 + 32 * kb4 + c) & (DM - 1)];
                sc[q2][kb4] = (up_ ? gv : 1.0f) * W8_SCALE;
#pragma unroll
                for (int nh = 0; nh < 2; ++nh) { v[q2][kb4][nh][0] = *(const f32x4*)(row + 64 * nh); v[q2][kb4][nh][1] = *(const f32x4*)(row + 64 * nh + 16); } }
        }
        u32x4 s0 = {0u, 0u, 0u, 0u}, s1 = {0u, 0u, 0u, 0u};
        { const int j0 = c - 8 * h, j1 = c - 16 - 8 * h;
#pragma unroll
          for (int j = 0; j < 8; ++j) { if (j == j0) s0[j >> 1] = (j & 1) ? 0x3f800000u : 0x00003f80u; if (j == j1) s1[j >> 1] = (j & 1) ? 0x3f800000u : 0x00003f80u; } }
        const bf16x8 sel0 = __builtin_bit_cast(bf16x8, s0), sel1 = __builtin_bit_cast(bf16x8, s1);
#pragma unroll
        for (int q2 = 0; q2 < NQ; ++q2)
#pragma unroll
            for (int kb4 = 0; kb4 < 4; ++kb4) {
                const float f = sc[q2][kb4];
                u32x4 a0, a1;
                { const f32x4 x0 = v[q2][kb4][0][0] * f, x1 = v[q2][kb4][0][1] * f, y0 = v[q2][kb4][1][0] * f, y1 = v[q2][kb4][1][1] * f;
                  a0.x = cvt_pk_bf16(x0[0], x0[1]); a0.y = cvt_pk_bf16(x0[2], x0[3]); a0.z = cvt_pk_bf16(x1[0], x1[1]); a0.w = cvt_pk_bf16(x1[2], x1[3]);
                  a1.x = cvt_pk_bf16(y0[0], y0[1]); a1.y = cvt_pk_bf16(y0[2], y0[3]); a1.z = cvt_pk_bf16(y1[0], y1[1]); a1.w = cvt_pk_bf16(y1[2], y1[3]); }
                f32x16 d = f32x16{};
                d = __builtin_amdgcn_mfma_f32_32x32x16_bf16(__builtin_bit_cast(bf16x8, a0), sel0, d, 0, 0, 0);
                d = __builtin_amdgcn_mfma_f32_32x32x16_bf16(__builtin_bit_cast(bf16x8, a1), sel1, d, 0, 0, 0);
                const unsigned w0 = pk4_fp8(d[0], d[1], d[2], d[3]), w1 = pk4_fp8(d[4], d[5], d[6], d[7]), w2 = pk4_fp8(d[8], d[9], d[10], d[11]), w3 = pk4_fp8(d[12], d[13], d[14], d[15]);
                const auto p02 = __builtin_amdgcn_permlane32_swap(w0, w2, false, false), p13 = __builtin_amdgcn_permlane32_swap(w1, w3, false, false);
                const u32x4 o = {p02[0], p02[1], p13[0], p13[1]};
                *(u32x4*)(dst[q2] + 32 * kb4) = o;
            }
        }
    }
};
__device__ __forceinline__ void mfma_f8_tied(f32x4& c, i32x8 a, i32x8 b, int sa, int sb) {
    asm volatile("v_mfma_scale_f32_16x16x128_f8f6f4 %0, %1, %2, %0, %3, %4 op_sel_hi:[0,0,0]" : "+v"(c) : "v"(a), "v"(b), "v"(sa), "v"(sb)); }
__device__ __forceinline__ void mfma_f8_drain() { asm volatile("s_nop 15\n\ts_nop 15" ::: "memory"); }
__device__ __forceinline__ void glds16s(unsigned voff, const char* sbase, unsigned lds_dst) { unsigned keep;
    asm volatile("s_mov_b32 %0, m0\n\ts_mov_b32 m0, %3\n\ts_nop 0\n\tglobal_load_lds_dwordx4 %1, %2\n\ts_mov_b32 m0, %0" : "=&s"(keep) : "v"(voff), "s"(sbase), "s"(lds_dst) : "memory"); }
template <class Epi, class Sched, bool F8 = false, int SCW = SC_ONE, int SCX = SC_ONE, class BG = NoBG>
__device__ __forceinline__ void gemm_phase(LAS unsigned char* lds, const Gemm g, const Sched& S, const Epi& E, const BG& bg = BG()) {
    const int tid = ltid(), wid = __builtin_amdgcn_readfirstlane(tid >> 6), lane = tid & 63, wr = wid >> 2, wc = wid & 3, fr = lane & 15, fq = lane >> 4;
    const int KB = g.KB, nt = KB / 128;
    int scw_ = SCW, scx_ = SCX; if constexpr (F8) { asm volatile("" : "+v"(scw_), "+v"(scx_)); }
    unsigned voffA[2], voffB[2];
#pragma unroll
    for (int i = 0; i < 2; ++i) { int R, C; stage_rc(tid * 16 + i * 8192, R, C); const int Rb = Epi::PERM ? ((R & ~31) + perm32(R & 31)) : R;
        voffA[i] = (unsigned)(R * KB + C * 2); voffB[i] = (unsigned)(Rb * KB + C * 2); }
    const size_t kstep = (size_t)128;
    const size_t hstep = (size_t)HALF * KB;
    const size_t tstep = 2 * hstep;
    const unsigned ldsb = (unsigned)(uintptr_t)lds + (unsigned)wid * 1024u;
    const int aoff = lds_byte(wr * 64 + fr, fq * 8), boff = lds_byte(wc * 32 + fr, fq * 8);
#define PG8_SA(b, h) (((b) * 2 + (h)) * HTB)
#define PG8_SB(b, h) ((4 + (b) * 2 + (h)) * HTB)
#define PG8_STAGE(bufoff, gbase, voff) do { _Pragma("unroll") for (int _i = 0; _i < 2; ++_i) \
        glds16s((voff)[_i], (const char*)(gbase), ldsb + (unsigned)((bufoff) + _i * 8192)); } while (0)
#define PG8_LDA(dst, b, h) do { _Pragma("unroll") for (int m = 0; m < 4; ++m) _Pragma("unroll") for (int k = 0; k < 2; ++k) dst[m][k] = *(const LAS bf16x8*)(lds + PG8_SA(b, h) + aoff + m * 2048 + k * 1024); } while (0)
#define PG8_LDB(dst, b, h) do { _Pragma("unroll") for (int n = 0; n < 2; ++n) _Pragma("unroll") for (int k = 0; k < 2; ++k) dst[n][k] = *(const LAS bf16x8*)(lds + PG8_SB(b, h) + boff + n * 2048 + k * 1024); } while (0)
#define PG8_CAT8(x) __builtin_shufflevector(__builtin_bit_cast(i32x4, (x)[0]), __builtin_bit_cast(i32x4, (x)[1]), 0, 1, 2, 3, 4, 5, 6, 7)
#define PG8_MMA(ai, bj, At, Bt) do { __builtin_amdgcn_s_setprio(1); \
        if constexpr (F8) { _Pragma("unroll") for (int m = 0; m < 4; ++m) _Pragma("unroll") for (int n = 0; n < 2; ++n) \
            mfma_f8_tied(acc[ai][bj][m][n], PG8_CAT8(Bt[n]), PG8_CAT8(At[m]), scw_, scx_); } \
        else { _Pragma("unroll") for (int m = 0; m < 4; ++m) _Pragma("unroll") for (int n = 0; n < 2; ++n) _Pragma("unroll") for (int k = 0; k < 2; ++k) \
            acc[ai][bj][m][n] = __builtin_amdgcn_mfma_f32_16x16x32_bf16(Bt[n][k], At[m][k], acc[ai][bj][m][n], 0, 0, 0); } \
        __builtin_amdgcn_s_setprio(0); } while (0)
#define PG8_WAIT_V(n) asm volatile("s_waitcnt vmcnt(" #n ")" ::: "memory")
#define PG8_WAIT_L(n) asm volatile("s_waitcnt lgkmcnt(" #n ")" ::: "memory")
#define PG8_BAR __builtin_amdgcn_s_barrier()
#define PG8_SCHED __builtin_amdgcn_sched_barrier(0)
    Unit cur, nxt; int ui = 0;
    if (!S.next(0, cur)) { for (int s = 0; s < bg.nslots; ++s) bg(s); return; }
    bf16x8 At[4][2], B0[2][2], B1[2][2];
    const char* cA = (const char*)g.A + (size_t)cur.pm * tstep + cur.kb0; const char* cB = (const char*)g.Bt + (size_t)cur.e * g.estride + (size_t)cur.pn * tstep + cur.kb0;
    PG8_STAGE(PG8_SB(0, 0), cB, voffB); PG8_STAGE(PG8_SB(0, 1), cB + hstep, voffB); PG8_STAGE(PG8_SA(0, 0), cA, voffA); PG8_STAGE(PG8_SA(0, 1), cA + hstep, voffA);
    if (wr == 1) PG8_BAR;
    PG8_WAIT_V(2); PG8_BAR;
    PG8_STAGE(PG8_SB(1, 0), cB + kstep, voffB); PG8_STAGE(PG8_SA(1, 0), cA + kstep, voffA); PG8_STAGE(PG8_SB(1, 1), cB + hstep + kstep, voffB);
    PG8_WAIT_V(6); PG8_BAR;
    for (;;) {
        f32x4 acc[2][2][4][2];
#pragma unroll
        for (int a = 0; a < 2; ++a)
#pragma unroll
            for (int b = 0; b < 2; ++b)
#pragma unroll
                for (int m = 0; m < 4; ++m)
#pragma unroll
                    for (int n = 0; n < 2; ++n) acc[a][b][m][n] = (f32x4){0.f, 0.f, 0.f, 0.f};
        const bool has_next = S.next(ui + 1, nxt);
        const char* nA = has_next ? (const char*)g.A + (size_t)nxt.pm * tstep + nxt.kb0 : cA; const char* nB = has_next ? (const char*)g.Bt + (size_t)nxt.e * g.estride + (size_t)nxt.pn * tstep + nxt.kb0 : cB;
        const int ntc = cur.ntu ? cur.ntu : nt;
        for (int t = 0; t < ntc; t += 2) {
            const bool last = (t == ntc - 2);
            const char* a1 = cA + (size_t)(t + 1) * kstep;
            const char* a2 = last ? nA : cA + (size_t)(t + 2) * kstep; const char* b2 = last ? nB : cB + (size_t)(t + 2) * kstep;
            const char* a3 = a2 + kstep; const char* b3 = b2 + kstep;
            PG8_LDB(B0, 0, 0); PG8_LDB(B1, 0, 1); PG8_SCHED; PG8_LDA(At, 0, 0); PG8_STAGE(PG8_SA(1, 1), a1 + hstep, voffA);
            PG8_WAIT_V(8); PG8_WAIT_L(0); PG8_BAR; PG8_MMA(0, 0, At, B0); PG8_MMA(0, 1, At, B1); PG8_BAR; PG8_SCHED;
            PG8_LDA(At, 0, 1); PG8_STAGE(PG8_SB(0, 0), b2, voffB); PG8_STAGE(PG8_SB(0, 1), b2 + hstep, voffB); PG8_STAGE(PG8_SA(0, 0), a2, voffA);
            PG8_WAIT_V(8); PG8_WAIT_L(0); PG8_BAR; PG8_MMA(1, 0, At, B0); PG8_MMA(1, 1, At, B1); PG8_BAR; PG8_SCHED;
            PG8_LDB(B0, 1, 0); PG8_LDB(B1, 1, 1); PG8_SCHED; PG8_LDA(At, 1, 0); PG8_STAGE(PG8_SA(0, 1), a2 + hstep, voffA);
            PG8_WAIT_V(8); PG8_WAIT_L(0); PG8_BAR; PG8_MMA(0, 0, At, B0); PG8_MMA(0, 1, At, B1); PG8_BAR; PG8_SCHED;
            PG8_LDA(At, 1, 1); PG8_STAGE(PG8_SB(1, 0), b3, voffB); PG8_STAGE(PG8_SB(1, 1), b3 + hstep, voffB); PG8_STAGE(PG8_SA(1, 0), a3, voffA);
            PG8_WAIT_V(8); PG8_WAIT_L(0); PG8_BAR; PG8_MMA(1, 0, At, B0); PG8_MMA(1, 1, At, B1); PG8_BAR; PG8_SCHED;
        }
        if (wr == 0) PG8_BAR;
        if constexpr (F8) mfma_f8_drain();
        E(acc, cur, wr, wc, fr, fq);
        asm volatile("" ::: "memory"); __builtin_amdgcn_sched_barrier(0);
        bg(ui);
        asm volatile("" ::: "memory"); __builtin_amdgcn_sched_barrier(0);
        if (!has_next) break;
        cur = nxt; cA = nA; cB = nB; ++ui;
        if (wr == 1) PG8_BAR;
    }
    for (int s = ui + 1; s < bg.nslots; ++s) bg(s);
    PG8_WAIT_V(0);
    PG8_BAR;
#undef PG8_SA
#undef PG8_SB
#undef PG8_STAGE
#undef PG8_LDA
#undef PG8_LDB
#undef PG8_MMA
#undef PG8_CAT8
#undef PG8_WAIT_V
#undef PG8_WAIT_L
#undef PG8_BAR
#undef PG8_SCHED
}
}

namespace att {
constexpr int D = 128, LDZ = INW, LDO = DM;
constexpr float SCALE = 0.08838834764831845f;
constexpr float THR = 8.f;
constexpr int NW = 8, QBLK = 32, KVBLK = 64, QB = NW * QBLK;
constexpr int SHM_V = KVBLK * D * 2, SHM_K = KVBLK * D * 2;
constexpr int ATT_LDS_BYTES = 2 * SHM_V + 2 * SHM_K + NW * 64 * 4;
#define KSWZ(row, colB) ((row) * 256 + ((colB) ^ (((row) & 7) << 4)))
#define SBAR() __builtin_amdgcn_sched_barrier(0)
__device__ __forceinline__ int v_st(int k, int c) { const int kk = (k & ~0xC) | ((k & 4) << 1) | ((k & 8) >> 1); return ((kk >> 3) * 4 + (c >> 5)) * 512 + ((kk & 7) * 32 + (c & 31)) * 2; }
__device__ __forceinline__ int v_rd_base(int lane) { return ((lane & 3) << 3) | (((lane >> 2) & 3) << 6) | (((lane >> 4) & 1) << 5) | (((lane >> 5) & 1) << 8); }
constexpr int v_rd_off(int d0, int ks, int half) { return d0 * 512 + ks * 4096 + half * 2048; }
__device__ __forceinline__ int crow(int r, int hi) { return (r & 3) + 8 * (r >> 2) + 4 * hi; }
__device__ __forceinline__ bf16x8 load8(const bf16_t* p) { return *reinterpret_cast<const bf16x8*>(p); }
__device__ __forceinline__ void mask_tile(f32x16& p0, f32x16& p1, int dq, unsigned W) {
    const float NEG = -__builtin_inff();
#pragma unroll
    for (int r = 0; r < 16; ++r) {
        const int c = (r & 3) + 8 * (r >> 2);
        if ((unsigned)(dq - c) >= W) p0[r] = NEG;
        if ((unsigned)(dq - c - 32) >= W) p1[r] = NEG;
    }
}
__device__ __forceinline__ void partialSM(f32x16& p0, f32x16& p1, float& m_reg, float& mn, float& alpha) {
    float pmax = p0[0];
#pragma unroll
    for (int r = 1; r < 16; ++r) pmax = fmaxf(pmax, p0[r]);
#pragma unroll
    for (int r = 0; r < 16; ++r) pmax = fmaxf(pmax, p1[r]);
    { auto rr = __builtin_amdgcn_permlane32_swap(__float_as_uint(pmax), __float_as_uint(pmax), false, false);
      pmax = fmaxf(__uint_as_float(rr[0]), __uint_as_float(rr[1])); }
    constexpr float C2 = 1.4426950408889634f * SCALE;
    if (__builtin_expect(__all((pmax - m_reg) * SCALE <= THR), 1)) { mn = m_reg; alpha = 1.f; }
    else { mn = fmaxf(m_reg, pmax); alpha = __builtin_amdgcn_exp2f((m_reg - mn) * C2); m_reg = mn; }
    const float mnL = -mn * C2;
#pragma unroll
    for (int r = 0; r < 16; ++r) p0[r] = fmaf(p0[r], C2, mnL);
#pragma unroll
    for (int r = 0; r < 16; ++r) p1[r] = fmaf(p1[r], C2, mnL);
#pragma unroll
    for (int r = 0; r < 16; ++r) p0[r] = __builtin_amdgcn_exp2f(p0[r]);
}
__device__ __forceinline__ void finishSM(f32x16& p0, f32x16& p1, float alpha, float& l_reg, bf16x8& pa0, bf16x8& pa1, bf16x8& pa2, bf16x8& pa3) {
#pragma unroll
    for (int r = 0; r < 16; ++r) p1[r] = __builtin_amdgcn_exp2f(p1[r]);
    float ps = 0;
#pragma unroll
    for (int r = 0; r < 16; ++r) ps += p0[r];
#pragma unroll
    for (int r = 0; r < 16; ++r) ps += p1[r];
    { auto rr = __builtin_amdgcn_permlane32_swap(__float_as_uint(ps), __float_as_uint(ps), false, false);
      ps = __uint_as_float(rr[0]) + __uint_as_float(rr[1]); }
    l_reg = l_reg * alpha + ps;
#define PK4(P, B_, OUT) do { unsigned a0 = cvt_pk_bf16(P[B_+0], P[B_+1]), a1 = cvt_pk_bf16(P[B_+2], P[B_+3]);                          \
        unsigned b0 = cvt_pk_bf16(P[B_+4], P[B_+5]), b1 = cvt_pk_bf16(P[B_+6], P[B_+7]);                                             \
        auto r0 = __builtin_amdgcn_permlane32_swap(a0, b0, false, false); auto r1 = __builtin_amdgcn_permlane32_swap(a1, b1, false, false); \
        u32x4 w = {r0[0], r1[0], r0[1], r1[1]}; OUT = *reinterpret_cast<bf16x8*>(&w); } while (0)
    PK4(p0, 0, pa0); PK4(p0, 8, pa1); PK4(p1, 0, pa2); PK4(p1, 8, pa3);
#undef PK4
}
template <int KB>
__device__ __forceinline__ void qkt(f32x16& p0, f32x16& p1, const char* K_lds, int r32, int hi, const bf16x8* qr) {
    p0 = f32x16{}; p1 = f32x16{};
    const char* kb[4];
#pragma unroll
    for (int dd = 0; dd < 4; ++dd) kb[dd] = K_lds + KB * SHM_K + KSWZ(r32, (dd * 16 + hi * 8) * 2);
#pragma unroll
    for (int d0 = 0; d0 < 8; ++d0) { const char* a = kb[d0 & 3] + (d0 >> 2) * 128;
        bf16x8 b0 = *reinterpret_cast<const bf16x8*>(a);
        bf16x8 b1 = *reinterpret_cast<const bf16x8*>(a + 32 * 256);
        p0 = __builtin_amdgcn_mfma_f32_32x32x16_bf16(b0, qr[d0], p0, 0, 0, 0);
        p1 = __builtin_amdgcn_mfma_f32_32x32x16_bf16(b1, qr[d0], p1, 0, 0, 0); }
}
template <int VB>
__device__ __forceinline__ void pv_tile(f32x16* o, int vb0, bf16x8 pa0, bf16x8 pa1, bf16x8 pa2, bf16x8 pa3) {
#define TRRD(dst, off) asm volatile("ds_read_b64_tr_b16 %0, %1 offset:%2" : "=&v"(dst) : "v"(vb0), "i"(off) : "memory")
#define PV_D0(d0) do { s16x4 l0, l1, l2, l3, h0, h1, h2, h3; constexpr int b_ = VB * SHM_V + v_rd_off(d0, 0, 0); \
        TRRD(l0, b_); TRRD(h0, b_ + 2048); TRRD(l1, b_ + 4096); TRRD(h1, b_ + 6144); TRRD(l2, b_ + 8192); TRRD(h2, b_ + 10240); TRRD(l3, b_ + 12288); TRRD(h3, b_ + 14336); \
        asm volatile("s_waitcnt lgkmcnt(0)" ::: "memory"); SBAR();   \
        o[d0] = __builtin_amdgcn_mfma_f32_32x32x16_bf16(pa0, (bf16x8){l0[0], l0[1], l0[2], l0[3], h0[0], h0[1], h0[2], h0[3]}, o[d0], 0, 0, 0);   \
        o[d0] = __builtin_amdgcn_mfma_f32_32x32x16_bf16(pa1, (bf16x8){l1[0], l1[1], l1[2], l1[3], h1[0], h1[1], h1[2], h1[3]}, o[d0], 0, 0, 0);   \
        o[d0] = __builtin_amdgcn_mfma_f32_32x32x16_bf16(pa2, (bf16x8){l2[0], l2[1], l2[2], l2[3], h2[0], h2[1], h2[2], h2[3]}, o[d0], 0, 0, 0);   \
        o[d0] = __builtin_amdgcn_mfma_f32_32x32x16_bf16(pa3, (bf16x8){l3[0], l3[1], l3[2], l3[3], h3[0], h3[1], h3[2], h3[3]}, o[d0], 0, 0, 0); } while (0)
    PV_D0(0); PV_D0(1); PV_D0(2); PV_D0(3);
#undef PV_D0
#undef TRRD
}
struct BlockRef { const bf16_t* Q; const bf16_t* K; const bf16_t* V; bf16_t* O; int P0; };
struct Seam { bf16x8 qr[8]; bf16x8 st_v0, st_v1, st_k0, st_k1; };
#define ROW(p, k0, rr) ((p) + (size_t)((k0) + (rr)) * LDZ + sc)
#define VMW() asm volatile("s_waitcnt vmcnt(0)" ::: "memory")
#define VMWN(n) asm volatile("s_waitcnt vmcnt(%0)" :: "i"(n) : "memory")
#define SLOAD_H(Kp, Vp, k0) do { S.st_v0 = load8(ROW(Vp, k0, sr)); S.st_v1 = load8(ROW(Vp, k0, 32 + sr));              \
                         S.st_k0 = load8(ROW(Kp, k0, sr)); S.st_k1 = load8(ROW(Kp, k0, 32 + sr)); } while (0)
#define SWRITE_HK(bf) do { *(bf16x8*)(K_lds + (bf) * SHM_K + kws) = S.st_k0; *(bf16x8*)(K_lds + (bf) * SHM_K + kws + 32 * 256) = S.st_k1; } while (0)
#define SWRITE_HV(bf) do { *(bf16x8*)(V_lds + (bf) * SHM_V + vst0) = S.st_v0; *(bf16x8*)(V_lds + (bf) * SHM_V + vst1) = S.st_v1; } while (0)
#define SWRITE_H(bf) do { SWRITE_HV(bf); SWRITE_HK(bf); } while (0)
__device__ __forceinline__ void causal_prime(const BlockRef& cur, char* lds, Seam& S) {
    const int tid = ltid(), wid = __builtin_amdgcn_readfirstlane(tid >> 6), lane = tid & 63, r32 = lane & 31, hi = lane >> 5;
    const int sr = tid >> 4, sc = (tid & 15) * 8, kws = KSWZ(sr, sc * 2); char* K_lds = lds + 2 * SHM_V;
    const int kb0 = 0;
#pragma unroll
    for (int d0 = 0; d0 < 8; ++d0) S.qr[d0] = load8(cur.Q + (size_t)(wid * QBLK + r32) * LDZ + d0 * 16 + hi * 8);
    SLOAD_H(cur.K, cur.V, kb0); VMW(); SWRITE_HK(0);
    __syncthreads();
}
template <int ORD>
__device__ __forceinline__ void causal_block(const BlockRef& cur, const BlockRef& nxt, int skv, char* lds, Seam& S) {
    const int tid = ltid(), wid = __builtin_amdgcn_readfirstlane(tid >> 6), lane = tid & 63, r32 = lane & 31, hi = lane >> 5;
    const int W = 1 << 30;
    const int j_lo = 0;
    int j_hi = (cur.P0 + QB - 1) / KVBLK + 1; if (j_hi > skv / KVBLK) j_hi = skv / KVBLK;
    const int NT = j_hi - j_lo;
    const int kbn = 0;
    const int qlo = cur.P0 + wid * QBLK, qm = qlo + r32 - 4 * hi;
    char* V_lds = lds; char* K_lds = lds + 2 * SHM_V;
    float* ws = (float*)(lds + 2 * SHM_V + 2 * SHM_K) + wid * 64; float* li_l = ws, * al_l = ws + 32;
    float m_reg = -1e30f, l_reg = 0; f32x16 o[4];
    { float z_ = 0.f; asm volatile("" : "+v"(z_));
#pragma unroll
      for (int d_ = 0; d_ < 4; ++d_)
#pragma unroll
          for (int r = 0; r < 16; ++r) o[d_][r] = z_; }
    const int sr = tid >> 4, sc = (tid & 15) * 8, vst0 = v_st(sr, sc), vst1 = v_st(32 + sr, sc), kws = KSWZ(sr, sc * 2);
    const int vb0 = (int)(uintptr_t)V_lds + v_rd_base(lane);
    const bf16_t* Kh = cur.K; const bf16_t* Vh = cur.V;
#define RESC(a) do { if (__any((a) < 1.f)) { if (hi == 0) al_l[r32] = (a); asm volatile("s_waitcnt lgkmcnt(0)" ::: "memory");              \
                     _Pragma("unroll") for (int d_ = 0; d_ < 4; ++d_) _Pragma("unroll") for (int r = 0; r < 16; ++r) o[d_][r] *= al_l[crow(r, hi)]; } } while (0)
#define KBASE(t) ((j_lo + (t)) * KVBLK)
#define MASKT(P0_, P1_, t) do { const int kb_ = KBASE(t); if (kb_ + KVBLK - 1 > qlo) mask_tile(P0_, P1_, qm - kb_, (unsigned)W); } while (0)
    constexpr int NQL = 8;
#define SEAM_K0() do { VMWN(NQL); SWRITE_HK(0); SBAR(); } while (0)
    f32x16 pA0, pA1, pB0, pB1; float mnA, mnB, alA, alB; bf16x8 pa0, pa1, pa2, pa3;
    SWRITE_HV(0); SBAR();
    if (NT > 1) { SLOAD_H(Kh, Vh, KBASE(1)); }
    SBAR(); qkt<0>(pA0, pA1, K_lds, r32, hi, S.qr);
    MASKT(pA0, pA1, 0); partialSM(pA0, pA1, m_reg, mnA, alA);
    if (NT > 1) { VMW(); SWRITE_H(1); }
    __syncthreads();
#define HALF_STEP(PX0, PX1, mnX, alX, PY0, PY1, alY, t, KB, VB, SB) do {                                                      \
        SBAR(); qkt<KB>(PX0, PX1, K_lds, r32, hi, S.qr);                                                                      \
        finishSM(PY0, PY1, alY, l_reg, pa0, pa1, pa2, pa3); SBAR();                                                           \
        if ((t) + 1 < NT) { SLOAD_H(Kh, Vh, KBASE((t) + 1)); SBAR(); }                                                        \
        pv_tile<VB>(o, vb0, pa0, pa1, pa2, pa3); MASKT(PX0, PX1, (t)); partialSM(PX0, PX1, m_reg, mnX, alX);                  \
        __syncthreads();                                                                                                      \
        if ((t) + 1 < NT) { VMW(); SWRITE_H(SB); }                                                                            \
        RESC(alX); __syncthreads(); } while (0)
#define HALF_STEP_V(PX0, PX1, mnX, alX, PY0, PY1, alY, t, KB, VB, SB) do {                                                    \
        SBAR(); finishSM(PY0, PY1, alY, l_reg, pa0, pa1, pa2, pa3); SBAR();                                                   \
        qkt<KB>(PX0, PX1, K_lds, r32, hi, S.qr); SBAR();                                                                      \
        if ((t) + 1 < NT) { SLOAD_H(Kh, Vh, KBASE((t) + 1)); SBAR(); }                                                        \
        MASKT(PX0, PX1, (t)); partialSM(PX0, PX1, m_reg, mnX, alX); SBAR();                                                   \
        pv_tile<VB>(o, vb0, pa0, pa1, pa2, pa3);                                                                              \
        __syncthreads();                                                                                                      \
        if ((t) + 1 < NT) { VMW(); SWRITE_H(SB); }                                                                            \
        RESC(alX); __syncthreads(); } while (0)
    for (int t = 1; t + 1 < NT; t += 2) {
        if constexpr (ORD == 0) { HALF_STEP(pB0, pB1, mnB, alB, pA0, pA1, alA, t, 1, 0, 0);
                                  HALF_STEP(pA0, pA1, mnA, alA, pB0, pB1, alB, t + 1, 0, 1, 1); }
        else                    { HALF_STEP_V(pB0, pB1, mnB, alB, pA0, pA1, alA, t, 1, 0, 0);
                                  HALF_STEP_V(pA0, pA1, mnA, alA, pB0, pB1, alB, t + 1, 0, 1, 1); }
    }
    const bool even = (NT & 1) == 0;
    if (even) { SBAR(); qkt<1>(pB0, pB1, K_lds, r32, hi, S.qr); SBAR(); }
    SLOAD_H(nxt.K, nxt.V, kbn); SBAR();
#pragma unroll
    for (int d0 = 0; d0 < 8; ++d0) S.qr[d0] = load8(nxt.Q + (size_t)(wid * QBLK + r32) * LDZ + d0 * 16 + hi * 8);
    SBAR();
    finishSM(pA0, pA1, alA, l_reg, pa0, pa1, pa2, pa3); SBAR();
    pv_tile<0>(o, vb0, pa0, pa1, pa2, pa3);
    if (even) { MASKT(pB0, pB1, NT - 1); partialSM(pB0, pB1, m_reg, mnB, alB); __syncthreads(); RESC(alB);
        finishSM(pB0, pB1, alB, l_reg, pa0, pa1, pa2, pa3); SBAR(); pv_tile<1>(o, vb0, pa0, pa1, pa2, pa3); }
    SBAR(); SEAM_K0();
    if (hi == 0) li_l[r32] = l_reg; asm volatile("s_waitcnt lgkmcnt(0)" ::: "memory");
    float rli[16];
#pragma unroll
    for (int r = 0; r < 16; ++r) rli[r] = __builtin_amdgcn_rcpf(li_l[crow(r, hi)]);
    bf16_t* Ow = cur.O + (size_t)(wid * QBLK) * LDO;
#pragma unroll
    for (int r = 0; r < 16; ++r) { const int orow = crow(r, hi);
#pragma unroll
        for (int d0 = 0; d0 < 4; ++d0) { const float v = o[d0][r] * rli[r]; const float vn = lx1(v);
            if ((r32 & 1) == 0) *(unsigned*)(Ow + (size_t)orow * LDO + d0 * 32 + r32) = cvt_pk_bf16(v, vn); } }
    __syncthreads();
#undef RESC
#undef KBASE
#undef MASKT
#undef SEAM_K0
#undef HALF_STEP
#undef HALF_STEP_V
}
#undef ROW
#undef VMW
#undef VMWN
#undef SLOAD_H
#undef SWRITE_HK
#undef SWRITE_HV
#undef SWRITE_H
#undef KSWZ
#undef SBAR
}

#define XB_TMO      128
#define XB_XCNT(j)  (256  + 64 * (j))
#define XB_XSUB(j)  (1280 + 64 * (j))
#define XB_XGEN(j)  (2304 + 64 * (j))
#define XB_TOP      3328
#define XB_TOPGEN   3392
#define XCD_BAR_WORDS 3456
#define XB_SPIN_CAP (1u << 18)

__device__ __forceinline__ unsigned xb_ld(unsigned* p)              { return __hip_atomic_load(p, __ATOMIC_RELAXED, __HIP_MEMORY_SCOPE_AGENT); }
__device__ __forceinline__ unsigned xb_add(unsigned* p, unsigned v) { return __hip_atomic_fetch_add(p, v, __ATOMIC_RELAXED, __HIP_MEMORY_SCOPE_AGENT); }
__device__ __forceinline__ unsigned xb_xcc_id() { return (unsigned)__builtin_amdgcn_s_getreg((3 << 11) | 20) & 0xFu; }
#define XB_SPIN(cond, bar) do { unsigned _sp = 0; while (cond) { __builtin_amdgcn_s_sleep(1); \
    if ((++_sp & 255u) == 0u) { if (xb_ld(&(bar)[XB_TMO])) break; if (_sp > XB_SPIN_CAP) { atomicAdd(&(bar)[XB_TMO], 1u); break; } } } } while (0)

struct XcdBarrier {
    unsigned* bar; unsigned x;
    volatile LAS unsigned* st;
};

__device__ __forceinline__ XcdBarrier xcd_barrier_post(unsigned* bar, volatile LAS unsigned* st) {
    XcdBarrier b; b.bar = bar; b.x = xb_xcc_id(); b.st = st;
    if (threadIdx.x == 0) (void)xb_add(&bar[XB_XCNT(b.x)], 1u);
    return b;
}
__device__ __forceinline__ void xcd_barrier_complete(unsigned* bar, unsigned x, unsigned& nloc, unsigned& nx) {
    const unsigned G = gridDim.x * gridDim.y * gridDim.z;
    unsigned sum, cnt, mine, sp = 0u;
    for (;;) {
        sum = 0u; cnt = 0u; mine = 0u;
#pragma unroll
        for (unsigned j = 0; j < 16; ++j) { const unsigned c = xb_ld(&bar[XB_XCNT(j)]); sum += c; cnt += (c > 0u) ? 1u : 0u; mine = (j == x) ? c : mine; }
        if (sum == G) break;
        __builtin_amdgcn_s_sleep(1);
        if ((++sp & 255u) == 0u) { if (xb_ld(&bar[XB_TMO])) break; if (sp > XB_SPIN_CAP) { atomicAdd(&bar[XB_TMO], 1u); break; } }
    }
    nloc = mine > 0u ? mine : 1u; nx = cnt > 0u ? cnt : 1u;
}

template <bool FIRST> __device__ __forceinline__ void xcd_barrier(const XcdBarrier& b) {
    asm volatile("s_waitcnt vmcnt(0)" ::: "memory");
    __syncthreads();
    if (threadIdx.x == 0) {
        unsigned* bar = b.bar;
        __builtin_amdgcn_s_waitcnt(0);
        unsigned nloc = b.st[0], nx = b.st[1];
        if (FIRST) { if (nloc == 0u) { xcd_barrier_complete(bar, b.x, nloc, nx); b.st[0] = nloc; b.st[1] = nx; } }
        const unsigned old = xb_add(&bar[XB_XSUB(b.x)], 1u);
        const unsigned gen = old / nloc;
        if (old + 1u == (gen + 1u) * nloc) {
            __builtin_amdgcn_fence(__ATOMIC_RELEASE, "agent");
            asm volatile("s_waitcnt vmcnt(0)" ::: "memory");
            const unsigned og = xb_add(&bar[XB_TOP], 1u);
            const unsigned tg = og / nx;
            if (og + 1u == (tg + 1u) * nx) xb_add(&bar[XB_TOPGEN], 1u);
            else XB_SPIN(xb_ld(&bar[XB_TOPGEN]) == tg, bar);
            __builtin_amdgcn_fence(__ATOMIC_ACQUIRE, "agent");
            xb_add(&bar[XB_XGEN(b.x)], 1u);
            asm volatile("s_waitcnt vmcnt(0)" ::: "memory");
        } else {
            XB_SPIN(xb_ld(&bar[XB_XGEN(b.x)]) == gen, bar);
            __builtin_amdgcn_fence(__ATOMIC_ACQUIRE, "agent");
            asm volatile("s_waitcnt vmcnt(0)" ::: "memory");
        }
    }
    __syncthreads();
}

template <int KT, bool F8>
__device__ __forceinline__ void transpose_item(const float* W, int K, int N, void* WT, int drow0, int k0, int n0, LAS float* scr, int lane, const float* gk) {
    const int kr = lane >> 3, n4 = 4 * (lane & 7);
    f32x4 v[KT / 8];
#pragma unroll
    for (int i = 0; i < KT / 8; ++i) v[i] = *(const f32x4*)(W + (size_t)(k0 + kr + 8 * i) * N + n0 + n4);
    if (gk) {
#pragma unroll
        for (int i = 0; i < KT / 8; ++i) v[i] = v[i] * gk[k0 + kr + 8 * i]; }
#pragma unroll
    for (int i = 0; i < KT / 8; ++i) { LAS float* s = scr + (kr + 8 * i) * 33 + 4 * ((kr + 8 * i) >> 4) + n4; s[0] = v[i][0]; s[1] = v[i][1]; s[2] = v[i][2]; s[3] = v[i][3]; }
    LDS_WAIT(); asm volatile("" ::: "memory");
    const int c = lane & 7;
#pragma unroll
    for (int j = 0; j < 4; ++j) { const int n = (lane >> 3) + 8 * j;
        if constexpr (!F8) { static_assert(F8 || KT == 64, "bf16 item is 64 k");
            const LAS float* s = scr + (8 * c) * 33 + 4 * ((8 * c) >> 4) + n;
            u32x4 o; o.x = cvt_pk_bf16(s[0 * 33], s[1 * 33]); o.y = cvt_pk_bf16(s[2 * 33], s[3 * 33]); o.z = cvt_pk_bf16(s[4 * 33], s[5 * 33]); o.w = cvt_pk_bf16(s[6 * 33], s[7 * 33]);
            *(u32x4*)((bf16_t*)WT + (size_t)(drow0 + n) * K + k0 + 8 * c) = o;
        } else { static_assert(!F8 || KT == 128, "fp8 item is 128 k");
            const LAS float* s = scr + (16 * c) * 33 + 4 * c + n;
            u32x4 o;
            o.x = pk4_fp8(s[0 * 33] * W8_SCALE, s[1 * 33] * W8_SCALE, s[2 * 33] * W8_SCALE, s[3 * 33] * W8_SCALE);
            o.y = pk4_fp8(s[4 * 33] * W8_SCALE, s[5 * 33] * W8_SCALE, s[6 * 33] * W8_SCALE, s[7 * 33] * W8_SCALE);
            o.z = pk4_fp8(s[8 * 33] * W8_SCALE, s[9 * 33] * W8_SCALE, s[10 * 33] * W8_SCALE, s[11 * 33] * W8_SCALE);
            o.w = pk4_fp8(s[12 * 33] * W8_SCALE, s[13 * 33] * W8_SCALE, s[14 * 33] * W8_SCALE, s[15 * 33] * W8_SCALE);
            *(u32x4*)((unsigned char*)WT + (size_t)(drow0 + n) * K + k0 + 16 * c) = o;
        } }
    LDS_WAIT(); asm volatile("" ::: "memory");
}
template <bool F8> struct TrItem { static constexpr int NB = F8 ? 4 : 2; f32x4 v[NB][4]; f32x4 g[NB]; };
template <bool F8> __device__ __forceinline__ void tr_load(TrItem<F8>& T, const float* W, int N, int k0, int n0, int lane, const float* gk, bool useg) {
    const int kq = lane >> 3, nq = lane & 7;
#pragma unroll
    for (int b = 0; b < TrItem<F8>::NB; ++b) {
        const int kr = k0 + 32 * b + 4 * kq;
        const f32x4 gv = *(const f32x4*)(gk + (kr & (DM - 1)));
        T.g[b] = useg ? gv : (f32x4){1.f, 1.f, 1.f, 1.f};
#pragma unroll
        for (int i = 0; i < 4; ++i) T.v[b][i] = *(const f32x4*)(W + (size_t)(kr + i) * N + n0 + 4 * nq);
    }
}
template <bool F8> __device__ __forceinline__ void tr_store(const TrItem<F8>& T, void* WT, int K, int drow0, int dstep, int k0, LAS unsigned char* scr, int lane) {
    const int kq = lane >> 3, nq = lane & 7;
#pragma unroll
    for (int b = 0; b < TrItem<F8>::NB; ++b) {
        f32x4 x[4];
#pragma unroll
        for (int i = 0; i < 4; ++i) x[i] = T.v[b][i] * (T.g[b][i] * (F8 ? W8_SCALE : 1.0f));
#pragma unroll
        for (int e = 0; e < 4; ++e) {
            LAS unsigned char* row = scr + (4 * nq + e) * 144;
            if constexpr (F8) { const int kb = 32 * b + 4 * kq, ch = (kb >> 4) ^ nq;
                *(LAS unsigned*)(row + 16 * ch + (kb & 15)) = pk4_fp8(x[0][e], x[1][e], x[2][e], x[3][e]); }
            else { const int kb = 64 * b + 8 * kq, ch = (kb >> 4) ^ nq;
                u32x2 w; w.x = cvt_pk_bf16(x[0][e], x[1][e]); w.y = cvt_pk_bf16(x[2][e], x[3][e]); *(LAS u32x2*)(row + 16 * ch + (kb & 15)) = w; }
        }
    }
    LDS_WAIT(); asm volatile("" ::: "memory");
    const int c = lane & 7;
#pragma unroll
    for (int j = 0; j < 4; ++j) { const int n = (lane >> 3) + 8 * j;
        const u32x4 o = *(const LAS u32x4*)(scr + n * 144 + 16 * (c ^ ((n >> 2) & 7)));
        *(u32x4*)((unsigned char*)WT + ((size_t)(drow0 + n * dstep) * K + k0) * (F8 ? 1 : 2) + 16 * c) = o; }
    LDS_WAIT(); asm volatile("" ::: "memory");
}

__device__ __forceinline__ float row_copy_ss(const float* xrow, bf16_t* orow, int lane) {
    const f32x4* xr = (const f32x4*)xrow + lane; u32x2* o8 = (u32x2*)orow + lane;
    float s = 0.f;
#pragma unroll
    for (int j = 0; j < 8; ++j) { const f32x4 v = xr[64 * j]; s += (v.x * v.x + v.y * v.y) + (v.z * v.z + v.w * v.w); u32x2 w; w.x = cvt_pk_bf16(v.x, v.y); w.y = cvt_pk_bf16(v.z, v.w); o8[64 * j] = w; }
    return wave_sum(s);
}

struct ItemDesc { const float* W; void* WT; const float* gk; int K, N, drow0, dstep, k0, n0; bool useg; };
template <bool F8, class Dec> __device__ __forceinline__ void conv_loop(int first, int end, int stride, const Dec& dec, LAS unsigned char* scr, int lane) {
    int it = first; if (it >= end) return;
    TrItem<F8> A, B; ItemDesc da, db;
    dec(it, da); tr_load<F8>(A, da.W, da.N, da.k0, da.n0, lane, da.gk, da.useg);
    for (;;) {
        int nx = it + stride; bool hn = nx < end; dec(hn ? nx : it, db); tr_load<F8>(B, db.W, db.N, db.k0, db.n0, lane, db.gk, db.useg);
        tr_store<F8>(A, da.WT, da.K, da.drow0, da.dstep, da.k0, scr, lane);
        if (!hn) break; it = nx;
        nx = it + stride; hn = nx < end; dec(hn ? nx : it, da); tr_load<F8>(A, da.W, da.N, da.k0, da.n0, lane, da.gk, da.useg);
        tr_store<F8>(B, db.WT, db.K, db.drow0, db.dstep, db.k0, scr, lane);
        if (!hn) break; it = nx;
    }
}
constexpr int MOE_J = 8;
#ifndef CONV_NUM
#define CONV_NUM 12
#endif
struct DecMoe {
    volatile LAS unsigned* LW; int cbase, wave, blk;
    __device__ __forceinline__ int item(int q) const { return (q / MOE_J) * blk + cbase + (q % MOE_J) * 8 + wave; }
    __device__ __forceinline__ unsigned long long ptr(int i) const { return (unsigned long long)(unsigned)__builtin_amdgcn_readfirstlane((int)LW[64 + 2 * i]) | ((unsigned long long)(unsigned)__builtin_amdgcn_readfirstlane((int)LW[64 + 2 * i + 1]) << 32); }
    __device__ __forceinline__ void operator()(int q, ItemDesc& d) const {
        constexpr int PER = 3584; const int it = item(q);
        const int mat = it / PER, r = it - mat * PER, e = mat & 7, kind = mat >> 3;
        const bool up_ = kind < 2;
        const int nblk = up_ ? 224 : 64, kb = r / nblk, nb = r - kb * nblk;
        d.K = up_ ? DM : FFE; d.N = up_ ? FFE : DM; d.n0 = 32 * nb; d.k0 = 128 * kb; d.useg = up_; d.dstep = 1;
        d.drow0 = up_ ? (256 * (d.n0 >> 7) + kind * 128 + (d.n0 & 127)) : d.n0;
        d.W = (const float*)(GAS const float*)ptr(kind == 0 ? 17 : (kind == 1 ? 18 : 19)) + (size_t)e * DM * FFE;
        d.gk = (const float*)(GAS const float*)ptr(12) + DM;
        d.WT = (unsigned char*)(GAS unsigned char*)(ptr(21) + (up_ ? WS_WMGU : WS_WMD)) + (size_t)e * (up_ ? 2 : 1) * FFE * DM;
    }
};
constexpr int MOE_ITEMS = 24 * 3584;
struct DecMoeLin : DecMoe { int first, stride; __device__ __forceinline__ void operator()(int q, ItemDesc& d) const { DecMoe t = *this; t.cbase = first + q * stride; t.wave = 0; t.blk = 0; t.DecMoe::operator()(0, d); } };
struct DecP0 {
    volatile LAS unsigned* LW;
    static constexpr int I_IN = 32 * 160, I_OUT = 32 * 64, I_DG = 32 * 176, I_DD = 88 * 64, J_DG = 16 * 176, J_DD = 44 * 64;
    static constexpr int N16A = 2 * I_IN + 2 * I_OUT, N16B = N16A + (DUP8 ? 0 : 2 * I_DG), N16 = N16B + (DDN8 ? 0 : I_DD);
    static constexpr int N8A = DUP8 ? 2 * J_DG : 0, N8 = N8A + (DDN8 ? J_DD : 0);
    __device__ __forceinline__ unsigned long long ptr(int i) const { return (unsigned long long)(unsigned)__builtin_amdgcn_readfirstlane((int)LW[64 + 2 * i]) | ((unsigned long long)(unsigned)__builtin_amdgcn_readfirstlane((int)LW[64 + 2 * i + 1]) << 32); }
    __device__ __forceinline__ const float* inf(int i) const { return (const float*)(GAS const float*)ptr(i); }
    __device__ __forceinline__ unsigned char* wsp(size_t off) const { return (unsigned char*)(GAS unsigned char*)(ptr(21) + off); }
    __device__ __forceinline__ void fin(ItemDesc& d, int r, int mode, int kt) const {
        const int nblk = d.N / 32, kb = r / nblk, nb = r - kb * nblk; d.n0 = 32 * nb; d.k0 = kt * kb;
        d.drow0 = mode == 0 ? d.n0 : (256 * (d.n0 >> 7) + (mode - 1) * 128 + (d.n0 & 127)); d.dstep = 1;
        if (mode == 3) { const int dd = d.n0 & 127; d.drow0 = (d.n0 & ~127) + (dd < 64 ? 2 * dd : 2 * (dd - 64) + 1); d.dstep = 2; } }
};
struct DecP0b16 : DecP0 {
    __device__ __forceinline__ void operator()(int it, ItemDesc& d) const {
        int r = it, mode = 0; d.K = DM; d.useg = false; d.gk = inf(2);
        if (r < 2 * I_IN) { const int l = r / I_IN; r -= l * I_IN; d.W = inf(3) + (size_t)l * DM * INW; d.WT = wsp(WS_WIN) + (size_t)l * INW * DM * 2; d.N = INW; d.gk = inf(2) + l * DM; d.useg = true;
                            if ((r % (INW / 32)) * 32 < ZV) mode = 3; }
        else if (r < N16A) { r -= 2 * I_IN; const int l = r / I_OUT; r -= l * I_OUT; d.W = inf(11) + (size_t)l * DM * DM; d.WT = wsp(WS_WOUT) + (size_t)l * DM * DM * 2; d.N = DM; }
        else if (r < N16B) { r -= N16A; mode = 1 + r / I_DG; r -= (mode - 1) * I_DG; d.W = mode == 1 ? inf(13) : inf(14); d.WT = wsp(WS_WDGU); d.N = FFD; d.gk = inf(12); d.useg = true; }
        else { r -= N16B; d.W = inf(15); d.WT = wsp(WS_WDD); d.K = FFD; d.N = DM; }
        fin(d, r, mode == 3 ? 3 : mode, 64);
    }
};
struct DecP0f8 : DecP0 {
    __device__ __forceinline__ void operator()(int it, ItemDesc& d) const {
        int r = it, mode = 0; d.useg = false; d.gk = inf(12);
        if (r < N8A) { mode = 1 + r / J_DG; r -= (mode - 1) * J_DG; d.W = mode == 1 ? inf(13) : inf(14); d.WT = wsp(WS_WDGU); d.K = DM; d.N = FFD; d.useg = true; }
        else { r -= N8A; d.W = inf(15); d.WT = wsp(WS_WDD); d.K = FFD; d.N = DM; }
        fin(d, r, mode, 128);
    }
};
__device__ __forceinline__ void moe_conv_slots(volatile LAS unsigned* LW, LAS unsigned char* lds, int slot0, int nsl, int bx, int G) {
    const int tid = ltid(), lane = tid & 63, wave = __builtin_amdgcn_readfirstlane(tid >> 6), gw = bx * 8 + wave, NGW = G * 8;
#pragma unroll 1
    for (int q = 0; q < 2; ++q) {
        const int first = (slot0 * NGW + gw) * 2 + q, stride = 2 * NGW;
        int cnt = first < MOE_ITEMS ? (MOE_ITEMS - 1 - first) / stride + 1 : 0; cnt = cnt < nsl ? cnt : nsl;
        const DecMoeLin dec{{LW, 0, 0, 0}, first, stride};
        conv_loop<true>(0, cnt, 1, dec, lds + 1024 + wave * 4608, lane);
    }
}

struct Args { const void* in[20]; float* out; unsigned char* ws; };

__global__ void __launch_bounds__(512, 2) hybrid_fwd(Args args) {
    extern __shared__ __attribute__((aligned(16))) unsigned char lds_raw[];
    LAS unsigned char* lds = (LAS unsigned char*)lds_raw;
    volatile LAS unsigned* LW = (volatile LAS unsigned*)(lds + LDSCTL_OFF);
    const int tid = threadIdx.x, lane = tid & 63, wave = __builtin_amdgcn_readfirstlane(tid >> 6);
    const int G = gridDim.x, bx = blockIdx.x;
    const int gw = bx * 8 + wave, NGW = G * 8;
    for (int u = tid; u < LDSCTL_BYTES / 4; u += 512) LW[u] = 0u;
    __syncthreads();
    if (lane == 0) LW[128 + ((unsigned)__builtin_amdgcn_s_getreg((5 << 11) | 4) & 63u)] = (unsigned)wave;
    if (tid < 22) { const unsigned long long pv = tid < 20 ? (unsigned long long)args.in[tid] : (tid == 20 ? (unsigned long long)args.out : (unsigned long long)args.ws);
        LW[64 + 2 * tid] = (unsigned)pv; LW[64 + 2 * tid + 1] = (unsigned)(pv >> 32); }
    __syncthreads();
#define PTR(i) ((unsigned long long)(unsigned)__builtin_amdgcn_readfirstlane((int)LW[64 + 2 * (i)]) | ((unsigned long long)(unsigned)__builtin_amdgcn_readfirstlane((int)LW[64 + 2 * (i) + 1]) << 32))
#define INF(i) ((const float*)(GAS const float*)PTR(i))
#define WSP(T, off) ((T*)(GAS T*)(PTR(21) + (unsigned long long)(off)))
#define OUTP ((float*)(GAS float*)PTR(20))
    { const XcdBarrier b0 = xcd_barrier_post(WSP(unsigned, WS_CTL) + CW_BAR, LW); if (threadIdx.x == 0) LW[2] = b0.x; }
    __syncthreads();
#define GRID_BAR_T(F) do { XcdBarrier b_; b_.bar = WSP(unsigned, WS_CTL) + CW_BAR; b_.x = (unsigned)__builtin_amdgcn_readfirstlane((int)LW[2]); b_.st = LW; xcd_barrier<F>(b_); } while (0)
#define GRID_BAR() GRID_BAR_T(false)

    unsigned long long tacc_ = 0ull, tph_ = 0ull; (void)tacc_; (void)tph_;
#define PH_BEGIN() do { if (PROBE_MASK) tph_ = __builtin_amdgcn_s_memrealtime(); } while (0)
#define PH_END(id) do { if (PROBE_MASK & (1u << (id))) tacc_ += __builtin_amdgcn_s_memrealtime() - tph_; } while (0)
    PH_BEGIN();
    for (int rep_ = 0; rep_ < REP_P0; ++rep_) {
        LAS float* scr = (LAS float*)(lds + 1024 + wave * 17152);
        unsigned char* ws = WSP(unsigned char, 0);
        {
            LAS unsigned char* tscr = lds + 1024 + wave * 4608;
            DecP0b16 d16; d16.LW = LW; conv_loop<false>(gw, DecP0::I_IN, NGW, d16, tscr, lane);
        }
        {
            const int* positions = (const int*)(GAS const int*)PTR(1); float* cosT = (float*)(ws + WS_COS); float* sinT = (float*)(ws + WS_SIN);
            for (int idx = (bx * 512 + tid); idx < NTOK * 64; idx += G * 512) {
                const int t = idx >> 6, i = idx & 63;
                const float inv = 1.0f / powf(10000.0f, (float)(2 * i) / 128.0f);
                const float ang = (float)positions[t] * inv;
                double rev = (double)ang * 0.15915494309189535; rev -= rint(rev);
                const float rf = (float)rev;
                cosT[idx] = __builtin_amdgcn_cosf(rf); sinT[idx] = __builtin_amdgcn_sinf(rf);
            }
        }
        {
            const float* w_pool = INF(8); bf16_t* wpt = (bf16_t*)(ws + WS_WPT);
            for (int idx = (bx * 512 + tid); idx < 2 * 4 * 128 * 128; idx += G * 512) {
                const int c = idx & 127, d = (idx >> 7) & 127, lg = idx >> 14;
                const float v = w_pool[((size_t)lg * 128 + c) * 128 + d];
                wpt[idx] = (bf16_t)(cvt_pk_bf16(v, 0.f) & 0xffffu);
            }
        }
        {
            const float* x_in = INF(0); bf16_t* xb = (bf16_t*)(ws + WS_XR); float* ss0 = (float*)(ws + WS_SS);
            for (int m = gw; m < NTOK; m += NGW) { const float s = row_copy_ss(x_in + (size_t)m * DM, xb + (size_t)m * DM, lane); if (lane < 8) ss0[(size_t)m * 8 + lane] = lane == 0 ? s : 0.f; }
        }
    }
    GRID_BAR_T(true); PH_END(0); PH_BEGIN();

    constexpr int BG_P1 = 5, BG_P5 = 2, BG_DU = 11, BG_DD = 2, BG_L1 = BG_P1 + BG_P5 + BG_DU + BG_DD, BG_ALL = BG_L1 + BG_P1 + BG_P5;
    for (int l = 0; l < DEPTH; ++l) {
#define PHASE_IDS() const int tid = ltid(), lane = tid & 63, wave = __builtin_amdgcn_readfirstlane(tid >> 6), gw = bx * 8 + wave; (void)tid; (void)lane; (void)wave; (void)gw
        if (l == 0) {
            const int NCV = (G * CONV_NUM / 32) & ~7;
            if (bx < NCV) {
                PHASE_IDS();
                LAS unsigned char* tscr = lds + 1024 + wave * 4608; const int NGC = NCV * 8;
                { DecP0b16 d16; d16.LW = LW; conv_loop<false>(DecP0::I_IN + gw, DecP0::N16, NGC, d16, tscr, lane); }
                if (DecP0::N8 > 0) { DecP0f8 d8; d8.LW = LW; conv_loop<true>(gw, DecP0::N8, NGC, d8, tscr, lane); }
                { const DecMoe dm{LW, bx * 8 * MOE_J, wave, NGC * MOE_J}; int cnt = 0; while (dm.item(cnt) < MOE_ITEMS) ++cnt; conv_loop<true>(0, cnt, 1, dm, tscr, lane); }
            } else {
                pg8::Gemm g{WSP(bf16_t, WS_XR), WSP(bf16_t, WS_WIN), DM * 2, 0};
                pg8::StaticOrder S; S.init(NTOK / 256, INW / 256, G - NCV, bx - NCV);
                pg8::EpiZ E{WSP(bf16_t, WS_Z), INW, WSP(float, WS_SS), INF(4), INF(5), WSP(float, WS_COS), WSP(float, WS_SIN), (LAS float*)(lds + 1024)};
                pg8::gemm_phase<pg8::EpiZ, pg8::StaticOrder>(lds + RING_OFF, g, S, E);
            }
        } else
        for (int rep_ = 0; rep_ < REP_P1; ++rep_) {
            const int pos_ = BG_SPLIT ? (bx >> 3) % (BG_P1 + 1) : 0;
            for (int part_ = 0; part_ < 2; ++part_) {
            pg8::Gemm g{WSP(bf16_t, WS_XR), WSP(bf16_t, WS_WIN) + (size_t)l * INW * DM, DM * 2, 0};
            pg8::StaticOrder S; S.init(NTOK / 256, INW / 256, G, bx, part_ ? pos_ : 0, part_ ? (1 << 30) : pos_);
            pg8::EpiZ E{WSP(bf16_t, WS_Z), INW, WSP(float, WS_SS) + (size_t)(l == 0 ? 0 : 2) * NTOK * 8, INF(4) + l * 128, INF(5) + l * 128, WSP(float, WS_COS), WSP(float, WS_SIN), (LAS float*)(lds + 1024)};
            pg8::gemm_phase<pg8::EpiZ, pg8::StaticOrder>(lds + RING_OFF, g, S, E);
            if (BG_SPLIT && part_ == 0) { moe_conv_slots(LW, lds, l == 0 ? 0 : BG_L1, BG_P1, bx, G); __syncthreads(); }
            }
        }
        GRID_BAR(); PH_END(1); PH_BEGIN();
        for (int rep_ = 0; rep_ < REP_P3; ++rep_) {
            constexpr int NITEM = 512;
            char* alds = (char*)lds_raw + RING_OFF;
            int L = bx;
            if (L < NITEM) {
                const bf16_t* zb = WSP(bf16_t, WS_Z); bf16_t* ao = WSP(bf16_t, WS_AO);
#define ATT_REF(ref, LL, pass) do { const int xcd_ = (LL) & 7, k_ = (LL) >> 3, bh_ = (k_ >> 4) * 8 + xcd_, b_ = bh_ >> 2, h_ = bh_ & 3, vh_ = (k_ & 15) >> 2, mp_ = vh_ >> 1, vj_ = vh_ & 1, x_ = k_ & 3; \
                    const int qb_ = (pass) ? 7 - x_ : x_; const bf16_t* zb_ = zb + (size_t)b_ * SEQ * INW; \
                    (ref).Q = zb_ + (size_t)qb_ * 256 * INW + ZQ + h_ * 256 + mp_ * 128; (ref).K = zb_ + ZK + h_ * 256 + mp_ * 128; (ref).V = zb_ + ZV + h_ * 256 + vj_ * 128; \
                    (ref).O = ao + ((size_t)b_ * SEQ + (size_t)qb_ * 256) * DM + h_ * 512 + mp_ * 256 + vj_ * 128; (ref).P0 = qb_ * 256; } while (0)
#define ATT_ITEMS(ORD) do { att::BlockRef cur, nxt; int pass = 0; \
                ATT_REF(cur, L, 0); \
                att::Seam S; \
                att::causal_prime(cur, alds, S); \
                for (;;) { \
                    const bool more_pass = pass == 0, more_item = L + G < NITEM, last = !more_pass && !more_item; \
                    int passn = pass + 1, Ln = L; \
                    if (!more_pass) { passn = 0; Ln = more_item ? L + G : L; } \
                    if (last) nxt = cur; else ATT_REF(nxt, Ln, passn); \
                    att::causal_block<ORD>(cur, nxt, SEQ, alds, S); \
                    if (last) break; \
                    cur = nxt; pass = passn; L = Ln; \
                } } while (0)
                if (__builtin_amdgcn_readfirstlane(ltid() >> 8)) { __builtin_amdgcn_s_setprio(1); ATT_ITEMS(0); }
                else { ATT_ITEMS(1); }
#undef ATT_ITEMS
                __builtin_amdgcn_s_setprio(0);
#undef ATT_REF
            }
        }
        GRID_BAR(); PH_END(3); PH_BEGIN();
        if (PH_MASK & (1 << 2)) {
            PHASE_IDS();
            bf16_t* zb = WSP(bf16_t, WS_Z); bf16_t* mix = WSP(bf16_t, WS_MIX);
            {
            const float* qg = INF(4) + l * 128; const float* kg = INF(5) + l * 128;
            const float* cw = INF(10) + (size_t)l * 3 * 512;
            const float* cosT = WSP(float, WS_COS); const float* sinT = WSP(float, WS_SIN);
            {
                const int ch = 8 * lane;
                f32x4 wk[3][2];
#pragma unroll
                for (int j = 0; j < 3; ++j) { wk[j][0] = *(const f32x4*)(cw + j * 512 + ch); wk[j][1] = *(const f32x4*)(cw + j * 512 + ch + 4); }
                for (int grp = gw; grp < NTOK / 8; grp += NGW) {
                    const int t0 = 8 * grp, tb0 = t0 & (SEQ - 1);
                    u32x4 gbv[8], gcv[10], hv[10];
#pragma unroll
                    for (int i = 0; i < 10; ++i) { const int tt = t0 - 2 + i, tc = tt < 0 ? 0 : tt; const bf16_t* zr = zb + (size_t)tc * INW; gcv[i] = *(const u32x4*)(zr + ZGC + ch); hv[i] = *(const u32x4*)(zr + ZH + ch);
                        if (i >= 2) gbv[i - 2] = *(const u32x4*)(zr + ZGB + ch); }
                    float u[10][8];
#pragma unroll
                    for (int i = 0; i < 10; ++i) { const bool ok = (i >= 2) || (tb0 - 2 + i >= 0);
#pragma unroll
                        for (int j = 0; j < 4; ++j) { u[i][2 * j] = ok ? bflo(gcv[i][j]) * bflo(hv[i][j]) : 0.f; u[i][2 * j + 1] = ok ? bfhi(gcv[i][j]) * bfhi(hv[i][j]) : 0.f; } }
#pragma unroll
                    for (int i = 0; i < 8; ++i) { u32x4 w;
#pragma unroll
                        for (int j = 0; j < 4; ++j) { const int c0 = 2 * j, c1 = 2 * j + 1;
                            const float y0 = wk[0][c0 >> 2][c0 & 3] * u[i][c0] + wk[1][c0 >> 2][c0 & 3] * u[i + 1][c0] + wk[2][c0 >> 2][c0 & 3] * u[i + 2][c0];
                            const float y1 = wk[0][c1 >> 2][c1 & 3] * u[i][c1] + wk[1][c1 >> 2][c1 & 3] * u[i + 1][c1] + wk[2][c1 >> 2][c1 & 3] * u[i + 2][c1];
                            w[j] = cvt_pk_bf16(bflo(gbv[i][j]) * y0, bfhi(gbv[i][j]) * y1); }
                        *(u32x4*)(mix + (size_t)(t0 + i) * DM + 1536 + ch) = w; }
                }
            }
            }
            {
            const bf16_t* wpt = WSP(bf16_t, WS_WPT); const float* pool_scale = INF(9) + l * 512;
            const unsigned ptile = (unsigned)(uintptr_t)lds + (unsigned)(RING_OFF + wave * 12800);
            for (int it = gw; it < (NTOK / 32) * 4; it += NGW) {
                const int T = it >> 2, gi = it & 3, wn = 2 << gi, t0 = T * 32, tb0 = t0 & (SEQ - 1);
                const int r32 = lane & 31, hi = lane >> 5, tb = tb0 + r32;
                const float inv = 1.0f / (float)((tb + 1) < wn ? (tb + 1) : wn);
                const bf16_t* wp = wpt + ((size_t)(l * 4 + gi) * 128) * 128;
                {
                    u32x4 tv[12];
#pragma unroll
                    for (int n = 0; n < 12; ++n) { const int q = lane + 64 * n, row = q >> 4, c16 = q & 15; int tt = t0 - 15 + row; tt = tt < 0 ? 0 : (tt < NTOK ? tt : NTOK - 1);
                        tv[n] = *(const u32x4*)(zb + (size_t)tt * INW + ZP + gi * 128 + c16 * 8); }
#pragma unroll
                    for (int n = 0; n < 12; ++n) { const int q = lane + 64 * n, row = q >> 4, c16 = q & 15; const bool ok = (tb0 - 15 + row) >= 0;
                        if (row < 47) *(LAS u32x4*)(uintptr_t)(ptile + row * 272 + c16 * 16) = ok ? tv[n] : (u32x4){0u, 0u, 0u, 0u}; }
                    LDS_WAIT(); asm volatile("" ::: "memory");
                }
                f32x16 acc[4];
#pragma unroll
                for (int nb = 0; nb < 4; ++nb) acc[nb] = f32x16{};
                bf16x8 bcur[4];
#pragma unroll
                for (int nb = 0; nb < 4; ++nb) bcur[nb] = *(const bf16x8*)(wp + (size_t)(nb * 32 + r32) * 128 + 8 * hi);
                const unsigned rbase = ptile + (unsigned)((r32 + 15) * 272 + 16 * hi);
#pragma unroll 1
                for (int s = 0; s < 8; ++s) {
                    const int sn = s < 7 ? s + 1 : 7;
                    bf16x8 bnxt[4];
#pragma unroll
                    for (int nb = 0; nb < 4; ++nb) bnxt[nb] = *(const bf16x8*)(wp + (size_t)(nb * 32 + r32) * 128 + 16 * sn + 8 * hi);
                    float sum[8], self[8];
#pragma unroll
                    for (int j = 0; j < 8; ++j) { sum[j] = 0.f; self[j] = 0.f; }
                    u32x4 rv[16];
#pragma unroll
                    for (int d = 0; d < 16; ++d) { rv[d] = (u32x4){0u, 0u, 0u, 0u}; if (d < wn) rv[d] = *(const LAS u32x4*)(uintptr_t)(rbase + (unsigned)(32 * s) - (unsigned)(272 * d)); }
#pragma unroll
                    for (int d = 0; d < 16; ++d) {
#pragma unroll
                        for (int j = 0; j < 4; ++j) { const float a = bflo(rv[d][j]), b = bfhi(rv[d][j]); sum[2 * j] += a; sum[2 * j + 1] += b; if (d == 0) { self[2 * j] = a; self[2 * j + 1] = b; } }
                    }
                    u32x4 aw;
#pragma unroll
                    for (int j = 0; j < 4; ++j) aw[j] = cvt_pk_bf16(sum[2 * j] * inv - self[2 * j], sum[2 * j + 1] * inv - self[2 * j + 1]);
                    const bf16x8 af = __builtin_bit_cast(bf16x8, aw);
#pragma unroll
                    for (int nb = 0; nb < 4; ++nb) { acc[nb] = __builtin_amdgcn_mfma_f32_32x32x16_bf16(af, bcur[nb], acc[nb], 0, 0, 0); bcur[nb] = bnxt[nb]; }
                }
#pragma unroll
                for (int nb = 0; nb < 4; ++nb) { const int col = gi * 128 + nb * 32 + r32; const float ps = pool_scale[col];
#pragma unroll
                    for (int r = 0; r < 16; ++r) { const int row = (r & 3) + 8 * (r >> 2) + 4 * hi; const float v = acc[nb][r] * ps, vn = lx1(v);
                        if ((r32 & 1) == 0) *(unsigned*)(mix + (size_t)(t0 + row) * DM + 1024 + col) = cvt_pk_bf16(v, vn); } }
                LDS_WAIT(); asm volatile("" ::: "memory");
            }
            }
        }
        if (PH_MASK & (1 << 4)) {
            PHASE_IDS();
            const float lam_init = (l == 0) ? 0.2f : 0.35550906759096926f;
            const float* lv = INF(6) + (size_t)l * 512;
            const float d01 = wave_sum(lv[lane] * lv[128 + lane] + lv[64 + lane] * lv[192 + lane]);
            const float d23 = wave_sum(lv[256 + lane] * lv[384 + lane] + lv[320 + lane] * lv[448 + lane]);
            const float lam = expf(d01) - expf(d23) + lam_init;
            const float oscale = 1.0f - lam_init;
            const int h = lane >> 4, e0 = (lane & 15) * 16;
            const float* sg = INF(7) + l * 256 + e0;
            const bf16_t* ao = WSP(bf16_t, WS_AO); bf16_t* mix = WSP(bf16_t, WS_MIX);
            float sgv[16];
#pragma unroll
            for (int j = 0; j < 16; ++j) sgv[j] = sg[j];
            for (int tb_ = gw; tb_ < NTOK; tb_ += 4 * NGW) {
                u32x4 av[4][2], bv[4][2];
#pragma unroll
                for (int q2 = 0; q2 < 4; ++q2) { int t = tb_ + q2 * NGW; t = t < NTOK ? t : NTOK - 1;
                    const bf16_t* o0 = ao + (size_t)t * DM + h * 512 + e0; const bf16_t* o1 = o0 + 256;
#pragma unroll
                    for (int j = 0; j < 2; ++j) { av[q2][j] = *(const u32x4*)(o0 + 8 * j); bv[q2][j] = *(const u32x4*)(o1 + 8 * j); } }
#pragma unroll
                for (int q2 = 0; q2 < 4; ++q2) { const int t = tb_ + q2 * NGW; if (t < NTOK) {
                float dv[16]; float ss = 0.f;
#pragma unroll
                for (int j = 0; j < 2; ++j) { const u32x4 a = av[q2][j], b = bv[q2][j];
#pragma unroll
                    for (int q = 0; q < 4; ++q) { const float d0_ = bflo(a[q]) - lam * bflo(b[q]), d1_ = bfhi(a[q]) - lam * bfhi(b[q]); dv[8 * j + 2 * q] = d0_; dv[8 * j + 2 * q + 1] = d1_; ss += d0_ * d0_ + d1_ * d1_; } }
                ss = row16_sum(ss);
                const float rstd = oscale / sqrtf(ss * (1.0f / 256.0f) + EPS);
                u32x4 w0, w1;
#pragma unroll
                for (int j = 0; j < 4; ++j) { w0[j] = cvt_pk_bf16(dv[2 * j] * rstd * sgv[2 * j], dv[2 * j + 1] * rstd * sgv[2 * j + 1]);
                                              w1[j] = cvt_pk_bf16(dv[8 + 2 * j] * rstd * sgv[8 + 2 * j], dv[8 + 2 * j + 1] * rstd * sgv[8 + 2 * j + 1]); }
                bf16_t* mp = mix + (size_t)t * DM + h * 256 + e0;
                *(u32x4*)mp = w0; *(u32x4*)(mp + 8) = w1; } }
            }
        }
        GRID_BAR(); PH_END(4); PH_BEGIN();
        if (PH_MASK & (1 << 5)) {
            const int pos_ = BG_SPLIT ? (bx >> 3) % (BG_P5 + 1) : 0;
            for (int part_ = 0; part_ < 2; ++part_) {
            pg8::Gemm g{WSP(bf16_t, WS_MIX), WSP(bf16_t, WS_WOUT) + (size_t)l * DM * DM, DM * 2, 0};
            pg8::StaticOrder S; S.init(NTOK / 256, DM / 256, G, bx, part_ ? pos_ : 0, part_ ? (1 << 30) : pos_);
            pg8::EpiResF32 E{INF(0), WSP(bf16_t, WS_XR), DM, WSP(unsigned char, WS_XN), WSP(float, WS_SS) + (size_t)(l == 0 ? 1 : 3) * NTOK * 8, 0  , l == 0 ? (int)DUP8 : 1, (LAS float*)(lds + 1024)};
            pg8::gemm_phase<pg8::EpiResF32, pg8::StaticOrder>(lds + RING_OFF, g, S, E);
            if (BG_SPLIT && part_ == 0) { moe_conv_slots(LW, lds, (l == 0 ? 0 : BG_L1) + BG_P1, BG_P5, bx, G); __syncthreads(); }
            }
        }
        GRID_BAR(); PH_END(5); PH_BEGIN();
        if (l == 0 && (PH_MASK & (1 << 6))) {
            {
                const int pos_ = BG_SPLIT ? (bx >> 3) % (BG_DU + 1) : 0;
                for (int part_ = 0; part_ < 2; ++part_) {
                pg8::Gemm g{DUP8 ? WSP(unsigned char, WS_XN) : WSP(unsigned char, WS_XR), WSP(unsigned char, WS_WDGU), DUP8 ? DM : 2 * DM, 0};
                pg8::StaticOrder S; S.init(NTOK / 256, 2 * FFD / 256, G, bx, part_ ? pos_ : 0, part_ ? (1 << 30) : pos_);
                const float* ss1 = WSP(float, WS_SS) + (size_t)NTOK * 8;
                if constexpr (DDN8) { pg8::EpiSwigluF8<1> E{WSP(unsigned char, WS_ACTD), FFD, ss1};
                    pg8::gemm_phase<pg8::EpiSwigluF8<1>, pg8::StaticOrder, (bool)DUP8, DUP8 ? SC_W : SC_ONE, SC_ONE>(lds + RING_OFF, g, S, E); }
                else { pg8::EpiSwiglu<1> E{WSP(bf16_t, WS_ACTD), FFD, ss1};
                    pg8::gemm_phase<pg8::EpiSwiglu<1>, pg8::StaticOrder, (bool)DUP8, DUP8 ? SC_W : SC_ONE, SC_ONE>(lds + RING_OFF, g, S, E); }
                if (BG_SPLIT && part_ == 0) { moe_conv_slots(LW, lds, BG_P1 + BG_P5, BG_DU, bx, G); __syncthreads(); }
                }
            }
            GRID_BAR(); PH_END(6); PH_BEGIN();
            {
                const int pos_ = BG_SPLIT ? (bx >> 3) % (BG_DD + 1) : 0;
                for (int part_ = 0; part_ < 2; ++part_) {
                pg8::Gemm g{WSP(unsigned char, WS_ACTD), WSP(unsigned char, WS_WDD), DDN8 ? FFD : 2 * FFD, 0};
                pg8::StaticOrder S; S.init(NTOK / 256, DM / 256, G, bx, part_ ? pos_ : 0, part_ ? (1 << 30) : pos_);
                pg8::EpiResF32 E{nullptr, WSP(bf16_t, WS_XR), DM, nullptr, WSP(float, WS_SS) + (size_t)2 * NTOK * 8, 0, 0, (LAS float*)(lds + 1024)};
                pg8::gemm_phase<pg8::EpiResF32, pg8::StaticOrder, (bool)DDN8, DDN8 ? SC_W : SC_ONE, DDN8 ? SC_A : SC_ONE>(lds + RING_OFF, g, S, E);
                if (BG_SPLIT && part_ == 0) { moe_conv_slots(LW, lds, BG_P1 + BG_P5 + BG_DU, BG_DD, bx, G); __syncthreads(); }
                }
            }
            GRID_BAR(); PH_END(7); PH_BEGIN();
        } else if (PH_MASK & (1 << 7)) {
            const int TPW = (NTOK + G - 1) / G;
            {
                PHASE_IDS();
                if (BG_SPLIT) { int nrem = 0; while ((BG_ALL + nrem) * (G * 8) * 2 < 24 * 3584) ++nrem; if (nrem) { moe_conv_slots(LW, lds, BG_ALL, nrem, bx, G); __syncthreads(); } }
                if (tid < 8) LW[LW_CNT + tid] = 0u;
                LAS float* RT = (LAS float*)(lds + RING_OFF);
                { const float* router_w = INF(16); const float* gn = INF(12) + DM;
                  for (int k = tid; k < DM; k += 512) { const f32x4 ra = *(const f32x4*)(router_w + (size_t)k * 8), rb = *(const f32x4*)(router_w + (size_t)k * 8 + 4); const float gk = gn[k];
                      RT[0 * DM + k] = ra[0] * gk; RT[1 * DM + k] = ra[1] * gk; RT[2 * DM + k] = ra[2] * gk; RT[3 * DM + k] = ra[3] * gk;
                      RT[4 * DM + k] = rb[0] * gk; RT[5 * DM + k] = rb[1] * gk; RT[6 * DM + k] = rb[2] * gk; RT[7 * DM + k] = rb[3] * gk; } }
                __syncthreads();
                const bf16_t* xrs = WSP(bf16_t, WS_XR); const float* ss3 = WSP(float, WS_SS) + (size_t)3 * NTOK * 8;
                int* tokE = WSP(int, WS_TOKE); int* tokR = WSP(int, WS_TOKR); float* tokG = WSP(float, WS_TOKG);
                const int tlo = bx * TPW, thi = (tlo + TPW) < NTOK ? (tlo + TPW) : NTOK;
                for (int tq = tlo + wave; tq < thi; tq += 32) {
                    float rstd[4]; f32x4 xv[4][8];
#pragma unroll
                    for (int q = 0; q < 4; ++q) { int t = tq + 8 * q; t = t < thi ? t : thi - 1;
                        rstd[q] = ss_rstd(ss3 + (size_t)t * 8);
                        const u32x2* xr = (const u32x2*)(xrs + (size_t)t * DM) + lane;
#pragma unroll
                        for (int j = 0; j < 8; ++j) { const u32x2 w = xr[64 * j]; xv[q][j] = (f32x4){bflo(w.x), bfhi(w.x), bflo(w.y), bfhi(w.y)}; } }
                    float lg[4][8];
#pragma unroll
                    for (int e = 0; e < 8; ++e) { float a[4] = {0.f, 0.f, 0.f, 0.f};
#pragma unroll
                        for (int j = 0; j < 8; ++j) { const f32x4 rv = *(const LAS f32x4*)(RT + e * DM + 256 * j + 4 * lane);
#pragma unroll
                            for (int q = 0; q < 4; ++q) a[q] += (xv[q][j][0] * rv[0] + xv[q][j][1] * rv[1]) + (xv[q][j][2] * rv[2] + xv[q][j][3] * rv[3]); }
#pragma unroll
                        for (int q = 0; q < 4; ++q) lg[q][e] = wave_sum(a[q]) * rstd[q]; }
#pragma unroll
                    for (int q = 0; q < 4; ++q) { const int t = tq + 8 * q;
                        if (lane == 0 && t < thi) {
                            int e0 = 0; float v0 = lg[q][0];
#pragma unroll
                            for (int e = 1; e < 8; ++e) if (lg[q][e] > v0) { v0 = lg[q][e]; e0 = e; }
                            int e1 = -1; float v1 = -3.0e38f;
#pragma unroll
                            for (int e = 0; e < 8; ++e) if (e != e0 && lg[q][e] > v1) { v1 = lg[q][e]; e1 = e; }
                            const float ex = expf(v1 - v0), g0 = 1.0f / (1.0f + ex), g1 = ex / (1.0f + ex);
                            const int r0 = (int)atomicAdd((unsigned*)(lds_raw + LDSCTL_OFF) + LW_CNT + e0, 1u);
                            const int r1 = (int)atomicAdd((unsigned*)(lds_raw + LDSCTL_OFF) + LW_CNT + e1, 1u);
                            tokE[2 * t] = e0; tokE[2 * t + 1] = e1; tokR[2 * t] = r0; tokR[2 * t + 1] = r1; tokG[2 * t] = g0; tokG[2 * t + 1] = g1;
                        } }
                }
                __syncthreads();
                if (tid < 8) WSP(int, WS_CNTWG)[bx * 8 + tid] = (int)LW[LW_CNT + tid];
            }
            GRID_BAR(); PH_END(8); PH_BEGIN();
            {
                PHASE_IDS();
                if (tid < 8) { LW[LW_TOT + tid] = 0u; LW[LW_PRE + tid] = 0u; }
                __syncthreads();
                {
                const int* cntWG = WSP(int, WS_CNTWG);
                for (int j0 = wave * 64; j0 < G; j0 += 512) { const int j = j0 + lane; const bool ok = j < G; const int jc = ok ? j : 0;
                    const i32x4 ca = *(const i32x4*)(cntWG + jc * 8), cb = *(const i32x4*)(cntWG + jc * 8 + 4);
                    unsigned* lw = (unsigned*)(lds_raw + LDSCTL_OFF);
#pragma unroll
                    for (int e = 0; e < 8; ++e) { const float c = ok ? (float)(e < 4 ? ca[e & 3] : cb[e & 3]) : 0.f;
                        const float tot = wave_sum(c), pre = wave_sum(j < bx ? c : 0.f);
                        if (lane == 0) { atomicAdd(lw + LW_TOT + e, (unsigned)tot); atomicAdd(lw + LW_PRE + e, (unsigned)pre); } }
                }
                }
                __syncthreads();
                if (tid == 0) { unsigned base = 0;
                    for (int e = 0; e < 8; ++e) { const unsigned tot = LW[LW_TOT + e]; LW[LW_BP + e] = base + LW[LW_PRE + e]; LW[LW_TOFF + e] = base >> 8; base += (tot + 255u) & ~255u; }
                    LW[LW_TOFF + 8] = base >> 8; }
                __syncthreads();
                const int* tokE = WSP(int, WS_TOKE); const int* tokR = WSP(int, WS_TOKR); int* tokS = WSP(int, WS_TOKS);
                const float* ss3 = WSP(float, WS_SS) + (size_t)3 * NTOK * 8; float* rslot = WSP(float, WS_RSLOT);
                const unsigned char* xn8 = WSP(unsigned char, WS_XN); unsigned char* hp = WSP(unsigned char, WS_HP);
                const int tlo = bx * TPW, thi = (tlo + TPW) < NTOK ? (tlo + TPW) : NTOK;
                for (int tb_ = tlo + wave; tb_ < thi; tb_ += 16) {
                    int sa[2], sb[2]; u32x4 v[2][2];
#pragma unroll
                    for (int q2 = 0; q2 < 2; ++q2) { int t = tb_ + 8 * q2; t = t < thi ? t : thi - 1;
                        const int e0 = tokE[2 * t], e1 = tokE[2 * t + 1];
                        sa[q2] = (int)LW[LW_BP + e0] + tokR[2 * t]; sb[q2] = (int)LW[LW_BP + e1] + tokR[2 * t + 1];
                        const u32x4* src_ = (const u32x4*)(xn8 + (size_t)t * DM) + lane; v[q2][0] = src_[0]; v[q2][1] = src_[64]; }
#pragma unroll
                    for (int q2 = 0; q2 < 2; ++q2) { const int t = tb_ + 8 * q2; if (t < thi) {
                        const int s0 = sa[q2], s1 = sb[q2];
                        if (lane == 0) { tokS[2 * t] = s0; tokS[2 * t + 1] = s1; const float rstd = ss_rstd(ss3 + (size_t)t * 8); rslot[s0] = rstd; rslot[s1] = rstd; }
                        u32x4* d0 = (u32x4*)(hp + (size_t)s0 * DM) + lane; u32x4* d1 = (u32x4*)(hp + (size_t)s1 * DM) + lane;
                        d0[0] = v[q2][0]; d0[64] = v[q2][1]; d1[0] = v[q2][0]; d1[64] = v[q2][1]; } }
                }
                for (int e = 0; e < 8; ++e) {
                    const int rlo = (int)LW[LW_TOFF + e] * 256 + (int)LW[LW_TOT + e], rhi = (int)LW[LW_TOFF + e + 1] * 256;
                    for (int r = rlo + gw; r < rhi; r += NGW) { if (lane == 0) rslot[r] = 0.f; u32x4* d0 = (u32x4*)(hp + (size_t)r * DM) + lane;
#pragma unroll
                        for (int j = 0; j < 2; ++j) d0[64 * j] = (u32x4){0u, 0u, 0u, 0u}; }
                }
            }
            GRID_BAR(); PH_END(9); PH_BEGIN();
#define RFL(i) __builtin_amdgcn_readfirstlane((int)LW[LW_TOFF + (i)])
#define MOE_TAIL_SP(R, G) ((R) == 0 ? 1 : ((R) * 4 <= (G) ? 4 : ((R) * 2 <= (G) ? 2 : 1)))
            for (int rep_ = 0; rep_ < REP_P7; ++rep_) {
                pg8::Gemm g{WSP(unsigned char, WS_HP), WSP(unsigned char, WS_WMGU), DM, (size_t)2 * FFE * DM};
                pg8::MoeOrder S; S.S.init(RFL(8), 2 * FFE / 256, G, bx);
                S.t1 = RFL(1); S.t2 = RFL(2); S.t3 = RFL(3); S.t4 = RFL(4); S.t5 = RFL(5); S.t6 = RFL(6); S.t7 = RFL(7); S.SP = 1; S.nfull = 0; S.R = 0; S.ntp = 0; S.kbs = 0;
                pg8::EpiSwigluF8<2> E{WSP(unsigned char, WS_ACTM), FFE, WSP(float, WS_RSLOT)};
                pg8::gemm_phase<pg8::EpiSwigluF8<2>, pg8::MoeOrder, true, SC_W, SC_ONE>(lds + RING_OFF, g, S, E);
            }
            GRID_BAR(); PH_END(10); PH_BEGIN();
            {
                pg8::Gemm g{WSP(unsigned char, WS_ACTM), WSP(unsigned char, WS_WMD), FFE, (size_t)DM * FFE};
                pg8::MoeOrder S; S.S.init(RFL(8), DM / 256, G, bx);
                S.t1 = RFL(1); S.t2 = RFL(2); S.t3 = RFL(3); S.t4 = RFL(4); S.t5 = RFL(5); S.t6 = RFL(6); S.t7 = RFL(7);
                { const int nwg_ = RFL(8) * (DM / 256), R_ = nwg_ % G; S.nfull = nwg_ / G; S.R = R_; S.SP = MOE_TAIL_SP(R_, G); S.ntp = (FFE / 128) / S.SP; S.kbs = FFE / S.SP; }
                S.rev = 1;
                pg8::EpiMoeDown E{WSP(bf16_t, WS_Y), DM, WSP(float, WS_PB), WSP(int, WS_TMAP), S.SP};
                pg8::gemm_phase<pg8::EpiMoeDown, pg8::MoeOrder, true, SC_W, SC_A>(lds + RING_OFF, g, S, E);
            }
            GRID_BAR(); PH_END(11); PH_BEGIN();
            {
                PHASE_IDS();
                const int* tokS = WSP(int, WS_TOKS); const float* tokG = WSP(float, WS_TOKG); float* out = OUTP; const bf16_t* yb = WSP(bf16_t, WS_Y); const bf16_t* xrs = WSP(bf16_t, WS_XR);
                const int* tmap = WSP(int, WS_TMAP); const float* PB = WSP(float, WS_PB);
                const int SP = MOE_TAIL_SP((RFL(8) * (DM / 256)) % G, G);
                for (int tb_ = gw; tb_ < NTOK; tb_ += 2 * NGW) {
                    int s0[2], s1[2]; float g0[2], g1[2];
#pragma unroll
                    for (int q2 = 0; q2 < 2; ++q2) { int t = tb_ + q2 * NGW; t = t < NTOK ? t : NTOK - 1; s0[q2] = tokS[2 * t]; s1[q2] = tokS[2 * t + 1]; g0[q2] = tokG[2 * t]; g1[q2] = tokG[2 * t + 1]; }
                    u32x4 ya[2][4], yc[2][4], xw[2][4]; int ea[2][4], ec[2][4];
#pragma unroll
                    for (int q2 = 0; q2 < 2; ++q2) { int t = tb_ + q2 * NGW; t = t < NTOK ? t : NTOK - 1;
                        const u32x4* o = (const u32x4*)(xrs + (size_t)t * DM) + lane; const u32x4* y0 = (const u32x4*)(yb + (size_t)s0[q2] * DM) + lane; const u32x4* y1 = (const u32x4*)(yb + (size_t)s1[q2] * DM) + lane;
#pragma unroll
                        for (int j = 0; j < 4; ++j) { ya[q2][j] = y0[64 * j]; yc[q2][j] = y1[64 * j]; xw[q2][j] = o[64 * j];
                            ea[q2][j] = tmap[(s0[q2] >> 8) * 8 + ((64 * j + lane) >> 5)]; ec[q2][j] = tmap[(s1[q2] >> 8) * 8 + ((64 * j + lane) >> 5)]; } }
#pragma unroll
                    for (int q2 = 0; q2 < 2; ++q2) { const int t = tb_ + q2 * NGW; if (t < NTOK) {
                        f32x4* o = (f32x4*)(out + (size_t)t * DM) + 2 * lane; const float ga = g0[q2], gb = g1[q2];
#pragma unroll
                        for (int j = 0; j < 4; ++j) { const u32x4 a = ya[q2][j], b = yc[q2][j], xx = xw[q2][j]; f32x4 o0 = {bflo(xx[0]), bfhi(xx[0]), bflo(xx[1]), bfhi(xx[1])}, o1 = {bflo(xx[2]), bfhi(xx[2]), bflo(xx[3]), bfhi(xx[3])};
                            f32x4 a0 = {bflo(a[0]), bfhi(a[0]), bflo(a[1]), bfhi(a[1])}, a1 = {bflo(a[2]), bfhi(a[2]), bflo(a[3]), bfhi(a[3])};
                            f32x4 b0 = {bflo(b[0]), bfhi(b[0]), bflo(b[1]), bfhi(b[1])}, b1 = {bflo(b[2]), bfhi(b[2]), bflo(b[3]), bfhi(b[3])};
                            const int cc = (8 * (64 * j + lane)) & 255;
                            if (ea[q2][j]) { a0 = (f32x4){0.f, 0.f, 0.f, 0.f}; a1 = a0;
                                for (int p = 0; p < SP; ++p) { const float* sp = PB + ((size_t)((ea[q2][j] - 1) * SP + p) * 256 + (s0[q2] & 255)) * 256 + cc; a0 += *(const f32x4*)sp; a1 += *(const f32x4*)(sp + 4); } }
                            if (ec[q2][j]) { b0 = (f32x4){0.f, 0.f, 0.f, 0.f}; b1 = b0;
                                for (int p = 0; p < SP; ++p) { const float* sp = PB + ((size_t)((ec[q2][j] - 1) * SP + p) * 256 + (s1[q2] & 255)) * 256 + cc; b0 += *(const f32x4*)sp; b1 += *(const f32x4*)(sp + 4); } }
                            o0 += a0 * ga + b0 * gb; o1 += a1 * ga + b1 * gb;
                            o[128 * j] = o0; o[128 * j + 1] = o1; } } }
                }
            }
#undef RFL
            PH_END(12);
        }
    }
    if (PROBE_MASK) { __syncthreads(); if (threadIdx.x == 0) { const unsigned long long t0_ = __builtin_amdgcn_s_memrealtime(); while (__builtin_amdgcn_s_memrealtime() - t0_ < tacc_) __builtin_amdgcn_s_sleep(8); } __syncthreads(); }
}

extern "C" void kernel_launch(void* const* d_in, const int* in_sizes, int n_in, void* d_out, int out_size, void* d_ws, size_t ws_size, hipStream_t stream) {
    static int grid = 0;
    if (grid == 0) {
        if (n_in != 20 || in_sizes[0] != NTOK * DM || out_size != NTOK * DM || ws_size < WS_END) {
            fprintf(stderr, "kernel_launch: unexpected shapes (n_in %d, in0 %d, out %d, ws %zu < %zu); nothing launched\n", n_in, n_in > 0 ? in_sizes[0] : -1, out_size, ws_size, (size_t)WS_END); grid = -1; return; }
        int dev = 0, cus = 0, per_cu = 0;
        if (hipGetDevice(&dev) != hipSuccess || hipDeviceGetAttribute(&cus, hipDeviceAttributeMultiprocessorCount, dev) != hipSuccess) { grid = -1; return; }
        if (hipFuncSetAttribute((const void*)hybrid_fwd, hipFuncAttributeMaxDynamicSharedMemorySize, LDS_BYTES) != hipSuccess) { fprintf(stderr, "kernel_launch: hipFuncSetAttribute failed\n"); grid = -1; return; }
        if (hipOccupancyMaxActiveBlocksPerMultiprocessor(&per_cu, (const void*)hybrid_fwd, 512, LDS_BYTES) != hipSuccess || per_cu < 1)
            fprintf(stderr, "kernel_launch: note: occupancy query reports %d workgroups per CU\n", per_cu);
        (void)hipGetLastError();
        grid = cus > 512 ? 512 : cus;
    }
    if (grid < 0) return;
    if (hipMemsetAsync((char*)d_ws + WS_CTL, 0, CTL_ZERO_BYTES, stream) != hipSuccess) { fprintf(stderr, "kernel_launch: memset failed\n"); return; }
    Args a{};
    for (int i = 0; i < 20; ++i) a.in[i] = d_in[i];
    a.out = (float*)d_out; a.ws = (unsigned char*)d_ws;
    hipLaunchKernelGGL(hybrid_fwd, dim3(grid), dim3(512), LDS_BYTES, stream, a);
    const hipError_t le = hipPeekAtLastError();
    if (le != hipSuccess) fprintf(stderr, "kernel_launch: launch failed: %s\n", hipGetErrorName(le));
}
```

```cpp
#include <hip/hip_runtime.h>
#include <hip/hip_bf16.h>
#include <cstdio>
#include <cstdint>

#define LAS __attribute__((address_space(3)))
#define GAS __attribute__((address_space(1)))
typedef unsigned short bf16_t;
typedef short bf16x8 __attribute__((ext_vector_type(8)));
typedef short s16x4 __attribute__((ext_vector_type(4)));
typedef float f32x4 __attribute__((ext_vector_type(4)));
typedef float f32x2 __attribute__((ext_vector_type(2)));
typedef float f32x16 __attribute__((ext_vector_type(16)));
typedef unsigned u32x4 __attribute__((ext_vector_type(4)));
typedef unsigned u32x2 __attribute__((ext_vector_type(2)));
typedef int i32x4 __attribute__((ext_vector_type(4)));
typedef int i32x8 __attribute__((ext_vector_type(8)));

constexpr int DM = 2048, NB = 8, SEQ = 2048, NTOK = NB * SEQ, DEPTH = 2;
constexpr int INW = 5120, FFD = 5632, NEXP = 8, FFE = 7168;
constexpr int ZQ = 0, ZK = 1024, ZV = 2048, ZP = 3072, ZGB = 3584, ZGC = 4096, ZH = 4608;
constexpr int MOE_ROWS = NTOK * 2 + NEXP * 256;
constexpr float EPS = 1e-6f;

constexpr size_t MiB = 1u << 20;
constexpr size_t WS_CTL = 0, CTL_ZERO_BYTES = 1 * MiB;
constexpr size_t WS_COS = 1 * MiB, WS_SIN = 5 * MiB;
constexpr size_t WS_WPT = 9 * MiB;
constexpr size_t WS_TOKE = 10 * MiB;
constexpr size_t WS_TOKR = WS_TOKE + 128 * 1024;
constexpr size_t WS_TOKG = WS_TOKR + 128 * 1024;
constexpr size_t WS_TOKS = WS_TOKG + 128 * 1024;
constexpr size_t WS_CNTWG = WS_TOKS + 128 * 1024;
constexpr size_t WS_WIN = 16 * MiB;
constexpr size_t WS_WOUT = WS_WIN + 40 * MiB;
constexpr size_t WS_WDGU = WS_WOUT + 16 * MiB;
constexpr size_t WS_WDD = WS_WDGU + 44 * MiB;
constexpr size_t WS_WMGU = WS_WDD + 22 * MiB;
constexpr size_t WS_WMD = WS_WMGU + 448 * MiB;
constexpr size_t WS_ACT0 = WS_WMD + 224 * MiB;
constexpr size_t WS_Z = WS_ACT0;
constexpr size_t WS_AO = WS_ACT0 + 160 * MiB;
constexpr size_t WS_MIX = WS_ACT0 + 288 * MiB;
constexpr size_t WS_XN = WS_ACT0 + 352 * MiB;
constexpr size_t WS_ACTM = WS_ACT0;
constexpr size_t WS_HP = WS_ACT0 + 476 * MiB;
constexpr size_t WS_Y = WS_ACT0 + 612 * MiB;
constexpr size_t WS_ACTD = WS_ACT0 + 476 * MiB;
constexpr size_t WS_XR = WS_ACT0 + 884 * MiB;
constexpr size_t WS_END = WS_ACT0 + 948 * MiB;
static_assert(WS_ACT0 == 810 * MiB, "map");
static_assert((size_t)MOE_ROWS * FFE * 2 <= 476 * MiB && (size_t)MOE_ROWS * DM * 2 <= 136 * MiB && (size_t)MOE_ROWS * DM * 4 <= 272 * MiB, "map");

#ifndef PH_MASK
#define PH_MASK 0xffff
#endif
#define REP_P0 1
#ifndef BG_SPLIT
#define BG_SPLIT 0
#endif
#ifndef BG_NQ
#define BG_NQ 2
#endif
#ifndef BG_NREP
#define BG_NREP 1
#endif
#ifndef PROBE_MASK
#define PROBE_MASK 0u
#endif
#ifndef DUP8
#define DUP8 1
#endif
#ifndef DDN8
#define DDN8 1
#endif
#define REP_P1 1
#define REP_P3 1
#define REP_P7 1
constexpr int CW_TMO = 0, CW_CODE = 1, CW_BAR = 4096;
constexpr size_t WS_SS = 14 * MiB;
typedef unsigned long long u64_t;
typedef float ssrow_t[8];
__device__ __forceinline__ float ss_rstd(const float* p) { const f32x4 a = *(const f32x4*)p, b = *(const f32x4*)(p + 4); return 1.0f / sqrtf((((a[0] + a[1]) + (a[2] + a[3])) + ((b[0] + b[1]) + (b[2] + b[3]))) * (1.0f / DM) + EPS); }
constexpr size_t WS_TMAP = WS_CTL + 768 * 1024;
constexpr size_t WS_PB = WS_ACT0 + 612 * MiB + 136 * MiB;
constexpr size_t WS_RSLOT = 12 * MiB;

constexpr int LDSCTL_OFF = 0, LDSCTL_BYTES = 1024;
constexpr int RING_OFF = 16384, RING_BYTES = 131072;
constexpr int LDS_BYTES = 147456;
constexpr int LW_CNT = 16, LW_TOT = 24, LW_PRE = 32, LW_BP = 40, LW_TOFF = 48;

#define LDS_WAIT() asm volatile("s_waitcnt lgkmcnt(0)" ::: "memory")
#define VM_WAIT() asm volatile("s_waitcnt vmcnt(0)" ::: "memory")

__device__ __forceinline__ unsigned cvt_pk_bf16(float lo, float hi) { unsigned r; asm volatile("v_cvt_pk_bf16_f32 %0, %1, %2" : "=v"(r) : "v"(lo), "v"(hi)); return r; }
__device__ __forceinline__ unsigned pk4_fp8(float a, float b, float c, float d) {
    a = __builtin_amdgcn_fmed3f(a, -448.f, 448.f); b = __builtin_amdgcn_fmed3f(b, -448.f, 448.f); c = __builtin_amdgcn_fmed3f(c, -448.f, 448.f); d = __builtin_amdgcn_fmed3f(d, -448.f, 448.f);
    int w = __builtin_amdgcn_cvt_pk_fp8_f32(a, b, 0, false); w = __builtin_amdgcn_cvt_pk_fp8_f32(c, d, w, true); return (unsigned)w; }
constexpr float W8_SCALE = 64.f, A8_SCALE = 8.f;
constexpr int SC_ONE = 0x7f7f7f7f, SC_W = 0x79797979  , SC_A = 0x7c7c7c7c  ;
__device__ __forceinline__ float bflo(unsigned w) { return __uint_as_float(w << 16); }
__device__ __forceinline__ float bfhi(unsigned w) { return __uint_as_float(w & 0xffff0000u); }
template <int CTRL> __device__ __forceinline__ float dppf(float v) { return __int_as_float(__builtin_amdgcn_update_dpp(0, __float_as_int(v), CTRL, 0xf, 0xf, true)); }
__device__ __forceinline__ float lx1(float v) { return dppf<0xB1>(v); }
__device__ __forceinline__ float lx2(float v) { return dppf<0x4E>(v); }
__device__ __forceinline__ float lhm(float v) { return dppf<0x141>(v); }
__device__ __forceinline__ float lrm(float v) { return dppf<0x140>(v); }
__device__ __forceinline__ float lx16(float v) { return __int_as_float(__builtin_amdgcn_ds_swizzle(__float_as_int(v), 0x401F)); }
__device__ __forceinline__ float sum_halves(float v) { const auto r = __builtin_amdgcn_permlane32_swap(__float_as_uint(v), __float_as_uint(v), false, false); return __uint_as_float(r[0]) + __uint_as_float(r[1]); }
__device__ __forceinline__ float row16_sum(float v) { v += lx1(v); v += lx2(v); v += lhm(v); v += lrm(v); return v; }
__device__ __forceinline__ float wave_sum(float v) { v = row16_sum(v); v += lx16(v); return sum_halves(v); }

__device__ __forceinline__ int ltid() {
    const unsigned key = (unsigned)__builtin_amdgcn_s_getreg((5 << 11) | 4) & 63u;
    const int wv = __builtin_amdgcn_readfirstlane((int)((volatile LAS unsigned*)(LDSCTL_OFF + 4 * 128))[key]);
    int ln; asm volatile("v_mbcnt_lo_u32_b32 %0, -1, 0\n\tv_mbcnt_hi_u32_b32 %0, -1, %0" : "=&v"(ln));
    return (wv << 6) | ln; }

namespace pg8 {
constexpr int BM = 256, BK = 64, HALF = 128, HTB = HALF * BK * 2, STAGE_BYTES = 8 * HTB, NXCD = 8, WGM = 8;
__host__ __device__ __forceinline__ int lds_byte(int r, int c) { const int st = (r >> 4) * 2 + (c >> 5), rr = r & 15, cc = c & 31, ob = rr * 64 + cc * 2; return st * 1024 + (ob ^ (((ob >> 9) & 1) << 5)); }
__host__ __device__ __forceinline__ void stage_rc(int b, int& R, int& C) { const int st = b / 1024, sb = b % 1024, swz = sb ^ (((sb >> 9) & 1) << 5); R = (st >> 1) * 16 + swz / 64; C = (st & 1) * 32 + (swz % 64) / 2; }
__host__ __device__ __forceinline__ int perm32(int rho) { const int n = rho >> 4, i = rho & 15; return 8 * (i >> 2) + 4 * n + (i & 3); }

struct Unit { int pm, pn, e, kb0, ntu, part; };
struct Gemm { const void* A; const void* Bt; int KB; size_t estride; };

struct StaticOrder {
    int nM, nN, nwg, G, c, i0, cnt;
    __device__ __forceinline__ void init(int nM_, int nN_, int G_, int c_, int i0_ = 0, int cnt_ = 1 << 30) { nM = nM_; nN = nN_; nwg = nM * nN; G = G_; c = c_; i0 = i0_; cnt = cnt_; }
    __device__ __forceinline__ void unit_of(int L, Unit& u) const {
        int wgid = L; { const int q = nwg / NXCD, r = nwg % NXCD, xcd = wgid % NXCD, off = wgid / NXCD; wgid = (xcd < r ? xcd * (q + 1) : r * (q + 1) + (xcd - r) * q) + off; }
        const int nig = WGM * nN, gid = wgid / nig, fm = gid * WGM, gsz = (nM - fm) < WGM ? (nM - fm) : WGM;
        u.pm = fm + ((wgid % nig) % gsz); u.pn = (wgid % nig) / gsz; u.e = 0; u.kb0 = 0; u.ntu = 0; u.part = -1;
    }
    __device__ __forceinline__ bool next(int i, Unit& u) const {
        if (i >= cnt) return false;
        const long L = (long)(i + i0) * G + c; if (L >= nwg) return false;
        unit_of((int)L, u); return true;
    }
};
struct MoeOrder {
    StaticOrder S; int t1, t2, t3, t4, t5, t6, t7; int SP, nfull, R, ntp, kbs; int rev = 0;
    __device__ __forceinline__ bool next(int i, Unit& u) const {
        if (SP > 1) {
            if (i < nfull) S.unit_of(i * S.G + S.c, u);
            else if (i == nfull && S.c < R * SP) { S.unit_of(nfull * S.G + S.c / SP, u); const int p = S.c % SP; u.kb0 = p * kbs; u.ntu = ntp; u.part = S.c; }
            else return false;
        } else if (!S.next(i, u)) return false;
        if (rev) u.pm = S.nM - 1 - u.pm;
        const int p = u.pm; u.e = __builtin_amdgcn_readfirstlane((p >= t1) + (p >= t2) + (p >= t3) + (p >= t4) + (p >= t5) + (p >= t6) + (p >= t7)); return true;
    }
};

template <int RS> __device__ __forceinline__ void row_scales(float (&sc)[2][4], const void* p, int row0) {
#pragma unroll
    for (int ai = 0; ai < 2; ++ai)
#pragma unroll
        for (int m = 0; m < 4; ++m) { if constexpr (RS == 0) sc[ai][m] = 1.0f; else if constexpr (RS == 1) sc[ai][m] = ss_rstd((const float*)p + (size_t)(row0 + ai * HALF + m * 16) * 8); else sc[ai][m] = ((const float*)p)[row0 + ai * HALF + m * 16]; }
}
template <int RS> struct EpiBf16 {
    static constexpr bool PERM = true; static constexpr bool HAS_PRE = false;
    bf16_t* O; int ldc; const void* rsp;
    __device__ __forceinline__ void operator()(const f32x4 (&acc)[2][2][4][2], const Unit& u, int wr, int wc, int fr, int fq) const {
        const int row0 = u.pm * BM + wr * 64 + fr, col0 = u.pn * BM + wc * 32 + 8 * fq;
        float sc[2][4]; row_scales<RS>(sc, rsp, row0);
#pragma unroll
        for (int ai = 0; ai < 2; ++ai)
#pragma unroll
            for (int m = 0; m < 4; ++m) { bf16_t* rowp = O + (size_t)(row0 + ai * HALF + m * 16) * ldc + col0;
#pragma unroll
                for (int bj = 0; bj < 2; ++bj) { const f32x4 v0 = acc[ai][bj][m][0] * sc[ai][m], v1 = acc[ai][bj][m][1] * sc[ai][m];
                    u32x4 w; w.x = cvt_pk_bf16(v0[0], v0[1]); w.y = cvt_pk_bf16(v0[2], v0[3]); w.z = cvt_pk_bf16(v1[0], v1[1]); w.w = cvt_pk_bf16(v1[2], v1[3]);
                    *(u32x4*)(rowp + bj * HALF) = w; } }
    }
};
struct EpiZ {
    static constexpr bool PERM = true; static constexpr bool HAS_PRE = false;
    bf16_t* O; int ldc; const void* rsp; const float* qg; const float* kg; const float* cosT; const float* sinT; LAS float* part;
    __device__ __forceinline__ void operator()(const f32x4 (&acc)[2][2][4][2], const Unit& u, int wr, int wc, int fr, int fq) const {
        const int row0 = u.pm * BM + wr * 64 + fr, col0 = u.pn * BM + wc * 32 + 8 * fq;
        float sc[2][4]; row_scales<1>(sc, rsp, row0);
        if (u.pn >= 8) {
#pragma unroll
            for (int ai = 0; ai < 2; ++ai)
#pragma unroll
                for (int m = 0; m < 4; ++m) { bf16_t* rowp = O + (size_t)(row0 + ai * HALF + m * 16) * ldc + col0;
#pragma unroll
                    for (int bj = 0; bj < 2; ++bj) { const f32x4 v0 = acc[ai][bj][m][0] * sc[ai][m], v1 = acc[ai][bj][m][1] * sc[ai][m];
                        u32x4 w; w.x = cvt_pk_bf16(v0[0], v0[1]); w.y = cvt_pk_bf16(v0[2], v0[3]); w.z = cvt_pk_bf16(v1[0], v1[1]); w.w = cvt_pk_bf16(v1[2], v1[3]);
                        *(u32x4*)(rowp + bj * HALF) = w; } }
            return;
        }
        LAS float* pw = part + ((wr * 4 + wc) * 16) * 16 + fr;
#pragma unroll
        for (int ai = 0; ai < 2; ++ai)
#pragma unroll
            for (int m = 0; m < 4; ++m)
#pragma unroll
                for (int bj = 0; bj < 2; ++bj) { const f32x4 v0 = acc[ai][bj][m][0] * sc[ai][m], v1 = acc[ai][bj][m][1] * sc[ai][m];
                    float p = (v0[0] * v0[0] + v0[1] * v0[1]) + (v0[2] * v0[2] + v0[3] * v0[3]) + (v1[0] * v1[0] + v1[1] * v1[1]) + (v1[2] * v1[2] + v1[3] * v1[3]);
                    p += lx16(p); p = sum_halves(p);
                    if (fq == 0) pw[((ai * 4 + m) * 2 + bj) * 16] = p; }
        asm volatile("s_waitcnt lgkmcnt(0)" ::: "memory"); __builtin_amdgcn_s_barrier(); asm volatile("" ::: "memory");
        const int i0 = 16 * wc + 4 * fq;
        const float* gp = (u.pn < 4 ? qg : kg) + i0;
        const f32x4 ga = *(const f32x4*)gp, gb = *(const f32x4*)(gp + 64);
        const LAS float* pr = part + (wr * 4 * 16) * 16 + fr;
#pragma unroll
        for (int ai = 0; ai < 2; ++ai)
#pragma unroll
            for (int m = 0; m < 4; ++m) { const int r = row0 + ai * HALF + m * 16; bf16_t* rowp = O + (size_t)r * ldc + col0;
                const f32x4 cs = *(const f32x4*)(cosT + (size_t)r * 64 + i0), sn = *(const f32x4*)(sinT + (size_t)r * 64 + i0);
#pragma unroll
                for (int bj = 0; bj < 2; ++bj) { const int pi = ((ai * 4 + m) * 2 + bj) * 16;
                    const float tot = (pr[pi] + pr[pi + 256]) + (pr[pi + 512] + pr[pi + 768]);
                    const float f = sc[ai][m] / sqrtf(tot * (1.0f / 128.0f) + EPS);
                    const f32x4 v0 = acc[ai][bj][m][0] * f, v1 = acc[ai][bj][m][1] * f;
                    const float a0 = v0[0] * ga[0], b0 = v0[1] * gb[0], a1 = v0[2] * ga[1], b1 = v0[3] * gb[1], a2 = v1[0] * ga[2], b2 = v1[1] * gb[2], a3 = v1[2] * ga[3], b3 = v1[3] * gb[3];
                    u32x4 w;
                    w.x = cvt_pk_bf16(a0 * cs[0] - b0 * sn[0], a0 * sn[0] + b0 * cs[0]); w.y = cvt_pk_bf16(a1 * cs[1] - b1 * sn[1], a1 * sn[1] + b1 * cs[1]);
                    w.z = cvt_pk_bf16(a2 * cs[2] - b2 * sn[2], a2 * sn[2] + b2 * cs[2]); w.w = cvt_pk_bf16(a3 * cs[3] - b3 * sn[3], a3 * sn[3] + b3 * cs[3]);
                    *(u32x4*)(rowp + bj * HALF) = w; } }
        asm volatile("s_waitcnt lgkmcnt(0)" ::: "memory"); __builtin_amdgcn_s_barrier(); asm volatile("" ::: "memory");
    }
};
__device__ __forceinline__ float silu_mul(float g, float u) { return g * __builtin_amdgcn_rcpf(1.0f + __builtin_amdgcn_exp2f(-1.4426950408889634f * g)) * u; }
__device__ __forceinline__ f32x2 silu_mul2(f32x2 g, f32x2 u, float sg, float su) {
    const f32x2 t = g * sg, a = t * (-1.4426950408889634f);
    f32x2 e; e.x = __builtin_amdgcn_exp2f(a.x); e.y = __builtin_amdgcn_exp2f(a.y);
    const f32x2 d = e + 1.0f;
    f32x2 r; r.x = __builtin_amdgcn_rcpf(d.x); r.y = __builtin_amdgcn_rcpf(d.y);
    return (t * r) * (u * su);
}
template <int RS> struct EpiSwiglu {
    static constexpr bool PERM = true; static constexpr bool HAS_PRE = false;
    bf16_t* O; int ldc; const void* rsp;
    __device__ __forceinline__ void operator()(const f32x4 (&acc)[2][2][4][2], const Unit& u, int wr, int wc, int fr, int fq) const {
        const int row0 = u.pm * BM + wr * 64 + fr, col0 = u.pn * HALF + wc * 32 + 8 * fq;
        float sc[2][4]; row_scales<RS>(sc, rsp, row0);
#pragma unroll
        for (int ai = 0; ai < 2; ++ai)
#pragma unroll
            for (int m = 0; m < 4; ++m) { bf16_t* rowp = O + (size_t)(row0 + ai * HALF + m * 16) * ldc + col0;
                const f32x4 g0 = acc[ai][0][m][0], g1 = acc[ai][0][m][1], u0 = acc[ai][1][m][0], u1 = acc[ai][1][m][1]; const float s = sc[ai][m];
                const f32x2 o0 = silu_mul2((f32x2){g0[0], g0[1]}, (f32x2){u0[0], u0[1]}, s, s), o1 = silu_mul2((f32x2){g0[2], g0[3]}, (f32x2){u0[2], u0[3]}, s, s);
                const f32x2 o2 = silu_mul2((f32x2){g1[0], g1[1]}, (f32x2){u1[0], u1[1]}, s, s), o3 = silu_mul2((f32x2){g1[2], g1[3]}, (f32x2){u1[2], u1[3]}, s, s);
                u32x4 w; w.x = cvt_pk_bf16(o0.x, o0.y); w.y = cvt_pk_bf16(o1.x, o1.y); w.z = cvt_pk_bf16(o2.x, o2.y); w.w = cvt_pk_bf16(o3.x, o3.y);
                *(u32x4*)rowp = w; }
    }
};
template <int RS> struct EpiSwigluF8 {
    static constexpr bool PERM = true; static constexpr bool HAS_PRE = (RS == 2);
    unsigned char* O; int ldc; const void* rsp;
    __device__ __forceinline__ void pre(float (&sc)[2][4], const Unit& u, int wr, int fr) const { row_scales<RS>(sc, rsp, u.pm * BM + wr * 64 + fr); }
    __device__ __forceinline__ void operator()(const f32x4 (&acc)[2][2][4][2], const Unit& u, int wr, int wc, int fr, int fq) const { float sc[2][4]; row_scales<RS>(sc, rsp, u.pm * BM + wr * 64 + fr); (*this)(acc, u, wr, wc, fr, fq, sc); }
    __device__ __forceinline__ void operator()(const f32x4 (&acc)[2][2][4][2], const Unit& u, int wr, int wc, int fr, int fq, const float (&sc)[2][4]) const {
        const int row0 = u.pm * BM + wr * 64 + fr, col0 = u.pn * HALF + wc * 32 + 8 * fq;
#pragma unroll
        for (int ai = 0; ai < 2; ++ai)
#pragma unroll
            for (int m = 0; m < 4; ++m) { unsigned char* rowp = O + (size_t)(row0 + ai * HALF + m * 16) * ldc + col0;
                const f32x4 g0 = acc[ai][0][m][0], g1 = acc[ai][0][m][1], u0 = acc[ai][1][m][0], u1 = acc[ai][1][m][1]; const float s = sc[ai][m], s8 = s * A8_SCALE;
                const f32x2 o0 = silu_mul2((f32x2){g0[0], g0[1]}, (f32x2){u0[0], u0[1]}, s, s8), o1 = silu_mul2((f32x2){g0[2], g0[3]}, (f32x2){u0[2], u0[3]}, s, s8);
                const f32x2 o2 = silu_mul2((f32x2){g1[0], g1[1]}, (f32x2){u1[0], u1[1]}, s, s8), o3 = silu_mul2((f32x2){g1[2], g1[3]}, (f32x2){u1[2], u1[3]}, s, s8);
                u32x2 w; w.x = pk4_fp8(o0.x, o0.y, o1.x, o1.y); w.y = pk4_fp8(o2.x, o2.y, o3.x, o3.y);
                *(u32x2*)rowp = w; }
    }
};
struct EpiResF32 {
    static constexpr bool PERM = true; static constexpr bool HAS_PRE = false;
    const float* R32; bf16_t* XR; int ldc; unsigned char* XB8; float* ss; int rf32; int f8out; LAS float* part;
    __device__ __forceinline__ void operator()(const f32x4 (&acc)[2][2][4][2], const Unit& u, int wr, int wc, int fr, int fq) const {
        const int col0 = u.pn * BM + wc * 32 + 8 * fq;
        float ssw[2][4];
        u32x4 rb[2][4][2];
#pragma unroll
        for (int ai = 0; ai < 2; ++ai)
#pragma unroll
            for (int m = 0; m < 4; ++m) { const unsigned boff = (unsigned)((u.pm * BM + ai * HALF + wr * 64 + m * 16 + fr) * ldc + col0) * 2u;
#pragma unroll
                for (int bj = 0; bj < 2; ++bj) rb[ai][m][bj] = *(const u32x4*)((const char*)XR + (size_t)(boff + (unsigned)(bj * HALF * 2))); }
#pragma unroll
        for (int ai = 0; ai < 2; ++ai) {
#pragma unroll
            for (int m = 0; m < 4; ++m) { const unsigned eoff = (unsigned)((u.pm * BM + ai * HALF + wr * 64 + m * 16 + fr) * ldc + col0);
                float ssp = 0.f;
#pragma unroll
                for (int bj = 0; bj < 2; ++bj) {
                    const u32x4 q = rb[ai][m][bj];
                    const f32x4 v0 = (f32x4){bflo(q[0]), bfhi(q[0]), bflo(q[1]), bfhi(q[1])} + acc[ai][bj][m][0], v1 = (f32x4){bflo(q[2]), bfhi(q[2]), bflo(q[3]), bfhi(q[3])} + acc[ai][bj][m][1];
                    ssp += (v0[0] * v0[0] + v0[1] * v0[1]) + (v0[2] * v0[2] + v0[3] * v0[3]) + (v1[0] * v1[0] + v1[1] * v1[1]) + (v1[2] * v1[2] + v1[3] * v1[3]);
                    { u32x4 w; w.x = cvt_pk_bf16(v0[0], v0[1]); w.y = cvt_pk_bf16(v0[2], v0[3]); w.z = cvt_pk_bf16(v1[0], v1[1]); w.w = cvt_pk_bf16(v1[2], v1[3]); *(u32x4*)((char*)XR + (size_t)((eoff + (unsigned)(bj * HALF)) * 2u)) = w; }
                    if (f8out) { u32x2 w; w.x = pk4_fp8(v0[0], v0[1], v0[2], v0[3]); w.y = pk4_fp8(v1[0], v1[1], v1[2], v1[3]); *(u32x2*)(XB8 + (size_t)(eoff + (unsigned)(bj * HALF))) = w; }
                }
                ssp += lx16(ssp); ssw[ai][m] = sum_halves(ssp);
            }
        }
        if (fq == 0) {
#pragma unroll
            for (int ai = 0; ai < 2; ++ai)
#pragma unroll
                for (int m = 0; m < 4; ++m) part[((wr * 4 + wc) * 8 + ai * 4 + m) * 16 + fr] = ssw[ai][m]; }
        asm volatile("s_waitcnt lgkmcnt(0)" ::: "memory"); __builtin_amdgcn_s_barrier(); asm volatile("" ::: "memory");
        if (wc == 0 && fq == 0) {
#pragma unroll
            for (int ai = 0; ai < 2; ++ai)
#pragma unroll
                for (int m = 0; m < 4; ++m) { const LAS float* p = part + (wr * 4 * 8 + ai * 4 + m) * 16 + fr;
                    ss[(size_t)(u.pm * BM + ai * HALF + wr * 64 + m * 16 + fr) * 8 + u.pn] = (p[0] + p[128]) + (p[256] + p[384]); } }
        asm volatile("s_waitcnt lgkmcnt(0)" ::: "memory"); __builtin_amdgcn_s_barrier(); asm volatile("" ::: "memory");
    }
};
struct EpiMoeDown {
    static constexpr bool PERM = true; static constexpr bool HAS_PRE = false;
    bf16_t* O; int ldc; float* PB; int* tmap; int SP;
    __device__ __forceinline__ void operator()(const f32x4 (&acc)[2][2][4][2], const Unit& u, int wr, int wc, int fr, int fq) const {
        if (u.part < 0) {
            const int row0 = u.pm * BM + wr * 64 + fr, col0 = u.pn * BM + wc * 32 + 8 * fq;
#pragma unroll
            for (int ai = 0; ai < 2; ++ai)
#pragma unroll
                for (int m = 0; m < 4; ++m) { bf16_t* rowp = O + (size_t)(row0 + ai * HALF + m * 16) * ldc + col0;
#pragma unroll
                    for (int bj = 0; bj < 2; ++bj) { const f32x4 v0 = acc[ai][bj][m][0], v1 = acc[ai][bj][m][1];
                        u32x4 w; w.x = cvt_pk_bf16(v0[0], v0[1]); w.y = cvt_pk_bf16(v0[2], v0[3]); w.z = cvt_pk_bf16(v1[0], v1[1]); w.w = cvt_pk_bf16(v1[2], v1[3]);
                        *(u32x4*)(rowp + bj * HALF) = w; } }
        } else {
            float* slab = PB + (size_t)u.part * (BM * BM);
            if ((u.part % SP) == 0 && wr == 0 && wc == 0 && fr == 0 && fq == 0) tmap[u.pm * 8 + u.pn] = 1 + u.part / SP;
#pragma unroll
            for (int ai = 0; ai < 2; ++ai)
#pragma unroll
                for (int m = 0; m < 4; ++m) { float* rowp = slab + (ai * HALF + wr * 64 + m * 16 + fr) * BM + wc * 32 + 8 * fq;
#pragma unroll
                    for (int bj = 0; bj < 2; ++bj) { *(f32x4*)(rowp + bj * HALF) = acc[ai][bj][m][0]; *(f32x4*)(rowp + bj * HALF + 4) = acc[ai][bj][m][1]; } }
        }
    }
};
struct EpiF32 {
    static constexpr bool PERM = false; static constexpr bool HAS_PRE = false;
    float* O; int ldc;
    __device__ __forceinline__ void operator()(const f32x4 (&acc)[2][2][4][2], const Unit& u, int wr, int wc, int fr, int fq) const {
        const int col0 = u.pn * BM + wc * 32 + 4 * fq;
#pragma unroll
        for (int ai = 0; ai < 2; ++ai)
#pragma unroll
            for (int m = 0; m < 4; ++m) { const size_t off = (size_t)(u.pm * BM + ai * HALF + wr * 64 + m * 16 + fr) * ldc + col0;
#pragma unroll
                for (int bj = 0; bj < 2; ++bj)
#pragma unroll
                    for (int n = 0; n < 2; ++n) *(f32x4*)(O + off + bj * HALF + n * 16) = acc[ai][bj][m][n]; }
    }
};

struct NoBG { static constexpr int nslots = 0; __device__ __forceinline__ void operator()(int) const {} };
struct MoeConv {
    volatile LAS unsigned* LW; int slot0, nslots, bx8, NGW;
    static constexpr int PER = 3584, NITEMS = 24 * PER, NQ = BG_NQ;
    __device__ __forceinline__ unsigned long long ptr(int i) const { return (unsigned long long)(unsigned)__builtin_amdgcn_readfirstlane((int)LW[64 + 2 * i]) | ((unsigned long long)(unsigned)__builtin_amdgcn_readfirstlane((int)LW[64 + 2 * i + 1]) << 32); }
    __device__ __forceinline__ void operator()(int s) const {
        if (s >= nslots) return;
        const int tid_ = ltid(), lane = tid_ & 63, c = lane & 31, h = lane >> 5, gw = bx8 + __builtin_amdgcn_readfirstlane(tid_ >> 6);
#pragma unroll 1
        for (int rp = 0; rp < BG_NREP; ++rp) {
        const int it0 = (((slot0 + s) * BG_NREP + rp) * NGW + gw) * NQ; if (it0 >= NITEMS) return;
        f32x4 v[NQ][4][2][2]; float sc[NQ][4]; unsigned char* dst[NQ];
#pragma unroll
        for (int q2 = 0; q2 < NQ; ++q2) {
            int it = it0 + q2; it = it < NITEMS ? it : it0;
            const int mat = it / PER, r = it - mat * PER, e = mat & 7, kind = mat >> 3;
            const bool up_ = kind < 2;
            const int K = up_ ? DM : FFE, N = up_ ? FFE : DM, nblk = up_ ? 224 : 64, kb = r / nblk, nb = r - kb * nblk, k0 = 128 * kb, n0 = 32 * nb;
            const int drow0 = up_ ? (256 * (n0 >> 7) + kind * 128 + (n0 & 127)) : n0;
            const float* W = (const float*)(GAS const float*)ptr(kind == 0 ? 17 : (kind == 1 ? 18 : 19)) + (size_t)e * DM * FFE;
            const float* gk = (const float*)(GAS const float*)ptr(12) + DM;
            dst[q2] = (unsigned char*)(GAS unsigned char*)(ptr(21) + (up_ ? WS_WMGU : WS_WMD)) + (size_t)e * (up_ ? 2 : 1) * FFE * DM + (size_t)(drow0 + c) * K + k0 + 16 * h;
#pragma unroll
            for (int kb4 = 0; kb4 < 4; ++kb4) {
                const unsigned off = (unsigned)(((k0 + 32 * kb4 + c) * N + n0 + 8 * h) * 4);
                const char* row = (const char*)W + off;
                const float gv = gk[(k0 + 32 * kb4 + c) & (DM - 1)];
                sc[q2][kb4] = (up_ ? gv : 1.0f) * W8_SCALE;
#pragma unroll
                for (int nh = 0; nh < 2; ++nh) { v[q2][kb4][nh][0] = *(const f32x4*)(row + 64 * nh); v[q2][kb4][nh][1] = *(const f32x4*)(row + 64 * nh + 16); } }
        }
        u32x4 s0 = {0u, 0u, 0u, 0u}, s1 = {0u, 0u, 0u, 0u};
        { const int j0 = c - 8 * h, j1 = c - 16 - 8 * h;
#pragma unroll
          for (int j = 0; j < 8; ++j) { if (j == j0) s0[j >> 1] = (j & 1) ? 0x3f800000u : 0x00003f80u; if (j == j1) s1[j >> 1] = (j & 1) ? 0x3f800000u : 0x00003f80u; } }
        const bf16x8 sel0 = __builtin_bit_cast(bf16x8, s0), sel1 = __builtin_bit_cast(bf16x8, s1);
#pragma unroll
        for (int q2 = 0; q2 < NQ; ++q2)
#pragma unroll
            for (int kb4 = 0; kb4 < 4; ++kb4) {
                const float f = sc[q2][kb4];
                u32x4 a0, a1;
                { const f32x4 x0 = v[q2][kb4][0][0] * f, x1 = v[q2][kb4][0][1] * f, y0 = v[q2][kb4][1][0] * f, y1 = v[q2][kb4][1][1] * f;
                  a0.x = cvt_pk_bf16(x0[0], x0[1]); a0.y = cvt_pk_bf16(x0[2], x0[3]); a0.z = cvt_pk_bf16(x1[0], x1[1]); a0.w = cvt_pk_bf16(x1[2], x1[3]);
                  a1.x = cvt_pk_bf16(y0[0], y0[1]); a1.y = cvt_pk_bf16(y0[2], y0[3]); a1.z = cvt_pk_bf16(y1[0], y1[1]); a1.w = cvt_pk_bf16(y1[2], y1[3]); }
                f32x16 d = f32x16{};
                d = __builtin_amdgcn_mfma_f32_32x32x16_bf16(__builtin_bit_cast(bf16x8, a0), sel0, d, 0, 0, 0);
                d = __builtin_amdgcn_mfma_f32_32x32x16_bf16(__builtin_bit_cast(bf16x8, a1), sel1, d, 0, 0, 0);
                const unsigned w0 = pk4_fp8(d[0], d[1], d[2], d[3]), w1 = pk4_fp8(d[4], d[5], d[6], d[7]), w2 = pk4_fp8(d[8], d[9], d[10], d[11]), w3 = pk4_fp8(d[12], d[13], d[14], d[15]);
                const auto p02 = __builtin_amdgcn_permlane32_swap(w0, w2, false, false), p13 = __builtin_amdgcn_permlane32_swap(w1, w3, false, false);
                const u32x4 o = {p02[0], p02[1], p13[0], p13[1]};
                *(u32x4*)(dst[q2] + 32 * kb4) = o;
            }
        }
    }
};
__device__ __forceinline__ void mfma_f8_tied(f32x4& c, i32x8 a, i32x8 b, int sa, int sb) {
    asm volatile("v_mfma_scale_f32_16x16x128_f8f6f4 %0, %1, %2, %0, %3, %4 op_sel_hi:[0,0,0]" : "+v"(c) : "v"(a), "v"(b), "v"(sa), "v"(sb)); }
__device__ __forceinline__ void mfma_f8_drain() { asm volatile("s_nop 15\n\ts_nop 15" ::: "memory"); }
__device__ __forceinline__ void glds16s(unsigned voff, const char* sbase, unsigned lds_dst) { unsigned keep;
    asm volatile("s_mov_b32 %0, m0\n\ts_mov_b32 m0, %3\n\ts_nop 0\n\tglobal_load_lds_dwordx4 %1, %2\n\ts_mov_b32 m0, %0" : "=&s"(keep) : "v"(voff), "s"(sbase), "s"(lds_dst) : "memory"); }
template <class Epi, class Sched, bool F8 = false, int SCW = SC_ONE, int SCX = SC_ONE, class BG = NoBG>
__device__ __forceinline__ void gemm_phase(LAS unsigned char* lds, const Gemm g, const Sched& S, const Epi& E, const BG& bg = BG()) {
    const int tid = ltid(), wid = __builtin_amdgcn_readfirstlane(tid >> 6), lane = tid & 63, wr = wid >> 2, wc = wid & 3, fr = lane & 15, fq = lane >> 4;
    const int KB = g.KB, nt = KB / 128;
    int scw_ = SCW, scx_ = SCX; if constexpr (F8) { asm volatile("" : "+v"(scw_), "+v"(scx_)); }
    unsigned voffA[2], voffB[2];
#pragma unroll
    for (int i = 0; i < 2; ++i) { int R, C; stage_rc(tid * 16 + i * 8192, R, C); const int Rb = Epi::PERM ? ((R & ~31) + perm32(R & 31)) : R;
        voffA[i] = (unsigned)(R * KB + C * 2); voffB[i] = (unsigned)(Rb * KB + C * 2); }
    const size_t kstep = (size_t)128;
    const size_t hstep = (size_t)HALF * KB;
    const size_t tstep = 2 * hstep;
    const unsigned ldsb = (unsigned)(uintptr_t)lds + (unsigned)wid * 1024u;
    const int aoff = lds_byte(wr * 64 + fr, fq * 8), boff = lds_byte(wc * 32 + fr, fq * 8);
#define PG8_SA(b, h) (((b) * 2 + (h)) * HTB)
#define PG8_SB(b, h) ((4 + (b) * 2 + (h)) * HTB)
#define PG8_STAGE(bufoff, gbase, voff) do { _Pragma("unroll") for (int _i = 0; _i < 2; ++_i) \
        glds16s((voff)[_i], (const char*)(gbase), ldsb + (unsigned)((bufoff) + _i * 8192)); } while (0)
#define PG8_LDA(dst, b, h) do { _Pragma("unroll") for (int m = 0; m < 4; ++m) _Pragma("unroll") for (int k = 0; k < 2; ++k) dst[m][k] = *(const LAS bf16x8*)(lds + PG8_SA(b, h) + aoff + m * 2048 + k * 1024); } while (0)
#define PG8_LDB(dst, b, h) do { _Pragma("unroll") for (int n = 0; n < 2; ++n) _Pragma("unroll") for (int k = 0; k < 2; ++k) dst[n][k] = *(const LAS bf16x8*)(lds + PG8_SB(b, h) + boff + n * 2048 + k * 1024); } while (0)
#define PG8_CAT8(x) __builtin_shufflevector(__builtin_bit_cast(i32x4, (x)[0]), __builtin_bit_cast(i32x4, (x)[1]), 0, 1, 2, 3, 4, 5, 6, 7)
#define PG8_MMA(ai, bj, At, Bt) do { __builtin_amdgcn_s_setprio(1); \
        if constexpr (F8) { _Pragma("unroll") for (int m = 0; m < 4; ++m) _Pragma("unroll") for (int n = 0; n < 2; ++n) \
            mfma_f8_tied(acc[ai][bj][m][n], PG8_CAT8(Bt[n]), PG8_CAT8(At[m]), scw_, scx_); } \
        else { _Pragma("unroll") for (int m = 0; m < 4; ++m) _Pragma("unroll") for (int n = 0; n < 2; ++n) _Pragma("unroll") for (int k = 0; k < 2; ++k) \
            acc[ai][bj][m][n] = __builtin_amdgcn_mfma_f32_16x16x32_bf16(Bt[n][k], At[m][k], acc[ai][bj][m][n], 0, 0, 0); } \
        __builtin_amdgcn_s_setprio(0); } while (0)
#define PG8_WAIT_V(n) asm volatile("s_waitcnt vmcnt(" #n ")" ::: "memory")
#define PG8_WAIT_L(n) asm volatile("s_waitcnt lgkmcnt(" #n ")" ::: "memory")
#define PG8_BAR __builtin_amdgcn_s_barrier()
#define PG8_SCHED __builtin_amdgcn_sched_barrier(0)
    Unit cur, nxt; int ui = 0;
    if (!S.next(0, cur)) { for (int s = 0; s < bg.nslots; ++s) bg(s); return; }
    bf16x8 At[4][2], B0[2][2], B1[2][2];
    const char* cA = (const char*)g.A + (size_t)cur.pm * tstep + cur.kb0; const char* cB = (const char*)g.Bt + (size_t)cur.e * g.estride + (size_t)cur.pn * tstep + cur.kb0;
    PG8_STAGE(PG8_SB(0, 0), cB, voffB); PG8_STAGE(PG8_SB(0, 1), cB + hstep, voffB); PG8_STAGE(PG8_SA(0, 0), cA, voffA); PG8_STAGE(PG8_SA(0, 1), cA + hstep, voffA);
    if (wr == 1) PG8_BAR;
    PG8_WAIT_V(2); PG8_BAR;
    PG8_STAGE(PG8_SB(1, 0), cB + kstep, voffB); PG8_STAGE(PG8_SA(1, 0), cA + kstep, voffA); PG8_STAGE(PG8_SB(1, 1), cB + hstep + kstep, voffB);
    PG8_WAIT_V(6); PG8_BAR;
    for (;;) {
        f32x4 acc[2][2][4][2];
#pragma unroll
        for (int a = 0; a < 2; ++a)
#pragma unroll
            for (int b = 0; b < 2; ++b)
#pragma unroll
                for (int m = 0; m < 4; ++m)
#pragma unroll
                    for (int n = 0; n < 2; ++n) acc[a][b][m][n] = (f32x4){0.f, 0.f, 0.f, 0.f};
        float psc[2][4];
        if constexpr (Epi::HAS_PRE) E.pre(psc, cur, wr, fr);
        const bool has_next = S.next(ui + 1, nxt);
        const char* nA = has_next ? (const char*)g.A + (size_t)nxt.pm * tstep + nxt.kb0 : cA; const char* nB = has_next ? (const char*)g.Bt + (size_t)nxt.e * g.estride + (size_t)nxt.pn * tstep + nxt.kb0 : cB;
        const int ntc = cur.ntu ? cur.ntu : nt;
        for (int t = 0; t < ntc; t += 2) {
            const bool last = (t == ntc - 2);
            const char* a1 = cA + (size_t)(t + 1) * kstep;
            const char* a2 = last ? nA : cA + (size_t)(t + 2) * kstep; const char* b2 = last ? nB : cB + (size_t)(t + 2) * kstep;
            const char* a3 = a2 + kstep; const char* b3 = b2 + kstep;
            PG8_LDB(B0, 0, 0); PG8_LDB(B1, 0, 1); PG8_SCHED; PG8_LDA(At, 0, 0); PG8_STAGE(PG8_SA(1, 1), a1 + hstep, voffA);
            PG8_WAIT_V(8); PG8_WAIT_L(0); PG8_BAR; PG8_MMA(0, 0, At, B0); PG8_MMA(0, 1, At, B1); PG8_BAR; PG8_SCHED;
            PG8_LDA(At, 0, 1); PG8_STAGE(PG8_SB(0, 0), b2, voffB); PG8_STAGE(PG8_SB(0, 1), b2 + hstep, voffB); PG8_STAGE(PG8_SA(0, 0), a2, voffA);
            PG8_WAIT_V(8); PG8_WAIT_L(0); PG8_BAR; PG8_MMA(1, 0, At, B0); PG8_MMA(1, 1, At, B1); PG8_BAR; PG8_SCHED;
            PG8_LDB(B0, 1, 0); PG8_LDB(B1, 1, 1); PG8_SCHED; PG8_LDA(At, 1, 0); PG8_STAGE(PG8_SA(0, 1), a2 + hstep, voffA);
            PG8_WAIT_V(8); PG8_WAIT_L(0); PG8_BAR; PG8_MMA(0, 0, At, B0); PG8_MMA(0, 1, At, B1); PG8_BAR; PG8_SCHED;
            PG8_LDA(At, 1, 1); PG8_STAGE(PG8_SB(1, 0), b3, voffB); PG8_STAGE(PG8_SB(1, 1), b3 + hstep, voffB); PG8_STAGE(PG8_SA(1, 0), a3, voffA);
            PG8_WAIT_V(8); PG8_WAIT_L(0); PG8_BAR; PG8_MMA(1, 0, At, B0); PG8_MMA(1, 1, At, B1); PG8_BAR; PG8_SCHED;
        }
        if (wr == 0) PG8_BAR;
        if constexpr (F8) mfma_f8_drain();
        if constexpr (Epi::HAS_PRE) E(acc, cur, wr, wc, fr, fq, psc); else E(acc, cur, wr, wc, fr, fq);
        asm volatile("" ::: "memory"); __builtin_amdgcn_sched_barrier(0);
        bg(ui);
        asm volatile("" ::: "memory"); __builtin_amdgcn_sched_barrier(0);
        if (!has_next) break;
        cur = nxt; cA = nA; cB = nB; ++ui;
        if (wr == 1) PG8_BAR;
    }
    for (int s = ui + 1; s < bg.nslots; ++s) bg(s);
    PG8_WAIT_V(0);
    PG8_BAR;
#undef PG8_SA
#undef PG8_SB
#undef PG8_STAGE
#undef PG8_LDA
#undef PG8_LDB
#undef PG8_MMA
#undef PG8_CAT8
#undef PG8_WAIT_V
#undef PG8_WAIT_L
#undef PG8_BAR
#undef PG8_SCHED
}
}

namespace att {
constexpr int D = 128, LDZ = INW, LDO = DM;
constexpr float SCALE = 0.08838834764831845f;
constexpr float THR = 8.f;
constexpr int NW = 8, QBLK = 32, KVBLK = 64, QB = NW * QBLK;
constexpr int SHM_V = KVBLK * D * 2, SHM_K = KVBLK * D * 2;
constexpr int ATT_LDS_BYTES = 2 * SHM_V + 2 * SHM_K + NW * 64 * 4;
#define KSWZ(row, colB) ((row) * 256 + ((colB) ^ (((row) & 7) << 4)))
#define SBAR() __builtin_amdgcn_sched_barrier(0)
__device__ __forceinline__ int v_st(int k, int c) { const int kk = (k & ~0xC) | ((k & 4) << 1) | ((k & 8) >> 1); return ((kk >> 3) * 4 + (c >> 5)) * 512 + ((kk & 7) * 32 + (c & 31)) * 2; }
__device__ __forceinline__ int v_rd_base(int lane) { return ((lane & 3) << 3) | (((lane >> 2) & 3) << 6) | (((lane >> 4) & 1) << 5) | (((lane >> 5) & 1) << 8); }
constexpr int v_rd_off(int d0, int ks, int half) { return d0 * 512 + ks * 4096 + half * 2048; }
__device__ __forceinline__ int crow(int r, int hi) { return (r & 3) + 8 * (r >> 2) + 4 * hi; }
__device__ __forceinline__ bf16x8 load8(const bf16_t* p) { return *reinterpret_cast<const bf16x8*>(p); }
__device__ __forceinline__ void mask_tile(f32x16& p0, f32x16& p1, int dq, unsigned W) {
    const float NEG = -__builtin_inff();
#pragma unroll
    for (int r = 0; r < 16; ++r) {
        const int c = (r & 3) + 8 * (r >> 2);
        if ((unsigned)(dq - c) >= W) p0[r] = NEG;
        if ((unsigned)(dq - c - 32) >= W) p1[r] = NEG;
    }
}
__device__ __forceinline__ void partialSM(f32x16& p0, f32x16& p1, float& m_reg, float& mn, float& alpha) {
    float pmax = p0[0];
#pragma unroll
    for (int r = 1; r < 16; ++r) pmax = fmaxf(pmax, p0[r]);
#pragma unroll
    for (int r = 0; r < 16; ++r) pmax = fmaxf(pmax, p1[r]);
    { auto rr = __builtin_amdgcn_permlane32_swap(__float_as_uint(pmax), __float_as_uint(pmax), false, false);
      pmax = fmaxf(__uint_as_float(rr[0]), __uint_as_float(rr[1])); }
    constexpr float C2 = 1.4426950408889634f * SCALE;
    if (__builtin_expect(__all((pmax - m_reg) * SCALE <= THR), 1)) { mn = m_reg; alpha = 1.f; }
    else { mn = fmaxf(m_reg, pmax); alpha = __builtin_amdgcn_exp2f((m_reg - mn) * C2); m_reg = mn; }
    const float mnL = -mn * C2;
#pragma unroll
    for (int r = 0; r < 16; ++r) p0[r] = fmaf(p0[r], C2, mnL);
#pragma unroll
    for (int r = 0; r < 16; ++r) p1[r] = fmaf(p1[r], C2, mnL);
#pragma unroll
    for (int r = 0; r < 16; ++r) p0[r] = __builtin_amdgcn_exp2f(p0[r]);
}
__device__ __forceinline__ void finishSM(f32x16& p0, f32x16& p1, float alpha, float& l_reg, bf16x8& pa0, bf16x8& pa1, bf16x8& pa2, bf16x8& pa3) {
#pragma unroll
    for (int r = 0; r < 16; ++r) p1[r] = __builtin_amdgcn_exp2f(p1[r]);
    float ps = 0;
#pragma unroll
    for (int r = 0; r < 16; ++r) ps += p0[r];
#pragma unroll
    for (int r = 0; r < 16; ++r) ps += p1[r];
    { auto rr = __builtin_amdgcn_permlane32_swap(__float_as_uint(ps), __float_as_uint(ps), false, false);
      ps = __uint_as_float(rr[0]) + __uint_as_float(rr[1]); }
    l_reg = l_reg * alpha + ps;
#define PK4(P, B_, OUT) do { unsigned a0 = cvt_pk_bf16(P[B_+0], P[B_+1]), a1 = cvt_pk_bf16(P[B_+2], P[B_+3]);                          \
        unsigned b0 = cvt_pk_bf16(P[B_+4], P[B_+5]), b1 = cvt_pk_bf16(P[B_+6], P[B_+7]);                                             \
        auto r0 = __builtin_amdgcn_permlane32_swap(a0, b0, false, false); auto r1 = __builtin_amdgcn_permlane32_swap(a1, b1, false, false); \
        u32x4 w = {r0[0], r1[0], r0[1], r1[1]}; OUT = *reinterpret_cast<bf16x8*>(&w); } while (0)
    PK4(p0, 0, pa0); PK4(p0, 8, pa1); PK4(p1, 0, pa2); PK4(p1, 8, pa3);
#undef PK4
}
template <int KB>
__device__ __forceinline__ void qkt(f32x16& p0, f32x16& p1, const char* K_lds, int r32, int hi, const bf16x8* qr) {
    p0 = f32x16{}; p1 = f32x16{};
    const char* kb[4];
#pragma unroll
    for (int dd = 0; dd < 4; ++dd) kb[dd] = K_lds + KB * SHM_K + KSWZ(r32, (dd * 16 + hi * 8) * 2);
#pragma unroll
    for (int d0 = 0; d0 < 8; ++d0) { const char* a = kb[d0 & 3] + (d0 >> 2) * 128;
        bf16x8 b0 = *reinterpret_cast<const bf16x8*>(a);
        bf16x8 b1 = *reinterpret_cast<const bf16x8*>(a + 32 * 256);
        p0 = __builtin_amdgcn_mfma_f32_32x32x16_bf16(b0, qr[d0], p0, 0, 0, 0);
        p1 = __builtin_amdgcn_mfma_f32_32x32x16_bf16(b1, qr[d0], p1, 0, 0, 0); }
}
template <int VB>
__device__ __forceinline__ void pv_tile(f32x16* o, int vb0, bf16x8 pa0, bf16x8 pa1, bf16x8 pa2, bf16x8 pa3) {
#define TRRD(dst, off) asm volatile("ds_read_b64_tr_b16 %0, %1 offset:%2" : "=&v"(dst) : "v"(vb0), "i"(off) : "memory")
#define PV_D0(d0) do { s16x4 l0, l1, l2, l3, h0, h1, h2, h3; constexpr int b_ = VB * SHM_V + v_rd_off(d0, 0, 0); \
        TRRD(l0, b_); TRRD(h0, b_ + 2048); TRRD(l1, b_ + 4096); TRRD(h1, b_ + 6144); TRRD(l2, b_ + 8192); TRRD(h2, b_ + 10240); TRRD(l3, b_ + 12288); TRRD(h3, b_ + 14336); \
        asm volatile("s_waitcnt lgkmcnt(0)" ::: "memory"); SBAR();   \
        o[d0] = __builtin_amdgcn_mfma_f32_32x32x16_bf16(pa0, (bf16x8){l0[0], l0[1], l0[2], l0[3], h0[0], h0[1], h0[2], h0[3]}, o[d0], 0, 0, 0);   \
        o[d0] = __builtin_amdgcn_mfma_f32_32x32x16_bf16(pa1, (bf16x8){l1[0], l1[1], l1[2], l1[3], h1[0], h1[1], h1[2], h1[3]}, o[d0], 0, 0, 0);   \
        o[d0] = __builtin_amdgcn_mfma_f32_32x32x16_bf16(pa2, (bf16x8){l2[0], l2[1], l2[2], l2[3], h2[0], h2[1], h2[2], h2[3]}, o[d0], 0, 0, 0);   \
        o[d0] = __builtin_amdgcn_mfma_f32_32x32x16_bf16(pa3, (bf16x8){l3[0], l3[1], l3[2], l3[3], h3[0], h3[1], h3[2], h3[3]}, o[d0], 0, 0, 0); } while (0)
    PV_D0(0); PV_D0(1); PV_D0(2); PV_D0(3);
#undef PV_D0
#undef TRRD
}
struct BlockRef { const bf16_t* Q; const bf16_t* K; const bf16_t* V; bf16_t* O; int P0; };
struct Seam { bf16x8 qr[8]; bf16x8 st_v0, st_v1, st_k0, st_k1; };
#define ROW(p, k0, rr) ((p) + (size_t)((k0) + (rr)) * LDZ + sc)
#define VMW() asm volatile("s_waitcnt vmcnt(0)" ::: "memory")
#define VMWN(n) asm volatile("s_waitcnt vmcnt(%0)" :: "i"(n) : "memory")
#define SLOAD_H(Kp, Vp, k0) do { S.st_v0 = load8(ROW(Vp, k0, sr)); S.st_v1 = load8(ROW(Vp, k0, 32 + sr));              \
                         S.st_k0 = load8(ROW(Kp, k0, sr)); S.st_k1 = load8(ROW(Kp, k0, 32 + sr)); } while (0)
#define SWRITE_HK(bf) do { *(bf16x8*)(K_lds + (bf) * SHM_K + kws) = S.st_k0; *(bf16x8*)(K_lds + (bf) * SHM_K + kws + 32 * 256) = S.st_k1; } while (0)
#define SWRITE_HV(bf) do { *(bf16x8*)(V_lds + (bf) * SHM_V + vst0) = S.st_v0; *(bf16x8*)(V_lds + (bf) * SHM_V + vst1) = S.st_v1; } while (0)
#define SWRITE_H(bf) do { SWRITE_HV(bf); SWRITE_HK(bf); } while (0)
__device__ __forceinline__ void causal_prime(const BlockRef& cur, char* lds, Seam& S) {
    const int tid = ltid(), wid = __builtin_amdgcn_readfirstlane(tid >> 6), lane = tid & 63, r32 = lane & 31, hi = lane >> 5;
    const int sr = tid >> 4, sc = (tid & 15) * 8, kws = KSWZ(sr, sc * 2); char* K_lds = lds + 2 * SHM_V;
    const int kb0 = 0;
#pragma unroll
    for (int d0 = 0; d0 < 8; ++d0) S.qr[d0] = load8(cur.Q + (size_t)(wid * QBLK + r32) * LDZ + d0 * 16 + hi * 8);
    SLOAD_H(cur.K, cur.V, kb0); VMW(); SWRITE_HK(0);
    __syncthreads();
}
template <int ORD>
__device__ __forceinline__ void causal_block(const BlockRef& cur, const BlockRef& nxt, int skv, char* lds, Seam& S) {
    const int tid = ltid(), wid = __builtin_amdgcn_readfirstlane(tid >> 6), lane = tid & 63, r32 = lane & 31, hi = lane >> 5;
    const int W = 1 << 30;
    const int j_lo = 0;
    int j_hi = (cur.P0 + QB - 1) / KVBLK + 1; if (j_hi > skv / KVBLK) j_hi = skv / KVBLK;
    const int NT = j_hi - j_lo;
    const int kbn = 0;
    const int qlo = cur.P0 + wid * QBLK, qm = qlo + r32 - 4 * hi;
    char* V_lds = lds; char* K_lds = lds + 2 * SHM_V;
    float* ws = (float*)(lds + 2 * SHM_V + 2 * SHM_K) + wid * 64; float* li_l = ws, * al_l = ws + 32;
    float m_reg = -1e30f, l_reg = 0; f32x16 o[4];
    { float z_ = 0.f; asm volatile("" : "+v"(z_));
#pragma unroll
      for (int d_ = 0; d_ < 4; ++d_)
#pragma unroll
          for (int r = 0; r < 16; ++r) o[d_][r] = z_; }
    const int sr = tid >> 4, sc = (tid & 15) * 8, vst0 = v_st(sr, sc), vst1 = v_st(32 + sr, sc), kws = KSWZ(sr, sc * 2);
    const int vb0 = (int)(uintptr_t)V_lds + v_rd_base(lane);
    const bf16_t* Kh = cur.K; const bf16_t* Vh = cur.V;
#define RESC(a) do { if (__any((a) < 1.f)) { if (hi == 0) al_l[r32] = (a); asm volatile("s_waitcnt lgkmcnt(0)" ::: "memory");              \
                     _Pragma("unroll") for (int d_ = 0; d_ < 4; ++d_) _Pragma("unroll") for (int r = 0; r < 16; ++r) o[d_][r] *= al_l[crow(r, hi)]; } } while (0)
#define KBASE(t) ((j_lo + (t)) * KVBLK)
#define MASKT(P0_, P1_, t) do { const int kb_ = KBASE(t); if (kb_ + KVBLK - 1 > qlo) mask_tile(P0_, P1_, qm - kb_, (unsigned)W); } while (0)
    constexpr int NQL = 8;
#define SEAM_K0() do { VMWN(NQL); SWRITE_HK(0); SBAR(); } while (0)
    f32x16 pA0, pA1, pB0, pB1; float mnA, mnB, alA, alB; bf16x8 pa0, pa1, pa2, pa3;
    SWRITE_HV(0); SBAR();
    if (NT > 1) { SLOAD_H(Kh, Vh, KBASE(1)); }
    SBAR(); qkt<0>(pA0, pA1, K_lds, r32, hi, S.qr);
    MASKT(pA0, pA1, 0); partialSM(pA0, pA1, m_reg, mnA, alA);
    if (NT > 1) { VMW(); SWRITE_H(1); }
    __syncthreads();
#define HALF_STEP(PX0, PX1, mnX, alX, PY0, PY1, alY, t, KB, VB, SB) do {                                                      \
        SBAR(); qkt<KB>(PX0, PX1, K_lds, r32, hi, S.qr);                                                                      \
        finishSM(PY0, PY1, alY, l_reg, pa0, pa1, pa2, pa3); SBAR();                                                           \
        if ((t) + 1 < NT) { SLOAD_H(Kh, Vh, KBASE((t) + 1)); SBAR(); }                                                        \
        pv_tile<VB>(o, vb0, pa0, pa1, pa2, pa3); MASKT(PX0, PX1, (t)); partialSM(PX0, PX1, m_reg, mnX, alX);                  \
        __syncthreads();                                                                                                      \
        if ((t) + 1 < NT) { VMW(); SWRITE_H(SB); }                                                                            \
        RESC(alX); __syncthreads(); } while (0)
#define HALF_STEP_V(PX0, PX1, mnX, alX, PY0, PY1, alY, t, KB, VB, SB) do {                                                    \
        SBAR(); finishSM(PY0, PY1, alY, l_reg, pa0, pa1, pa2, pa3); SBAR();                                                   \
        qkt<KB>(PX0, PX1, K_lds, r32, hi, S.qr); SBAR();                                                                      \
        if ((t) + 1 < NT) { SLOAD_H(Kh, Vh, KBASE((t) + 1)); SBAR(); }                                                        \
        MASKT(PX0, PX1, (t)); partialSM(PX0, PX1, m_reg, mnX, alX); SBAR();                                                   \
        pv_tile<VB>(o, vb0, pa0, pa1, pa2, pa3);                                                                              \
        __syncthreads();                                                                                                      \
        if ((t) + 1 < NT) { VMW(); SWRITE_H(SB); }                                                                            \
        RESC(alX); __syncthreads(); } while (0)
    for (int t = 1; t + 1 < NT; t += 2) {
        if constexpr (ORD == 0) { HALF_STEP(pB0, pB1, mnB, alB, pA0, pA1, alA, t, 1, 0, 0);
                                  HALF_STEP(pA0, pA1, mnA, alA, pB0, pB1, alB, t + 1, 0, 1, 1); }
        else                    { HALF_STEP_V(pB0, pB1, mnB, alB, pA0, pA1, alA, t, 1, 0, 0);
                                  HALF_STEP_V(pA0, pA1, mnA, alA, pB0, pB1, alB, t + 1, 0, 1, 1); }
    }
    const bool even = (NT & 1) == 0;
    if (even) { SBAR(); qkt<1>(pB0, pB1, K_lds, r32, hi, S.qr); SBAR(); }
    SLOAD_H(nxt.K, nxt.V, kbn); SBAR();
#pragma unroll
    for (int d0 = 0; d0 < 8; ++d0) S.qr[d0] = load8(nxt.Q + (size_t)(wid * QBLK + r32) * LDZ + d0 * 16 + hi * 8);
    SBAR();
    finishSM(pA0, pA1, alA, l_reg, pa0, pa1, pa2, pa3); SBAR();
    pv_tile<0>(o, vb0, pa0, pa1, pa2, pa3);
    if (even) { MASKT(pB0, pB1, NT - 1); partialSM(pB0, pB1, m_reg, mnB, alB); __syncthreads(); RESC(alB);
        finishSM(pB0, pB1, alB, l_reg, pa0, pa1, pa2, pa3); SBAR(); pv_tile<1>(o, vb0, pa0, pa1, pa2, pa3); }
    SBAR(); SEAM_K0();
    if (hi == 0) li_l[r32] = l_reg; asm volatile("s_waitcnt lgkmcnt(0)" ::: "memory");
    float rli[16];
#pragma unroll
    for (int r = 0; r < 16; ++r) rli[r] = __builtin_amdgcn_rcpf(li_l[crow(r, hi)]);
    bf16_t* Ow = cur.O + (size_t)(wid * QBLK) * LDO;
#pragma unroll
    for (int r = 0; r < 16; ++r) { const int orow = crow(r, hi);
#pragma unroll
        for (int d0 = 0; d0 < 4; ++d0) { const float v = o[d0][r] * rli[r]; const float vn = lx1(v);
            if ((r32 & 1) == 0) *(unsigned*)(Ow + (size_t)orow * LDO + d0 * 32 + r32) = cvt_pk_bf16(v, vn); } }
    __syncthreads();
#undef RESC
#undef KBASE
#undef MASKT
#undef SEAM_K0
#undef HALF_STEP
#undef HALF_STEP_V
}
#undef ROW
#undef VMW
#undef VMWN
#undef SLOAD_H
#undef SWRITE_HK
#undef SWRITE_HV
#undef SWRITE_H
#undef KSWZ
#undef SBAR
}

#define XB_TMO      128
#define XB_XCNT(j)  (256  + 64 * (j))
#define XB_XSUB(j)  (1280 + 64 * (j))
#define XB_XGEN(j)  (2304 + 64 * (j))
#define XB_TOP      3328
#define XB_TOPGEN   3392
#define XCD_BAR_WORDS 3456
#define XB_SPIN_CAP (1u << 18)

__device__ __forceinline__ unsigned xb_ld(unsigned* p)              { return __hip_atomic_load(p, __ATOMIC_RELAXED, __HIP_MEMORY_SCOPE_AGENT); }
__device__ __forceinline__ unsigned xb_add(unsigned* p, unsigned v) { return __hip_atomic_fetch_add(p, v, __ATOMIC_RELAXED, __HIP_MEMORY_SCOPE_AGENT); }
__device__ __forceinline__ unsigned xb_xcc_id() { return (unsigned)__builtin_amdgcn_s_getreg((3 << 11) | 20) & 0xFu; }
#define XB_SPIN(cond, bar) do { unsigned _sp = 0; while (cond) { __builtin_amdgcn_s_sleep(1); \
    if ((++_sp & 255u) == 0u) { if (xb_ld(&(bar)[XB_TMO])) break; if (_sp > XB_SPIN_CAP) { atomicAdd(&(bar)[XB_TMO], 1u); break; } } } } while (0)

struct XcdBarrier {
    unsigned* bar; unsigned x;
    volatile LAS unsigned* st;
};

__device__ __forceinline__ XcdBarrier xcd_barrier_post(unsigned* bar, volatile LAS unsigned* st) {
    XcdBarrier b; b.bar = bar; b.x = xb_xcc_id(); b.st = st;
    if (threadIdx.x == 0) (void)xb_add(&bar[XB_XCNT(b.x)], 1u);
    return b;
}
__device__ __forceinline__ void xcd_barrier_complete(unsigned* bar, unsigned x, unsigned& nloc, unsigned& nx) {
    const unsigned G = gridDim.x * gridDim.y * gridDim.z;
    unsigned sum, cnt, mine, sp = 0u;
    for (;;) {
        sum = 0u; cnt = 0u; mine = 0u;
#pragma unroll
        for (unsigned j = 0; j < 16; ++j) { const unsigned c = xb_ld(&bar[XB_XCNT(j)]); sum += c; cnt += (c > 0u) ? 1u : 0u; mine = (j == x) ? c : mine; }
        if (sum == G) break;
        __builtin_amdgcn_s_sleep(1);
        if ((++sp & 255u) == 0u) { if (xb_ld(&bar[XB_TMO])) break; if (sp > XB_SPIN_CAP) { atomicAdd(&bar[XB_TMO], 1u); break; } }
    }
    nloc = mine > 0u ? mine : 1u; nx = cnt > 0u ? cnt : 1u;
}

template <bool FIRST> __device__ __forceinline__ void xcd_barrier(const XcdBarrier& b) {
    asm volatile("s_waitcnt vmcnt(0)" ::: "memory");
    __syncthreads();
    if (threadIdx.x == 0) {
        unsigned* bar = b.bar;
        __builtin_amdgcn_s_waitcnt(0);
        unsigned nloc = b.st[0], nx = b.st[1];
        if (FIRST) { if (nloc == 0u) { xcd_barrier_complete(bar, b.x, nloc, nx); b.st[0] = nloc; b.st[1] = nx; } }
        const unsigned old = xb_add(&bar[XB_XSUB(b.x)], 1u);
        const unsigned gen = old / nloc;
        if (old + 1u == (gen + 1u) * nloc) {
            __builtin_amdgcn_fence(__ATOMIC_RELEASE, "agent");
            asm volatile("s_waitcnt vmcnt(0)" ::: "memory");
            const unsigned og = xb_add(&bar[XB_TOP], 1u);
            const unsigned tg = og / nx;
            if (og + 1u == (tg + 1u) * nx) xb_add(&bar[XB_TOPGEN], 1u);
            else XB_SPIN(xb_ld(&bar[XB_TOPGEN]) == tg, bar);
            __builtin_amdgcn_fence(__ATOMIC_ACQUIRE, "agent");
            xb_add(&bar[XB_XGEN(b.x)], 1u);
            asm volatile("s_waitcnt vmcnt(0)" ::: "memory");
        } else {
            XB_SPIN(xb_ld(&bar[XB_XGEN(b.x)]) == gen, bar);
            __builtin_amdgcn_fence(__ATOMIC_ACQUIRE, "agent");
            asm volatile("s_waitcnt vmcnt(0)" ::: "memory");
        }
    }
    __syncthreads();
}

template <int KT, bool F8>
__device__ __forceinline__ void transpose_item(const float* W, int K, int N, void* WT, int drow0, int k0, int n0, LAS float* scr, int lane, const float* gk) {
    const int kr = lane >> 3, n4 = 4 * (lane & 7);
    f32x4 v[KT / 8];
#pragma unroll
    for (int i = 0; i < KT / 8; ++i) v[i] = *(const f32x4*)(W + (size_t)(k0 + kr + 8 * i) * N + n0 + n4);
    if (gk) {
#pragma unroll
        for (int i = 0; i < KT / 8; ++i) v[i] = v[i] * gk[k0 + kr + 8 * i]; }
#pragma unroll
    for (int i = 0; i < KT / 8; ++i) { LAS float* s = scr + (kr + 8 * i) * 33 + 4 * ((kr + 8 * i) >> 4) + n4; s[0] = v[i][0]; s[1] = v[i][1]; s[2] = v[i][2]; s[3] = v[i][3]; }
    LDS_WAIT(); asm volatile("" ::: "memory");
    const int c = lane & 7;
#pragma unroll
    for (int j = 0; j < 4; ++j) { const int n = (lane >> 3) + 8 * j;
        if constexpr (!F8) { static_assert(F8 || KT == 64, "bf16 item is 64 k");
            const LAS float* s = scr + (8 * c) * 33 + 4 * ((8 * c) >> 4) + n;
            u32x4 o; o.x = cvt_pk_bf16(s[0 * 33], s[1 * 33]); o.y = cvt_pk_bf16(s[2 * 33], s[3 * 33]); o.z = cvt_pk_bf16(s[4 * 33], s[5 * 33]); o.w = cvt_pk_bf16(s[6 * 33], s[7 * 33]);
            *(u32x4*)((bf16_t*)WT + (size_t)(drow0 + n) * K + k0 + 8 * c) = o;
        } else { static_assert(!F8 || KT == 128, "fp8 item is 128 k");
            const LAS float* s = scr + (16 * c) * 33 + 4 * c + n;
            u32x4 o;
            o.x = pk4_fp8(s[0 * 33] * W8_SCALE, s[1 * 33] * W8_SCALE, s[2 * 33] * W8_SCALE, s[3 * 33] * W8_SCALE);
            o.y = pk4_fp8(s[4 * 33] * W8_SCALE, s[5 * 33] * W8_SCALE, s[6 * 33] * W8_SCALE, s[7 * 33] * W8_SCALE);
            o.z = pk4_fp8(s[8 * 33] * W8_SCALE, s[9 * 33] * W8_SCALE, s[10 * 33] * W8_SCALE, s[11 * 33] * W8_SCALE);
            o.w = pk4_fp8(s[12 * 33] * W8_SCALE, s[13 * 33] * W8_SCALE, s[14 * 33] * W8_SCALE, s[15 * 33] * W8_SCALE);
            *(u32x4*)((unsigned char*)WT + (size_t)(drow0 + n) * K + k0 + 16 * c) = o;
        } }
    LDS_WAIT(); asm volatile("" ::: "memory");
}
template <bool F8> struct TrItem { static constexpr int NB = F8 ? 4 : 2; f32x4 v[NB][4]; f32x4 g[NB]; };
template <bool F8> __device__ __forceinline__ void tr_load(TrItem<F8>& T, const float* W, int N, int k0, int n0, int lane, const float* gk, bool useg) {
    const int kq = lane >> 3, nq = lane & 7;
#pragma unroll
    for (int b = 0; b < TrItem<F8>::NB; ++b) {
        const int kr = k0 + 32 * b + 4 * kq;
        const f32x4 gv = *(const f32x4*)(gk + (kr & (DM - 1)));
        T.g[b] = useg ? gv : (f32x4){1.f, 1.f, 1.f, 1.f};
#pragma unroll
        for (int i = 0; i < 4; ++i) T.v[b][i] = *(const f32x4*)(W + (size_t)(kr + i) * N + n0 + 4 * nq);
    }
}
template <bool F8> __device__ __forceinline__ void tr_store(const TrItem<F8>& T, void* WT, int K, int drow0, int dstep, int k0, LAS unsigned char* scr, int lane) {
    const int kq = lane >> 3, nq = lane & 7;
#pragma unroll
    for (int b = 0; b < TrItem<F8>::NB; ++b) {
        f32x4 x[4];
#pragma unroll
        for (int i = 0; i < 4; ++i) x[i] = T.v[b][i] * (T.g[b][i] * (F8 ? W8_SCALE : 1.0f));
#pragma unroll
        for (int e = 0; e < 4; ++e) {
            LAS unsigned char* row = scr + (4 * nq + e) * 144;
            if constexpr (F8) { const int kb = 32 * b + 4 * kq, ch = (kb >> 4) ^ nq;
                *(LAS unsigned*)(row + 16 * ch + (kb & 15)) = pk4_fp8(x[0][e], x[1][e], x[2][e], x[3][e]); }
            else { const int kb = 64 * b + 8 * kq, ch = (kb >> 4) ^ nq;
                u32x2 w; w.x = cvt_pk_bf16(x[0][e], x[1][e]); w.y = cvt_pk_bf16(x[2][e], x[3][e]); *(LAS u32x2*)(row + 16 * ch + (kb & 15)) = w; }
        }
    }
    LDS_WAIT(); asm volatile("" ::: "memory");
    const int c = lane & 7;
#pragma unroll
    for (int j = 0; j < 4; ++j) { const int n = (lane >> 3) + 8 * j;
        const u32x4 o = *(const LAS u32x4*)(scr + n * 144 + 16 * (c ^ ((n >> 2) & 7)));
        *(u32x4*)((unsigned char*)WT + ((size_t)(drow0 + n * dstep) * K + k0) * (F8 ? 1 : 2) + 16 * c) = o; }
    LDS_WAIT(); asm volatile("" ::: "memory");
}

__device__ __forceinline__ float row_copy_ss(const float* xrow, bf16_t* orow, int lane) {
    const f32x4* xr = (const f32x4*)xrow + lane; u32x2* o8 = (u32x2*)orow + lane;
    float s = 0.f;
#pragma unroll
    for (int j = 0; j < 8; ++j) { const f32x4 v = xr[64 * j]; s += (v.x * v.x + v.y * v.y) + (v.z * v.z + v.w * v.w); u32x2 w; w.x = cvt_pk_bf16(v.x, v.y); w.y = cvt_pk_bf16(v.z, v.w); o8[64 * j] = w; }
    return wave_sum(s);
}

struct ItemDesc { const float* W; void* WT; const float* gk; int K, N, drow0, dstep, k0, n0; bool useg; };
template <bool F8, class Dec> __device__ __forceinline__ void conv_loop(int first, int end, int stride, const Dec& dec, LAS unsigned char* scr, int lane) {
    int it = first; if (it >= end) return;
    TrItem<F8> A, B; ItemDesc da, db;
    dec(it, da); tr_load<F8>(A, da.W, da.N, da.k0, da.n0, lane, da.gk, da.useg);
    for (;;) {
        int nx = it + stride; bool hn = nx < end; dec(hn ? nx : it, db); tr_load<F8>(B, db.W, db.N, db.k0, db.n0, lane, db.gk, db.useg);
        tr_store<F8>(A, da.WT, da.K, da.drow0, da.dstep, da.k0, scr, lane);
        if (!hn) break; it = nx;
        nx = it + stride; hn = nx < end; dec(hn ? nx : it, da); tr_load<F8>(A, da.W, da.N, da.k0, da.n0, lane, da.gk, da.useg);
        tr_store<F8>(B, db.WT, db.K, db.drow0, db.dstep, db.k0, scr, lane);
        if (!hn) break; it = nx;
    }
}
constexpr int MOE_J = 8;
#ifndef CONV_NUM
#define CONV_NUM 12
#endif
struct DecMoe {
    volatile LAS unsigned* LW; int cbase, wave, blk;
    __device__ __forceinline__ int item(int q) const { return (q / MOE_J) * blk + cbase + (q % MOE_J) * 8 + wave; }
    __device__ __forceinline__ unsigned long long ptr(int i) const { return (unsigned long long)(unsigned)__builtin_amdgcn_readfirstlane((int)LW[64 + 2 * i]) | ((unsigned long long)(unsigned)__builtin_amdgcn_readfirstlane((int)LW[64 + 2 * i + 1]) << 32); }
    __device__ __forceinline__ void operator()(int q, ItemDesc& d) const {
        constexpr int PER = 3584; const int it = item(q);
        const int mat = it / PER, r = it - mat * PER, e = mat & 7, kind = mat >> 3;
        const bool up_ = kind < 2;
        const int nblk = up_ ? 224 : 64, kb = r / nblk, nb = r - kb * nblk;
        d.K = up_ ? DM : FFE; d.N = up_ ? FFE : DM; d.n0 = 32 * nb; d.k0 = 128 * kb; d.useg = up_; d.dstep = 1;
        d.drow0 = up_ ? (256 * (d.n0 >> 7) + kind * 128 + (d.n0 & 127)) : d.n0;
        d.W = (const float*)(GAS const float*)ptr(kind == 0 ? 17 : (kind == 1 ? 18 : 19)) + (size_t)e * DM * FFE;
        d.gk = (const float*)(GAS const float*)ptr(12) + DM;
        d.WT = (unsigned char*)(GAS unsigned char*)(ptr(21) + (up_ ? WS_WMGU : WS_WMD)) + (size_t)e * (up_ ? 2 : 1) * FFE * DM;
    }
};
constexpr int MOE_ITEMS = 24 * 3584;
struct DecMoeLin : DecMoe { int first, stride; __device__ __forceinline__ void operator()(int q, ItemDesc& d) const { DecMoe t = *this; t.cbase = first + q * stride; t.wave = 0; t.blk = 0; t.DecMoe::operator()(0, d); } };
struct DecP0 {
    volatile LAS unsigned* LW;
    static constexpr int I_IN = 32 * 160, I_OUT = 32 * 64, I_DG = 32 * 176, I_DD = 88 * 64, J_DG = 16 * 176, J_DD = 44 * 64;
    static constexpr int N16A = 2 * I_IN + 2 * I_OUT, N16B = N16A + (DUP8 ? 0 : 2 * I_DG), N16 = N16B + (DDN8 ? 0 : I_DD);
    static constexpr int N8A = DUP8 ? 2 * J_DG : 0, N8 = N8A + (DDN8 ? J_DD : 0);
    __device__ __forceinline__ unsigned long long ptr(int i) const { return (unsigned long long)(unsigned)__builtin_amdgcn_readfirstlane((int)LW[64 + 2 * i]) | ((unsigned long long)(unsigned)__builtin_amdgcn_readfirstlane((int)LW[64 + 2 * i + 1]) << 32); }
    __device__ __forceinline__ const float* inf(int i) const { return (const float*)(GAS const float*)ptr(i); }
    __device__ __forceinline__ unsigned char* wsp(size_t off) const { return (unsigned char*)(GAS unsigned char*)(ptr(21) + off); }
    __device__ __forceinline__ void fin(ItemDesc& d, int r, int mode, int kt) const {
        const int nblk = d.N / 32, kb = r / nblk, nb = r - kb * nblk; d.n0 = 32 * nb; d.k0 = kt * kb;
        d.drow0 = mode == 0 ? d.n0 : (256 * (d.n0 >> 7) + (mode - 1) * 128 + (d.n0 & 127)); d.dstep = 1;
        if (mode == 3) { const int dd = d.n0 & 127; d.drow0 = (d.n0 & ~127) + (dd < 64 ? 2 * dd : 2 * (dd - 64) + 1); d.dstep = 2; } }
};
struct DecP0b16 : DecP0 {
    __device__ __forceinline__ void operator()(int it, ItemDesc& d) const {
        int r = it, mode = 0; d.K = DM; d.useg = false; d.gk = inf(2);
        if (r < 2 * I_IN) { const int l = r / I_IN; r -= l * I_IN; d.W = inf(3) + (size_t)l * DM * INW; d.WT = wsp(WS_WIN) + (size_t)l * INW * DM * 2; d.N = INW; d.gk = inf(2) + l * DM; d.useg = true;
                            if ((r % (INW / 32)) * 32 < ZV) mode = 3; }
        else if (r < N16A) { r -= 2 * I_IN; const int l = r / I_OUT; r -= l * I_OUT; d.W = inf(11) + (size_t)l * DM * DM; d.WT = wsp(WS_WOUT) + (size_t)l * DM * DM * 2; d.N = DM; }
        else if (r < N16B) { r -= N16A; mode = 1 + r / I_DG; r -= (mode - 1) * I_DG; d.W = mode == 1 ? inf(13) : inf(14); d.WT = wsp(WS_WDGU); d.N = FFD; d.gk = inf(12); d.useg = true; }
        else { r -= N16B; d.W = inf(15); d.WT = wsp(WS_WDD); d.K = FFD; d.N = DM; }
        fin(d, r, mode == 3 ? 3 : mode, 64);
    }
};
struct DecP0f8 : DecP0 {
    __device__ __forceinline__ void operator()(int it, ItemDesc& d) const {
        int r = it, mode = 0; d.useg = false; d.gk = inf(12);
        if (r < N8A) { mode = 1 + r / J_DG; r -= (mode - 1) * J_DG; d.W = mode == 1 ? inf(13) : inf(14); d.WT = wsp(WS_WDGU); d.K = DM; d.N = FFD; d.useg = true; }
        else { r -= N8A; d.W = inf(15); d.WT = wsp(WS_WDD); d.K = FFD; d.N = DM; }
        fin(d, r, mode, 128);
    }
};
__device__ __forceinline__ void moe_conv_slots(volatile LAS unsigned* LW, LAS unsigned char* lds, int slot0, int nsl, int bx, int G) {
    const int tid = ltid(), lane = tid & 63, wave = __builtin_amdgcn_readfirstlane(tid >> 6), gw = bx * 8 + wave, NGW = G * 8;
#pragma unroll 1
    for (int q = 0; q < 2; ++q) {
        const int first = (slot0 * NGW + gw) * 2 + q, stride = 2 * NGW;
        int cnt = first < MOE_ITEMS ? (MOE_ITEMS - 1 - first) / stride + 1 : 0; cnt = cnt < nsl ? cnt : nsl;
        const DecMoeLin dec{{LW, 0, 0, 0}, first, stride};
        conv_loop<true>(0, cnt, 1, dec, lds + 1024 + wave * 4608, lane);
    }
}

struct Args { const void* in[20]; float* out; unsigned char* ws; };

__global__ void __launch_bounds__(512, 2) hybrid_fwd(Args args) {
    extern __shared__ __attribute__((aligned(16))) unsigned char lds_raw[];
    LAS unsigned char* lds = (LAS unsigned char*)lds_raw;
    volatile LAS unsigned* LW = (volatile LAS unsigned*)(lds + LDSCTL_OFF);
    const int tid = threadIdx.x, lane = tid & 63, wave = __builtin_amdgcn_readfirstlane(tid >> 6);
    const int G = gridDim.x, bx = blockIdx.x;
    const int gw = bx * 8 + wave, NGW = G * 8;
    for (int u = tid; u < LDSCTL_BYTES / 4; u += 512) LW[u] = 0u;
    __syncthreads();
    if (lane == 0) LW[128 + ((unsigned)__builtin_amdgcn_s_getreg((5 << 11) | 4) & 63u)] = (unsigned)wave;
    if (tid < 22) { const unsigned long long pv = tid < 20 ? (unsigned long long)args.in[tid] : (tid == 20 ? (unsigned long long)args.out : (unsigned long long)args.ws);
        LW[64 + 2 * tid] = (unsigned)pv; LW[64 + 2 * tid + 1] = (unsigned)(pv >> 32); }
    __syncthreads();
#define PTR(i) ((unsigned long long)(unsigned)__builtin_amdgcn_readfirstlane((int)LW[64 + 2 * (i)]) | ((unsigned long long)(unsigned)__builtin_amdgcn_readfirstlane((int)LW[64 + 2 * (i) + 1]) << 32))
#define INF(i) ((const float*)(GAS const float*)PTR(i))
#define WSP(T, off) ((T*)(GAS T*)(PTR(21) + (unsigned long long)(off)))
#define OUTP ((float*)(GAS float*)PTR(20))
    { const XcdBarrier b0 = xcd_barrier_post(WSP(unsigned, WS_CTL) + CW_BAR, LW); if (threadIdx.x == 0) LW[2] = b0.x; }
    __syncthreads();
#define GRID_BAR_T(F) do { XcdBarrier b_; b_.bar = WSP(unsigned, WS_CTL) + CW_BAR; b_.x = (unsigned)__builtin_amdgcn_readfirstlane((int)LW[2]); b_.st = LW; xcd_barrier<F>(b_); } while (0)
#define GRID_BAR() GRID_BAR_T(false)

    unsigned long long tacc_ = 0ull, tph_ = 0ull; (void)tacc_; (void)tph_;
#define PH_BEGIN() do { if (PROBE_MASK) tph_ = __builtin_amdgcn_s_memrealtime(); } while (0)
#define PH_END(id) do { if (PROBE_MASK & (1u << (id))) tacc_ += __builtin_amdgcn_s_memrealtime() - tph_; } while (0)
    PH_BEGIN();
    for (int rep_ = 0; rep_ < REP_P0; ++rep_) {
        LAS float* scr = (LAS float*)(lds + 1024 + wave * 17152);
        unsigned char* ws = WSP(unsigned char, 0);
        {
            LAS unsigned char* tscr = lds + 1024 + wave * 4608;
            DecP0b16 d16; d16.LW = LW; conv_loop<false>(gw, DecP0::I_IN, NGW, d16, tscr, lane);
        }
        {
            const int* positions = (const int*)(GAS const int*)PTR(1); float* cosT = (float*)(ws + WS_COS); float* sinT = (float*)(ws + WS_SIN);
            for (int idx = (bx * 512 + tid); idx < NTOK * 64; idx += G * 512) {
                const int t = idx >> 6, i = idx & 63;
                const float inv = 1.0f / powf(10000.0f, (float)(2 * i) / 128.0f);
                const float ang = (float)positions[t] * inv;
                double rev = (double)ang * 0.15915494309189535; rev -= rint(rev);
                const float rf = (float)rev;
                cosT[idx] = __builtin_amdgcn_cosf(rf); sinT[idx] = __builtin_amdgcn_sinf(rf);
            }
        }
        {
            const float* w_pool = INF(8); bf16_t* wpt = (bf16_t*)(ws + WS_WPT);
            for (int idx = (bx * 512 + tid); idx < 2 * 4 * 128 * 128; idx += G * 512) {
                const int c = idx & 127, d = (idx >> 7) & 127, lg = idx >> 14;
                const float v = w_pool[((size_t)lg * 128 + c) * 128 + d];
                wpt[idx] = (bf16_t)(cvt_pk_bf16(v, 0.f) & 0xffffu);
            }
        }
        {
            const float* x_in = INF(0); bf16_t* xb = (bf16_t*)(ws + WS_XR); float* ss0 = (float*)(ws + WS_SS);
            for (int m = gw; m < NTOK; m += NGW) { const float s = row_copy_ss(x_in + (size_t)m * DM, xb + (size_t)m * DM, lane); if (lane < 8) ss0[(size_t)m * 8 + lane] = lane == 0 ? s : 0.f; }
        }
    }
    GRID_BAR_T(true); PH_END(0); PH_BEGIN();

    constexpr int BG_P1 = 5, BG_P5 = 2, BG_DU = 11, BG_DD = 2, BG_L1 = BG_P1 + BG_P5 + BG_DU + BG_DD, BG_ALL = BG_L1 + BG_P1 + BG_P5;
    for (int l = 0; l < DEPTH; ++l) {
#define PHASE_IDS() const int tid = ltid(), lane = tid & 63, wave = __builtin_amdgcn_readfirstlane(tid >> 6), gw = bx * 8 + wave; (void)tid; (void)lane; (void)wave; (void)gw
        if (l == 0) {
            const int NCV = (G * CONV_NUM / 32) & ~7;
            if (bx < NCV) {
                PHASE_IDS();
                LAS unsigned char* tscr = lds + 1024 + wave * 4608; const int NGC = NCV * 8;
                { DecP0b16 d16; d16.LW = LW; conv_loop<false>(DecP0::I_IN + gw, DecP0::N16, NGC, d16, tscr, lane); }
                if (DecP0::N8 > 0) { DecP0f8 d8; d8.LW = LW; conv_loop<true>(gw, DecP0::N8, NGC, d8, tscr, lane); }
                { const DecMoe dm{LW, bx * 8 * MOE_J, wave, NGC * MOE_J}; int cnt = 0; while (dm.item(cnt) < MOE_ITEMS) ++cnt; conv_loop<true>(0, cnt, 1, dm, tscr, lane); }
            } else {
                pg8::Gemm g{WSP(bf16_t, WS_XR), WSP(bf16_t, WS_WIN), DM * 2, 0};
                pg8::StaticOrder S; S.init(NTOK / 256, INW / 256, G - NCV, bx - NCV);
                pg8::EpiZ E{WSP(bf16_t, WS_Z), INW, WSP(float, WS_SS), INF(4), INF(5), WSP(float, WS_COS), WSP(float, WS_SIN), (LAS float*)(lds + 1024)};
                pg8::gemm_phase<pg8::EpiZ, pg8::StaticOrder>(lds + RING_OFF, g, S, E);
            }
        } else
        for (int rep_ = 0; rep_ < REP_P1; ++rep_) {
            const int pos_ = BG_SPLIT ? (bx >> 3) % (BG_P1 + 1) : 0;
            for (int part_ = 0; part_ < 2; ++part_) {
            pg8::Gemm g{WSP(bf16_t, WS_XR), WSP(bf16_t, WS_WIN) + (size_t)l * INW * DM, DM * 2, 0};
            pg8::StaticOrder S; S.init(NTOK / 256, INW / 256, G, bx, part_ ? pos_ : 0, part_ ? (1 << 30) : pos_);
            pg8::EpiZ E{WSP(bf16_t, WS_Z), INW, WSP(float, WS_SS) + (size_t)(l == 0 ? 0 : 2) * NTOK * 8, INF(4) + l * 128, INF(5) + l * 128, WSP(float, WS_COS), WSP(float, WS_SIN), (LAS float*)(lds + 1024)};
            pg8::gemm_phase<pg8::EpiZ, pg8::StaticOrder>(lds + RING_OFF, g, S, E);
            if (BG_SPLIT && part_ == 0) { moe_conv_slots(LW, lds, l == 0 ? 0 : BG_L1, BG_P1, bx, G); __syncthreads(); }
            }
        }
        GRID_BAR(); PH_END(1); PH_BEGIN();
        for (int rep_ = 0; rep_ < REP_P3; ++rep_) {
            constexpr int NITEM = 512;
            char* alds = (char*)lds_raw + RING_OFF;
            int L = bx;
            if (L < NITEM) {
                const bf16_t* zb = WSP(bf16_t, WS_Z); bf16_t* ao = WSP(bf16_t, WS_AO);
#define ATT_REF(ref, LL, pass) do { const int xcd_ = (LL) & 7, k_ = (LL) >> 3, bh_ = (k_ >> 4) * 8 + xcd_, b_ = bh_ >> 2, h_ = bh_ & 3, vh_ = (k_ & 15) >> 2, mp_ = vh_ >> 1, vj_ = vh_ & 1, x_ = k_ & 3; \
                    const int qb_ = (pass) ? 7 - x_ : x_; const bf16_t* zb_ = zb + (size_t)b_ * SEQ * INW; \
                    (ref).Q = zb_ + (size_t)qb_ * 256 * INW + ZQ + h_ * 256 + mp_ * 128; (ref).K = zb_ + ZK + h_ * 256 + mp_ * 128; (ref).V = zb_ + ZV + h_ * 256 + vj_ * 128; \
                    (ref).O = ao + ((size_t)b_ * SEQ + (size_t)qb_ * 256) * DM + h_ * 512 + mp_ * 256 + vj_ * 128; (ref).P0 = qb_ * 256; } while (0)
#define ATT_ITEMS(ORD) do { att::BlockRef cur, nxt; int pass = 0; \
                ATT_REF(cur, L, 0); \
                att::Seam S; \
                att::causal_prime(cur, alds, S); \
                for (;;) { \
                    const bool more_pass = pass == 0, more_item = L + G < NITEM, last = !more_pass && !more_item; \
                    int passn = pass + 1, Ln = L; \
                    if (!more_pass) { passn = 0; Ln = more_item ? L + G : L; } \
                    if (last) nxt = cur; else ATT_REF(nxt, Ln, passn); \
                    att::causal_block<ORD>(cur, nxt, SEQ, alds, S); \
                    if (last) break; \
                    cur = nxt; pass = passn; L = Ln; \
                } } while (0)
                if (__builtin_amdgcn_readfirstlane(ltid() >> 8)) { __builtin_amdgcn_s_setprio(1); ATT_ITEMS(0); }
                else { ATT_ITEMS(1); }
#undef ATT_ITEMS
                __builtin_amdgcn_s_setprio(0);
#undef ATT_REF
            }
        }
        GRID_BAR(); PH_END(3); PH_BEGIN();
        if (PH_MASK & (1 << 2)) {
            PHASE_IDS();
            bf16_t* zb = WSP(bf16_t, WS_Z); bf16_t* mix = WSP(bf16_t, WS_MIX);
            {
            const float* qg = INF(4) + l * 128; const float* kg = INF(5) + l * 128;
            const float* cw = INF(10) + (size_t)l * 3 * 512;
            const float* cosT = WSP(float, WS_COS); const float* sinT = WSP(float, WS_SIN);
            {
                const int ch = 8 * lane;
                f32x4 wk[3][2];
#pragma unroll
                for (int j = 0; j < 3; ++j) { wk[j][0] = *(const f32x4*)(cw + j * 512 + ch); wk[j][1] = *(const f32x4*)(cw + j * 512 + ch + 4); }
                for (int grp = gw; grp < NTOK / 8; grp += NGW) {
                    const int t0 = 8 * grp, tb0 = t0 & (SEQ - 1);
                    u32x4 gbv[8], gcv[10], hv[10];
#pragma unroll
                    for (int i = 0; i < 10; ++i) { const int tt = t0 - 2 + i, tc = tt < 0 ? 0 : tt; const bf16_t* zr = zb + (size_t)tc * INW; gcv[i] = *(const u32x4*)(zr + ZGC + ch); hv[i] = *(const u32x4*)(zr + ZH + ch);
                        if (i >= 2) gbv[i - 2] = *(const u32x4*)(zr + ZGB + ch); }
                    float u[10][8];
#pragma unroll
                    for (int i = 0; i < 10; ++i) { const bool ok = (i >= 2) || (tb0 - 2 + i >= 0);
#pragma unroll
                        for (int j = 0; j < 4; ++j) { u[i][2 * j] = ok ? bflo(gcv[i][j]) * bflo(hv[i][j]) : 0.f; u[i][2 * j + 1] = ok ? bfhi(gcv[i][j]) * bfhi(hv[i][j]) : 0.f; } }
#pragma unroll
                    for (int i = 0; i < 8; ++i) { u32x4 w;
#pragma unroll
                        for (int j = 0; j < 4; ++j) { const int c0 = 2 * j, c1 = 2 * j + 1;
                            const float y0 = wk[0][c0 >> 2][c0 & 3] * u[i][c0] + wk[1][c0 >> 2][c0 & 3] * u[i + 1][c0] + wk[2][c0 >> 2][c0 & 3] * u[i + 2][c0];
                            const float y1 = wk[0][c1 >> 2][c1 & 3] * u[i][c1] + wk[1][c1 >> 2][c1 & 3] * u[i + 1][c1] + wk[2][c1 >> 2][c1 & 3] * u[i + 2][c1];
                            w[j] = cvt_pk_bf16(bflo(gbv[i][j]) * y0, bfhi(gbv[i][j]) * y1); }
                        *(u32x4*)(mix + (size_t)(t0 + i) * DM + 1536 + ch) = w; }
                }
            }
            }
            {
            const bf16_t* wpt = WSP(bf16_t, WS_WPT); const float* pool_scale = INF(9) + l * 512;
            const unsigned ptile = (unsigned)(uintptr_t)lds + (unsigned)(RING_OFF + wave * 12800);
            for (int it = gw; it < (NTOK / 32) * 4; it += NGW) {
                const int T = it >> 2, gi = it & 3, wn = 2 << gi, t0 = T * 32, tb0 = t0 & (SEQ - 1);
                const int r32 = lane & 31, hi = lane >> 5, tb = tb0 + r32;
                const float inv = 1.0f / (float)((tb + 1) < wn ? (tb + 1) : wn);
                const bf16_t* wp = wpt + ((size_t)(l * 4 + gi) * 128) * 128;
                {
                    u32x4 tv[12];
#pragma unroll
                    for (int n = 0; n < 12; ++n) { const int q = lane + 64 * n, row = q >> 4, c16 = q & 15; int tt = t0 - 15 + row; tt = tt < 0 ? 0 : (tt < NTOK ? tt : NTOK - 1);
                        tv[n] = *(const u32x4*)(zb + (size_t)tt * INW + ZP + gi * 128 + c16 * 8); }
#pragma unroll
                    for (int n = 0; n < 12; ++n) { const int q = lane + 64 * n, row = q >> 4, c16 = q & 15; const bool ok = (tb0 - 15 + row) >= 0;
                        if (row < 47) *(LAS u32x4*)(uintptr_t)(ptile + row * 272 + c16 * 16) = ok ? tv[n] : (u32x4){0u, 0u, 0u, 0u}; }
                    LDS_WAIT(); asm volatile("" ::: "memory");
                }
                f32x16 acc[4];
#pragma unroll
                for (int nb = 0; nb < 4; ++nb) acc[nb] = f32x16{};
                bf16x8 bcur[4];
#pragma unroll
                for (int nb = 0; nb < 4; ++nb) bcur[nb] = *(const bf16x8*)(wp + (size_t)(nb * 32 + r32) * 128 + 8 * hi);
                const unsigned rbase = ptile + (unsigned)((r32 + 15) * 272 + 16 * hi);
#pragma unroll 1
                for (int s = 0; s < 8; ++s) {
                    const int sn = s < 7 ? s + 1 : 7;
                    bf16x8 bnxt[4];
#pragma unroll
                    for (int nb = 0; nb < 4; ++nb) bnxt[nb] = *(const bf16x8*)(wp + (size_t)(nb * 32 + r32) * 128 + 16 * sn + 8 * hi);
                    float sum[8], self[8];
#pragma unroll
                    for (int j = 0; j < 8; ++j) { sum[j] = 0.f; self[j] = 0.f; }
                    u32x4 rv[16];
#pragma unroll
                    for (int d = 0; d < 16; ++d) { rv[d] = (u32x4){0u, 0u, 0u, 0u}; if (d < wn) rv[d] = *(const LAS u32x4*)(uintptr_t)(rbase + (unsigned)(32 * s) - (unsigned)(272 * d)); }
#pragma unroll
                    for (int d = 0; d < 16; ++d) {
#pragma unroll
                        for (int j = 0; j < 4; ++j) { const float a = bflo(rv[d][j]), b = bfhi(rv[d][j]); sum[2 * j] += a; sum[2 * j + 1] += b; if (d == 0) { self[2 * j] = a; self[2 * j + 1] = b; } }
                    }
                    u32x4 aw;
#pragma unroll
                    for (int j = 0; j < 4; ++j) aw[j] = cvt_pk_bf16(sum[2 * j] * inv - self[2 * j], sum[2 * j + 1] * inv - self[2 * j + 1]);
                    const bf16x8 af = __builtin_bit_cast(bf16x8, aw);
#pragma unroll
                    for (int nb = 0; nb < 4; ++nb) { acc[nb] = __builtin_amdgcn_mfma_f32_32x32x16_bf16(af, bcur[nb], acc[nb], 0, 0, 0); bcur[nb] = bnxt[nb]; }
                }
#pragma unroll
                for (int nb = 0; nb < 4; ++nb) { const int col = gi * 128 + nb * 32 + r32; const float ps = pool_scale[col];
#pragma unroll
                    for (int r = 0; r < 16; ++r) { const int row = (r & 3) + 8 * (r >> 2) + 4 * hi; const float v = acc[nb][r] * ps, vn = lx1(v);
                        if ((r32 & 1) == 0) *(unsigned*)(mix + (size_t)(t0 + row) * DM + 1024 + col) = cvt_pk_bf16(v, vn); } }
                LDS_WAIT(); asm volatile("" ::: "memory");
            }
            }
        }
        if (PH_MASK & (1 << 4)) {
            PHASE_IDS();
            const float lam_init = (l == 0) ? 0.2f : 0.35550906759096926f;
            const float* lv = INF(6) + (size_t)l * 512;
            const float d01 = wave_sum(lv[lane] * lv[128 + lane] + lv[64 + lane] * lv[192 + lane]);
            const float d23 = wave_sum(lv[256 + lane] * lv[384 + lane] + lv[320 + lane] * lv[448 + lane]);
            const float lam = expf(d01) - expf(d23) + lam_init;
            const float oscale = 1.0f - lam_init;
            const int h = lane >> 4, e0 = (lane & 15) * 16;
            const float* sg = INF(7) + l * 256 + e0;
            const bf16_t* ao = WSP(bf16_t, WS_AO); bf16_t* mix = WSP(bf16_t, WS_MIX);
            float sgv[16];
#pragma unroll
            for (int j = 0; j < 16; ++j) sgv[j] = sg[j];
            for (int tb_ = gw; tb_ < NTOK; tb_ += 4 * NGW) {
                u32x4 av[4][2], bv[4][2];
#pragma unroll
                for (int q2 = 0; q2 < 4; ++q2) { int t = tb_ + q2 * NGW; t = t < NTOK ? t : NTOK - 1;
                    const bf16_t* o0 = ao + (size_t)t * DM + h * 512 + e0; const bf16_t* o1 = o0 + 256;
#pragma unroll
                    for (int j = 0; j < 2; ++j) { av[q2][j] = *(const u32x4*)(o0 + 8 * j); bv[q2][j] = *(const u32x4*)(o1 + 8 * j); } }
#pragma unroll
                for (int q2 = 0; q2 < 4; ++q2) { const int t = tb_ + q2 * NGW; if (t < NTOK) {
                float dv[16]; float ss = 0.f;
#pragma unroll
                for (int j = 0; j < 2; ++j) { const u32x4 a = av[q2][j], b = bv[q2][j];
#pragma unroll
                    for (int q = 0; q < 4; ++q) { const float d0_ = bflo(a[q]) - lam * bflo(b[q]), d1_ = bfhi(a[q]) - lam * bfhi(b[q]); dv[8 * j + 2 * q] = d0_; dv[8 * j + 2 * q + 1] = d1_; ss += d0_ * d0_ + d1_ * d1_; } }
                ss = row16_sum(ss);
                const float rstd = oscale / sqrtf(ss * (1.0f / 256.0f) + EPS);
                u32x4 w0, w1;
#pragma unroll
                for (int j = 0; j < 4; ++j) { w0[j] = cvt_pk_bf16(dv[2 * j] * rstd * sgv[2 * j], dv[2 * j + 1] * rstd * sgv[2 * j + 1]);
                                              w1[j] = cvt_pk_bf16(dv[8 + 2 * j] * rstd * sgv[8 + 2 * j], dv[8 + 2 * j + 1] * rstd * sgv[8 + 2 * j + 1]); }
                bf16_t* mp = mix + (size_t)t * DM + h * 256 + e0;
                *(u32x4*)mp = w0; *(u32x4*)(mp + 8) = w1; } }
            }
        }
        GRID_BAR(); PH_END(4); PH_BEGIN();
        if (PH_MASK & (1 << 5)) {
            const int pos_ = BG_SPLIT ? (bx >> 3) % (BG_P5 + 1) : 0;
            for (int part_ = 0; part_ < 2; ++part_) {
            pg8::Gemm g{WSP(bf16_t, WS_MIX), WSP(bf16_t, WS_WOUT) + (size_t)l * DM * DM, DM * 2, 0};
            pg8::StaticOrder S; S.init(NTOK / 256, DM / 256, G, bx, part_ ? pos_ : 0, part_ ? (1 << 30) : pos_);
            pg8::EpiResF32 E{INF(0), WSP(bf16_t, WS_XR), DM, WSP(unsigned char, WS_XN), WSP(float, WS_SS) + (size_t)(l == 0 ? 1 : 3) * NTOK * 8, 0  , l == 0 ? (int)DUP8 : 1, (LAS float*)(lds + 1024)};
            pg8::gemm_phase<pg8::EpiResF32, pg8::StaticOrder>(lds + RING_OFF, g, S, E);
            if (BG_SPLIT && part_ == 0) { moe_conv_slots(LW, lds, (l == 0 ? 0 : BG_L1) + BG_P1, BG_P5, bx, G); __syncthreads(); }
            }
        }
        GRID_BAR(); PH_END(5); PH_BEGIN();
        if (l == 0 && (PH_MASK & (1 << 6))) {
            {
                const int pos_ = BG_SPLIT ? (bx >> 3) % (BG_DU + 1) : 0;
                for (int part_ = 0; part_ < 2; ++part_) {
                pg8::Gemm g{DUP8 ? WSP(unsigned char, WS_XN) : WSP(unsigned char, WS_XR), WSP(unsigned char, WS_WDGU), DUP8 ? DM : 2 * DM, 0};
                pg8::StaticOrder S; S.init(NTOK / 256, 2 * FFD / 256, G, bx, part_ ? pos_ : 0, part_ ? (1 << 30) : pos_);
                const float* ss1 = WSP(float, WS_SS) + (size_t)NTOK * 8;
                if constexpr (DDN8) { pg8::EpiSwigluF8<1> E{WSP(unsigned char, WS_ACTD), FFD, ss1};
                    pg8::gemm_phase<pg8::EpiSwigluF8<1>, pg8::StaticOrder, (bool)DUP8, DUP8 ? SC_W : SC_ONE, SC_ONE>(lds + RING_OFF, g, S, E); }
                else { pg8::EpiSwiglu<1> E{WSP(bf16_t, WS_ACTD), FFD, ss1};
                    pg8::gemm_phase<pg8::EpiSwiglu<1>, pg8::StaticOrder, (bool)DUP8, DUP8 ? SC_W : SC_ONE, SC_ONE>(lds + RING_OFF, g, S, E); }
                if (BG_SPLIT && part_ == 0) { moe_conv_slots(LW, lds, BG_P1 + BG_P5, BG_DU, bx, G); __syncthreads(); }
                }
            }
            GRID_BAR(); PH_END(6); PH_BEGIN();
            {
                const int pos_ = BG_SPLIT ? (bx >> 3) % (BG_DD + 1) : 0;
                for (int part_ = 0; part_ < 2; ++part_) {
                pg8::Gemm g{WSP(unsigned char, WS_ACTD), WSP(unsigned char, WS_WDD), DDN8 ? FFD : 2 * FFD, 0};
                pg8::StaticOrder S; S.init(NTOK / 256, DM / 256, G, bx, part_ ? pos_ : 0, part_ ? (1 << 30) : pos_);
                pg8::EpiResF32 E{nullptr, WSP(bf16_t, WS_XR), DM, nullptr, WSP(float, WS_SS) + (size_t)2 * NTOK * 8, 0, 0, (LAS float*)(lds + 1024)};
                pg8::gemm_phase<pg8::EpiResF32, pg8::StaticOrder, (bool)DDN8, DDN8 ? SC_W : SC_ONE, DDN8 ? SC_A : SC_ONE>(lds + RING_OFF, g, S, E);
                if (BG_SPLIT && part_ == 0) { moe_conv_slots(LW, lds, BG_P1 + BG_P5 + BG_DU, BG_DD, bx, G); __syncthreads(); }
                }
            }
            GRID_BAR(); PH_END(7); PH_BEGIN();
        } else if (PH_MASK & (1 << 7)) {
            const int TPW = (NTOK + G - 1) / G;
            {
                PHASE_IDS();
                if (BG_SPLIT) { int nrem = 0; while ((BG_ALL + nrem) * (G * 8) * 2 < 24 * 3584) ++nrem; if (nrem) { moe_conv_slots(LW, lds, BG_ALL, nrem, bx, G); __syncthreads(); } }
                if (tid < 8) LW[LW_CNT + tid] = 0u;
                LAS float* RT = (LAS float*)(lds + RING_OFF);
                { const float* router_w = INF(16); const float* gn = INF(12) + DM;
                  for (int k = tid; k < DM; k += 512) { const f32x4 ra = *(const f32x4*)(router_w + (size_t)k * 8), rb = *(const f32x4*)(router_w + (size_t)k * 8 + 4); const float gk = gn[k];
                      RT[0 * DM + k] = ra[0] * gk; RT[1 * DM + k] = ra[1] * gk; RT[2 * DM + k] = ra[2] * gk; RT[3 * DM + k] = ra[3] * gk;
                      RT[4 * DM + k] = rb[0] * gk; RT[5 * DM + k] = rb[1] * gk; RT[6 * DM + k] = rb[2] * gk; RT[7 * DM + k] = rb[3] * gk; } }
                __syncthreads();
                const bf16_t* xrs = WSP(bf16_t, WS_XR); const float* ss3 = WSP(float, WS_SS) + (size_t)3 * NTOK * 8;
                int* tokE = WSP(int, WS_TOKE); int* tokR = WSP(int, WS_TOKR); float* tokG = WSP(float, WS_TOKG);
                const int tlo = bx * TPW, thi = (tlo + TPW) < NTOK ? (tlo + TPW) : NTOK;
                for (int tq = tlo + wave; tq < thi; tq += 32) {
                    float rstd[4]; f32x4 xv[4][8];
#pragma unroll
                    for (int q = 0; q < 4; ++q) { int t = tq + 8 * q; t = t < thi ? t : thi - 1;
                        rstd[q] = ss_rstd(ss3 + (size_t)t * 8);
                        const u32x2* xr = (const u32x2*)(xrs + (size_t)t * DM) + lane;
#pragma unroll
                        for (int j = 0; j < 8; ++j) { const u32x2 w = xr[64 * j]; xv[q][j] = (f32x4){bflo(w.x), bfhi(w.x), bflo(w.y), bfhi(w.y)}; } }
                    float lg[4][8];
#pragma unroll
                    for (int e = 0; e < 8; ++e) { float a[4] = {0.f, 0.f, 0.f, 0.f};
#pragma unroll
                        for (int j = 0; j < 8; ++j) { const f32x4 rv = *(const LAS f32x4*)(RT + e * DM + 256 * j + 4 * lane);
#pragma unroll
                            for (int q = 0; q < 4; ++q) a[q] += (xv[q][j][0] * rv[0] + xv[q][j][1] * rv[1]) + (xv[q][j][2] * rv[2] + xv[q][j][3] * rv[3]); }
#pragma unroll
                        for (int q = 0; q < 4; ++q) lg[q][e] = wave_sum(a[q]) * rstd[q]; }
#pragma unroll
                    for (int q = 0; q < 4; ++q) { const int t = tq + 8 * q;
                        if (lane == 0 && t < thi) {
                            int e0 = 0; float v0 = lg[q][0];
#pragma unroll
                            for (int e = 1; e < 8; ++e) if (lg[q][e] > v0) { v0 = lg[q][e]; e0 = e; }
                            int e1 = -1; float v1 = -3.0e38f;
#pragma unroll
                            for (int e = 0; e < 8; ++e) if (e != e0 && lg[q][e] > v1) { v1 = lg[q][e]; e1 = e; }
                            const float ex = expf(v1 - v0), g0 = 1.0f / (1.0f + ex), g1 = ex / (1.0f + ex);
                            const int r0 = (int)atomicAdd((unsigned*)(lds_raw + LDSCTL_OFF) + LW_CNT + e0, 1u);
                            const int r1 = (int)atomicAdd((unsigned*)(lds_raw + LDSCTL_OFF) + LW_CNT + e1, 1u);
                            tokE[2 * t] = e0; tokE[2 * t + 1] = e1; tokR[2 * t] = r0; tokR[2 * t + 1] = r1; tokG[2 * t] = g0; tokG[2 * t + 1] = g1;
                        } }
                }
                __syncthreads();
                if (tid < 8) WSP(int, WS_CNTWG)[bx * 8 + tid] = (int)LW[LW_CNT + tid];
            }
            GRID_BAR(); PH_END(8); PH_BEGIN();
            {
                PHASE_IDS();
                if (tid < 8) { LW[LW_TOT + tid] = 0u; LW[LW_PRE + tid] = 0u; }
                __syncthreads();
                {
                const int* cntWG = WSP(int, WS_CNTWG);
                for (int j0 = wave * 64; j0 < G; j0 += 512) { const int j = j0 + lane; const bool ok = j < G; const int jc = ok ? j : 0;
                    const i32x4 ca = *(const i32x4*)(cntWG + jc * 8), cb = *(const i32x4*)(cntWG + jc * 8 + 4);
                    unsigned* lw = (unsigned*)(lds_raw + LDSCTL_OFF);
#pragma unroll
                    for (int e = 0; e < 8; ++e) { const float c = ok ? (float)(e < 4 ? ca[e & 3] : cb[e & 3]) : 0.f;
                        const float tot = wave_sum(c), pre = wave_sum(j < bx ? c : 0.f);
                        if (lane == 0) { atomicAdd(lw + LW_TOT + e, (unsigned)tot); atomicAdd(lw + LW_PRE + e, (unsigned)pre); } }
                }
                }
                __syncthreads();
                if (tid == 0) { unsigned base = 0;
                    for (int e = 0; e < 8; ++e) { const unsigned tot = LW[LW_TOT + e]; LW[LW_BP + e] = base + LW[LW_PRE + e]; LW[LW_TOFF + e] = base >> 8; base += (tot + 255u) & ~255u; }
                    LW[LW_TOFF + 8] = base >> 8; }
                __syncthreads();
                const int* tokE = WSP(int, WS_TOKE); const int* tokR = WSP(int, WS_TOKR); int* tokS = WSP(int, WS_TOKS);
                const float* ss3 = WSP(float, WS_SS) + (size_t)3 * NTOK * 8; float* rslot = WSP(float, WS_RSLOT);
                const unsigned char* xn8 = WSP(unsigned char, WS_XN); unsigned char* hp = WSP(unsigned char, WS_HP);
                const int tlo = bx * TPW, thi = (tlo + TPW) < NTOK ? (tlo + TPW) : NTOK;
                for (int tb_ = tlo + wave; tb_ < thi; tb_ += 16) {
                    int sa[2], sb[2]; u32x4 v[2][2];
#pragma unroll
                    for (int q2 = 0; q2 < 2; ++q2) { int t = tb_ + 8 * q2; t = t < thi ? t : thi - 1;
                        const int e0 = tokE[2 * t], e1 = tokE[2 * t + 1];
                        sa[q2] = (int)LW[LW_BP + e0] + tokR[2 * t]; sb[q2] = (int)LW[LW_BP + e1] + tokR[2 * t + 1];
                        const u32x4* src_ = (const u32x4*)(xn8 + (size_t)t * DM) + lane; v[q2][0] = src_[0]; v[q2][1] = src_[64]; }
#pragma unroll
                    for (int q2 = 0; q2 < 2; ++q2) { const int t = tb_ + 8 * q2; if (t < thi) {
                        const int s0 = sa[q2], s1 = sb[q2];
                        if (lane == 0) { tokS[2 * t] = s0; tokS[2 * t + 1] = s1; const float rstd = ss_rstd(ss3 + (size_t)t * 8); rslot[s0] = rstd; rslot[s1] = rstd; }
                        u32x4* d0 = (u32x4*)(hp + (size_t)s0 * DM) + lane; u32x4* d1 = (u32x4*)(hp + (size_t)s1 * DM) + lane;
                        d0[0] = v[q2][0]; d0[64] = v[q2][1]; d1[0] = v[q2][0]; d1[64] = v[q2][1]; } }
                }
                for (int e = 0; e < 8; ++e) {
                    const int rlo = (int)LW[LW_TOFF + e] * 256 + (int)LW[LW_TOT + e], rhi = (int)LW[LW_TOFF + e + 1] * 256;
                    for (int r = rlo + gw; r < rhi; r += NGW) { if (lane == 0) rslot[r] = 0.f; u32x4* d0 = (u32x4*)(hp + (size_t)r * DM) + lane;
#pragma unroll
                        for (int j = 0; j < 2; ++j) d0[64 * j] = (u32x4){0u, 0u, 0u, 0u}; }
                }
            }
            GRID_BAR(); PH_END(9); PH_BEGIN();
#define RFL(i) __builtin_amdgcn_readfirstlane((int)LW[LW_TOFF + (i)])
#define MOE_TAIL_SP(R, G) ((R) == 0 ? 1 : ((R) * 4 <= (G) ? 4 : ((R) * 2 <= (G) ? 2 : 1)))
            for (int rep_ = 0; rep_ < REP_P7; ++rep_) {
                pg8::Gemm g{WSP(unsigned char, WS_HP), WSP(unsigned char, WS_WMGU), DM, (size_t)2 * FFE * DM};
                pg8::MoeOrder S; S.S.init(RFL(8), 2 * FFE / 256, G, bx);
                S.t1 = RFL(1); S.t2 = RFL(2); S.t3 = RFL(3); S.t4 = RFL(4); S.t5 = RFL(5); S.t6 = RFL(6); S.t7 = RFL(7); S.SP = 1; S.nfull = 0; S.R = 0; S.ntp = 0; S.kbs = 0;
                pg8::EpiSwigluF8<2> E{WSP(unsigned char, WS_ACTM), FFE, WSP(float, WS_RSLOT)};
                pg8::gemm_phase<pg8::EpiSwigluF8<2>, pg8::MoeOrder, true, SC_W, SC_ONE>(lds + RING_OFF, g, S, E);
            }
            GRID_BAR(); PH_END(10); PH_BEGIN();
            {
                pg8::Gemm g{WSP(unsigned char, WS_ACTM), WSP(unsigned char, WS_WMD), FFE, (size_t)DM * FFE};
                pg8::MoeOrder S; S.S.init(RFL(8), DM / 256, G, bx);
                S.t1 = RFL(1); S.t2 = RFL(2); S.t3 = RFL(3); S.t4 = RFL(4); S.t5 = RFL(5); S.t6 = RFL(6); S.t7 = RFL(7);
                { const int nwg_ = RFL(8) * (DM / 256), R_ = nwg_ % G; S.nfull = nwg_ / G; S.R = R_; S.SP = MOE_TAIL_SP(R_, G); S.ntp = (FFE / 128) / S.SP; S.kbs = FFE / S.SP; }
                S.rev = 1;
                pg8::EpiMoeDown E{WSP(bf16_t, WS_Y), DM, WSP(float, WS_PB), WSP(int, WS_TMAP), S.SP};
                pg8::gemm_phase<pg8::EpiMoeDown, pg8::MoeOrder, true, SC_W, SC_A>(lds + RING_OFF, g, S, E);
            }
            GRID_BAR(); PH_END(11); PH_BEGIN();
            {
                PHASE_IDS();
                const int* tokS = WSP(int, WS_TOKS); const float* tokG = WSP(float, WS_TOKG); float* out = OUTP; const bf16_t* yb = WSP(bf16_t, WS_Y); const bf16_t* xrs = WSP(bf16_t, WS_XR);
                const int* tmap = WSP(int, WS_TMAP); const float* PB = WSP(float, WS_PB);
                const int SP = MOE_TAIL_SP((RFL(8) * (DM / 256)) % G, G);
                for (int tb_ = gw; tb_ < NTOK; tb_ += 2 * NGW) {
                    int s0[2], s1[2]; float g0[2], g1[2];
#pragma unroll
                    for (int q2 = 0; q2 < 2; ++q2) { int t = tb_ + q2 * NGW; t = t < NTOK ? t : NTOK - 1; s0[q2] = tokS[2 * t]; s1[q2] = tokS[2 * t + 1]; g0[q2] = tokG[2 * t]; g1[q2] = tokG[2 * t + 1]; }
                    u32x4 ya[2][4], yc[2][4], xw[2][4]; int ea[2][4], ec[2][4];
#pragma unroll
                    for (int q2 = 0; q2 < 2; ++q2) { int t = tb_ + q2 * NGW; t = t < NTOK ? t : NTOK - 1;
                        const u32x4* o = (const u32x4*)(xrs + (size_t)t * DM) + lane; const u32x4* y0 = (const u32x4*)(yb + (size_t)s0[q2] * DM) + lane; const u32x4* y1 = (const u32x4*)(yb + (size_t)s1[q2] * DM) + lane;
#pragma unroll
                        for (int j = 0; j < 4; ++j) { ya[q2][j] = y0[64 * j]; yc[q2][j] = y1[64 * j]; xw[q2][j] = o[64 * j];
                            ea[q2][j] = tmap[(s0[q2] >> 8) * 8 + ((64 * j + lane) >> 5)]; ec[q2][j] = tmap[(s1[q2] >> 8) * 8 + ((64 * j + lane) >> 5)]; } }
#pragma unroll
                    for (int q2 = 0; q2 < 2; ++q2) { const int t = tb_ + q2 * NGW; if (t < NTOK) {
                        f32x4* o = (f32x4*)(out + (size_t)t * DM) + 2 * lane; const float ga = g0[q2], gb = g1[q2];
#pragma unroll
                        for (int j = 0; j < 4; ++j) { const u32x4 a = ya[q2][j], b = yc[q2][j], xx = xw[q2][j]; f32x4 o0 = {bflo(xx[0]), bfhi(xx[0]), bflo(xx[1]), bfhi(xx[1])}, o1 = {bflo(xx[2]), bfhi(xx[2]), bflo(xx[3]), bfhi(xx[3])};
                            f32x4 a0 = {bflo(a[0]), bfhi(a[0]), bflo(a[1]), bfhi(a[1])}, a1 = {bflo(a[2]), bfhi(a[2]), bflo(a[3]), bfhi(a[3])};
                            f32x4 b0 = {bflo(b[0]), bfhi(b[0]), bflo(b[1]), bfhi(b[1])}, b1 = {bflo(b[2]), bfhi(b[2]), bflo(b[3]), bfhi(b[3])};
                            const int cc = (8 * (64 * j + lane)) & 255;
                            if (ea[q2][j]) { a0 = (f32x4){0.f, 0.f, 0.f, 0.f}; a1 = a0;
                                for (int p = 0; p < SP; ++p) { const float* sp = PB + ((size_t)((ea[q2][j] - 1) * SP + p) * 256 + (s0[q2] & 255)) * 256 + cc; a0 += *(const f32x4*)sp; a1 += *(const f32x4*)(sp + 4); } }
                            if (ec[q2][j]) { b0 = (f32x4){0.f, 0.f, 0.f, 0.f}; b1 = b0;
                                for (int p = 0; p < SP; ++p) { const float* sp = PB + ((size_t)((ec[q2][j] - 1) * SP + p) * 256 + (s1[q2] & 255)) * 256 + cc; b0 += *(const f32x4*)sp; b1 += *(const f32x4*)(sp + 4); } }
                            o0 += a0 * ga + b0 * gb; o1 += a1 * ga + b1 * gb;
                            o[128 * j] = o0; o[128 * j + 1] = o1; } } }
                }
            }
#undef RFL
            PH_END(12);
        }
    }
    if (PROBE_MASK) { __syncthreads(); if (threadIdx.x == 0) { const unsigned long long t0_ = __builtin_amdgcn_s_memrealtime(); while (__builtin_amdgcn_s_memrealtime() - t0_ < tacc_) __builtin_amdgcn_s_sleep(8); } __syncthreads(); }
}

extern "C" void kernel_launch(void* const* d_in, const int* in_sizes, int n_in, void* d_out, int out_size, void* d_ws, size_t ws_size, hipStream_t stream) {
    static int grid = 0;
    if (grid == 0) {
        if (n_in != 20 || in_sizes[0] != NTOK * DM || out_size != NTOK * DM || ws_size < WS_END) {
            fprintf(stderr, "kernel_launch: unexpected shapes (n_in %d, in0 %d, out %d, ws %zu < %zu); nothing launched\n", n_in, n_in > 0 ? in_sizes[0] : -1, out_size, ws_size, (size_t)WS_END); grid = -1; return; }
        int dev = 0, cus = 0, per_cu = 0;
        if (hipGetDevice(&dev) != hipSuccess || hipDeviceGetAttribute(&cus, hipDeviceAttributeMultiprocessorCount, dev) != hipSuccess) { grid = -1; return; }
        if (hipFuncSetAttribute((const void*)hybrid_fwd, hipFuncAttributeMaxDynamicSharedMemorySize, LDS_BYTES) != hipSuccess) { fprintf(stderr, "kernel_launch: hipFuncSetAttribute failed\n"); grid = -1; return; }
        if (hipOccupancyMaxActiveBlocksPerMultiprocessor(&per_cu, (const void*)hybrid_fwd, 512, LDS_BYTES) != hipSuccess || per_cu < 1)
            fprintf(stderr, "kernel_launch: note: occupancy query reports %d workgroups per CU\n", per_cu);
        (void)hipGetLastError();
        grid = cus > 512 ? 512 : cus;
    }
    if (grid < 0) return;
    if (hipMemsetAsync((char*)d_ws + WS_CTL, 0, CTL_ZERO_BYTES, stream) != hipSuccess) { fprintf(stderr, "kernel_launch: memset failed\n"); return; }
    Args a{};
    for (int i = 0; i < 20; ++i) a.in[i] = d_in[i];
    a.out = (float*)d_out; a.ws = (unsigned char*)d_ws;
    hipLaunchKernelGGL(hybrid_fwd, dim3(grid), dim3(512), LDS_BYTES, stream, a);
    const hipError_t le = hipPeekAtLastError();
    if (le != hipSuccess) fprintf(stderr, "kernel_launch: launch failed: %s\n", hipGetErrorName(le));
}
```

```cpp
#include <hip/hip_runtime.h>
#include <hip/hip_bf16.h>
#include <cstdio>
#include <cstdint>

#define LAS __attribute__((address_space(3)))
#define GAS __attribute__((address_space(1)))
typedef unsigned short bf16_t;
typedef short bf16x8 __attribute__((ext_vector_type(8)));
typedef short s16x4 __attribute__((ext_vector_type(4)));
typedef float f32x4 __attribute__((ext_vector_type(4)));
typedef float f32x2 __attribute__((ext_vector_type(2)));
typedef float f32x16 __attribute__((ext_vector_type(16)));
typedef unsigned u32x4 __attribute__((ext_vector_type(4)));
typedef unsigned u32x2 __attribute__((ext_vector_type(2)));
typedef int i32x4 __attribute__((ext_vector_type(4)));
typedef int i32x8 __attribute__((ext_vector_type(8)));

constexpr int DM = 2048, NB = 8, SEQ = 2048, NTOK = NB * SEQ, DEPTH = 2;
constexpr int INW = 5120, FFD = 5632, NEXP = 8, FFE = 7168;
constexpr int ZQ = 0, ZK = 1024, ZV = 2048, ZP = 3072, ZGB = 3584, ZGC = 4096, ZH = 4608;
constexpr int MOE_ROWS = NTOK * 2 + NEXP * 256;
constexpr float EPS = 1e-6f;

constexpr size_t MiB = 1u << 20;
constexpr size_t WS_CTL = 0, CTL_ZERO_BYTES = 1 * MiB;
constexpr size_t WS_COS = 1 * MiB, WS_SIN = 5 * MiB;
constexpr size_t WS_WPT = 9 * MiB;
constexpr size_t WS_TOKE = 10 * MiB;
constexpr size_t WS_TOKR = WS_TOKE + 128 * 1024;
constexpr size_t WS_TOKG = WS_TOKR + 128 * 1024;
constexpr size_t WS_TOKS = WS_TOKG + 128 * 1024;
constexpr size_t WS_CNTWG = WS_TOKS + 128 * 1024;
constexpr size_t WS_WIN = 16 * MiB;
constexpr size_t WS_WOUT = WS_WIN + 40 * MiB;
constexpr size_t WS_WDGU = WS_WOUT + 16 * MiB;
constexpr size_t WS_WDD = WS_WDGU + 44 * MiB;
constexpr size_t WS_WMGU = WS_WDD + 22 * MiB;
constexpr size_t WS_WMD = WS_WMGU + 448 * MiB;
constexpr size_t WS_ACT0 = WS_WMD + 224 * MiB;
constexpr size_t WS_Z = WS_ACT0;
constexpr size_t WS_AO = WS_ACT0 + 160 * MiB;
constexpr size_t WS_MIX = WS_ACT0 + 288 * MiB;
constexpr size_t WS_XN = WS_ACT0 + 352 * MiB;
constexpr size_t WS_ACTM = WS_ACT0;
constexpr size_t WS_HP = WS_ACT0 + 476 * MiB;
constexpr size_t WS_Y = WS_ACT0 + 612 * MiB;
constexpr size_t WS_ACTD = WS_ACT0 + 476 * MiB;
constexpr size_t WS_XR = WS_ACT0 + 884 * MiB;
constexpr size_t WS_END = WS_ACT0 + 948 * MiB;
static_assert(WS_ACT0 == 810 * MiB, "map");
static_assert((size_t)MOE_ROWS * FFE * 2 <= 476 * MiB && (size_t)MOE_ROWS * DM * 2 <= 136 * MiB && (size_t)MOE_ROWS * DM * 4 <= 272 * MiB, "map");

#ifndef PH_MASK
#define PH_MASK 0xffff
#endif
#define REP_P0 1
#ifndef BG_SPLIT
#define BG_SPLIT 0
#endif
#ifndef BG_NQ
#define BG_NQ 2
#endif
#ifndef BG_NREP
#define BG_NREP 1
#endif
#ifndef PROBE_MASK
#define PROBE_MASK 0u
#endif
#ifndef DUP8
#define DUP8 1
#endif
#ifndef DDN8
#define DDN8 1
#endif
#define REP_P1 1
#define REP_P3 1
#define REP_P7 1
constexpr int CW_TMO = 0, CW_CODE = 1, CW_BAR = 4096;
constexpr size_t WS_SS = 14 * MiB;
typedef unsigned long long u64_t;
typedef float ssrow_t[8];
__device__ __forceinline__ float ss_rstd(const float* p) { const f32x4 a = *(const f32x4*)p, b = *(const f32x4*)(p + 4); return 1.0f / sqrtf((((a[0] + a[1]) + (a[2] + a[3])) + ((b[0] + b[1]) + (b[2] + b[3]))) * (1.0f / DM) + EPS); }
constexpr size_t WS_TMAP = WS_CTL + 768 * 1024;
constexpr size_t WS_PB = WS_ACT0 + 612 * MiB + 136 * MiB;
constexpr size_t WS_RSLOT = 12 * MiB;

constexpr int LDSCTL_OFF = 0, LDSCTL_BYTES = 1024;
constexpr int RING_OFF = 16384, RING_BYTES = 131072;
constexpr int LDS_BYTES = 147456;
constexpr int LW_CNT = 16, LW_TOT = 24, LW_PRE = 32, LW_BP = 40, LW_TOFF = 48;

#define LDS_WAIT() asm volatile("s_waitcnt lgkmcnt(0)" ::: "memory")
#define VM_WAIT() asm volatile("s_waitcnt vmcnt(0)" ::: "memory")

__device__ __forceinline__ unsigned cvt_pk_bf16(float lo, float hi) { unsigned r; asm volatile("v_cvt_pk_bf16_f32 %0, %1, %2" : "=v"(r) : "v"(lo), "v"(hi)); return r; }
__device__ __forceinline__ unsigned pk4_fp8(float a, float b, float c, float d) {
    a = __builtin_amdgcn_fmed3f(a, -448.f, 448.f); b = __builtin_amdgcn_fmed3f(b, -448.f, 448.f); c = __builtin_amdgcn_fmed3f(c, -448.f, 448.f); d = __builtin_amdgcn_fmed3f(d, -448.f, 448.f);
    int w = __builtin_amdgcn_cvt_pk_fp8_f32(a, b, 0, false); w = __builtin_amdgcn_cvt_pk_fp8_f32(c, d, w, true); return (unsigned)w; }
constexpr float W8_SCALE = 64.f, A8_SCALE = 8.f;
constexpr int SC_ONE = 0x7f7f7f7f, SC_W = 0x79797979  , SC_A = 0x7c7c7c7c  ;
__device__ __forceinline__ float bflo(unsigned w) { return __uint_as_float(w << 16); }
__device__ __forceinline__ float bfhi(unsigned w) { return __uint_as_float(w & 0xffff0000u); }
template <int CTRL> __device__ __forceinline__ float dppf(float v) { return __int_as_float(__builtin_amdgcn_update_dpp(0, __float_as_int(v), CTRL, 0xf, 0xf, true)); }
__device__ __forceinline__ float lx1(float v) { return dppf<0xB1>(v); }
__device__ __forceinline__ float lx2(float v) { return dppf<0x4E>(v); }
__device__ __forceinline__ float lhm(float v) { return dppf<0x141>(v); }
__device__ __forceinline__ float lrm(float v) { return dppf<0x140>(v); }
__device__ __forceinline__ float lx16(float v) { return __int_as_float(__builtin_amdgcn_ds_swizzle(__float_as_int(v), 0x401F)); }
__device__ __forceinline__ float sum_halves(float v) { const auto r = __builtin_amdgcn_permlane32_swap(__float_as_uint(v), __float_as_uint(v), false, false); return __uint_as_float(r[0]) + __uint_as_float(r[1]); }
__device__ __forceinline__ float row16_sum(float v) { v += lx1(v); v += lx2(v); v += lhm(v); v += lrm(v); return v; }
__device__ __forceinline__ float wave_sum(float v) { v = row16_sum(v); v += lx16(v); return sum_halves(v); }

__device__ __forceinline__ int ltid() {
    const unsigned key = (unsigned)__builtin_amdgcn_s_getreg((5 << 11) | 4) & 63u;
    const int wv = __builtin_amdgcn_readfirstlane((int)((volatile LAS unsigned*)(LDSCTL_OFF + 4 * 128))[key]);
    int ln; asm volatile("v_mbcnt_lo_u32_b32 %0, -1, 0\n\tv_mbcnt_hi_u32_b32 %0, -1, %0" : "=&v"(ln));
    return (wv << 6) | ln; }

namespace pg8 {
constexpr int BM = 256, BK = 64, HALF = 128, HTB = HALF * BK * 2, STAGE_BYTES = 8 * HTB, NXCD = 8, WGM = 8;
__host__ __device__ __forceinline__ int lds_byte(int r, int c) { const int st = (r >> 4) * 2 + (c >> 5), rr = r & 15, cc = c & 31, ob = rr * 64 + cc * 2; return st * 1024 + (ob ^ (((ob >> 9) & 1) << 5)); }
__host__ __device__ __forceinline__ void stage_rc(int b, int& R, int& C) { const int st = b / 1024, sb = b % 1024, swz = sb ^ (((sb >> 9) & 1) << 5); R = (st >> 1) * 16 + swz / 64; C = (st & 1) * 32 + (swz % 64) / 2; }
__host__ __device__ __forceinline__ int perm32(int rho) { const int n = rho >> 4, i = rho & 15; return 8 * (i >> 2) + 4 * n + (i & 3); }

struct Unit { int pm, pn, e, kb0, ntu, part; };
struct Gemm { const void* A; const void* Bt; int KB; size_t estride; };

struct StaticOrder {
    int nM, nN, nwg, G, c, i0, cnt;
    __device__ __forceinline__ void init(int nM_, int nN_, int G_, int c_, int i0_ = 0, int cnt_ = 1 << 30) { nM = nM_; nN = nN_; nwg = nM * nN; G = G_; c = c_; i0 = i0_; cnt = cnt_; }
    __device__ __forceinline__ void unit_of(int L, Unit& u) const {
        int wgid = L; { const int q = nwg / NXCD, r = nwg % NXCD, xcd = wgid % NXCD, off = wgid / NXCD; wgid = (xcd < r ? xcd * (q + 1) : r * (q + 1) + (xcd - r) * q) + off; }
        const int nig = WGM * nN, gid = wgid / nig, fm = gid * WGM, gsz = (nM - fm) < WGM ? (nM - fm) : WGM;
        u.pm = fm + ((wgid % nig) % gsz); u.pn = (wgid % nig) / gsz; u.e = 0; u.kb0 = 0; u.ntu = 0; u.part = -1;
    }
    __device__ __forceinline__ bool next(int i, Unit& u) const {
        if (i >= cnt) return false;
        const long L = (long)(i + i0) * G + c; if (L >= nwg) return false;
        unit_of((int)L, u); return true;
    }
};
struct MoeOrder {
    StaticOrder S; int t1, t2, t3, t4, t5, t6, t7; int SP, nfull, R, ntp, kbs; int rev = 0;
    __device__ __forceinline__ bool next(int i, Unit& u) const {
        if (SP > 1) {
            if (i < nfull) S.unit_of(i * S.G + S.c, u);
            else if (i == nfull && S.c < R * SP) { S.unit_of(nfull * S.G + S.c / SP, u); const int p = S.c % SP; u.kb0 = p * kbs; u.ntu = ntp; u.part = S.c; }
            else return false;
        } else if (!S.next(i, u)) return false;
        if (rev) u.pm = S.nM - 1 - u.pm;
        const int p = u.pm; u.e = __builtin_amdgcn_readfirstlane((p >= t1) + (p >= t2) + (p >= t3) + (p >= t4) + (p >= t5) + (p >= t6) + (p >= t7)); return true;
    }
};

template <int RS> __device__ __forceinline__ void row_scales(float (&sc)[2][4], const void* p, int row0) {
#pragma unroll
    for (int ai = 0; ai < 2; ++ai)
#pragma unroll
        for (int m = 0; m < 4; ++m) { if constexpr (RS == 0) sc[ai][m] = 1.0f; else if constexpr (RS == 1) sc[ai][m] = ss_rstd((const float*)p + (size_t)(row0 + ai * HALF + m * 16) * 8); else sc[ai][m] = ((const float*)p)[row0 + ai * HALF + m * 16]; }
}
template <int RS> struct EpiBf16 {
    static constexpr bool PERM = true; static constexpr bool HAS_INIT = false;
    bf16_t* O; int ldc; const void* rsp;
    __device__ __forceinline__ void operator()(const f32x4 (&acc)[2][2][4][2], const Unit& u, int wr, int wc, int fr, int fq) const {
        const int row0 = u.pm * BM + wr * 64 + fr, col0 = u.pn * BM + wc * 32 + 8 * fq;
        float sc[2][4]; row_scales<RS>(sc, rsp, row0);
#pragma unroll
        for (int ai = 0; ai < 2; ++ai)
#pragma unroll
            for (int m = 0; m < 4; ++m) { bf16_t* rowp = O + (size_t)(row0 + ai * HALF + m * 16) * ldc + col0;
#pragma unroll
                for (int bj = 0; bj < 2; ++bj) { const f32x4 v0 = acc[ai][bj][m][0] * sc[ai][m], v1 = acc[ai][bj][m][1] * sc[ai][m];
                    u32x4 w; w.x = cvt_pk_bf16(v0[0], v0[1]); w.y = cvt_pk_bf16(v0[2], v0[3]); w.z = cvt_pk_bf16(v1[0], v1[1]); w.w = cvt_pk_bf16(v1[2], v1[3]);
                    *(u32x4*)(rowp + bj * HALF) = w; } }
    }
};
struct EpiZ {
    static constexpr bool PERM = true; static constexpr bool HAS_INIT = false;
    bf16_t* O; int ldc; const void* rsp; const float* qg; const float* kg; const float* cosT; const float* sinT; LAS float* part;
    __device__ __forceinline__ void operator()(const f32x4 (&acc)[2][2][4][2], const Unit& u, int wr, int wc, int fr, int fq) const {
        const int row0 = u.pm * BM + wr * 64 + fr, col0 = u.pn * BM + wc * 32 + 8 * fq;
        float sc[2][4]; row_scales<1>(sc, rsp, row0);
        if (u.pn >= 8) {
#pragma unroll
            for (int ai = 0; ai < 2; ++ai)
#pragma unroll
                for (int m = 0; m < 4; ++m) { bf16_t* rowp = O + (size_t)(row0 + ai * HALF + m * 16) * ldc + col0;
#pragma unroll
                    for (int bj = 0; bj < 2; ++bj) { const f32x4 v0 = acc[ai][bj][m][0] * sc[ai][m], v1 = acc[ai][bj][m][1] * sc[ai][m];
                        u32x4 w; w.x = cvt_pk_bf16(v0[0], v0[1]); w.y = cvt_pk_bf16(v0[2], v0[3]); w.z = cvt_pk_bf16(v1[0], v1[1]); w.w = cvt_pk_bf16(v1[2], v1[3]);
                        *(u32x4*)(rowp + bj * HALF) = w; } }
            return;
        }
        LAS float* pw = part + ((wr * 4 + wc) * 16) * 16 + fr;
#pragma unroll
        for (int ai = 0; ai < 2; ++ai)
#pragma unroll
            for (int m = 0; m < 4; ++m)
#pragma unroll
                for (int bj = 0; bj < 2; ++bj) { const f32x4 v0 = acc[ai][bj][m][0] * sc[ai][m], v1 = acc[ai][bj][m][1] * sc[ai][m];
                    float p = (v0[0] * v0[0] + v0[1] * v0[1]) + (v0[2] * v0[2] + v0[3] * v0[3]) + (v1[0] * v1[0] + v1[1] * v1[1]) + (v1[2] * v1[2] + v1[3] * v1[3]);
                    p += lx16(p); p = sum_halves(p);
                    if (fq == 0) pw[((ai * 4 + m) * 2 + bj) * 16] = p; }
        asm volatile("s_waitcnt lgkmcnt(0)" ::: "memory"); __builtin_amdgcn_s_barrier(); asm volatile("" ::: "memory");
        const int i0 = 16 * wc + 4 * fq;
        const float* gp = (u.pn < 4 ? qg : kg) + i0;
        const f32x4 ga = *(const f32x4*)gp, gb = *(const f32x4*)(gp + 64);
        const LAS float* pr = part + (wr * 4 * 16) * 16 + fr;
#pragma unroll
        for (int ai = 0; ai < 2; ++ai)
#pragma unroll
            for (int m = 0; m < 4; ++m) { const int r = row0 + ai * HALF + m * 16; bf16_t* rowp = O + (size_t)r * ldc + col0;
                const f32x4 cs = *(const f32x4*)(cosT + (size_t)r * 64 + i0), sn = *(const f32x4*)(sinT + (size_t)r * 64 + i0);
#pragma unroll
                for (int bj = 0; bj < 2; ++bj) { const int pi = ((ai * 4 + m) * 2 + bj) * 16;
                    const float tot = (pr[pi] + pr[pi + 256]) + (pr[pi + 512] + pr[pi + 768]);
                    const float f = sc[ai][m] / sqrtf(tot * (1.0f / 128.0f) + EPS);
                    const f32x4 v0 = acc[ai][bj][m][0] * f, v1 = acc[ai][bj][m][1] * f;
                    const float a0 = v0[0] * ga[0], b0 = v0[1] * gb[0], a1 = v0[2] * ga[1], b1 = v0[3] * gb[1], a2 = v1[0] * ga[2], b2 = v1[1] * gb[2], a3 = v1[2] * ga[3], b3 = v1[3] * gb[3];
                    u32x4 w;
                    w.x = cvt_pk_bf16(a0 * cs[0] - b0 * sn[0], a0 * sn[0] + b0 * cs[0]); w.y = cvt_pk_bf16(a1 * cs[1] - b1 * sn[1], a1 * sn[1] + b1 * cs[1]);
                    w.z = cvt_pk_bf16(a2 * cs[2] - b2 * sn[2], a2 * sn[2] + b2 * cs[2]); w.w = cvt_pk_bf16(a3 * cs[3] - b3 * sn[3], a3 * sn[3] + b3 * cs[3]);
                    *(u32x4*)(rowp + bj * HALF) = w; } }
        asm volatile("s_waitcnt lgkmcnt(0)" ::: "memory"); __builtin_amdgcn_s_barrier(); asm volatile("" ::: "memory");
    }
};
__device__ __forceinline__ float silu_mul(float g, float u) { return g * __builtin_amdgcn_rcpf(1.0f + __builtin_amdgcn_exp2f(-1.4426950408889634f * g)) * u; }
__device__ __forceinline__ f32x2 silu_mul2(f32x2 g, f32x2 u, float sg, float su) {
    const f32x2 t = g * sg, a = t * (-1.4426950408889634f);
    f32x2 e; e.x = __builtin_amdgcn_exp2f(a.x); e.y = __builtin_amdgcn_exp2f(a.y);
    const f32x2 d = e + 1.0f;
    f32x2 r; r.x = __builtin_amdgcn_rcpf(d.x); r.y = __builtin_amdgcn_rcpf(d.y);
    return (t * r) * (u * su);
}
template <int RS> struct EpiSwiglu {
    static constexpr bool PERM = true; static constexpr bool HAS_INIT = false;
    bf16_t* O; int ldc; const void* rsp;
    __device__ __forceinline__ void operator()(const f32x4 (&acc)[2][2][4][2], const Unit& u, int wr, int wc, int fr, int fq) const {
        const int row0 = u.pm * BM + wr * 64 + fr, col0 = u.pn * HALF + wc * 32 + 8 * fq;
        float sc[2][4]; row_scales<RS>(sc, rsp, row0);
#pragma unroll
        for (int ai = 0; ai < 2; ++ai)
#pragma unroll
            for (int m = 0; m < 4; ++m) { bf16_t* rowp = O + (size_t)(row0 + ai * HALF + m * 16) * ldc + col0;
                const f32x4 g0 = acc[ai][0][m][0], g1 = acc[ai][0][m][1], u0 = acc[ai][1][m][0], u1 = acc[ai][1][m][1]; const float s = sc[ai][m];
                const f32x2 o0 = silu_mul2((f32x2){g0[0], g0[1]}, (f32x2){u0[0], u0[1]}, s, s), o1 = silu_mul2((f32x2){g0[2], g0[3]}, (f32x2){u0[2], u0[3]}, s, s);
                const f32x2 o2 = silu_mul2((f32x2){g1[0], g1[1]}, (f32x2){u1[0], u1[1]}, s, s), o3 = silu_mul2((f32x2){g1[2], g1[3]}, (f32x2){u1[2], u1[3]}, s, s);
                u32x4 w; w.x = cvt_pk_bf16(o0.x, o0.y); w.y = cvt_pk_bf16(o1.x, o1.y); w.z = cvt_pk_bf16(o2.x, o2.y); w.w = cvt_pk_bf16(o3.x, o3.y);
                *(u32x4*)rowp = w; }
    }
};
template <int RS> struct EpiSwigluF8 {
    static constexpr bool PERM = true; static constexpr bool HAS_INIT = false;
    unsigned char* O; int ldc; const void* rsp;
    __device__ __forceinline__ void operator()(const f32x4 (&acc)[2][2][4][2], const Unit& u, int wr, int wc, int fr, int fq) const {
        const int row0 = u.pm * BM + wr * 64 + fr, col0 = u.pn * HALF + wc * 32 + 8 * fq;
        float sc[2][4]; row_scales<RS>(sc, rsp, row0);
#pragma unroll
        for (int ai = 0; ai < 2; ++ai)
#pragma unroll
            for (int m = 0; m < 4; ++m) { unsigned char* rowp = O + (size_t)(row0 + ai * HALF + m * 16) * ldc + col0;
                const f32x4 g0 = acc[ai][0][m][0], g1 = acc[ai][0][m][1], u0 = acc[ai][1][m][0], u1 = acc[ai][1][m][1]; const float s = sc[ai][m], s8 = s * A8_SCALE;
                const f32x2 o0 = silu_mul2((f32x2){g0[0], g0[1]}, (f32x2){u0[0], u0[1]}, s, s8), o1 = silu_mul2((f32x2){g0[2], g0[3]}, (f32x2){u0[2], u0[3]}, s, s8);
                const f32x2 o2 = silu_mul2((f32x2){g1[0], g1[1]}, (f32x2){u1[0], u1[1]}, s, s8), o3 = silu_mul2((f32x2){g1[2], g1[3]}, (f32x2){u1[2], u1[3]}, s, s8);
                u32x2 w; w.x = pk4_fp8(o0.x, o0.y, o1.x, o1.y); w.y = pk4_fp8(o2.x, o2.y, o3.x, o3.y);
                *(u32x2*)rowp = w; }
    }
};
struct EpiResF32 {
    static constexpr bool PERM = true; static constexpr bool HAS_INIT = true;
    const float* R32; bf16_t* XR; int ldc; unsigned char* XB8; float* ss; int rf32; int f8out; LAS float* part;
    __device__ __forceinline__ void init(f32x4 (&acc)[2][2][4][2], const Unit& u, int wr, int wc, int fr, int fq) const {
        const int col0 = u.pn * BM + wc * 32 + 8 * fq;
        u32x4 rb[2][4][2];
#pragma unroll
        for (int ai = 0; ai < 2; ++ai)
#pragma unroll
            for (int m = 0; m < 4; ++m) { const unsigned boff = (unsigned)((u.pm * BM + ai * HALF + wr * 64 + m * 16 + fr) * ldc + col0) * 2u;
#pragma unroll
                for (int bj = 0; bj < 2; ++bj) rb[ai][m][bj] = *(const u32x4*)((const char*)XR + (size_t)(boff + (unsigned)(bj * HALF * 2))); }
#pragma unroll
        for (int ai = 0; ai < 2; ++ai)
#pragma unroll
            for (int m = 0; m < 4; ++m)
#pragma unroll
                for (int bj = 0; bj < 2; ++bj) { const u32x4 q = rb[ai][m][bj];
                    acc[ai][bj][m][0] = (f32x4){bflo(q[0]), bfhi(q[0]), bflo(q[1]), bfhi(q[1])}; acc[ai][bj][m][1] = (f32x4){bflo(q[2]), bfhi(q[2]), bflo(q[3]), bfhi(q[3])}; }
    }
    __device__ __forceinline__ void operator()(const f32x4 (&acc)[2][2][4][2], const Unit& u, int wr, int wc, int fr, int fq) const {
        const int col0 = u.pn * BM + wc * 32 + 8 * fq;
        float ssw[2][4];
#pragma unroll
        for (int ai = 0; ai < 2; ++ai) {
#pragma unroll
            for (int m = 0; m < 4; ++m) { const unsigned eoff = (unsigned)((u.pm * BM + ai * HALF + wr * 64 + m * 16 + fr) * ldc + col0);
                float ssp = 0.f;
#pragma unroll
                for (int bj = 0; bj < 2; ++bj) {
                    const f32x4 v0 = acc[ai][bj][m][0], v1 = acc[ai][bj][m][1];
                    ssp += (v0[0] * v0[0] + v0[1] * v0[1]) + (v0[2] * v0[2] + v0[3] * v0[3]) + (v1[0] * v1[0] + v1[1] * v1[1]) + (v1[2] * v1[2] + v1[3] * v1[3]);
                    { u32x4 w; w.x = cvt_pk_bf16(v0[0], v0[1]); w.y = cvt_pk_bf16(v0[2], v0[3]); w.z = cvt_pk_bf16(v1[0], v1[1]); w.w = cvt_pk_bf16(v1[2], v1[3]); *(u32x4*)((char*)XR + (size_t)((eoff + (unsigned)(bj * HALF)) * 2u)) = w; }
                    if (f8out) { u32x2 w; w.x = pk4_fp8(v0[0], v0[1], v0[2], v0[3]); w.y = pk4_fp8(v1[0], v1[1], v1[2], v1[3]); *(u32x2*)(XB8 + (size_t)(eoff + (unsigned)(bj * HALF))) = w; }
                }
                ssp += lx16(ssp); ssw[ai][m] = sum_halves(ssp);
            }
        }
        if (fq == 0) {
#pragma unroll
            for (int ai = 0; ai < 2; ++ai)
#pragma unroll
                for (int m = 0; m < 4; ++m) part[((wr * 4 + wc) * 8 + ai * 4 + m) * 16 + fr] = ssw[ai][m]; }
        asm volatile("s_waitcnt lgkmcnt(0)" ::: "memory"); __builtin_amdgcn_s_barrier(); asm volatile("" ::: "memory");
        if (wc == 0 && fq == 0) {
#pragma unroll
            for (int ai = 0; ai < 2; ++ai)
#pragma unroll
                for (int m = 0; m < 4; ++m) { const LAS float* p = part + (wr * 4 * 8 + ai * 4 + m) * 16 + fr;
                    ss[(size_t)(u.pm * BM + ai * HALF + wr * 64 + m * 16 + fr) * 8 + u.pn] = (p[0] + p[128]) + (p[256] + p[384]); } }
        asm volatile("s_waitcnt lgkmcnt(0)" ::: "memory"); __builtin_amdgcn_s_barrier(); asm volatile("" ::: "memory");
    }
};
struct EpiMoeDown {
    static constexpr bool PERM = true; static constexpr bool HAS_INIT = false;
    bf16_t* O; int ldc; float* PB; int* tmap; int SP;
    __device__ __forceinline__ void operator()(const f32x4 (&acc)[2][2][4][2], const Unit& u, int wr, int wc, int fr, int fq) const {
        if (u.part < 0) {
            const int row0 = u.pm * BM + wr * 64 + fr, col0 = u.pn * BM + wc * 32 + 8 * fq;
#pragma unroll
            for (int ai = 0; ai < 2; ++ai)
#pragma unroll
                for (int m = 0; m < 4; ++m) { bf16_t* rowp = O + (size_t)(row0 + ai * HALF + m * 16) * ldc + col0;
#pragma unroll
                    for (int bj = 0; bj < 2; ++bj) { const f32x4 v0 = acc[ai][bj][m][0], v1 = acc[ai][bj][m][1];
                        u32x4 w; w.x = cvt_pk_bf16(v0[0], v0[1]); w.y = cvt_pk_bf16(v0[2], v0[3]); w.z = cvt_pk_bf16(v1[0], v1[1]); w.w = cvt_pk_bf16(v1[2], v1[3]);
                        *(u32x4*)(rowp + bj * HALF) = w; } }
        } else {
            float* slab = PB + (size_t)u.part * (BM * BM);
            if ((u.part % SP) == 0 && wr == 0 && wc == 0 && fr == 0 && fq == 0) tmap[u.pm * 8 + u.pn] = 1 + u.part / SP;
#pragma unroll
            for (int ai = 0; ai < 2; ++ai)
#pragma unroll
                for (int m = 0; m < 4; ++m) { float* rowp = slab + (ai * HALF + wr * 64 + m * 16 + fr) * BM + wc * 32 + 8 * fq;
#pragma unroll
                    for (int bj = 0; bj < 2; ++bj) { *(f32x4*)(rowp + bj * HALF) = acc[ai][bj][m][0]; *(f32x4*)(rowp + bj * HALF + 4) = acc[ai][bj][m][1]; } }
        }
    }
};
struct EpiF32 {
    static constexpr bool PERM = false; static constexpr bool HAS_INIT = false;
    float* O; int ldc;
    __device__ __forceinline__ void operator()(const f32x4 (&acc)[2][2][4][2], const Unit& u, int wr, int wc, int fr, int fq) const {
        const int col0 = u.pn * BM + wc * 32 + 4 * fq;
#pragma unroll
        for (int ai = 0; ai < 2; ++ai)
#pragma unroll
            for (int m = 0; m < 4; ++m) { const size_t off = (size_t)(u.pm * BM + ai * HALF + wr * 64 + m * 16 + fr) * ldc + col0;
#pragma unroll
                for (int bj = 0; bj < 2; ++bj)
#pragma unroll
                    for (int n = 0; n < 2; ++n) *(f32x4*)(O + off + bj * HALF + n * 16) = acc[ai][bj][m][n]; }
    }
};

struct NoBG { static constexpr int nslots = 0; __device__ __forceinline__ void operator()(int) const {} };
struct MoeConv {
    volatile LAS unsigned* LW; int slot0, nslots, bx8, NGW;
    static constexpr int PER = 3584, NITEMS = 24 * PER, NQ = BG_NQ;
    __device__ __forceinline__ unsigned long long ptr(int i) const { return (unsigned long long)(unsigned)__builtin_amdgcn_readfirstlane((int)LW[64 + 2 * i]) | ((unsigned long long)(unsigned)__builtin_amdgcn_readfirstlane((int)LW[64 + 2 * i + 1]) << 32); }
    __device__ __forceinline__ void operator()(int s) const {
        if (s >= nslots) return;
        const int tid_ = ltid(), lane = tid_ & 63, c = lane & 31, h = lane >> 5, gw = bx8 + __builtin_amdgcn_readfirstlane(tid_ >> 6);
#pragma unroll 1
        for (int rp = 0; rp < BG_NREP; ++rp) {
        const int it0 = (((slot0 + s) * BG_NREP + rp) * NGW + gw) * NQ; if (it0 >= NITEMS) return;
        f32x4 v[NQ][4][2][2]; float sc[NQ][4]; unsigned char* dst[NQ];
#pragma unroll
        for (int q2 = 0; q2 < NQ; ++q2) {
            int it = it0 + q2; it = it < NITEMS ? it : it0;
            const int mat = it / PER, r = it - mat * PER, e = mat & 7, kind = mat >> 3;
            const bool up_ = kind < 2;
            const int K = up_ ? DM : FFE, N = up_ ? FFE : DM, nblk = up_ ? 224 : 64, kb = r / nblk, nb = r - kb * nblk, k0 = 128 * kb, n0 = 32 * nb;
            const int drow0 = up_ ? (256 * (n0 >> 7) + kind * 128 + (n0 & 127)) : n0;
            const float* W = (const float*)(GAS const float*)ptr(kind == 0 ? 17 : (kind == 1 ? 18 : 19)) + (size_t)e * DM * FFE;
            const float* gk = (const float*)(GAS const float*)ptr(12) + DM;
            dst[q2] = (unsigned char*)(GAS unsigned char*)(ptr(21) + (up_ ? WS_WMGU : WS_WMD)) + (size_t)e * (up_ ? 2 : 1) * FFE * DM + (size_t)(drow0 + c) * K + k0 + 16 * h;
#pragma unroll
            for (int kb4 = 0; kb4 < 4; ++kb4) {
                const unsigned off = (unsigned)(((k0 + 32 * kb4 + c) * N + n0 + 8 * h) * 4);
                const char* row = (const char*)W + off;
                const float gv = gk[(k0 + 32 * kb4 + c) & (DM - 1)];
                sc[q2][kb4] = (up_ ? gv : 1.0f) * W8_SCALE;
#pragma unroll
                for (int nh = 0; nh < 2; ++nh) { v[q2][kb4][nh][0] = *(const f32x4*)(row + 64 * nh); v[q2][kb4][nh][1] = *(const f32x4*)(row + 64 * nh + 16); } }
        }
        u32x4 s0 = {0u, 0u, 0u, 0u}, s1 = {0u, 0u, 0u, 0u};
        { const int j0 = c - 8 * h, j1 = c - 16 - 8 * h;
#pragma unroll
          for (int j = 0; j < 8; ++j) { if (j == j0) s0[j >> 1] = (j & 1) ? 0x3f800000u : 0x00003f80u; if (j == j1) s1[j >> 1] = (j & 1) ? 0x3f800000u : 0x00003f80u; } }
        const bf16x8 sel0 = __builtin_bit_cast(bf16x8, s0), sel1 = __builtin_bit_cast(bf16x8, s1);
#pragma unroll
        for (int q2 = 0; q2 < NQ; ++q2)
#pragma unroll
            for (int kb4 = 0; kb4 < 4; ++kb4) {
                const float f = sc[q2][kb4];
                u32x4 a0, a1;
                { const f32x4 x0 = v[q2][kb4][0][0] * f, x1 = v[q2][kb4][0][1] * f, y0 = v[q2][kb4][1][0] * f, y1 = v[q2][kb4][1][1] * f;
                  a0.x = cvt_pk_bf16(x0[0], x0[1]); a0.y = cvt_pk_bf16(x0[2], x0[3]); a0.z = cvt_pk_bf16(x1[0], x1[1]); a0.w = cvt_pk_bf16(x1[2], x1[3]);
                  a1.x = cvt_pk_bf16(y0[0], y0[1]); a1.y = cvt_pk_bf16(y0[2], y0[3]); a1.z = cvt_pk_bf16(y1[0], y1[1]); a1.w = cvt_pk_bf16(y1[2], y1[3]); }
                f32x16 d = f32x16{};
                d = __builtin_amdgcn_mfma_f32_32x32x16_bf16(__builtin_bit_cast(bf16x8, a0), sel0, d, 0, 0, 0);
                d = __builtin_amdgcn_mfma_f32_32x32x16_bf16(__builtin_bit_cast(bf16x8, a1), sel1, d, 0, 0, 0);
                const unsigned w0 = pk4_fp8(d[0], d[1], d[2], d[3]), w1 = pk4_fp8(d[4], d[5], d[6], d[7]), w2 = pk4_fp8(d[8], d[9], d[10], d[11]), w3 = pk4_fp8(d[12], d[13], d[14], d[15]);
                const auto p02 = __builtin_amdgcn_permlane32_swap(w0, w2, false, false), p13 = __builtin_amdgcn_permlane32_swap(w1, w3, false, false);
                const u32x4 o = {p02[0], p02[1], p13[0], p13[1]};
                *(u32x4*)(dst[q2] + 32 * kb4) = o;
            }
        }
    }
};
__device__ __forceinline__ void mfma_f8_tied(f32x4& c, i32x8 a, i32x8 b, int sa, int sb) {
    asm volatile("v_mfma_scale_f32_16x16x128_f8f6f4 %0, %1, %2, %0, %3, %4 op_sel_hi:[0,0,0]" : "+v"(c) : "v"(a), "v"(b), "v"(sa), "v"(sb)); }
__device__ __forceinline__ void mfma_f8_drain() { asm volatile("s_nop 15\n\ts_nop 15" ::: "memory"); }
__device__ __forceinline__ void glds16s(unsigned voff, const char* sbase, unsigned lds_dst) { unsigned keep;
    asm volatile("s_mov_b32 %0, m0\n\ts_mov_b32 m0, %3\n\ts_nop 0\n\tglobal_load_lds_dwordx4 %1, %2\n\ts_mov_b32 m0, %0" : "=&s"(keep) : "v"(voff), "s"(sbase), "s"(lds_dst) : "memory"); }
template <class Epi, class Sched, bool F8 = false, int SCW = SC_ONE, int SCX = SC_ONE, class BG = NoBG>
__device__ __forceinline__ void gemm_phase(LAS unsigned char* lds, const Gemm g, const Sched& S, const Epi& E, const BG& bg = BG()) {
    const int tid = ltid(), wid = __builtin_amdgcn_readfirstlane(tid >> 6), lane = tid & 63, wr = wid >> 2, wc = wid & 3, fr = lane & 15, fq = lane >> 4;
    const int KB = g.KB, nt = KB / 128;
    int scw_ = SCW, scx_ = SCX; if constexpr (F8) { asm volatile("" : "+v"(scw_), "+v"(scx_)); }
    unsigned voffA[2], voffB[2];
#pragma unroll
    for (int i = 0; i < 2; ++i) { int R, C; stage_rc(tid * 16 + i * 8192, R, C); const int Rb = Epi::PERM ? ((R & ~31) + perm32(R & 31)) : R;
        voffA[i] = (unsigned)(R * KB + C * 2); voffB[i] = (unsigned)(Rb * KB + C * 2); }
    const size_t kstep = (size_t)128;
    const size_t hstep = (size_t)HALF * KB;
    const size_t tstep = 2 * hstep;
    const unsigned ldsb = (unsigned)(uintptr_t)lds + (unsigned)wid * 1024u;
    const int aoff = lds_byte(wr * 64 + fr, fq * 8), boff = lds_byte(wc * 32 + fr, fq * 8);
#define PG8_SA(b, h) (((b) * 2 + (h)) * HTB)
#define PG8_SB(b, h) ((4 + (b) * 2 + (h)) * HTB)
#define PG8_STAGE(bufoff, gbase, voff) do { _Pragma("unroll") for (int _i = 0; _i < 2; ++_i) \
        glds16s((voff)[_i], (const char*)(gbase), ldsb + (unsigned)((bufoff) + _i * 8192)); } while (0)
#define PG8_LDA(dst, b, h) do { _Pragma("unroll") for (int m = 0; m < 4; ++m) _Pragma("unroll") for (int k = 0; k < 2; ++k) dst[m][k] = *(const LAS bf16x8*)(lds + PG8_SA(b, h) + aoff + m * 2048 + k * 1024); } while (0)
#define PG8_LDB(dst, b, h) do { _Pragma("unroll") for (int n = 0; n < 2; ++n) _Pragma("unroll") for (int k = 0; k < 2; ++k) dst[n][k] = *(const LAS bf16x8*)(lds + PG8_SB(b, h) + boff + n * 2048 + k * 1024); } while (0)
#define PG8_CAT8(x) __builtin_shufflevector(__builtin_bit_cast(i32x4, (x)[0]), __builtin_bit_cast(i32x4, (x)[1]), 0, 1, 2, 3, 4, 5, 6, 7)
#define PG8_MMA(ai, bj, At, Bt) do { __builtin_amdgcn_s_setprio(1); \
        if constexpr (F8) { _Pragma("unroll") for (int m = 0; m < 4; ++m) _Pragma("unroll") for (int n = 0; n < 2; ++n) \
            mfma_f8_tied(acc[ai][bj][m][n], PG8_CAT8(Bt[n]), PG8_CAT8(At[m]), scw_, scx_); } \
        else { _Pragma("unroll") for (int m = 0; m < 4; ++m) _Pragma("unroll") for (int n = 0; n < 2; ++n) _Pragma("unroll") for (int k = 0; k < 2; ++k) \
            acc[ai][bj][m][n] = __builtin_amdgcn_mfma_f32_16x16x32_bf16(Bt[n][k], At[m][k], acc[ai][bj][m][n], 0, 0, 0); } \
        __builtin_amdgcn_s_setprio(0); } while (0)
#define PG8_WAIT_V(n) asm volatile("s_waitcnt vmcnt(" #n ")" ::: "memory")
#define PG8_WAIT_L(n) asm volatile("s_waitcnt lgkmcnt(" #n ")" ::: "memory")
#define PG8_BAR __builtin_amdgcn_s_barrier()
#define PG8_SCHED __builtin_amdgcn_sched_barrier(0)
    Unit cur, nxt; int ui = 0;
    if (!S.next(0, cur)) { for (int s = 0; s < bg.nslots; ++s) bg(s); return; }
    bf16x8 At[4][2], B0[2][2], B1[2][2];
    const char* cA = (const char*)g.A + (size_t)cur.pm * tstep + cur.kb0; const char* cB = (const char*)g.Bt + (size_t)cur.e * g.estride + (size_t)cur.pn * tstep + cur.kb0;
    PG8_STAGE(PG8_SB(0, 0), cB, voffB); PG8_STAGE(PG8_SB(0, 1), cB + hstep, voffB); PG8_STAGE(PG8_SA(0, 0), cA, voffA); PG8_STAGE(PG8_SA(0, 1), cA + hstep, voffA);
    if (wr == 1) PG8_BAR;
    PG8_WAIT_V(2); PG8_BAR;
    PG8_STAGE(PG8_SB(1, 0), cB + kstep, voffB); PG8_STAGE(PG8_SA(1, 0), cA + kstep, voffA); PG8_STAGE(PG8_SB(1, 1), cB + hstep + kstep, voffB);
    PG8_WAIT_V(6); PG8_BAR;
    for (;;) {
        f32x4 acc[2][2][4][2];
        if constexpr (Epi::HAS_INIT) E.init(acc, cur, wr, wc, fr, fq);
        else {
#pragma unroll
        for (int a = 0; a < 2; ++a)
#pragma unroll
            for (int b = 0; b < 2; ++b)
#pragma unroll
                for (int m = 0; m < 4; ++m)
#pragma unroll
                    for (int n = 0; n < 2; ++n) acc[a][b][m][n] = (f32x4){0.f, 0.f, 0.f, 0.f};
        }
        const bool has_next = S.next(ui + 1, nxt);
        const char* nA = has_next ? (const char*)g.A + (size_t)nxt.pm * tstep + nxt.kb0 : cA; const char* nB = has_next ? (const char*)g.Bt + (size_t)nxt.e * g.estride + (size_t)nxt.pn * tstep + nxt.kb0 : cB;
        const int ntc = cur.ntu ? cur.ntu : nt;
        for (int t = 0; t < ntc; t += 2) {
            const bool last = (t == ntc - 2);
            const char* a1 = cA + (size_t)(t + 1) * kstep;
            const char* a2 = last ? nA : cA + (size_t)(t + 2) * kstep; const char* b2 = last ? nB : cB + (size_t)(t + 2) * kstep;
            const char* a3 = a2 + kstep; const char* b3 = b2 + kstep;
            PG8_LDB(B0, 0, 0); PG8_LDB(B1, 0, 1); PG8_SCHED; PG8_LDA(At, 0, 0); PG8_STAGE(PG8_SA(1, 1), a1 + hstep, voffA);
            PG8_WAIT_V(8); PG8_WAIT_L(0); PG8_BAR; PG8_MMA(0, 0, At, B0); PG8_MMA(0, 1, At, B1); PG8_BAR; PG8_SCHED;
            PG8_LDA(At, 0, 1); PG8_STAGE(PG8_SB(0, 0), b2, voffB); PG8_STAGE(PG8_SB(0, 1), b2 + hstep, voffB); PG8_STAGE(PG8_SA(0, 0), a2, voffA);
            PG8_WAIT_V(8); PG8_WAIT_L(0); PG8_BAR; PG8_MMA(1, 0, At, B0); PG8_MMA(1, 1, At, B1); PG8_BAR; PG8_SCHED;
            PG8_LDB(B0, 1, 0); PG8_LDB(B1, 1, 1); PG8_SCHED; PG8_LDA(At, 1, 0); PG8_STAGE(PG8_SA(0, 1), a2 + hstep, voffA);
            PG8_WAIT_V(8); PG8_WAIT_L(0); PG8_BAR; PG8_MMA(0, 0, At, B0); PG8_MMA(0, 1, At, B1); PG8_BAR; PG8_SCHED;
            PG8_LDA(At, 1, 1); PG8_STAGE(PG8_SB(1, 0), b3, voffB); PG8_STAGE(PG8_SB(1, 1), b3 + hstep, voffB); PG8_STAGE(PG8_SA(1, 0), a3, voffA);
            PG8_WAIT_V(8); PG8_WAIT_L(0); PG8_BAR; PG8_MMA(1, 0, At, B0); PG8_MMA(1, 1, At, B1); PG8_BAR; PG8_SCHED;
        }
        if (wr == 0) PG8_BAR;
        if constexpr (F8) mfma_f8_drain();
        E(acc, cur, wr, wc, fr, fq);
        asm volatile("" ::: "memory"); __builtin_amdgcn_sched_barrier(0);
        bg(ui);
        asm volatile("" ::: "memory"); __builtin_amdgcn_sched_barrier(0);
        if (!has_next) break;
        cur = nxt; cA = nA; cB = nB; ++ui;
        if (wr == 1) PG8_BAR;
    }
    for (int s = ui + 1; s < bg.nslots; ++s) bg(s);
    PG8_WAIT_V(0);
    PG8_BAR;
#undef PG8_SA
#undef PG8_SB
#undef PG8_STAGE
#undef PG8_LDA
#undef PG8_LDB
#undef PG8_MMA
#undef PG8_CAT8
#undef PG8_WAIT_V
#undef PG8_WAIT_L
#undef PG8_BAR
#undef PG8_SCHED
}
}

namespace att {
constexpr int D = 128, LDZ = INW, LDO = DM;
constexpr float SCALE = 0.08838834764831845f;
constexpr float THR = 8.f;
constexpr int NW = 8, QBLK = 32, KVBLK = 64, QB = NW * QBLK;
constexpr int SHM_V = KVBLK * D * 2, SHM_K = KVBLK * D * 2;
constexpr int ATT_LDS_BYTES = 2 * SHM_V + 2 * SHM_K + NW * 64 * 4;
#define KSWZ(row, colB) ((row) * 256 + ((colB) ^ (((row) & 7) << 4)))
#define SBAR() __builtin_amdgcn_sched_barrier(0)
__device__ __forceinline__ int v_st(int k, int c) { const int kk = (k & ~0xC) | ((k & 4) << 1) | ((k & 8) >> 1); return ((kk >> 3) * 4 + (c >> 5)) * 512 + ((kk & 7) * 32 + (c & 31)) * 2; }
__device__ __forceinline__ int v_rd_base(int lane) { return ((lane & 3) << 3) | (((lane >> 2) & 3) << 6) | (((lane >> 4) & 1) << 5) | (((lane >> 5) & 1) << 8); }
constexpr int v_rd_off(int d0, int ks, int half) { return d0 * 512 + ks * 4096 + half * 2048; }
__device__ __forceinline__ int crow(int r, int hi) { return (r & 3) + 8 * (r >> 2) + 4 * hi; }
__device__ __forceinline__ bf16x8 load8(const bf16_t* p) { return *reinterpret_cast<const bf16x8*>(p); }
__device__ __forceinline__ void mask_tile(f32x16& p0, f32x16& p1, int dq, unsigned W) {
    const float NEG = -__builtin_inff();
#pragma unroll
    for (int r = 0; r < 16; ++r) {
        const int c = (r & 3) + 8 * (r >> 2);
        if ((unsigned)(dq - c) >= W) p0[r] = NEG;
        if ((unsigned)(dq - c - 32) >= W) p1[r] = NEG;
    }
}
__device__ __forceinline__ void partialSM(f32x16& p0, f32x16& p1, float& m_reg, float& mn, float& alpha) {
    float pmax = p0[0];
#pragma unroll
    for (int r = 1; r < 16; ++r) pmax = fmaxf(pmax, p0[r]);
#pragma unroll
    for (int r = 0; r < 16; ++r) pmax = fmaxf(pmax, p1[r]);
    { auto rr = __builtin_amdgcn_permlane32_swap(__float_as_uint(pmax), __float_as_uint(pmax), false, false);
      pmax = fmaxf(__uint_as_float(rr[0]), __uint_as_float(rr[1])); }
    constexpr float C2 = 1.4426950408889634f * SCALE;
    if (__builtin_expect(__all((pmax - m_reg) * SCALE <= THR), 1)) { mn = m_reg; alpha = 1.f; }
    else { mn = fmaxf(m_reg, pmax); alpha = __builtin_amdgcn_exp2f((m_reg - mn) * C2); m_reg = mn; }
    const float mnL = -mn * C2;
#pragma unroll
    for (int r = 0; r < 16; ++r) p0[r] = fmaf(p0[r], C2, mnL);
#pragma unroll
    for (int r = 0; r < 16; ++r) p1[r] = fmaf(p1[r], C2, mnL);
#pragma unroll
    for (int r = 0; r < 16; ++r) p0[r] = __builtin_amdgcn_exp2f(p0[r]);
}
__device__ __forceinline__ void finishSM(f32x16& p0, f32x16& p1, float alpha, float& l_reg, bf16x8& pa0, bf16x8& pa1, bf16x8& pa2, bf16x8& pa3) {
#pragma unroll
    for (int r = 0; r < 16; ++r) p1[r] = __builtin_amdgcn_exp2f(p1[r]);
    float ps = 0;
#pragma unroll
    for (int r = 0; r < 16; ++r) ps += p0[r];
#pragma unroll
    for (int r = 0; r < 16; ++r) ps += p1[r];
    { auto rr = __builtin_amdgcn_permlane32_swap(__float_as_uint(ps), __float_as_uint(ps), false, false);
      ps = __uint_as_float(rr[0]) + __uint_as_float(rr[1]); }
    l_reg = l_reg * alpha + ps;
#define PK4(P, B_, OUT) do { unsigned a0 = cvt_pk_bf16(P[B_+0], P[B_+1]), a1 = cvt_pk_bf16(P[B_+2], P[B_+3]);                          \
        unsigned b0 = cvt_pk_bf16(P[B_+4], P[B_+5]), b1 = cvt_pk_bf16(P[B_+6], P[B_+7]);                                             \
        auto r0 = __builtin_amdgcn_permlane32_swap(a0, b0, false, false); auto r1 = __builtin_amdgcn_permlane32_swap(a1, b1, false, false); \
        u32x4 w = {r0[0], r1[0], r0[1], r1[1]}; OUT = *reinterpret_cast<bf16x8*>(&w); } while (0)
    PK4(p0, 0, pa0); PK4(p0, 8, pa1); PK4(p1, 0, pa2); PK4(p1, 8, pa3);
#undef PK4
}
template <int KB>
__device__ __forceinline__ void qkt(f32x16& p0, f32x16& p1, const char* K_lds, int r32, int hi, const bf16x8* qr) {
    p0 = f32x16{}; p1 = f32x16{};
    const char* kb[4];
#pragma unroll
    for (int dd = 0; dd < 4; ++dd) kb[dd] = K_lds + KB * SHM_K + KSWZ(r32, (dd * 16 + hi * 8) * 2);
#pragma unroll
    for (int d0 = 0; d0 < 8; ++d0) { const char* a = kb[d0 & 3] + (d0 >> 2) * 128;
        bf16x8 b0 = *reinterpret_cast<const bf16x8*>(a);
        bf16x8 b1 = *reinterpret_cast<const bf16x8*>(a + 32 * 256);
        p0 = __builtin_amdgcn_mfma_f32_32x32x16_bf16(b0, qr[d0], p0, 0, 0, 0);
        p1 = __builtin_amdgcn_mfma_f32_32x32x16_bf16(b1, qr[d0], p1, 0, 0, 0); }
}
template <int VB>
__device__ __forceinline__ void pv_tile(f32x16* o, int vb0, bf16x8 pa0, bf16x8 pa1, bf16x8 pa2, bf16x8 pa3) {
#define TRRD(dst, off) asm volatile("ds_read_b64_tr_b16 %0, %1 offset:%2" : "=&v"(dst) : "v"(vb0), "i"(off) : "memory")
#define PV_D0(d0) do { s16x4 l0, l1, l2, l3, h0, h1, h2, h3; constexpr int b_ = VB * SHM_V + v_rd_off(d0, 0, 0); \
        TRRD(l0, b_); TRRD(h0, b_ + 2048); TRRD(l1, b_ + 4096); TRRD(h1, b_ + 6144); TRRD(l2, b_ + 8192); TRRD(h2, b_ + 10240); TRRD(l3, b_ + 12288); TRRD(h3, b_ + 14336); \
        asm volatile("s_waitcnt lgkmcnt(0)" ::: "memory"); SBAR();   \
        o[d0] = __builtin_amdgcn_mfma_f32_32x32x16_bf16(pa0, (bf16x8){l0[0], l0[1], l0[2], l0[3], h0[0], h0[1], h0[2], h0[3]}, o[d0], 0, 0, 0);   \
        o[d0] = __builtin_amdgcn_mfma_f32_32x32x16_bf16(pa1, (bf16x8){l1[0], l1[1], l1[2], l1[3], h1[0], h1[1], h1[2], h1[3]}, o[d0], 0, 0, 0);   \
        o[d0] = __builtin_amdgcn_mfma_f32_32x32x16_bf16(pa2, (bf16x8){l2[0], l2[1], l2[2], l2[3], h2[0], h2[1], h2[2], h2[3]}, o[d0], 0, 0, 0);   \
        o[d0] = __builtin_amdgcn_mfma_f32_32x32x16_bf16(pa3, (bf16x8){l3[0], l3[1], l3[2], l3[3], h3[0], h3[1], h3[2], h3[3]}, o[d0], 0, 0, 0); } while (0)
    PV_D0(0); PV_D0(1); PV_D0(2); PV_D0(3);
#undef PV_D0
#undef TRRD
}
struct BlockRef { const bf16_t* Q; const bf16_t* K; const bf16_t* V; bf16_t* O; int P0; };
struct Seam { bf16x8 qr[8]; bf16x8 st_v0, st_v1, st_k0, st_k1; };
#define ROW(p, k0, rr) ((p) + (size_t)((k0) + (rr)) * LDZ + sc)
#define VMW() asm volatile("s_waitcnt vmcnt(0)" ::: "memory")
#define VMWN(n) asm volatile("s_waitcnt vmcnt(%0)" :: "i"(n) : "memory")
#define SLOAD_H(Kp, Vp, k0) do { S.st_v0 = load8(ROW(Vp, k0, sr)); S.st_v1 = load8(ROW(Vp, k0, 32 + sr));              \
                         S.st_k0 = load8(ROW(Kp, k0, sr)); S.st_k1 = load8(ROW(Kp, k0, 32 + sr)); } while (0)
#define SWRITE_HK(bf) do { *(bf16x8*)(K_lds + (bf) * SHM_K + kws) = S.st_k0; *(bf16x8*)(K_lds + (bf) * SHM_K + kws + 32 * 256) = S.st_k1; } while (0)
#define SWRITE_HV(bf) do { *(bf16x8*)(V_lds + (bf) * SHM_V + vst0) = S.st_v0; *(bf16x8*)(V_lds + (bf) * SHM_V + vst1) = S.st_v1; } while (0)
#define SWRITE_H(bf) do { SWRITE_HV(bf); SWRITE_HK(bf); } while (0)
__device__ __forceinline__ void causal_prime(const BlockRef& cur, char* lds, Seam& S) {
    const int tid = ltid(), wid = __builtin_amdgcn_readfirstlane(tid >> 6), lane = tid & 63, r32 = lane & 31, hi = lane >> 5;
    const int sr = tid >> 4, sc = (tid & 15) * 8, kws = KSWZ(sr, sc * 2); char* K_lds = lds + 2 * SHM_V;
    const int kb0 = 0;
#pragma unroll
    for (int d0 = 0; d0 < 8; ++d0) S.qr[d0] = load8(cur.Q + (size_t)(wid * QBLK + r32) * LDZ + d0 * 16 + hi * 8);
    SLOAD_H(cur.K, cur.V, kb0); VMW(); SWRITE_HK(0);
    __syncthreads();
}
template <int ORD>
__device__ __forceinline__ void causal_block(const BlockRef& cur, const BlockRef& nxt, int skv, char* lds, Seam& S) {
    const int tid = ltid(), wid = __builtin_amdgcn_readfirstlane(tid >> 6), lane = tid & 63, r32 = lane & 31, hi = lane >> 5;
    const int W = 1 << 30;
    const int j_lo = 0;
    int j_hi = (cur.P0 + QB - 1) / KVBLK + 1; if (j_hi > skv / KVBLK) j_hi = skv / KVBLK;
    const int NT = j_hi - j_lo;
    const int kbn = 0;
    const int qlo = cur.P0 + wid * QBLK, qm = qlo + r32 - 4 * hi;
    char* V_lds = lds; char* K_lds = lds + 2 * SHM_V;
    float* ws = (float*)(lds + 2 * SHM_V + 2 * SHM_K) + wid * 64; float* li_l = ws, * al_l = ws + 32;
    float m_reg = -1e30f, l_reg = 0; f32x16 o[4];
    { float z_ = 0.f; asm volatile("" : "+v"(z_));
#pragma unroll
      for (int d_ = 0; d_ < 4; ++d_)
#pragma unroll
          for (int r = 0; r < 16; ++r) o[d_][r] = z_; }
    const int sr = tid >> 4, sc = (tid & 15) * 8, vst0 = v_st(sr, sc), vst1 = v_st(32 + sr, sc), kws = KSWZ(sr, sc * 2);
    const int vb0 = (int)(uintptr_t)V_lds + v_rd_base(lane);
    const bf16_t* Kh = cur.K; const bf16_t* Vh = cur.V;
#define RESC(a) do { if (__any((a) < 1.f)) { if (hi == 0) al_l[r32] = (a); asm volatile("s_waitcnt lgkmcnt(0)" ::: "memory");              \
                     _Pragma("unroll") for (int d_ = 0; d_ < 4; ++d_) _Pragma("unroll") for (int r = 0; r < 16; ++r) o[d_][r] *= al_l[crow(r, hi)]; } } while (0)
#define KBASE(t) ((j_lo + (t)) * KVBLK)
#define MASKT(P0_, P1_, t) do { const int kb_ = KBASE(t); if (kb_ + KVBLK - 1 > qlo) mask_tile(P0_, P1_, qm - kb_, (unsigned)W); } while (0)
    constexpr int NQL = 8;
#define SEAM_K0() do { VMWN(NQL); SWRITE_HK(0); SBAR(); } while (0)
    f32x16 pA0, pA1, pB0, pB1; float mnA, mnB, alA, alB; bf16x8 pa0, pa1, pa2, pa3;
    SWRITE_HV(0); SBAR();
    if (NT > 1) { SLOAD_H(Kh, Vh, KBASE(1)); }
    SBAR(); qkt<0>(pA0, pA1, K_lds, r32, hi, S.qr);
    MASKT(pA0, pA1, 0); partialSM(pA0, pA1, m_reg, mnA, alA);
    if (NT > 1) { VMW(); SWRITE_H(1); }
    __syncthreads();
#define HALF_STEP(PX0, PX1, mnX, alX, PY0, PY1, alY, t, KB, VB, SB) do {                                                      \
        SBAR(); qkt<KB>(PX0, PX1, K_lds, r32, hi, S.qr);                                                                      \
        finishSM(PY0, PY1, alY, l_reg, pa0, pa1, pa2, pa3); SBAR();                                                           \
        if ((t) + 1 < NT) { SLOAD_H(Kh, Vh, KBASE((t) + 1)); SBAR(); }                                                        \
        pv_tile<VB>(o, vb0, pa0, pa1, pa2, pa3); MASKT(PX0, PX1, (t)); partialSM(PX0, PX1, m_reg, mnX, alX);                  \
        __syncthreads();                                                                                                      \
        if ((t) + 1 < NT) { VMW(); SWRITE_H(SB); }                                                                            \
        RESC(alX); __syncthreads(); } while (0)
#define HALF_STEP_V(PX0, PX1, mnX, alX, PY0, PY1, alY, t, KB, VB, SB) do {                                                    \
        SBAR(); finishSM(PY0, PY1, alY, l_reg, pa0, pa1, pa2, pa3); SBAR();                                                   \
        qkt<KB>(PX0, PX1, K_lds, r32, hi, S.qr); SBAR();                                                                      \
        if ((t) + 1 < NT) { SLOAD_H(Kh, Vh, KBASE((t) + 1)); SBAR(); }                                                        \
        MASKT(PX0, PX1, (t)); partialSM(PX0, PX1, m_reg, mnX, alX); SBAR();                                                   \
        pv_tile<VB>(o, vb0, pa0, pa1, pa2, pa3);                                                                              \
        __syncthreads();                                                                                                      \
        if ((t) + 1 < NT) { VMW(); SWRITE_H(SB); }                                                                            \
        RESC(alX); __syncthreads(); } while (0)
    for (int t = 1; t + 1 < NT; t += 2) {
        if constexpr (ORD == 0) { HALF_STEP(pB0, pB1, mnB, alB, pA0, pA1, alA, t, 1, 0, 0);
                                  HALF_STEP(pA0, pA1, mnA, alA, pB0, pB1, alB, t + 1, 0, 1, 1); }
        else                    { HALF_STEP_V(pB0, pB1, mnB, alB, pA0, pA1, alA, t, 1, 0, 0);
                                  HALF_STEP_V(pA0, pA1, mnA, alA, pB0, pB1, alB, t + 1, 0, 1, 1); }
    }
    const bool even = (NT & 1) == 0;
    if (even) { SBAR(); qkt<1>(pB0, pB1, K_lds, r32, hi, S.qr); SBAR(); }
    SLOAD_H(nxt.K, nxt.V, kbn); SBAR();
#pragma unroll
    for (int d0 = 0; d0 < 8; ++d0) S.qr[d0] = load8(nxt.Q + (size_t)(wid * QBLK + r32) * LDZ + d0 * 16 + hi * 8);
    SBAR();
    finishSM(pA0, pA1, alA, l_reg, pa0, pa1, pa2, pa3); SBAR();
    pv_tile<0>(o, vb0, pa0, pa1, pa2, pa3);
    if (even) { MASKT(pB0, pB1, NT - 1); partialSM(pB0, pB1, m_reg, mnB, alB); __syncthreads(); RESC(alB);
        finishSM(pB0, pB1, alB, l_reg, pa0, pa1, pa2, pa3); SBAR(); pv_tile<1>(o, vb0, pa0, pa1, pa2, pa3); }
    SBAR(); SEAM_K0();
    if (hi == 0) li_l[r32] = l_reg; asm volatile("s_waitcnt lgkmcnt(0)" ::: "memory");
    float rli[16];
#pragma unroll
    for (int r = 0; r < 16; ++r) rli[r] = __builtin_amdgcn_rcpf(li_l[crow(r, hi)]);
    bf16_t* Ow = cur.O + (size_t)(wid * QBLK) * LDO;
#pragma unroll
    for (int r = 0; r < 16; ++r) { const int orow = crow(r, hi);
#pragma unroll
        for (int d0 = 0; d0 < 4; ++d0) { const float v = o[d0][r] * rli[r]; const float vn = lx1(v);
            if ((r32 & 1) == 0) *(unsigned*)(Ow + (size_t)orow * LDO + d0 * 32 + r32) = cvt_pk_bf16(v, vn); } }
    __syncthreads();
#undef RESC
#undef KBASE
#undef MASKT
#undef SEAM_K0
#undef HALF_STEP
#undef HALF_STEP_V
}
#undef ROW
#undef VMW
#undef VMWN
#undef SLOAD_H
#undef SWRITE_HK
#undef SWRITE_HV
#undef SWRITE_H
#undef KSWZ
#undef SBAR
}

#define XB_TMO      128
#define XB_XCNT(j)  (256  + 64 * (j))
#define XB_XSUB(j)  (1280 + 64 * (j))
#define XB_XGEN(j)  (2304 + 64 * (j))
#define XB_TOP      3328
#define XB_TOPGEN   3392
#define XCD_BAR_WORDS 3456
#define XB_SPIN_CAP (1u << 18)

__device__ __forceinline__ unsigned xb_ld(unsigned* p)              { return __hip_atomic_load(p, __ATOMIC_RELAXED, __HIP_MEMORY_SCOPE_AGENT); }
__device__ __forceinline__ unsigned xb_add(unsigned* p, unsigned v) { return __hip_atomic_fetch_add(p, v, __ATOMIC_RELAXED, __HIP_MEMORY_SCOPE_AGENT); }
__device__ __forceinline__ unsigned xb_xcc_id() { return (unsigned)__builtin_amdgcn_s_getreg((3 << 11) | 20) & 0xFu; }
#define XB_SPIN(cond, bar) do { unsigned _sp = 0; while (cond) { __builtin_amdgcn_s_sleep(1); \
    if ((++_sp & 255u) == 0u) { if (xb_ld(&(bar)[XB_TMO])) break; if (_sp > XB_SPIN_CAP) { atomicAdd(&(bar)[XB_TMO], 1u); break; } } } } while (0)

struct XcdBarrier {
    unsigned* bar; unsigned x;
    volatile LAS unsigned* st;
};

__device__ __forceinline__ XcdBarrier xcd_barrier_post(unsigned* bar, volatile LAS unsigned* st) {
    XcdBarrier b; b.bar = bar; b.x = xb_xcc_id(); b.st = st;
    if (threadIdx.x == 0) (void)xb_add(&bar[XB_XCNT(b.x)], 1u);
    return b;
}
__device__ __forceinline__ void xcd_barrier_complete(unsigned* bar, unsigned x, unsigned& nloc, unsigned& nx) {
    const unsigned G = gridDim.x * gridDim.y * gridDim.z;
    unsigned sum, cnt, mine, sp = 0u;
    for (;;) {
        sum = 0u; cnt = 0u; mine = 0u;
#pragma unroll
        for (unsigned j = 0; j < 16; ++j) { const unsigned c = xb_ld(&bar[XB_XCNT(j)]); sum += c; cnt += (c > 0u) ? 1u : 0u; mine = (j == x) ? c : mine; }
        if (sum == G) break;
        __builtin_amdgcn_s_sleep(1);
        if ((++sp & 255u) == 0u) { if (xb_ld(&bar[XB_TMO])) break; if (sp > XB_SPIN_CAP) { atomicAdd(&bar[XB_TMO], 1u); break; } }
    }
    nloc = mine > 0u ? mine : 1u; nx = cnt > 0u ? cnt : 1u;
}

template <bool FIRST> __device__ __forceinline__ void xcd_barrier(const XcdBarrier& b) {
    asm volatile("s_waitcnt vmcnt(0)" ::: "memory");
    __syncthreads();
    if (threadIdx.x == 0) {
        unsigned* bar = b.bar;
        __builtin_amdgcn_s_waitcnt(0);
        unsigned nloc = b.st[0], nx = b.st[1];
        if (FIRST) { if (nloc == 0u) { xcd_barrier_complete(bar, b.x, nloc, nx); b.st[0] = nloc; b.st[1] = nx; } }
        const unsigned old = xb_add(&bar[XB_XSUB(b.x)], 1u);
        const unsigned gen = old / nloc;
        if (old + 1u == (gen + 1u) * nloc) {
            __builtin_amdgcn_fence(__ATOMIC_RELEASE, "agent");
            asm volatile("s_waitcnt vmcnt(0)" ::: "memory");
            const unsigned og = xb_add(&bar[XB_TOP], 1u);
            const unsigned tg = og / nx;
            if (og + 1u == (tg + 1u) * nx) xb_add(&bar[XB_TOPGEN], 1u);
            else XB_SPIN(xb_ld(&bar[XB_TOPGEN]) == tg, bar);
            __builtin_amdgcn_fence(__ATOMIC_ACQUIRE, "agent");
            xb_add(&bar[XB_XGEN(b.x)], 1u);
            asm volatile("s_waitcnt vmcnt(0)" ::: "memory");
        } else {
            XB_SPIN(xb_ld(&bar[XB_XGEN(b.x)]) == gen, bar);
            __builtin_amdgcn_fence(__ATOMIC_ACQUIRE, "agent");
            asm volatile("s_waitcnt vmcnt(0)" ::: "memory");
        }
    }
    __syncthreads();
}

template <int KT, bool F8>
__device__ __forceinline__ void transpose_item(const float* W, int K, int N, void* WT, int drow0, int k0, int n0, LAS float* scr, int lane, const float* gk) {
    const int kr = lane >> 3, n4 = 4 * (lane & 7);
    f32x4 v[KT / 8];
#pragma unroll
    for (int i = 0; i < KT / 8; ++i) v[i] = *(const f32x4*)(W + (size_t)(k0 + kr + 8 * i) * N + n0 + n4);
    if (gk) {
#pragma unroll
        for (int i = 0; i < KT / 8; ++i) v[i] = v[i] * gk[k0 + kr + 8 * i]; }
#pragma unroll
    for (int i = 0; i < KT / 8; ++i) { LAS float* s = scr + (kr + 8 * i) * 33 + 4 * ((kr + 8 * i) >> 4) + n4; s[0] = v[i][0]; s[1] = v[i][1]; s[2] = v[i][2]; s[3] = v[i][3]; }
    LDS_WAIT(); asm volatile("" ::: "memory");
    const int c = lane & 7;
#pragma unroll
    for (int j = 0; j < 4; ++j) { const int n = (lane >> 3) + 8 * j;
        if constexpr (!F8) { static_assert(F8 || KT == 64, "bf16 item is 64 k");
            const LAS float* s = scr + (8 * c) * 33 + 4 * ((8 * c) >> 4) + n;
            u32x4 o; o.x = cvt_pk_bf16(s[0 * 33], s[1 * 33]); o.y = cvt_pk_bf16(s[2 * 33], s[3 * 33]); o.z = cvt_pk_bf16(s[4 * 33], s[5 * 33]); o.w = cvt_pk_bf16(s[6 * 33], s[7 * 33]);
            *(u32x4*)((bf16_t*)WT + (size_t)(drow0 + n) * K + k0 + 8 * c) = o;
        } else { static_assert(!F8 || KT == 128, "fp8 item is 128 k");
            const LAS float* s = scr + (16 * c) * 33 + 4 * c + n;
            u32x4 o;
            o.x = pk4_fp8(s[0 * 33] * W8_SCALE, s[1 * 33] * W8_SCALE, s[2 * 33] * W8_SCALE, s[3 * 33] * W8_SCALE);
            o.y = pk4_fp8(s[4 * 33] * W8_SCALE, s[5 * 33] * W8_SCALE, s[6 * 33] * W8_SCALE, s[7 * 33] * W8_SCALE);
            o.z = pk4_fp8(s[8 * 33] * W8_SCALE, s[9 * 33] * W8_SCALE, s[10 * 33] * W8_SCALE, s[11 * 33] * W8_SCALE);
            o.w = pk4_fp8(s[12 * 33] * W8_SCALE, s[13 * 33] * W8_SCALE, s[14 * 33] * W8_SCALE, s[15 * 33] * W8_SCALE);
            *(u32x4*)((unsigned char*)WT + (size_t)(drow0 + n) * K + k0 + 16 * c) = o;
        } }
    LDS_WAIT(); asm volatile("" ::: "memory");
}
template <bool F8> struct TrItem { static constexpr int NB = F8 ? 4 : 2; f32x4 v[NB][4]; f32x4 g[NB]; };
template <bool F8> __device__ __forceinline__ void tr_load(TrItem<F8>& T, const float* W, int N, int k0, int n0, int lane, const float* gk, bool useg) {
    const int kq = lane >> 3, nq = lane & 7;
#pragma unroll
    for (int b = 0; b < TrItem<F8>::NB; ++b) {
        const int kr = k0 + 32 * b + 4 * kq;
        const f32x4 gv = *(const f32x4*)(gk + (kr & (DM - 1)));
        T.g[b] = useg ? gv : (f32x4){1.f, 1.f, 1.f, 1.f};
#pragma unroll
        for (int i = 0; i < 4; ++i) T.v[b][i] = *(const f32x4*)(W + (size_t)(kr + i) * N + n0 + 4 * nq);
    }
}
template <bool F8> __device__ __forceinline__ void tr_store(const TrItem<F8>& T, void* WT, int K, int drow0, int dstep, int k0, LAS unsigned char* scr, int lane) {
    const int kq = lane >> 3, nq = lane & 7;
#pragma unroll
    for (int b = 0; b < TrItem<F8>::NB; ++b) {
        f32x4 x[4];
#pragma unroll
        for (int i = 0; i < 4; ++i) x[i] = T.v[b][i] * (T.g[b][i] * (F8 ? W8_SCALE : 1.0f));
#pragma unroll
        for (int e = 0; e < 4; ++e) {
            LAS unsigned char* row = scr + (4 * nq + e) * 144;
            if constexpr (F8) { const int kb = 32 * b + 4 * kq, ch = (kb >> 4) ^ nq;
                *(LAS unsigned*)(row + 16 * ch + (kb & 15)) = pk4_fp8(x[0][e], x[1][e], x[2][e], x[3][e]); }
            else { const int kb = 64 * b + 8 * kq, ch = (kb >> 4) ^ nq;
                u32x2 w; w.x = cvt_pk_bf16(x[0][e], x[1][e]); w.y = cvt_pk_bf16(x[2][e], x[3][e]); *(LAS u32x2*)(row + 16 * ch + (kb & 15)) = w; }
        }
    }
    LDS_WAIT(); asm volatile("" ::: "memory");
    const int c = lane & 7;
#pragma unroll
    for (int j = 0; j < 4; ++j) { const int n = (lane >> 3) + 8 * j;
        const u32x4 o = *(const LAS u32x4*)(scr + n * 144 + 16 * (c ^ ((n >> 2) & 7)));
        *(u32x4*)((unsigned char*)WT + ((size_t)(drow0 + n * dstep) * K + k0) * (F8 ? 1 : 2) + 16 * c) = o; }
    LDS_WAIT(); asm volatile("" ::: "memory");
}

__device__ __forceinline__ float row_copy_ss(const float* xrow, bf16_t* orow, int lane) {
    const f32x4* xr = (const f32x4*)xrow + lane; u32x2* o8 = (u32x2*)orow + lane;
    float s = 0.f;
#pragma unroll
    for (int j = 0; j < 8; ++j) { const f32x4 v = xr[64 * j]; s += (v.x * v.x + v.y * v.y) + (v.z * v.z + v.w * v.w); u32x2 w; w.x = cvt_pk_bf16(v.x, v.y); w.y = cvt_pk_bf16(v.z, v.w); o8[64 * j] = w; }
    return wave_sum(s);
}

struct ItemDesc { const float* W; void* WT; const float* gk; int K, N, drow0, dstep, k0, n0; bool useg; };
template <bool F8, class Dec> __device__ __forceinline__ void conv_loop(int first, int end, int stride, const Dec& dec, LAS unsigned char* scr, int lane) {
    int it = first; if (it >= end) return;
    TrItem<F8> A, B; ItemDesc da, db;
    dec(it, da); tr_load<F8>(A, da.W, da.N, da.k0, da.n0, lane, da.gk, da.useg);
    for (;;) {
        int nx = it + stride; bool hn = nx < end; dec(hn ? nx : it, db); tr_load<F8>(B, db.W, db.N, db.k0, db.n0, lane, db.gk, db.useg);
        tr_store<F8>(A, da.WT, da.K, da.drow0, da.dstep, da.k0, scr, lane);
        if (!hn) break; it = nx;
        nx = it + stride; hn = nx < end; dec(hn ? nx : it, da); tr_load<F8>(A, da.W, da.N, da.k0, da.n0, lane, da.gk, da.useg);
        tr_store<F8>(B, db.WT, db.K, db.drow0, db.dstep, db.k0, scr, lane);
        if (!hn) break; it = nx;
    }
}
constexpr int MOE_J = 8;
#ifndef CONV_NUM
#define CONV_NUM 12
#endif
struct DecMoe {
    volatile LAS unsigned* LW; int cbase, wave, blk;
    __device__ __forceinline__ int item(int q) const { return (q / MOE_J) * blk + cbase + (q % MOE_J) * 8 + wave; }
    __device__ __forceinline__ unsigned long long ptr(int i) const { return (unsigned long long)(unsigned)__builtin_amdgcn_readfirstlane((int)LW[64 + 2 * i]) | ((unsigned long long)(unsigned)__builtin_amdgcn_readfirstlane((int)LW[64 + 2 * i + 1]) << 32); }
    __device__ __forceinline__ void operator()(int q, ItemDesc& d) const {
        constexpr int PER = 3584; const int it = item(q);
        const int mat = it / PER, r = it - mat * PER, e = mat & 7, kind = mat >> 3;
        const bool up_ = kind < 2;
        const int nblk = up_ ? 224 : 64, kb = r / nblk, nb = r - kb * nblk;
        d.K = up_ ? DM : FFE; d.N = up_ ? FFE : DM; d.n0 = 32 * nb; d.k0 = 128 * kb; d.useg = up_; d.dstep = 1;
        d.drow0 = up_ ? (256 * (d.n0 >> 7) + kind * 128 + (d.n0 & 127)) : d.n0;
        d.W = (const float*)(GAS const float*)ptr(kind == 0 ? 17 : (kind == 1 ? 18 : 19)) + (size_t)e * DM * FFE;
        d.gk = (const float*)(GAS const float*)ptr(12) + DM;
        d.WT = (unsigned char*)(GAS unsigned char*)(ptr(21) + (up_ ? WS_WMGU : WS_WMD)) + (size_t)e * (up_ ? 2 : 1) * FFE * DM;
    }
};
constexpr int MOE_ITEMS = 24 * 3584;
struct DecMoeLin : DecMoe { int first, stride; __device__ __forceinline__ void operator()(int q, ItemDesc& d) const { DecMoe t = *this; t.cbase = first + q * stride; t.wave = 0; t.blk = 0; t.DecMoe::operator()(0, d); } };
struct DecP0 {
    volatile LAS unsigned* LW;
    static constexpr int I_IN = 32 * 160, I_OUT = 32 * 64, I_DG = 32 * 176, I_DD = 88 * 64, J_DG = 16 * 176, J_DD = 44 * 64;
    static constexpr int N16A = 2 * I_IN + 2 * I_OUT, N16B = N16A + (DUP8 ? 0 : 2 * I_DG), N16 = N16B + (DDN8 ? 0 : I_DD);
    static constexpr int N8A = DUP8 ? 2 * J_DG : 0, N8 = N8A + (DDN8 ? J_DD : 0);
    __device__ __forceinline__ unsigned long long ptr(int i) const { return (unsigned long long)(unsigned)__builtin_amdgcn_readfirstlane((int)LW[64 + 2 * i]) | ((unsigned long long)(unsigned)__builtin_amdgcn_readfirstlane((int)LW[64 + 2 * i + 1]) << 32); }
    __device__ __forceinline__ const float* inf(int i) const { return (const float*)(GAS const float*)ptr(i); }
    __device__ __forceinline__ unsigned char* wsp(size_t off) const { return (unsigned char*)(GAS unsigned char*)(ptr(21) + off); }
    __device__ __forceinline__ void fin(ItemDesc& d, int r, int mode, int kt) const {
        const int nblk = d.N / 32, kb = r / nblk, nb = r - kb * nblk; d.n0 = 32 * nb; d.k0 = kt * kb;
        d.drow0 = mode == 0 ? d.n0 : (256 * (d.n0 >> 7) + (mode - 1) * 128 + (d.n0 & 127)); d.dstep = 1;
        if (mode == 3) { const int dd = d.n0 & 127; d.drow0 = (d.n0 & ~127) + (dd < 64 ? 2 * dd : 2 * (dd - 64) + 1); d.dstep = 2; } }
};
struct DecP0b16 : DecP0 {
    __device__ __forceinline__ void operator()(int it, ItemDesc& d) const {
        int r = it, mode = 0; d.K = DM; d.useg = false; d.gk = inf(2);
        if (r < 2 * I_IN) { const int l = r / I_IN; r -= l * I_IN; d.W = inf(3) + (size_t)l * DM * INW; d.WT = wsp(WS_WIN) + (size_t)l * INW * DM * 2; d.N = INW; d.gk = inf(2) + l * DM; d.useg = true;
                            if ((r % (INW / 32)) * 32 < ZV) mode = 3; }
        else if (r < N16A) { r -= 2 * I_IN; const int l = r / I_OUT; r -= l * I_OUT; d.W = inf(11) + (size_t)l * DM * DM; d.WT = wsp(WS_WOUT) + (size_t)l * DM * DM * 2; d.N = DM; }
        else if (r < N16B) { r -= N16A; mode = 1 + r / I_DG; r -= (mode - 1) * I_DG; d.W = mode == 1 ? inf(13) : inf(14); d.WT = wsp(WS_WDGU); d.N = FFD; d.gk = inf(12); d.useg = true; }
        else { r -= N16B; d.W = inf(15); d.WT = wsp(WS_WDD); d.K = FFD; d.N = DM; }
        fin(d, r, mode == 3 ? 3 : mode, 64);
    }
};
struct DecP0f8 : DecP0 {
    __device__ __forceinline__ void operator()(int it, ItemDesc& d) const {
        int r = it, mode = 0; d.useg = false; d.gk = inf(12);
        if (r < N8A) { mode = 1 + r / J_DG; r -= (mode - 1) * J_DG; d.W = mode == 1 ? inf(13) : inf(14); d.WT = wsp(WS_WDGU); d.K = DM; d.N = FFD; d.useg = true; }
        else { r -= N8A; d.W = inf(15); d.WT = wsp(WS_WDD); d.K = FFD; d.N = DM; }
        fin(d, r, mode, 128);
    }
};
__device__ __forceinline__ void moe_conv_slots(volatile LAS unsigned* LW, LAS unsigned char* lds, int slot0, int nsl, int bx, int G) {
    const int tid = ltid(), lane = tid & 63, wave = __builtin_amdgcn_readfirstlane(tid >> 6), gw = bx * 8 + wave, NGW = G * 8;
#pragma unroll 1
    for (int q = 0; q < 2; ++q) {
        const int first = (slot0 * NGW + gw) * 2 + q, stride = 2 * NGW;
        int cnt = first < MOE_ITEMS ? (MOE_ITEMS - 1 - first) / stride + 1 : 0; cnt = cnt < nsl ? cnt : nsl;
        const DecMoeLin dec{{LW, 0, 0, 0}, first, stride};
        conv_loop<true>(0, cnt, 1, dec, lds + 1024 + wave * 4608, lane);
    }
}

struct Args { const void* in[20]; float* out; unsigned char* ws; };

__global__ void __launch_bounds__(512, 2) hybrid_fwd(Args args) {
    extern __shared__ __attribute__((aligned(16))) unsigned char lds_raw[];
    LAS unsigned char* lds = (LAS unsigned char*)lds_raw;
    volatile LAS unsigned* LW = (volatile LAS unsigned*)(lds + LDSCTL_OFF);
    const int tid = threadIdx.x, lane = tid & 63, wave = __builtin_amdgcn_readfirstlane(tid >> 6);
    const int G = gridDim.x, bx = blockIdx.x;
    const int gw = bx * 8 + wave, NGW = G * 8;
    for (int u = tid; u < LDSCTL_BYTES / 4; u += 512) LW[u] = 0u;
    __syncthreads();
    if (lane == 0) LW[128 + ((unsigned)__builtin_amdgcn_s_getreg((5 << 11) | 4) & 63u)] = (unsigned)wave;
    if (tid < 22) { const unsigned long long pv = tid < 20 ? (unsigned long long)args.in[tid] : (tid == 20 ? (unsigned long long)args.out : (unsigned long long)args.ws);
        LW[64 + 2 * tid] = (unsigned)pv; LW[64 + 2 * tid + 1] = (unsigned)(pv >> 32); }
    __syncthreads();
#define PTR(i) ((unsigned long long)(unsigned)__builtin_amdgcn_readfirstlane((int)LW[64 + 2 * (i)]) | ((unsigned long long)(unsigned)__builtin_amdgcn_readfirstlane((int)LW[64 + 2 * (i) + 1]) << 32))
#define INF(i) ((const float*)(GAS const float*)PTR(i))
#define WSP(T, off) ((T*)(GAS T*)(PTR(21) + (unsigned long long)(off)))
#define OUTP ((float*)(GAS float*)PTR(20))
    { const XcdBarrier b0 = xcd_barrier_post(WSP(unsigned, WS_CTL) + CW_BAR, LW); if (threadIdx.x == 0) LW[2] = b0.x; }
    __syncthreads();
#define GRID_BAR_T(F) do { XcdBarrier b_; b_.bar = WSP(unsigned, WS_CTL) + CW_BAR; b_.x = (unsigned)__builtin_amdgcn_readfirstlane((int)LW[2]); b_.st = LW; xcd_barrier<F>(b_); } while (0)
#define GRID_BAR() GRID_BAR_T(false)

    unsigned long long tacc_ = 0ull, tph_ = 0ull; (void)tacc_; (void)tph_;
#define PH_BEGIN() do { if (PROBE_MASK) tph_ = __builtin_amdgcn_s_memrealtime(); } while (0)
#define PH_END(id) do { if (PROBE_MASK & (1u << (id))) tacc_ += __builtin_amdgcn_s_memrealtime() - tph_; } while (0)
    PH_BEGIN();
    for (int rep_ = 0; rep_ < REP_P0; ++rep_) {
        LAS float* scr = (LAS float*)(lds + 1024 + wave * 17152);
        unsigned char* ws = WSP(unsigned char, 0);
        {
            LAS unsigned char* tscr = lds + 1024 + wave * 4608;
            DecP0b16 d16; d16.LW = LW; conv_loop<false>(gw, DecP0::I_IN, NGW, d16, tscr, lane);
        }
        {
            const int* positions = (const int*)(GAS const int*)PTR(1); float* cosT = (float*)(ws + WS_COS); float* sinT = (float*)(ws + WS_SIN);
            for (int idx = (bx * 512 + tid); idx < NTOK * 64; idx += G * 512) {
                const int t = idx >> 6, i = idx & 63;
                const float inv = 1.0f / powf(10000.0f, (float)(2 * i) / 128.0f);
                const float ang = (float)positions[t] * inv;
                double rev = (double)ang * 0.15915494309189535; rev -= rint(rev);
                const float rf = (float)rev;
                cosT[idx] = __builtin_amdgcn_cosf(rf); sinT[idx] = __builtin_amdgcn_sinf(rf);
            }
        }
        {
            const float* w_pool = INF(8); bf16_t* wpt = (bf16_t*)(ws + WS_WPT);
            for (int idx = (bx * 512 + tid); idx < 2 * 4 * 128 * 128; idx += G * 512) {
                const int c = idx & 127, d = (idx >> 7) & 127, lg = idx >> 14;
                const float v = w_pool[((size_t)lg * 128 + c) * 128 + d];
                wpt[idx] = (bf16_t)(cvt_pk_bf16(v, 0.f) & 0xffffu);
            }
        }
        {
            const float* x_in = INF(0); bf16_t* xb = (bf16_t*)(ws + WS_XR); float* ss0 = (float*)(ws + WS_SS);
            for (int m = gw; m < NTOK; m += NGW) { const float s = row_copy_ss(x_in + (size_t)m * DM, xb + (size_t)m * DM, lane); if (lane < 8) ss0[(size_t)m * 8 + lane] = lane == 0 ? s : 0.f; }
        }
    }
    GRID_BAR_T(true); PH_END(0); PH_BEGIN();

    constexpr int BG_P1 = 5, BG_P5 = 2, BG_DU = 11, BG_DD = 2, BG_L1 = BG_P1 + BG_P5 + BG_DU + BG_DD, BG_ALL = BG_L1 + BG_P1 + BG_P5;
    for (int l = 0; l < DEPTH; ++l) {
#define PHASE_IDS() const int tid = ltid(), lane = tid & 63, wave = __builtin_amdgcn_readfirstlane(tid >> 6), gw = bx * 8 + wave; (void)tid; (void)lane; (void)wave; (void)gw
        if (l == 0) {
            const int NCV = (G * CONV_NUM / 32) & ~7;
            if (bx < NCV) {
                PHASE_IDS();
                LAS unsigned char* tscr = lds + 1024 + wave * 4608; const int NGC = NCV * 8;
                { DecP0b16 d16; d16.LW = LW; conv_loop<false>(DecP0::I_IN + gw, DecP0::N16, NGC, d16, tscr, lane); }
                if (DecP0::N8 > 0) { DecP0f8 d8; d8.LW = LW; conv_loop<true>(gw, DecP0::N8, NGC, d8, tscr, lane); }
                { const DecMoe dm{LW, bx * 8 * MOE_J, wave, NGC * MOE_J}; int cnt = 0; while (dm.item(cnt) < MOE_ITEMS) ++cnt; conv_loop<true>(0, cnt, 1, dm, tscr, lane); }
            } else {
                pg8::Gemm g{WSP(bf16_t, WS_XR), WSP(bf16_t, WS_WIN), DM * 2, 0};
                pg8::StaticOrder S; S.init(NTOK / 256, INW / 256, G - NCV, bx - NCV);
                pg8::EpiZ E{WSP(bf16_t, WS_Z), INW, WSP(float, WS_SS), INF(4), INF(5), WSP(float, WS_COS), WSP(float, WS_SIN), (LAS float*)(lds + 1024)};
                pg8::gemm_phase<pg8::EpiZ, pg8::StaticOrder>(lds + RING_OFF, g, S, E);
            }
        } else
        for (int rep_ = 0; rep_ < REP_P1; ++rep_) {
            const int pos_ = BG_SPLIT ? (bx >> 3) % (BG_P1 + 1) : 0;
            for (int part_ = 0; part_ < 2; ++part_) {
            pg8::Gemm g{WSP(bf16_t, WS_XR), WSP(bf16_t, WS_WIN) + (size_t)l * INW * DM, DM * 2, 0};
            pg8::StaticOrder S; S.init(NTOK / 256, INW / 256, G, bx, part_ ? pos_ : 0, part_ ? (1 << 30) : pos_);
            pg8::EpiZ E{WSP(bf16_t, WS_Z), INW, WSP(float, WS_SS) + (size_t)(l == 0 ? 0 : 2) * NTOK * 8, INF(4) + l * 128, INF(5) + l * 128, WSP(float, WS_COS), WSP(float, WS_SIN), (LAS float*)(lds + 1024)};
            pg8::gemm_phase<pg8::EpiZ, pg8::StaticOrder>(lds + RING_OFF, g, S, E);
            if (BG_SPLIT && part_ == 0) { moe_conv_slots(LW, lds, l == 0 ? 0 : BG_L1, BG_P1, bx, G); __syncthreads(); }
            }
        }
        GRID_BAR(); PH_END(1); PH_BEGIN();
        for (int rep_ = 0; rep_ < REP_P3; ++rep_) {
            constexpr int NITEM = 512;
            char* alds = (char*)lds_raw + RING_OFF;
            int L = bx;
            if (L < NITEM) {
                const bf16_t* zb = WSP(bf16_t, WS_Z); bf16_t* ao = WSP(bf16_t, WS_AO);
#define ATT_REF(ref, LL, pass) do { const int xcd_ = (LL) & 7, k_ = (LL) >> 3, bh_ = (k_ >> 4) * 8 + xcd_, b_ = bh_ >> 2, h_ = bh_ & 3, vh_ = (k_ & 15) >> 2, mp_ = vh_ >> 1, vj_ = vh_ & 1, x_ = k_ & 3; \
                    const int qb_ = (pass) ? 7 - x_ : x_; const bf16_t* zb_ = zb + (size_t)b_ * SEQ * INW; \
                    (ref).Q = zb_ + (size_t)qb_ * 256 * INW + ZQ + h_ * 256 + mp_ * 128; (ref).K = zb_ + ZK + h_ * 256 + mp_ * 128; (ref).V = zb_ + ZV + h_ * 256 + vj_ * 128; \
                    (ref).O = ao + ((size_t)b_ * SEQ + (size_t)qb_ * 256) * DM + h_ * 512 + mp_ * 256 + vj_ * 128; (ref).P0 = qb_ * 256; } while (0)
#define ATT_ITEMS(ORD) do { att::BlockRef cur, nxt; int pass = 0; \
                ATT_REF(cur, L, 0); \
                att::Seam S; \
                att::causal_prime(cur, alds, S); \
                for (;;) { \
                    const bool more_pass = pass == 0, more_item = L + G < NITEM, last = !more_pass && !more_item; \
                    int passn = pass + 1, Ln = L; \
                    if (!more_pass) { passn = 0; Ln = more_item ? L + G : L; } \
                    if (last) nxt = cur; else ATT_REF(nxt, Ln, passn); \
                    att::causal_block<ORD>(cur, nxt, SEQ, alds, S); \
                    if (last) break; \
                    cur = nxt; pass = passn; L = Ln; \
                } } while (0)
                if (__builtin_amdgcn_readfirstlane(ltid() >> 8)) { __builtin_amdgcn_s_setprio(1); ATT_ITEMS(0); }
                else { ATT_ITEMS(1); }
#undef ATT_ITEMS
                __builtin_amdgcn_s_setprio(0);
#undef ATT_REF
            }
        }
        GRID_BAR(); PH_END(3); PH_BEGIN();
        if (PH_MASK & (1 << 2)) {
            PHASE_IDS();
            bf16_t* zb = WSP(bf16_t, WS_Z); bf16_t* mix = WSP(bf16_t, WS_MIX);
            {
            const float* qg = INF(4) + l * 128; const float* kg = INF(5) + l * 128;
            const float* cw = INF(10) + (size_t)l * 3 * 512;
            const float* cosT = WSP(float, WS_COS); const float* sinT = WSP(float, WS_SIN);
            {
                const int ch = 8 * lane;
                f32x4 wk[3][2];
#pragma unroll
                for (int j = 0; j < 3; ++j) { wk[j][0] = *(const f32x4*)(cw + j * 512 + ch); wk[j][1] = *(const f32x4*)(cw + j * 512 + ch + 4); }
                for (int grp = gw; grp < NTOK / 8; grp += NGW) {
                    const int t0 = 8 * grp, tb0 = t0 & (SEQ - 1);
                    u32x4 gbv[8], gcv[10], hv[10];
#pragma unroll
                    for (int i = 0; i < 10; ++i) { const int tt = t0 - 2 + i, tc = tt < 0 ? 0 : tt; const bf16_t* zr = zb + (size_t)tc * INW; gcv[i] = *(const u32x4*)(zr + ZGC + ch); hv[i] = *(const u32x4*)(zr + ZH + ch);
                        if (i >= 2) gbv[i - 2] = *(const u32x4*)(zr + ZGB + ch); }
                    float u[10][8];
#pragma unroll
                    for (int i = 0; i < 10; ++i) { const bool ok = (i >= 2) || (tb0 - 2 + i >= 0);
#pragma unroll
                        for (int j = 0; j < 4; ++j) { u[i][2 * j] = ok ? bflo(gcv[i][j]) * bflo(hv[i][j]) : 0.f; u[i][2 * j + 1] = ok ? bfhi(gcv[i][j]) * bfhi(hv[i][j]) : 0.f; } }
#pragma unroll
                    for (int i = 0; i < 8; ++i) { u32x4 w;
#pragma unroll
                        for (int j = 0; j < 4; ++j) { const int c0 = 2 * j, c1 = 2 * j + 1;
                            const float y0 = wk[0][c0 >> 2][c0 & 3] * u[i][c0] + wk[1][c0 >> 2][c0 & 3] * u[i + 1][c0] + wk[2][c0 >> 2][c0 & 3] * u[i + 2][c0];
                            const float y1 = wk[0][c1 >> 2][c1 & 3] * u[i][c1] + wk[1][c1 >> 2][c1 & 3] * u[i + 1][c1] + wk[2][c1 >> 2][c1 & 3] * u[i + 2][c1];
                            w[j] = cvt_pk_bf16(bflo(gbv[i][j]) * y0, bfhi(gbv[i][j]) * y1); }
                        *(u32x4*)(mix + (size_t)(t0 + i) * DM + 1536 + ch) = w; }
                }
            }
            }
            {
            const bf16_t* wpt = WSP(bf16_t, WS_WPT); const float* pool_scale = INF(9) + l * 512;
            const unsigned ptile = (unsigned)(uintptr_t)lds + (unsigned)(RING_OFF + wave * 12800);
            for (int it = gw; it < (NTOK / 32) * 4; it += NGW) {
                const int T = it >> 2, gi = it & 3, wn = 2 << gi, t0 = T * 32, tb0 = t0 & (SEQ - 1);
                const int r32 = lane & 31, hi = lane >> 5, tb = tb0 + r32;
                const float inv = 1.0f / (float)((tb + 1) < wn ? (tb + 1) : wn);
                const bf16_t* wp = wpt + ((size_t)(l * 4 + gi) * 128) * 128;
                {
                    u32x4 tv[12];
#pragma unroll
                    for (int n = 0; n < 12; ++n) { const int q = lane + 64 * n, row = q >> 4, c16 = q & 15; int tt = t0 - 15 + row; tt = tt < 0 ? 0 : (tt < NTOK ? tt : NTOK - 1);
                        tv[n] = *(const u32x4*)(zb + (size_t)tt * INW + ZP + gi * 128 + c16 * 8); }
#pragma unroll
                    for (int n = 0; n < 12; ++n) { const int q = lane + 64 * n, row = q >> 4, c16 = q & 15; const bool ok = (tb0 - 15 + row) >= 0;
                        if (row < 47) *(LAS u32x4*)(uintptr_t)(ptile + row * 272 + c16 * 16) = ok ? tv[n] : (u32x4){0u, 0u, 0u, 0u}; }
                    LDS_WAIT(); asm volatile("" ::: "memory");
                }
                f32x16 acc[4];
#pragma unroll
                for (int nb = 0; nb < 4; ++nb) acc[nb] = f32x16{};
                bf16x8 bcur[4];
#pragma unroll
                for (int nb = 0; nb < 4; ++nb) bcur[nb] = *(const bf16x8*)(wp + (size_t)(nb * 32 + r32) * 128 + 8 * hi);
                const unsigned rbase = ptile + (unsigned)((r32 + 15) * 272 + 16 * hi);
#pragma unroll 1
                for (int s = 0; s < 8; ++s) {
                    const int sn = s < 7 ? s + 1 : 7;
                    bf16x8 bnxt[4];
#pragma unroll
                    for (int nb = 0; nb < 4; ++nb) bnxt[nb] = *(const bf16x8*)(wp + (size_t)(nb * 32 + r32) * 128 + 16 * sn + 8 * hi);
                    float sum[8], self[8];
#pragma unroll
                    for (int j = 0; j < 8; ++j) { sum[j] = 0.f; self[j] = 0.f; }
                    u32x4 rv[16];
#pragma unroll
                    for (int d = 0; d < 16; ++d) { rv[d] = (u32x4){0u, 0u, 0u, 0u}; if (d < wn) rv[d] = *(const LAS u32x4*)(uintptr_t)(rbase + (unsigned)(32 * s) - (unsigned)(272 * d)); }
#pragma unroll
                    for (int d = 0; d < 16; ++d) {
#pragma unroll
                        for (int j = 0; j < 4; ++j) { const float a = bflo(rv[d][j]), b = bfhi(rv[d][j]); sum[2 * j] += a; sum[2 * j + 1] += b; if (d == 0) { self[2 * j] = a; self[2 * j + 1] = b; } }
                    }
                    u32x4 aw;
#pragma unroll
                    for (int j = 0; j < 4; ++j) aw[j] = cvt_pk_bf16(sum[2 * j] * inv - self[2 * j], sum[2 * j + 1] * inv - self[2 * j + 1]);
                    const bf16x8 af = __builtin_bit_cast(bf16x8, aw);
#pragma unroll
                    for (int nb = 0; nb < 4; ++nb) { acc[nb] = __builtin_amdgcn_mfma_f32_32x32x16_bf16(af, bcur[nb], acc[nb], 0, 0, 0); bcur[nb] = bnxt[nb]; }
                }
#pragma unroll
                for (int nb = 0; nb < 4; ++nb) { const int col = gi * 128 + nb * 32 + r32; const float ps = pool_scale[col];
#pragma unroll
                    for (int r = 0; r < 16; ++r) { const int row = (r & 3) + 8 * (r >> 2) + 4 * hi; const float v = acc[nb][r] * ps, vn = lx1(v);
                        if ((r32 & 1) == 0) *(unsigned*)(mix + (size_t)(t0 + row) * DM + 1024 + col) = cvt_pk_bf16(v, vn); } }
                LDS_WAIT(); asm volatile("" ::: "memory");
            }
            }
        }
        if (PH_MASK & (1 << 4)) {
            PHASE_IDS();
            const float lam_init = (l == 0) ? 0.2f : 0.35550906759096926f;
            const float* lv = INF(6) + (size_t)l * 512;
            const float d01 = wave_sum(lv[lane] * lv[128 + lane] + lv[64 + lane] * lv[192 + lane]);
            const float d23 = wave_sum(lv[256 + lane] * lv[384 + lane] + lv[320 + lane] * lv[448 + lane]);
            const float lam = expf(d01) - expf(d23) + lam_init;
            const float oscale = 1.0f - lam_init;
            const int h = lane >> 4, e0 = (lane & 15) * 16;
            const float* sg = INF(7) + l * 256 + e0;
            const bf16_t* ao = WSP(bf16_t, WS_AO); bf16_t* mix = WSP(bf16_t, WS_MIX);
            float sgv[16];
#pragma unroll
            for (int j = 0; j < 16; ++j) sgv[j] = sg[j];
            for (int tb_ = gw; tb_ < NTOK; tb_ += 4 * NGW) {
                u32x4 av[4][2], bv[4][2];
#pragma unroll
                for (int q2 = 0; q2 < 4; ++q2) { int t = tb_ + q2 * NGW; t = t < NTOK ? t : NTOK - 1;
                    const bf16_t* o0 = ao + (size_t)t * DM + h * 512 + e0; const bf16_t* o1 = o0 + 256;
#pragma unroll
                    for (int j = 0; j < 2; ++j) { av[q2][j] = *(const u32x4*)(o0 + 8 * j); bv[q2][j] = *(const u32x4*)(o1 + 8 * j); } }
#pragma unroll
                for (int q2 = 0; q2 < 4; ++q2) { const int t = tb_ + q2 * NGW; if (t < NTOK) {
                float dv[16]; float ss = 0.f;
#pragma unroll
                for (int j = 0; j < 2; ++j) { const u32x4 a = av[q2][j], b = bv[q2][j];
#pragma unroll
                    for (int q = 0; q < 4; ++q) { const float d0_ = bflo(a[q]) - lam * bflo(b[q]), d1_ = bfhi(a[q]) - lam * bfhi(b[q]); dv[8 * j + 2 * q] = d0_; dv[8 * j + 2 * q + 1] = d1_; ss += d0_ * d0_ + d1_ * d1_; } }
                ss = row16_sum(ss);
                const float rstd = oscale / sqrtf(ss * (1.0f / 256.0f) + EPS);
                u32x4 w0, w1;
#pragma unroll
                for (int j = 0; j < 4; ++j) { w0[j] = cvt_pk_bf16(dv[2 * j] * rstd * sgv[2 * j], dv[2 * j + 1] * rstd * sgv[2 * j + 1]);
                                              w1[j] = cvt_pk_bf16(dv[8 + 2 * j] * rstd * sgv[8 + 2 * j], dv[8 + 2 * j + 1] * rstd * sgv[8 + 2 * j + 1]); }
                bf16_t* mp = mix + (size_t)t * DM + h * 256 + e0;
                *(u32x4*)mp = w0; *(u32x4*)(mp + 8) = w1; } }
            }
        }
        GRID_BAR(); PH_END(4); PH_BEGIN();
        if (PH_MASK & (1 << 5)) {
            const int pos_ = BG_SPLIT ? (bx >> 3) % (BG_P5 + 1) : 0;
            for (int part_ = 0; part_ < 2; ++part_) {
            pg8::Gemm g{WSP(bf16_t, WS_MIX), WSP(bf16_t, WS_WOUT) + (size_t)l * DM * DM, DM * 2, 0};
            pg8::StaticOrder S; S.init(NTOK / 256, DM / 256, G, bx, part_ ? pos_ : 0, part_ ? (1 << 30) : pos_);
            pg8::EpiResF32 E{INF(0), WSP(bf16_t, WS_XR), DM, WSP(unsigned char, WS_XN), WSP(float, WS_SS) + (size_t)(l == 0 ? 1 : 3) * NTOK * 8, 0  , l == 0 ? (int)DUP8 : 1, (LAS float*)(lds + 1024)};
            pg8::gemm_phase<pg8::EpiResF32, pg8::StaticOrder>(lds + RING_OFF, g, S, E);
            if (BG_SPLIT && part_ == 0) { moe_conv_slots(LW, lds, (l == 0 ? 0 : BG_L1) + BG_P1, BG_P5, bx, G); __syncthreads(); }
            }
        }
        GRID_BAR(); PH_END(5); PH_BEGIN();
        if (l == 0 && (PH_MASK & (1 << 6))) {
            {
                const int pos_ = BG_SPLIT ? (bx >> 3) % (BG_DU + 1) : 0;
                for (int part_ = 0; part_ < 2; ++part_) {
                pg8::Gemm g{DUP8 ? WSP(unsigned char, WS_XN) : WSP(unsigned char, WS_XR), WSP(unsigned char, WS_WDGU), DUP8 ? DM : 2 * DM, 0};
                pg8::StaticOrder S; S.init(NTOK / 256, 2 * FFD / 256, G, bx, part_ ? pos_ : 0, part_ ? (1 << 30) : pos_);
                const float* ss1 = WSP(float, WS_SS) + (size_t)NTOK * 8;
                if constexpr (DDN8) { pg8::EpiSwigluF8<1> E{WSP(unsigned char, WS_ACTD), FFD, ss1};
                    pg8::gemm_phase<pg8::EpiSwigluF8<1>, pg8::StaticOrder, (bool)DUP8, DUP8 ? SC_W : SC_ONE, SC_ONE>(lds + RING_OFF, g, S, E); }
                else { pg8::EpiSwiglu<1> E{WSP(bf16_t, WS_ACTD), FFD, ss1};
                    pg8::gemm_phase<pg8::EpiSwiglu<1>, pg8::StaticOrder, (bool)DUP8, DUP8 ? SC_W : SC_ONE, SC_ONE>(lds + RING_OFF, g, S, E); }
                if (BG_SPLIT && part_ == 0) { moe_conv_slots(LW, lds, BG_P1 + BG_P5, BG_DU, bx, G); __syncthreads(); }
                }
            }
            GRID_BAR(); PH_END(6); PH_BEGIN();
            {
                const int pos_ = BG_SPLIT ? (bx >> 3) % (BG_DD + 1) : 0;
                for (int part_ = 0; part_ < 2; ++part_) {
                pg8::Gemm g{WSP(unsigned char, WS_ACTD), WSP(unsigned char, WS_WDD), DDN8 ? FFD : 2 * FFD, 0};
                pg8::StaticOrder S; S.init(NTOK / 256, DM / 256, G, bx, part_ ? pos_ : 0, part_ ? (1 << 30) : pos_);
                pg8::EpiResF32 E{nullptr, WSP(bf16_t, WS_XR), DM, nullptr, WSP(float, WS_SS) + (size_t)2 * NTOK * 8, 0, 0, (LAS float*)(lds + 1024)};
                pg8::gemm_phase<pg8::EpiResF32, pg8::StaticOrder, (bool)DDN8, DDN8 ? SC_W : SC_ONE, DDN8 ? SC_A : SC_ONE>(lds + RING_OFF, g, S, E);
                if (BG_SPLIT && part_ == 0) { moe_conv_slots(LW, lds, BG_P1 + BG_P5 + BG_DU, BG_DD, bx, G); __syncthreads(); }
                }
            }
            GRID_BAR(); PH_END(7); PH_BEGIN();
        } else if (PH_MASK & (1 << 7)) {
            const int TPW = (NTOK + G - 1) / G;
            {
                PHASE_IDS();
                if (BG_SPLIT) { int nrem = 0; while ((BG_ALL + nrem) * (G * 8) * 2 < 24 * 3584) ++nrem; if (nrem) { moe_conv_slots(LW, lds, BG_ALL, nrem, bx, G); __syncthreads(); } }
                if (tid < 8) LW[LW_CNT + tid] = 0u;
                LAS float* RT = (LAS float*)(lds + RING_OFF);
                { const float* router_w = INF(16); const float* gn = INF(12) + DM;
                  for (int k = tid; k < DM; k += 512) { const f32x4 ra = *(const f32x4*)(router_w + (size_t)k * 8), rb = *(const f32x4*)(router_w + (size_t)k * 8 + 4); const float gk = gn[k];
                      RT[0 * DM + k] = ra[0] * gk; RT[1 * DM + k] = ra[1] * gk; RT[2 * DM + k] = ra[2] * gk; RT[3 * DM + k] = ra[3] * gk;
                      RT[4 * DM + k] = rb[0] * gk; RT[5 * DM + k] = rb[1] * gk; RT[6 * DM + k] = rb[2] * gk; RT[7 * DM + k] = rb[3] * gk; } }
                __syncthreads();
                const bf16_t* xrs = WSP(bf16_t, WS_XR); const float* ss3 = WSP(float, WS_SS) + (size_t)3 * NTOK * 8;
                int* tokE = WSP(int, WS_TOKE); int* tokR = WSP(int, WS_TOKR); float* tokG = WSP(float, WS_TOKG);
                const int tlo = bx * TPW, thi = (tlo + TPW) < NTOK ? (tlo + TPW) : NTOK;
                for (int tq = tlo + wave; tq < thi; tq += 32) {
                    float rstd[4]; f32x4 xv[4][8];
#pragma unroll
                    for (int q = 0; q < 4; ++q) { int t = tq + 8 * q; t = t < thi ? t : thi - 1;
                        rstd[q] = ss_rstd(ss3 + (size_t)t * 8);
                        const u32x2* xr = (const u32x2*)(xrs + (size_t)t * DM) + lane;
#pragma unroll
                        for (int j = 0; j < 8; ++j) { const u32x2 w = xr[64 * j]; xv[q][j] = (f32x4){bflo(w.x), bfhi(w.x), bflo(w.y), bfhi(w.y)}; } }
                    float lg[4][8];
#pragma unroll
                    for (int e = 0; e < 8; ++e) { float a[4] = {0.f, 0.f, 0.f, 0.f};
#pragma unroll
                        for (int j = 0; j < 8; ++j) { const f32x4 rv = *(const LAS f32x4*)(RT + e * DM + 256 * j + 4 * lane);
#pragma unroll
                            for (int q = 0; q < 4; ++q) a[q] += (xv[q][j][0] * rv[0] + xv[q][j][1] * rv[1]) + (xv[q][j][2] * rv[2] + xv[q][j][3] * rv[3]); }
#pragma unroll
                        for (int q = 0; q < 4; ++q) lg[q][e] = wave_sum(a[q]) * rstd[q]; }
#pragma unroll
                    for (int q = 0; q < 4; ++q) { const int t = tq + 8 * q;
                        if (lane == 0 && t < thi) {
                            int e0 = 0; float v0 = lg[q][0];
#pragma unroll
                            for (int e = 1; e < 8; ++e) if (lg[q][e] > v0) { v0 = lg[q][e]; e0 = e; }
                            int e1 = -1; float v1 = -3.0e38f;
#pragma unroll
                            for (int e = 0; e < 8; ++e) if (e != e0 && lg[q][e] > v1) { v1 = lg[q][e]; e1 = e; }
                            const float ex = expf(v1 - v0), g0 = 1.0f / (1.0f + ex), g1 = ex / (1.0f + ex);
                            const int r0 = (int)atomicAdd((unsigned*)(lds_raw + LDSCTL_OFF) + LW_CNT + e0, 1u);
                            const int r1 = (int)atomicAdd((unsigned*)(lds_raw + LDSCTL_OFF) + LW_CNT + e1, 1u);
                            tokE[2 * t] = e0; tokE[2 * t + 1] = e1; tokR[2 * t] = r0; tokR[2 * t + 1] = r1; tokG[2 * t] = g0; tokG[2 * t + 1] = g1;
                        } }
                }
                __syncthreads();
                if (tid < 8) WSP(int, WS_CNTWG)[bx * 8 + tid] = (int)LW[LW_CNT + tid];
            }
            GRID_BAR(); PH_END(8); PH_BEGIN();
            {
                PHASE_IDS();
                if (tid < 8) { LW[LW_TOT + tid] = 0u; LW[LW_PRE + tid] = 0u; }
                __syncthreads();
                {
                const int* cntWG = WSP(int, WS_CNTWG);
                for (int j0 = wave * 64; j0 < G; j0 += 512) { const int j = j0 + lane; const bool ok = j < G; const int jc = ok ? j : 0;
                    const i32x4 ca = *(const i32x4*)(cntWG + jc * 8), cb = *(const i32x4*)(cntWG + jc * 8 + 4);
                    unsigned* lw = (unsigned*)(lds_raw + LDSCTL_OFF);
#pragma unroll
                    for (int e = 0; e < 8; ++e) { const float c = ok ? (float)(e < 4 ? ca[e & 3] : cb[e & 3]) : 0.f;
                        const float tot = wave_sum(c), pre = wave_sum(j < bx ? c : 0.f);
                        if (lane == 0) { atomicAdd(lw + LW_TOT + e, (unsigned)tot); atomicAdd(lw + LW_PRE + e, (unsigned)pre); } }
                }
                }
                __syncthreads();
                if (tid == 0) { unsigned base = 0;
                    for (int e = 0; e < 8; ++e) { const unsigned tot = LW[LW_TOT + e]; LW[LW_BP + e] = base + LW[LW_PRE + e]; LW[LW_TOFF + e] = base >> 8; base += (tot + 255u) & ~255u; }
                    LW[LW_TOFF + 8] = base >> 8; }
                __syncthreads();
                const int* tokE = WSP(int, WS_TOKE); const int* tokR = WSP(int, WS_TOKR); int* tokS = WSP(int, WS_TOKS);
                const float* ss3 = WSP(float, WS_SS) + (size_t)3 * NTOK * 8; float* rslot = WSP(float, WS_RSLOT);
                const unsigned char* xn8 = WSP(unsigned char, WS_XN); unsigned char* hp = WSP(unsigned char, WS_HP);
                const int tlo = bx * TPW, thi = (tlo + TPW) < NTOK ? (tlo + TPW) : NTOK;
                for (int tb_ = tlo + wave; tb_ < thi; tb_ += 16) {
                    int sa[2], sb[2]; u32x4 v[2][2];
#pragma unroll
                    for (int q2 = 0; q2 < 2; ++q2) { int t = tb_ + 8 * q2; t = t < thi ? t : thi - 1;
                        const int e0 = tokE[2 * t], e1 = tokE[2 * t + 1];
                        sa[q2] = (int)LW[LW_BP + e0] + tokR[2 * t]; sb[q2] = (int)LW[LW_BP + e1] + tokR[2 * t + 1];
                        const u32x4* src_ = (const u32x4*)(xn8 + (size_t)t * DM) + lane; v[q2][0] = src_[0]; v[q2][1] = src_[64]; }
#pragma unroll
                    for (int q2 = 0; q2 < 2; ++q2) { const int t = tb_ + 8 * q2; if (t < thi) {
                        const int s0 = sa[q2], s1 = sb[q2];
                        if (lane == 0) { tokS[2 * t] = s0; tokS[2 * t + 1] = s1; const float rstd = ss_rstd(ss3 + (size_t)t * 8); rslot[s0] = rstd; rslot[s1] = rstd; }
                        u32x4* d0 = (u32x4*)(hp + (size_t)s0 * DM) + lane; u32x4* d1 = (u32x4*)(hp + (size_t)s1 * DM) + lane;
                        d0[0] = v[q2][0]; d0[64] = v[q2][1]; d1[0] = v[q2][0]; d1[64] = v[q2][1]; } }
                }
                for (int e = 0; e < 8; ++e) {
                    const int rlo = (int)LW[LW_TOFF + e] * 256 + (int)LW[LW_TOT + e], rhi = (int)LW[LW_TOFF + e + 1] * 256;
                    for (int r = rlo + gw; r < rhi; r += NGW) { if (lane == 0) rslot[r] = 0.f; u32x4* d0 = (u32x4*)(hp + (size_t)r * DM) + lane;
#pragma unroll
                        for (int j = 0; j < 2; ++j) d0[64 * j] = (u32x4){0u, 0u, 0u, 0u}; }
                }
            }
            GRID_BAR(); PH_END(9); PH_BEGIN();
#define RFL(i) __builtin_amdgcn_readfirstlane((int)LW[LW_TOFF + (i)])
#define MOE_TAIL_SP(R, G) ((R) == 0 ? 1 : ((R) * 4 <= (G) ? 4 : ((R) * 2 <= (G) ? 2 : 1)))
            for (int rep_ = 0; rep_ < REP_P7; ++rep_) {
                pg8::Gemm g{WSP(unsigned char, WS_HP), WSP(unsigned char, WS_WMGU), DM, (size_t)2 * FFE * DM};
                pg8::MoeOrder S; S.S.init(RFL(8), 2 * FFE / 256, G, bx);
                S.t1 = RFL(1); S.t2 = RFL(2); S.t3 = RFL(3); S.t4 = RFL(4); S.t5 = RFL(5); S.t6 = RFL(6); S.t7 = RFL(7); S.SP = 1; S.nfull = 0; S.R = 0; S.ntp = 0; S.kbs = 0;
                pg8::EpiSwigluF8<2> E{WSP(unsigned char, WS_ACTM), FFE, WSP(float, WS_RSLOT)};
                pg8::gemm_phase<pg8::EpiSwigluF8<2>, pg8::MoeOrder, true, SC_W, SC_ONE>(lds + RING_OFF, g, S, E);
            }
            GRID_BAR(); PH_END(10); PH_BEGIN();
            {
                pg8::Gemm g{WSP(unsigned char, WS_ACTM), WSP(unsigned char, WS_WMD), FFE, (size_t)DM * FFE};
                pg8::MoeOrder S; S.S.init(RFL(8), DM / 256, G, bx);
                S.t1 = RFL(1); S.t2 = RFL(2); S.t3 = RFL(3); S.t4 = RFL(4); S.t5 = RFL(5); S.t6 = RFL(6); S.t7 = RFL(7);
                { const int nwg_ = RFL(8) * (DM / 256), R_ = nwg_ % G; S.nfull = nwg_ / G; S.R = R_; S.SP = MOE_TAIL_SP(R_, G); S.ntp = (FFE / 128) / S.SP; S.kbs = FFE / S.SP; }
                S.rev = 1;
                pg8::EpiMoeDown E{WSP(bf16_t, WS_Y), DM, WSP(float, WS_PB), WSP(int, WS_TMAP), S.SP};
                pg8::gemm_phase<pg8::EpiMoeDown, pg8::MoeOrder, true, SC_W, SC_A>(lds + RING_OFF, g, S, E);
            }
            GRID_BAR(); PH_END(11); PH_BEGIN();
            {
                PHASE_IDS();
                const int* tokS = WSP(int, WS_TOKS); const float* tokG = WSP(float, WS_TOKG); float* out = OUTP; const bf16_t* yb = WSP(bf16_t, WS_Y); const bf16_t* xrs = WSP(bf16_t, WS_XR);
                const int* tmap = WSP(int, WS_TMAP); const float* PB = WSP(float, WS_PB);
                const int SP = MOE_TAIL_SP((RFL(8) * (DM / 256)) % G, G);
                for (int tb_ = gw; tb_ < NTOK; tb_ += 2 * NGW) {
                    int s0[2], s1[2]; float g0[2], g1[2];
#pragma unroll
                    for (int q2 = 0; q2 < 2; ++q2) { int t = tb_ + q2 * NGW; t = t < NTOK ? t : NTOK - 1; s0[q2] = tokS[2 * t]; s1[q2] = tokS[2 * t + 1]; g0[q2] = tokG[2 * t]; g1[q2] = tokG[2 * t + 1]; }
                    u32x4 ya[2][4], yc[2][4], xw[2][4]; int ea[2][4], ec[2][4];
#pragma unroll
                    for (int q2 = 0; q2 < 2; ++q2) { int t = tb_ + q2 * NGW; t = t < NTOK ? t : NTOK - 1;
                        const u32x4* o = (const u32x4*)(xrs + (size_t)t * DM) + lane; const u32x4* y0 = (const u32x4*)(yb + (size_t)s0[q2] * DM) + lane; const u32x4* y1 = (const u32x4*)(yb + (size_t)s1[q2] * DM) + lane;
#pragma unroll
                        for (int j = 0; j < 4; ++j) { ya[q2][j] = y0[64 * j]; yc[q2][j] = y1[64 * j]; xw[q2][j] = o[64 * j];
                            ea[q2][j] = tmap[(s0[q2] >> 8) * 8 + ((64 * j + lane) >> 5)]; ec[q2][j] = tmap[(s1[q2] >> 8) * 8 + ((64 * j + lane) >> 5)]; } }
#pragma unroll
                    for (int q2 = 0; q2 < 2; ++q2) { const int t = tb_ + q2 * NGW; if (t < NTOK) {
                        f32x4* o = (f32x4*)(out + (size_t)t * DM) + 2 * lane; const float ga = g0[q2], gb = g1[q2];
#pragma unroll
                        for (int j = 0; j < 4; ++j) { const u32x4 a = ya[q2][j], b = yc[q2][j], xx = xw[q2][j]; f32x4 o0 = {bflo(xx[0]), bfhi(xx[0]), bflo(xx[1]), bfhi(xx[1])}, o1 = {bflo(xx[2]), bfhi(xx[2]), bflo(xx[3]), bfhi(xx[3])};
                            f32x4 a0 = {bflo(a[0]), bfhi(a[0]), bflo(a[1]), bfhi(a[1])}, a1 = {bflo(a[2]), bfhi(a[2]), bflo(a[3]), bfhi(a[3])};
                            f32x4 b0 = {bflo(b[0]), bfhi(b[0]), bflo(b[1]), bfhi(b[1])}, b1 = {bflo(b[2]), bfhi(b[2]), bflo(b[3]), bfhi(b[3])};
                            const int cc = (8 * (64 * j + lane)) & 255;
                            if (ea[q2][j]) { a0 = (f32x4){0.f, 0.f, 0.f, 0.f}; a1 = a0;
                                for (int p = 0; p < SP; ++p) { const float* sp = PB + ((size_t)((ea[q2][j] - 1) * SP + p) * 256 + (s0[q2] & 255)) * 256 + cc; a0 += *(const f32x4*)sp; a1 += *(const f32x4*)(sp + 4); } }
                            if (ec[q2][j]) { b0 = (f32x4){0.f, 0.f, 0.f, 0.f}; b1 = b0;
                                for (int p = 0; p < SP; ++p) { const float* sp = PB + ((size_t)((ec[q2][j] - 1) * SP + p) * 256 + (s1[q2] & 255)) * 256 + cc; b0 += *(const f32x4*)sp; b1 += *(const f32x4*)(sp + 4); } }
                            o0 += a0 * ga + b0 * gb; o1 += a1 * ga + b1 * gb;
                            o[128 * j] = o0; o[128 * j + 1] = o1; } } }
                }
            }
#undef RFL
            PH_END(12);
        }
    }
    if (PROBE_MASK) { __syncthreads(); if (threadIdx.x == 0) { const unsigned long long t0_ = __builtin_amdgcn_s_memrealtime(); while (__builtin_amdgcn_s_memrealtime() - t0_ < tacc_) __builtin_amdgcn_s_sleep(8); } __syncthreads(); }
}

extern "C" void kernel_launch(void* const* d_in, const int* in_sizes, int n_in, void* d_out, int out_size, void* d_ws, size_t ws_size, hipStream_t stream) {
    static int grid = 0;
    if (grid == 0) {
        if (n_in != 20 || in_sizes[0] != NTOK * DM || out_size != NTOK * DM || ws_size < WS_END) {
            fprintf(stderr, "kernel_launch: unexpected shapes (n_in %d, in0 %d, out %d, ws %zu < %zu); nothing launched\n", n_in, n_in > 0 ? in_sizes[0] : -1, out_size, ws_size, (size_t)WS_END); grid = -1; return; }
        int dev = 0, cus = 0, per_cu = 0;
        if (hipGetDevice(&dev) != hipSuccess || hipDeviceGetAttribute(&cus, hipDeviceAttributeMultiprocessorCount, dev) != hipSuccess) { grid = -1; return; }
        if (hipFuncSetAttribute((const void*)hybrid_fwd, hipFuncAttributeMaxDynamicSharedMemorySize, LDS_BYTES) != hipSuccess) { fprintf(stderr, "kernel_launch: hipFuncSetAttribute failed\n"); grid = -1; return; }
        if (hipOccupancyMaxActiveBlocksPerMultiprocessor(&per_cu, (const void*)hybrid_fwd, 512, LDS_BYTES) != hipSuccess || per_cu < 1)
            fprintf(stderr, "kernel_launch: note: occupancy query reports %d workgroups per CU\n", per_cu);
        (void)hipGetLastError();
        grid = cus > 512 ? 512 : cus;
    }
    if (grid < 0) return;
    if (hipMemsetAsync((char*)d_ws + WS_CTL, 0, CTL_ZERO_BYTES, stream) != hipSuccess) { fprintf(stderr, "kernel_launch: memset failed\n"); return; }
    Args a{};
    for (int i = 0; i < 20; ++i) a.in[i] = d_in[i];
    a.out = (float*)d_out; a.ws = (unsigned char*)d_ws;
    hipLaunchKernelGGL(hybrid_fwd, dim3(grid), dim3(512), LDS_BYTES, stream, a);
    const hipError_t le = hipPeekAtLastError();
    if (le != hipSuccess) fprintf(stderr, "kernel_launch: launch failed: %s\n", hipGetErrorName(le));
}
```

```cpp
#include <hip/hip_runtime.h>
#include <hip/hip_bf16.h>
#include <cstdio>
#include <cstdint>

#define LAS __attribute__((address_space(3)))
#define GAS __attribute__((address_space(1)))
typedef unsigned short bf16_t;
typedef short bf16x8 __attribute__((ext_vector_type(8)));
typedef short s16x4 __attribute__((ext_vector_type(4)));
typedef float f32x4 __attribute__((ext_vector_type(4)));
typedef float f32x2 __attribute__((ext_vector_type(2)));
typedef float f32x16 __attribute__((ext_vector_type(16)));
typedef unsigned u32x4 __attribute__((ext_vector_type(4)));
typedef unsigned u32x2 __attribute__((ext_vector_type(2)));
typedef int i32x4 __attribute__((ext_vector_type(4)));
typedef int i32x8 __attribute__((ext_vector_type(8)));

constexpr int DM = 2048, NB = 8, SEQ = 2048, NTOK = NB * SEQ, DEPTH = 2;
constexpr int INW = 5120, FFD = 5632, NEXP = 8, FFE = 7168;
constexpr int ZQ = 0, ZK = 1024, ZV = 2048, ZP = 3072, ZGB = 3584, ZGC = 4096, ZH = 4608;
constexpr int MOE_ROWS = NTOK * 2 + NEXP * 256;
constexpr float EPS = 1e-6f;

constexpr size_t MiB = 1u << 20;
constexpr size_t WS_CTL = 0, CTL_ZERO_BYTES = 1 * MiB;
constexpr size_t WS_COS = 1 * MiB, WS_SIN = 5 * MiB;
constexpr size_t WS_WPT = 9 * MiB;
constexpr size_t WS_TOKE = 10 * MiB;
constexpr size_t WS_TOKR = WS_TOKE + 128 * 1024;
constexpr size_t WS_TOKG = WS_TOKR + 128 * 1024;
constexpr size_t WS_TOKS = WS_TOKG + 128 * 1024;
constexpr size_t WS_CNTWG = WS_TOKS + 128 * 1024;
constexpr size_t WS_WIN = 16 * MiB;
constexpr size_t WS_WOUT = WS_WIN + 40 * MiB;
constexpr size_t WS_WDGU = WS_WOUT + 16 * MiB;
constexpr size_t WS_WDD = WS_WDGU + 44 * MiB;
constexpr size_t WS_WMGU = WS_WDD + 22 * MiB;
constexpr size_t WS_WMD = WS_WMGU + 448 * MiB;
constexpr size_t WS_ACT0 = WS_WMD + 224 * MiB;
constexpr size_t WS_Z = WS_ACT0;
constexpr size_t WS_AO = WS_ACT0 + 160 * MiB;
constexpr size_t WS_MIX = WS_ACT0 + 288 * MiB;
constexpr size_t WS_XN = WS_ACT0 + 352 * MiB;
constexpr size_t WS_ACTM = WS_ACT0;
constexpr size_t WS_HP = WS_ACT0 + 476 * MiB;
constexpr size_t WS_Y = WS_ACT0 + 612 * MiB;
constexpr size_t WS_ACTD = WS_ACT0 + 476 * MiB;
constexpr size_t WS_XR = WS_ACT0 + 884 * MiB;
constexpr size_t WS_END = WS_ACT0 + 948 * MiB;
static_assert(WS_ACT0 == 810 * MiB, "map");
static_assert((size_t)MOE_ROWS * FFE * 2 <= 476 * MiB && (size_t)MOE_ROWS * DM * 2 <= 136 * MiB && (size_t)MOE_ROWS * DM * 4 <= 272 * MiB, "map");

#ifndef PH_MASK
#define PH_MASK 0xffff
#endif
#define REP_P0 1
#ifndef BG_SPLIT
#define BG_SPLIT 0
#endif
#ifndef BG_NQ
#define BG_NQ 2
#endif
#ifndef BG_NREP
#define BG_NREP 1
#endif
#ifndef PROBE_MASK
#define PROBE_MASK 0u
#endif
#ifndef DUP8
#define DUP8 1
#endif
#ifndef DDN8
#define DDN8 1
#endif
#define REP_P1 1
#define REP_P3 1
#define REP_P7 1
constexpr int CW_TMO = 0, CW_CODE = 1, CW_BAR = 4096;
constexpr size_t WS_SS = 14 * MiB;
typedef unsigned long long u64_t;
typedef float ssrow_t[8];
__device__ __forceinline__ float ss_rstd(const float* p) { const f32x4 a = *(const f32x4*)p, b = *(const f32x4*)(p + 4); return 1.0f / sqrtf((((a[0] + a[1]) + (a[2] + a[3])) + ((b[0] + b[1]) + (b[2] + b[3]))) * (1.0f / DM) + EPS); }
constexpr size_t WS_TMAP = WS_CTL + 768 * 1024;
constexpr size_t WS_PB = WS_ACT0 + 612 * MiB + 136 * MiB;
constexpr size_t WS_RSLOT = 12 * MiB;

constexpr int LDSCTL_OFF = 0, LDSCTL_BYTES = 1024;
constexpr int RING_OFF = 16384, RING_BYTES = 131072;
constexpr int LDS_BYTES = 147456;
constexpr int LW_CNT = 16, LW_TOT = 24, LW_PRE = 32, LW_BP = 40, LW_TOFF = 48;

#define LDS_WAIT() asm volatile("s_waitcnt lgkmcnt(0)" ::: "memory")
#define VM_WAIT() asm volatile("s_waitcnt vmcnt(0)" ::: "memory")

__device__ __forceinline__ unsigned cvt_pk_bf16(float lo, float hi) { unsigned r; asm volatile("v_cvt_pk_bf16_f32 %0, %1, %2" : "=v"(r) : "v"(lo), "v"(hi)); return r; }
__device__ __forceinline__ unsigned pk4_fp8(float a, float b, float c, float d) {
    a = __builtin_amdgcn_fmed3f(a, -448.f, 448.f); b = __builtin_amdgcn_fmed3f(b, -448.f, 448.f); c = __builtin_amdgcn_fmed3f(c, -448.f, 448.f); d = __builtin_amdgcn_fmed3f(d, -448.f, 448.f);
    int w = __builtin_amdgcn_cvt_pk_fp8_f32(a, b, 0, false); w = __builtin_amdgcn_cvt_pk_fp8_f32(c, d, w, true); return (unsigned)w; }
constexpr float W8_SCALE = 64.f, A8_SCALE = 8.f;
constexpr int SC_ONE = 0x7f7f7f7f, SC_W = 0x79797979  , SC_A = 0x7c7c7c7c  ;
__device__ __forceinline__ float bflo(unsigned w) { return __uint_as_float(w << 16); }
__device__ __forceinline__ float bfhi(unsigned w) { return __uint_as_float(w & 0xffff0000u); }
template <int CTRL> __device__ __forceinline__ float dppf(float v) { return __int_as_float(__builtin_amdgcn_update_dpp(0, __float_as_int(v), CTRL, 0xf, 0xf, true)); }
__device__ __forceinline__ float lx1(float v) { return dppf<0xB1>(v); }
__device__ __forceinline__ float lx2(float v) { return dppf<0x4E>(v); }
__device__ __forceinline__ float lhm(float v) { return dppf<0x141>(v); }
__device__ __forceinline__ float lrm(float v) { return dppf<0x140>(v); }
__device__ __forceinline__ float lx16(float v) { return __int_as_float(__builtin_amdgcn_ds_swizzle(__float_as_int(v), 0x401F)); }
__device__ __forceinline__ float sum_halves(float v) { const auto r = __builtin_amdgcn_permlane32_swap(__float_as_uint(v), __float_as_uint(v), false, false); return __uint_as_float(r[0]) + __uint_as_float(r[1]); }
__device__ __forceinline__ float row16_sum(float v) { v += lx1(v); v += lx2(v); v += lhm(v); v += lrm(v); return v; }
__device__ __forceinline__ float wave_sum(float v) { v = row16_sum(v); v += lx16(v); return sum_halves(v); }

__device__ __forceinline__ int ltid() {
    const unsigned key = (unsigned)__builtin_amdgcn_s_getreg((5 << 11) | 4) & 63u;
    const int wv = __builtin_amdgcn_readfirstlane((int)((volatile LAS unsigned*)(LDSCTL_OFF + 4 * 128))[key]);
    int ln; asm volatile("v_mbcnt_lo_u32_b32 %0, -1, 0\n\tv_mbcnt_hi_u32_b32 %0, -1, %0" : "=&v"(ln));
    return (wv << 6) | ln; }

namespace pg8 {
constexpr int BM = 256, BK = 64, HALF = 128, HTB = HALF * BK * 2, STAGE_BYTES = 8 * HTB, NXCD = 8, WGM = 8;
__host__ __device__ __forceinline__ int lds_byte(int r, int c) { const int st = (r >> 4) * 2 + (c >> 5), rr = r & 15, cc = c & 31, ob = rr * 64 + cc * 2; return st * 1024 + (ob ^ (((ob >> 9) & 1) << 5)); }
__host__ __device__ __forceinline__ void stage_rc(int b, int& R, int& C) { const int st = b / 1024, sb = b % 1024, swz = sb ^ (((sb >> 9) & 1) << 5); R = (st >> 1) * 16 + swz / 64; C = (st & 1) * 32 + (swz % 64) / 2; }
__host__ __device__ __forceinline__ int perm32(int rho) { const int n = rho >> 4, i = rho & 15; return 8 * (i >> 2) + 4 * n + (i & 3); }

struct Unit { int pm, pn, e, kb0, ntu, part; };
struct Gemm { const void* A; const void* Bt; int KB; size_t estride; };

struct StaticOrder {
    int nM, nN, nwg, G, c, i0, cnt;
    __device__ __forceinline__ void init(int nM_, int nN_, int G_, int c_, int i0_ = 0, int cnt_ = 1 << 30) { nM = nM_; nN = nN_; nwg = nM * nN; G = G_; c = c_; i0 = i0_; cnt = cnt_; }
    __device__ __forceinline__ void unit_of(int L, Unit& u) const {
        int wgid = L; { const int q = nwg / NXCD, r = nwg % NXCD, xcd = wgid % NXCD, off = wgid / NXCD; wgid = (xcd < r ? xcd * (q + 1) : r * (q + 1) + (xcd - r) * q) + off; }
        const int nig = WGM * nN, gid = wgid / nig, fm = gid * WGM, gsz = (nM - fm) < WGM ? (nM - fm) : WGM;
        u.pm = fm + ((wgid % nig) % gsz); u.pn = (wgid % nig) / gsz; u.e = 0; u.kb0 = 0; u.ntu = 0; u.part = -1;
    }
    __device__ __forceinline__ bool next(int i, Unit& u) const {
        if (i >= cnt) return false;
        const long L = (long)(i + i0) * G + c; if (L >= nwg) return false;
        unit_of((int)L, u); return true;
    }
};
struct MoeOrder {
    StaticOrder S; int t1, t2, t3, t4, t5, t6, t7; int SP, nfull, R, ntp, kbs; int rev = 0;
    __device__ __forceinline__ bool next(int i, Unit& u) const {
        if (SP > 1) {
            if (i < nfull) S.unit_of(i * S.G + S.c, u);
            else if (i == nfull && S.c < R * SP) { S.unit_of(nfull * S.G + S.c / SP, u); const int p = S.c % SP; u.kb0 = p * kbs; u.ntu = ntp; u.part = S.c; }
            else return false;
        } else if (!S.next(i, u)) return false;
        if (rev) u.pm = S.nM - 1 - u.pm;
        const int p = u.pm; u.e = __builtin_amdgcn_readfirstlane((p >= t1) + (p >= t2) + (p >= t3) + (p >= t4) + (p >= t5) + (p >= t6) + (p >= t7)); return true;
    }
};

template <int RS> __device__ __forceinline__ void row_scales(float (&sc)[2][4], const void* p, int row0) {
#pragma unroll
    for (int ai = 0; ai < 2; ++ai)
#pragma unroll
        for (int m = 0; m < 4; ++m) { if constexpr (RS == 0) sc[ai][m] = 1.0f; else if constexpr (RS == 1) sc[ai][m] = ss_rstd((const float*)p + (size_t)(row0 + ai * HALF + m * 16) * 8); else sc[ai][m] = ((const float*)p)[row0 + ai * HALF + m * 16]; }
}
template <int RS> struct EpiBf16 {
    static constexpr bool PERM = true; static constexpr bool HAS_INIT = false; static constexpr bool HAS_PRE = false;
    bf16_t* O; int ldc; const void* rsp;
    __device__ __forceinline__ void operator()(const f32x4 (&acc)[2][2][4][2], const Unit& u, int wr, int wc, int fr, int fq) const {
        const int row0 = u.pm * BM + wr * 64 + fr, col0 = u.pn * BM + wc * 32 + 8 * fq;
        float sc[2][4]; row_scales<RS>(sc, rsp, row0);
#pragma unroll
        for (int ai = 0; ai < 2; ++ai)
#pragma unroll
            for (int m = 0; m < 4; ++m) { bf16_t* rowp = O + (size_t)(row0 + ai * HALF + m * 16) * ldc + col0;
#pragma unroll
                for (int bj = 0; bj < 2; ++bj) { const f32x4 v0 = acc[ai][bj][m][0] * sc[ai][m], v1 = acc[ai][bj][m][1] * sc[ai][m];
                    u32x4 w; w.x = cvt_pk_bf16(v0[0], v0[1]); w.y = cvt_pk_bf16(v0[2], v0[3]); w.z = cvt_pk_bf16(v1[0], v1[1]); w.w = cvt_pk_bf16(v1[2], v1[3]);
                    *(u32x4*)(rowp + bj * HALF) = w; } }
    }
};
struct EpiZ {
    static constexpr bool PERM = true; static constexpr bool HAS_INIT = false; static constexpr bool HAS_PRE = false;
    bf16_t* O; int ldc; const void* rsp; const float* qg; const float* kg; const float* cosT; const float* sinT; LAS float* part;
    __device__ __forceinline__ void operator()(const f32x4 (&acc)[2][2][4][2], const Unit& u, int wr, int wc, int fr, int fq) const {
        const int row0 = u.pm * BM + wr * 64 + fr, col0 = u.pn * BM + wc * 32 + 8 * fq;
        float sc[2][4]; row_scales<1>(sc, rsp, row0);
        if (u.pn >= 8) {
#pragma unroll
            for (int ai = 0; ai < 2; ++ai)
#pragma unroll
                for (int m = 0; m < 4; ++m) { bf16_t* rowp = O + (size_t)(row0 + ai * HALF + m * 16) * ldc + col0;
#pragma unroll
                    for (int bj = 0; bj < 2; ++bj) { const f32x4 v0 = acc[ai][bj][m][0] * sc[ai][m], v1 = acc[ai][bj][m][1] * sc[ai][m];
                        u32x4 w; w.x = cvt_pk_bf16(v0[0], v0[1]); w.y = cvt_pk_bf16(v0[2], v0[3]); w.z = cvt_pk_bf16(v1[0], v1[1]); w.w = cvt_pk_bf16(v1[2], v1[3]);
                        *(u32x4*)(rowp + bj * HALF) = w; } }
            return;
        }
        LAS float* pw = part + ((wr * 4 + wc) * 16) * 16 + fr;
#pragma unroll
        for (int ai = 0; ai < 2; ++ai)
#pragma unroll
            for (int m = 0; m < 4; ++m)
#pragma unroll
                for (int bj = 0; bj < 2; ++bj) { const f32x4 v0 = acc[ai][bj][m][0] * sc[ai][m], v1 = acc[ai][bj][m][1] * sc[ai][m];
                    float p = (v0[0] * v0[0] + v0[1] * v0[1]) + (v0[2] * v0[2] + v0[3] * v0[3]) + (v1[0] * v1[0] + v1[1] * v1[1]) + (v1[2] * v1[2] + v1[3] * v1[3]);
                    p += lx16(p); p = sum_halves(p);
                    if (fq == 0) pw[((ai * 4 + m) * 2 + bj) * 16] = p; }
        asm volatile("s_waitcnt lgkmcnt(0)" ::: "memory"); __builtin_amdgcn_s_barrier(); asm volatile("" ::: "memory");
        const int i0 = 16 * wc + 4 * fq;
        const float* gp = (u.pn < 4 ? qg : kg) + i0;
        const f32x4 ga = *(const f32x4*)gp, gb = *(const f32x4*)(gp + 64);
        const LAS float* pr = part + (wr * 4 * 16) * 16 + fr;
#pragma unroll
        for (int ai = 0; ai < 2; ++ai)
#pragma unroll
            for (int m = 0; m < 4; ++m) { const int r = row0 + ai * HALF + m * 16; bf16_t* rowp = O + (size_t)r * ldc + col0;
                const f32x4 cs = *(const f32x4*)(cosT + (size_t)r * 64 + i0), sn = *(const f32x4*)(sinT + (size_t)r * 64 + i0);
#pragma unroll
                for (int bj = 0; bj < 2; ++bj) { const int pi = ((ai * 4 + m) * 2 + bj) * 16;
                    const float tot = (pr[pi] + pr[pi + 256]) + (pr[pi + 512] + pr[pi + 768]);
                    const float f = sc[ai][m] / sqrtf(tot * (1.0f / 128.0f) + EPS);
                    const f32x4 v0 = acc[ai][bj][m][0] * f, v1 = acc[ai][bj][m][1] * f;
                    const float a0 = v0[0] * ga[0], b0 = v0[1] * gb[0], a1 = v0[2] * ga[1], b1 = v0[3] * gb[1], a2 = v1[0] * ga[2], b2 = v1[1] * gb[2], a3 = v1[2] * ga[3], b3 = v1[3] * gb[3];
                    u32x4 w;
                    w.x = cvt_pk_bf16(a0 * cs[0] - b0 * sn[0], a0 * sn[0] + b0 * cs[0]); w.y = cvt_pk_bf16(a1 * cs[1] - b1 * sn[1], a1 * sn[1] + b1 * cs[1]);
                    w.z = cvt_pk_bf16(a2 * cs[2] - b2 * sn[2], a2 * sn[2] + b2 * cs[2]); w.w = cvt_pk_bf16(a3 * cs[3] - b3 * sn[3], a3 * sn[3] + b3 * cs[3]);
                    *(u32x4*)(rowp + bj * HALF) = w; } }
        asm volatile("s_waitcnt lgkmcnt(0)" ::: "memory"); __builtin_amdgcn_s_barrier(); asm volatile("" ::: "memory");
    }
};
__device__ __forceinline__ float silu_mul(float g, float u) { return g * __builtin_amdgcn_rcpf(1.0f + __builtin_amdgcn_exp2f(-1.4426950408889634f * g)) * u; }
__device__ __forceinline__ f32x2 silu_mul2(f32x2 g, f32x2 u, float sg, float su) {
    const f32x2 t = g * sg, a = t * (-1.4426950408889634f);
    f32x2 e; e.x = __builtin_amdgcn_exp2f(a.x); e.y = __builtin_amdgcn_exp2f(a.y);
    const f32x2 d = e + 1.0f;
    f32x2 r; r.x = __builtin_amdgcn_rcpf(d.x); r.y = __builtin_amdgcn_rcpf(d.y);
    return (t * r) * (u * su);
}
template <int RS> struct EpiSwiglu {
    static constexpr bool PERM = true; static constexpr bool HAS_INIT = false; static constexpr bool HAS_PRE = false;
    bf16_t* O; int ldc; const void* rsp;
    __device__ __forceinline__ void operator()(const f32x4 (&acc)[2][2][4][2], const Unit& u, int wr, int wc, int fr, int fq) const {
        const int row0 = u.pm * BM + wr * 64 + fr, col0 = u.pn * HALF + wc * 32 + 8 * fq;
        float sc[2][4]; row_scales<RS>(sc, rsp, row0);
#pragma unroll
        for (int ai = 0; ai < 2; ++ai)
#pragma unroll
            for (int m = 0; m < 4; ++m) { bf16_t* rowp = O + (size_t)(row0 + ai * HALF + m * 16) * ldc + col0;
                const f32x4 g0 = acc[ai][0][m][0], g1 = acc[ai][0][m][1], u0 = acc[ai][1][m][0], u1 = acc[ai][1][m][1]; const float s = sc[ai][m];
                const f32x2 o0 = silu_mul2((f32x2){g0[0], g0[1]}, (f32x2){u0[0], u0[1]}, s, s), o1 = silu_mul2((f32x2){g0[2], g0[3]}, (f32x2){u0[2], u0[3]}, s, s);
                const f32x2 o2 = silu_mul2((f32x2){g1[0], g1[1]}, (f32x2){u1[0], u1[1]}, s, s), o3 = silu_mul2((f32x2){g1[2], g1[3]}, (f32x2){u1[2], u1[3]}, s, s);
                u32x4 w; w.x = cvt_pk_bf16(o0.x, o0.y); w.y = cvt_pk_bf16(o1.x, o1.y); w.z = cvt_pk_bf16(o2.x, o2.y); w.w = cvt_pk_bf16(o3.x, o3.y);
                *(u32x4*)rowp = w; }
    }
};
template <int RS> struct EpiSwigluF8 {
    static constexpr bool PERM = true; static constexpr bool HAS_INIT = false; static constexpr bool HAS_PRE = (RS == 2);
    unsigned char* O; int ldc; const void* rsp;
    __device__ __forceinline__ void pre(float (&sc)[2][4], const Unit& u, int wr, int fr) const { row_scales<RS>(sc, rsp, u.pm * BM + wr * 64 + fr); }
    __device__ __forceinline__ void operator()(const f32x4 (&acc)[2][2][4][2], const Unit& u, int wr, int wc, int fr, int fq) const { float sc[2][4]; row_scales<RS>(sc, rsp, u.pm * BM + wr * 64 + fr); (*this)(acc, u, wr, wc, fr, fq, sc); }
    __device__ __forceinline__ void operator()(const f32x4 (&acc)[2][2][4][2], const Unit& u, int wr, int wc, int fr, int fq, const float (&sc)[2][4]) const {
        const int row0 = u.pm * BM + wr * 64 + fr, col0 = u.pn * HALF + wc * 32 + 8 * fq;
#pragma unroll
        for (int ai = 0; ai < 2; ++ai)
#pragma unroll
            for (int m = 0; m < 4; ++m) { unsigned char* rowp = O + (size_t)(row0 + ai * HALF + m * 16) * ldc + col0;
                const f32x4 g0 = acc[ai][0][m][0], g1 = acc[ai][0][m][1], u0 = acc[ai][1][m][0], u1 = acc[ai][1][m][1]; const float s = sc[ai][m], s8 = s * A8_SCALE;
                const f32x2 o0 = silu_mul2((f32x2){g0[0], g0[1]}, (f32x2){u0[0], u0[1]}, s, s8), o1 = silu_mul2((f32x2){g0[2], g0[3]}, (f32x2){u0[2], u0[3]}, s, s8);
                const f32x2 o2 = silu_mul2((f32x2){g1[0], g1[1]}, (f32x2){u1[0], u1[1]}, s, s8), o3 = silu_mul2((f32x2){g1[2], g1[3]}, (f32x2){u1[2], u1[3]}, s, s8);
                u32x2 w; w.x = pk4_fp8(o0.x, o0.y, o1.x, o1.y); w.y = pk4_fp8(o2.x, o2.y, o3.x, o3.y);
                *(u32x2*)rowp = w; }
    }
};
struct EpiResF32 {
    static constexpr bool PERM = true; static constexpr bool HAS_PRE = false; static constexpr bool HAS_INIT = true;
    const float* R32; bf16_t* XR; int ldc; unsigned char* XB8; float* ss; int rf32; int f8out; LAS float* part;
    __device__ __forceinline__ void init(f32x4 (&acc)[2][2][4][2], const Unit& u, int wr, int wc, int fr, int fq) const {
        const int col0 = u.pn * BM + wc * 32 + 8 * fq;
        u32x4 rb[2][4][2];
#pragma unroll
        for (int ai = 0; ai < 2; ++ai)
#pragma unroll
            for (int m = 0; m < 4; ++m) { const unsigned boff = (unsigned)((u.pm * BM + ai * HALF + wr * 64 + m * 16 + fr) * ldc + col0) * 2u;
#pragma unroll
                for (int bj = 0; bj < 2; ++bj) rb[ai][m][bj] = *(const u32x4*)((const char*)XR + (size_t)(boff + (unsigned)(bj * HALF * 2))); }
#pragma unroll
        for (int ai = 0; ai < 2; ++ai)
#pragma unroll
            for (int m = 0; m < 4; ++m)
#pragma unroll
                for (int bj = 0; bj < 2; ++bj) { const u32x4 q = rb[ai][m][bj];
                    acc[ai][bj][m][0] = (f32x4){bflo(q[0]), bfhi(q[0]), bflo(q[1]), bfhi(q[1])}; acc[ai][bj][m][1] = (f32x4){bflo(q[2]), bfhi(q[2]), bflo(q[3]), bfhi(q[3])}; }
    }
    __device__ __forceinline__ void operator()(const f32x4 (&acc)[2][2][4][2], const Unit& u, int wr, int wc, int fr, int fq) const {
        const int col0 = u.pn * BM + wc * 32 + 8 * fq;
        float ssw[2][4];
#pragma unroll
        for (int ai = 0; ai < 2; ++ai) {
#pragma unroll
            for (int m = 0; m < 4; ++m) { const unsigned eoff = (unsigned)((u.pm * BM + ai * HALF + wr * 64 + m * 16 + fr) * ldc + col0);
                float ssp = 0.f;
#pragma unroll
                for (int bj = 0; bj < 2; ++bj) {
                    const f32x4 v0 = acc[ai][bj][m][0], v1 = acc[ai][bj][m][1];
                    ssp += (v0[0] * v0[0] + v0[1] * v0[1]) + (v0[2] * v0[2] + v0[3] * v0[3]) + (v1[0] * v1[0] + v1[1] * v1[1]) + (v1[2] * v1[2] + v1[3] * v1[3]);
                    { u32x4 w; w.x = cvt_pk_bf16(v0[0], v0[1]); w.y = cvt_pk_bf16(v0[2], v0[3]); w.z = cvt_pk_bf16(v1[0], v1[1]); w.w = cvt_pk_bf16(v1[2], v1[3]); *(u32x4*)((char*)XR + (size_t)((eoff + (unsigned)(bj * HALF)) * 2u)) = w; }
                    if (f8out) { u32x2 w; w.x = pk4_fp8(v0[0], v0[1], v0[2], v0[3]); w.y = pk4_fp8(v1[0], v1[1], v1[2], v1[3]); *(u32x2*)(XB8 + (size_t)(eoff + (unsigned)(bj * HALF))) = w; }
                }
                ssp += lx16(ssp); ssw[ai][m] = sum_halves(ssp);
            }
        }
        if (fq == 0) {
#pragma unroll
            for (int ai = 0; ai < 2; ++ai)
#pragma unroll
                for (int m = 0; m < 4; ++m) part[((wr * 4 + wc) * 8 + ai * 4 + m) * 16 + fr] = ssw[ai][m]; }
        asm volatile("s_waitcnt lgkmcnt(0)" ::: "memory"); __builtin_amdgcn_s_barrier(); asm volatile("" ::: "memory");
        if (wc == 0 && fq == 0) {
#pragma unroll
            for (int ai = 0; ai < 2; ++ai)
#pragma unroll
                for (int m = 0; m < 4; ++m) { const LAS float* p = part + (wr * 4 * 8 + ai * 4 + m) * 16 + fr;
                    ss[(size_t)(u.pm * BM + ai * HALF + wr * 64 + m * 16 + fr) * 8 + u.pn] = (p[0] + p[128]) + (p[256] + p[384]); } }
        asm volatile("s_waitcnt lgkmcnt(0)" ::: "memory"); __builtin_amdgcn_s_barrier(); asm volatile("" ::: "memory");
    }
};
struct EpiMoeDown {
    static constexpr bool PERM = true; static constexpr bool HAS_INIT = false; static constexpr bool HAS_PRE = false;
    bf16_t* O; int ldc; float* PB; int* tmap; int SP;
    __device__ __forceinline__ void operator()(const f32x4 (&acc)[2][2][4][2], const Unit& u, int wr, int wc, int fr, int fq) const {
        if (u.part < 0) {
            const int row0 = u.pm * BM + wr * 64 + fr, col0 = u.pn * BM + wc * 32 + 8 * fq;
#pragma unroll
            for (int ai = 0; ai < 2; ++ai)
#pragma unroll
                for (int m = 0; m < 4; ++m) { bf16_t* rowp = O + (size_t)(row0 + ai * HALF + m * 16) * ldc + col0;
#pragma unroll
                    for (int bj = 0; bj < 2; ++bj) { const f32x4 v0 = acc[ai][bj][m][0], v1 = acc[ai][bj][m][1];
                        u32x4 w; w.x = cvt_pk_bf16(v0[0], v0[1]); w.y = cvt_pk_bf16(v0[2], v0[3]); w.z = cvt_pk_bf16(v1[0], v1[1]); w.w = cvt_pk_bf16(v1[2], v1[3]);
                        *(u32x4*)(rowp + bj * HALF) = w; } }
        } else {
            float* slab = PB + (size_t)u.part * (BM * BM);
            if ((u.part % SP) == 0 && wr == 0 && wc == 0 && fr == 0 && fq == 0) tmap[u.pm * 8 + u.pn] = 1 + u.part / SP;
#pragma unroll
            for (int ai = 0; ai < 2; ++ai)
#pragma unroll
                for (int m = 0; m < 4; ++m) { float* rowp = slab + (ai * HALF + wr * 64 + m * 16 + fr) * BM + wc * 32 + 8 * fq;
#pragma unroll
                    for (int bj = 0; bj < 2; ++bj) { *(f32x4*)(rowp + bj * HALF) = acc[ai][bj][m][0]; *(f32x4*)(rowp + bj * HALF + 4) = acc[ai][bj][m][1]; } }
        }
    }
};
struct EpiF32 {
    static constexpr bool PERM = false; static constexpr bool HAS_INIT = false; static constexpr bool HAS_PRE = false;
    float* O; int ldc;
    __device__ __forceinline__ void operator()(const f32x4 (&acc)[2][2][4][2], const Unit& u, int wr, int wc, int fr, int fq) const {
        const int col0 = u.pn * BM + wc * 32 + 4 * fq;
#pragma unroll
        for (int ai = 0; ai < 2; ++ai)
#pragma unroll
            for (int m = 0; m < 4; ++m) { const size_t off = (size_t)(u.pm * BM + ai * HALF + wr * 64 + m * 16 + fr) * ldc + col0;
#pragma unroll
                for (int bj = 0; bj < 2; ++bj)
#pragma unroll
                    for (int n = 0; n < 2; ++n) *(f32x4*)(O + off + bj * HALF + n * 16) = acc[ai][bj][m][n]; }
    }
};

struct NoBG { static constexpr int nslots = 0; __device__ __forceinline__ void operator()(int) const {} };
struct MoeConv {
    volatile LAS unsigned* LW; int slot0, nslots, bx8, NGW;
    static constexpr int PER = 3584, NITEMS = 24 * PER, NQ = BG_NQ;
    __device__ __forceinline__ unsigned long long ptr(int i) const { return (unsigned long long)(unsigned)__builtin_amdgcn_readfirstlane((int)LW[64 + 2 * i]) | ((unsigned long long)(unsigned)__builtin_amdgcn_readfirstlane((int)LW[64 + 2 * i + 1]) << 32); }
    __device__ __forceinline__ void operator()(int s) const {
        if (s >= nslots) return;
        const int tid_ = ltid(), lane = tid_ & 63, c = lane & 31, h = lane >> 5, gw = bx8 + __builtin_amdgcn_readfirstlane(tid_ >> 6);
#pragma unroll 1
        for (int rp = 0; rp < BG_NREP; ++rp) {
        const int it0 = (((slot0 + s) * BG_NREP + rp) * NGW + gw) * NQ; if (it0 >= NITEMS) return;
        f32x4 v[NQ][4][2][2]; float sc[NQ][4]; unsigned char* dst[NQ];
#pragma unroll
        for (int q2 = 0; q2 < NQ; ++q2) {
            int it = it0 + q2; it = it < NITEMS ? it : it0;
            const int mat = it / PER, r = it - mat * PER, e = mat & 7, kind = mat >> 3;
            const bool up_ = kind < 2;
            const int K = up_ ? DM : FFE, N = up_ ? FFE : DM, nblk = up_ ? 224 : 64, kb = r / nblk, nb = r - kb * nblk, k0 = 128 * kb, n0 = 32 * nb;
            const int drow0 = up_ ? (256 * (n0 >> 7) + kind * 128 + (n0 & 127)) : n0;
            const float* W = (const float*)(GAS const float*)ptr(kind == 0 ? 17 : (kind == 1 ? 18 : 19)) + (size_t)e * DM * FFE;
            const float* gk = (const float*)(GAS const float*)ptr(12) + DM;
            dst[q2] = (unsigned char*)(GAS unsigned char*)(ptr(21) + (up_ ? WS_WMGU : WS_WMD)) + (size_t)e * (up_ ? 2 : 1) * FFE * DM + (size_t)(drow0 + c) * K + k0 + 16 * h;
#pragma unroll
            for (int kb4 = 0; kb4 < 4; ++kb4) {
                const unsigned off = (unsigned)(((k0 + 32 * kb4 + c) * N + n0 + 8 * h) * 4);
                const char* row = (const char*)W + off;
                const float gv = gk[(k0 + 32 * kb4 + c) & (DM - 1)];
                sc[q2][kb4] = (up_ ? gv : 1.0f) * W8_SCALE;
#pragma unroll
                for (int nh = 0; nh < 2; ++nh) { v[q2][kb4][nh][0] = *(const f32x4*)(row + 64 * nh); v[q2][kb4][nh][1] = *(const f32x4*)(row + 64 * nh + 16); } }
        }
        u32x4 s0 = {0u, 0u, 0u, 0u}, s1 = {0u, 0u, 0u, 0u};
        { const int j0 = c - 8 * h, j1 = c - 16 - 8 * h;
#pragma unroll
          for (int j = 0; j < 8; ++j) { if (j == j0) s0[j >> 1] = (j & 1) ? 0x3f800000u : 0x00003f80u; if (j == j1) s1[j >> 1] = (j & 1) ? 0x3f800000u : 0x00003f80u; } }
        const bf16x8 sel0 = __builtin_bit_cast(bf16x8, s0), sel1 = __builtin_bit_cast(bf16x8, s1);
#pragma unroll
        for (int q2 = 0; q2 < NQ; ++q2)
#pragma unroll
            for (int kb4 = 0; kb4 < 4; ++kb4) {
                const float f = sc[q2][kb4];
                u32x4 a0, a1;
                { const f32x4 x0 = v[q2][kb4][0][0] * f, x1 = v[q2][kb4][0][1] * f, y0 = v[q2][kb4][1][0] * f, y1 = v[q2][kb4][1][1] * f;
                  a0.x = cvt_pk_bf16(x0[0], x0[1]); a0.y = cvt_pk_bf16(x0[2], x0[3]); a0.z = cvt_pk_bf16(x1[0], x1[1]); a0.w = cvt_pk_bf16(x1[2], x1[3]);
                  a1.x = cvt_pk_bf16(y0[0], y0[1]); a1.y = cvt_pk_bf16(y0[2], y0[3]); a1.z = cvt_pk_bf16(y1[0], y1[1]); a1.w = cvt_pk_bf16(y1[2], y1[3]); }
                f32x16 d = f32x16{};
                d = __builtin_amdgcn_mfma_f32_32x32x16_bf16(__builtin_bit_cast(bf16x8, a0), sel0, d, 0, 0, 0);
                d = __builtin_amdgcn_mfma_f32_32x32x16_bf16(__builtin_bit_cast(bf16x8, a1), sel1, d, 0, 0, 0);
                const unsigned w0 = pk4_fp8(d[0], d[1], d[2], d[3]), w1 = pk4_fp8(d[4], d[5], d[6], d[7]), w2 = pk4_fp8(d[8], d[9], d[10], d[11]), w3 = pk4_fp8(d[12], d[13], d[14], d[15]);
                const auto p02 = __builtin_amdgcn_permlane32_swap(w0, w2, false, false), p13 = __builtin_amdgcn_permlane32_swap(w1, w3, false, false);
                const u32x4 o = {p02[0], p02[1], p13[0], p13[1]};
                *(u32x4*)(dst[q2] + 32 * kb4) = o;
            }
        }
    }
};
__device__ __forceinline__ void mfma_f8_tied(f32x4& c, i32x8 a, i32x8 b, int sa, int sb) {
    asm volatile("v_mfma_scale_f32_16x16x128_f8f6f4 %0, %1, %2, %0, %3, %4 op_sel_hi:[0,0,0]" : "+v"(c) : "v"(a), "v"(b), "v"(sa), "v"(sb)); }
__device__ __forceinline__ void mfma_f8_drain() { asm volatile("s_nop 15\n\ts_nop 15" ::: "memory"); }
__device__ __forceinline__ void glds16s(unsigned voff, const char* sbase, unsigned lds_dst) { unsigned keep;
    asm volatile("s_mov_b32 %0, m0\n\ts_mov_b32 m0, %3\n\ts_nop 0\n\tglobal_load_lds_dwordx4 %1, %2\n\ts_mov_b32 m0, %0" : "=&s"(keep) : "v"(voff), "s"(sbase), "s"(lds_dst) : "memory"); }
template <class Epi, class Sched, bool F8 = false, int SCW = SC_ONE, int SCX = SC_ONE, class BG = NoBG>
__device__ __forceinline__ void gemm_phase(LAS unsigned char* lds, const Gemm g, const Sched& S, const Epi& E, const BG& bg = BG()) {
    const int tid = ltid(), wid = __builtin_amdgcn_readfirstlane(tid >> 6), lane = tid & 63, wr = wid >> 2, wc = wid & 3, fr = lane & 15, fq = lane >> 4;
    const int KB = g.KB, nt = KB / 128;
    int scw_ = SCW, scx_ = SCX; if constexpr (F8) { asm volatile("" : "+v"(scw_), "+v"(scx_)); }
    unsigned voffA[2], voffB[2];
#pragma unroll
    for (int i = 0; i < 2; ++i) { int R, C; stage_rc(tid * 16 + i * 8192, R, C); const int Rb = Epi::PERM ? ((R & ~31) + perm32(R & 31)) : R;
        voffA[i] = (unsigned)(R * KB + C * 2); voffB[i] = (unsigned)(Rb * KB + C * 2); }
    const size_t kstep = (size_t)128;
    const size_t hstep = (size_t)HALF * KB;
    const size_t tstep = 2 * hstep;
    const unsigned ldsb = (unsigned)(uintptr_t)lds + (unsigned)wid * 1024u;
    const int aoff = lds_byte(wr * 64 + fr, fq * 8), boff = lds_byte(wc * 32 + fr, fq * 8);
#define PG8_SA(b, h) (((b) * 2 + (h)) * HTB)
#define PG8_SB(b, h) ((4 + (b) * 2 + (h)) * HTB)
#define PG8_STAGE(bufoff, gbase, voff) do { _Pragma("unroll") for (int _i = 0; _i < 2; ++_i) \
        glds16s((voff)[_i], (const char*)(gbase), ldsb + (unsigned)((bufoff) + _i * 8192)); } while (0)
#define PG8_LDA(dst, b, h) do { _Pragma("unroll") for (int m = 0; m < 4; ++m) _Pragma("unroll") for (int k = 0; k < 2; ++k) dst[m][k] = *(const LAS bf16x8*)(lds + PG8_SA(b, h) + aoff + m * 2048 + k * 1024); } while (0)
#define PG8_LDB(dst, b, h) do { _Pragma("unroll") for (int n = 0; n < 2; ++n) _Pragma("unroll") for (int k = 0; k < 2; ++k) dst[n][k] = *(const LAS bf16x8*)(lds + PG8_SB(b, h) + boff + n * 2048 + k * 1024); } while (0)
#define PG8_CAT8(x) __builtin_shufflevector(__builtin_bit_cast(i32x4, (x)[0]), __builtin_bit_cast(i32x4, (x)[1]), 0, 1, 2, 3, 4, 5, 6, 7)
#define PG8_MMA(ai, bj, At, Bt) do { __builtin_amdgcn_s_setprio(1); \
        if constexpr (F8) { _Pragma("unroll") for (int m = 0; m < 4; ++m) _Pragma("unroll") for (int n = 0; n < 2; ++n) \
            mfma_f8_tied(acc[ai][bj][m][n], PG8_CAT8(Bt[n]), PG8_CAT8(At[m]), scw_, scx_); } \
        else { _Pragma("unroll") for (int m = 0; m < 4; ++m) _Pragma("unroll") for (int n = 0; n < 2; ++n) _Pragma("unroll") for (int k = 0; k < 2; ++k) \
            acc[ai][bj][m][n] = __builtin_amdgcn_mfma_f32_16x16x32_bf16(Bt[n][k], At[m][k], acc[ai][bj][m][n], 0, 0, 0); } \
        __builtin_amdgcn_s_setprio(0); } while (0)
#define PG8_WAIT_V(n) asm volatile("s_waitcnt vmcnt(" #n ")" ::: "memory")
#define PG8_WAIT_L(n) asm volatile("s_waitcnt lgkmcnt(" #n ")" ::: "memory")
#define PG8_BAR __builtin_amdgcn_s_barrier()
#define PG8_SCHED __builtin_amdgcn_sched_barrier(0)
    Unit cur, nxt; int ui = 0;
    if (!S.next(0, cur)) { for (int s = 0; s < bg.nslots; ++s) bg(s); return; }
    bf16x8 At[4][2], B0[2][2], B1[2][2];
    const char* cA = (const char*)g.A + (size_t)cur.pm * tstep + cur.kb0; const char* cB = (const char*)g.Bt + (size_t)cur.e * g.estride + (size_t)cur.pn * tstep + cur.kb0;
    PG8_STAGE(PG8_SB(0, 0), cB, voffB); PG8_STAGE(PG8_SB(0, 1), cB + hstep, voffB); PG8_STAGE(PG8_SA(0, 0), cA, voffA); PG8_STAGE(PG8_SA(0, 1), cA + hstep, voffA);
    if (wr == 1) PG8_BAR;
    PG8_WAIT_V(2); PG8_BAR;
    PG8_STAGE(PG8_SB(1, 0), cB + kstep, voffB); PG8_STAGE(PG8_SA(1, 0), cA + kstep, voffA); PG8_STAGE(PG8_SB(1, 1), cB + hstep + kstep, voffB);
    PG8_WAIT_V(6); PG8_BAR;
    for (;;) {
        f32x4 acc[2][2][4][2];
        if constexpr (Epi::HAS_INIT) E.init(acc, cur, wr, wc, fr, fq);
        else {
#pragma unroll
        for (int a = 0; a < 2; ++a)
#pragma unroll
            for (int b = 0; b < 2; ++b)
#pragma unroll
                for (int m = 0; m < 4; ++m)
#pragma unroll
                    for (int n = 0; n < 2; ++n) acc[a][b][m][n] = (f32x4){0.f, 0.f, 0.f, 0.f};
        }
        float psc[2][4];
        if constexpr (Epi::HAS_PRE) E.pre(psc, cur, wr, fr);
        const bool has_next = S.next(ui + 1, nxt);
        const char* nA = has_next ? (const char*)g.A + (size_t)nxt.pm * tstep + nxt.kb0 : cA; const char* nB = has_next ? (const char*)g.Bt + (size_t)nxt.e * g.estride + (size_t)nxt.pn * tstep + nxt.kb0 : cB;
        const int ntc = cur.ntu ? cur.ntu : nt;
        for (int t = 0; t < ntc; t += 2) {
            const bool last = (t == ntc - 2);
            const char* a1 = cA + (size_t)(t + 1) * kstep;
            const char* a2 = last ? nA : cA + (size_t)(t + 2) * kstep; const char* b2 = last ? nB : cB + (size_t)(t + 2) * kstep;
            const char* a3 = a2 + kstep; const char* b3 = b2 + kstep;
            PG8_LDB(B0, 0, 0); PG8_LDB(B1, 0, 1); PG8_SCHED; PG8_LDA(At, 0, 0); PG8_STAGE(PG8_SA(1, 1), a1 + hstep, voffA);
            PG8_WAIT_V(8); PG8_WAIT_L(0); PG8_BAR; PG8_MMA(0, 0, At, B0); PG8_MMA(0, 1, At, B1); PG8_BAR; PG8_SCHED;
            PG8_LDA(At, 0, 1); PG8_STAGE(PG8_SB(0, 0), b2, voffB); PG8_STAGE(PG8_SB(0, 1), b2 + hstep, voffB); PG8_STAGE(PG8_SA(0, 0), a2, voffA);
            PG8_WAIT_V(8); PG8_WAIT_L(0); PG8_BAR; PG8_MMA(1, 0, At, B0); PG8_MMA(1, 1, At, B1); PG8_BAR; PG8_SCHED;
            PG8_LDB(B0, 1, 0); PG8_LDB(B1, 1, 1); PG8_SCHED; PG8_LDA(At, 1, 0); PG8_STAGE(PG8_SA(0, 1), a2 + hstep, voffA);
            PG8_WAIT_V(8); PG8_WAIT_L(0); PG8_BAR; PG8_MMA(0, 0, At, B0); PG8_MMA(0, 1, At, B1); PG8_BAR; PG8_SCHED;
            PG8_LDA(At, 1, 1); PG8_STAGE(PG8_SB(1, 0), b3, voffB); PG8_STAGE(PG8_SB(1, 1), b3 + hstep, voffB); PG8_STAGE(PG8_SA(1, 0), a3, voffA);
            PG8_WAIT_V(8); PG8_WAIT_L(0); PG8_BAR; PG8_MMA(1, 0, At, B0); PG8_MMA(1, 1, At, B1); PG8_BAR; PG8_SCHED;
        }
        if (wr == 0) PG8_BAR;
        if constexpr (F8) mfma_f8_drain();
        if constexpr (Epi::HAS_PRE) E(acc, cur, wr, wc, fr, fq, psc); else E(acc, cur, wr, wc, fr, fq);
        asm volatile("" ::: "memory"); __builtin_amdgcn_sched_barrier(0);
        bg(ui);
        asm volatile("" ::: "memory"); __builtin_amdgcn_sched_barrier(0);
        if (!has_next) break;
        cur = nxt; cA = nA; cB = nB; ++ui;
        if (wr == 1) PG8_BAR;
    }
    for (int s = ui + 1; s < bg.nslots; ++s) bg(s);
    PG8_WAIT_V(0);
    PG8_BAR;
#undef PG8_SA
#undef PG8_SB
#undef PG8_STAGE
#undef PG8_LDA
#undef PG8_LDB
#undef PG8_MMA
#undef PG8_CAT8
#undef PG8_WAIT_V
#undef PG8_WAIT_L
#undef PG8_BAR
#undef PG8_SCHED
}
}

namespace att {
constexpr int D = 128, LDZ = INW, LDO = DM;
constexpr float SCALE = 0.08838834764831845f;
constexpr float THR = 8.f;
constexpr int NW = 8, QBLK = 32, KVBLK = 64, QB = NW * QBLK;
constexpr int SHM_V = KVBLK * D * 2, SHM_K = KVBLK * D * 2;
constexpr int ATT_LDS_BYTES = 2 * SHM_V + 2 * SHM_K + NW * 64 * 4;
#define KSWZ(row, colB) ((row) * 256 + ((colB) ^ (((row) & 7) << 4)))
#define SBAR() __builtin_amdgcn_sched_barrier(0)
__device__ __forceinline__ int v_st(int k, int c) { const int kk = (k & ~0xC) | ((k & 4) << 1) | ((k & 8) >> 1); return ((kk >> 3) * 4 + (c >> 5)) * 512 + ((kk & 7) * 32 + (c & 31)) * 2; }
__device__ __forceinline__ int v_rd_base(int lane) { return ((lane & 3) << 3) | (((lane >> 2) & 3) << 6) | (((lane >> 4) & 1) << 5) | (((lane >> 5) & 1) << 8); }
constexpr int v_rd_off(int d0, int ks, int half) { return d0 * 512 + ks * 4096 + half * 2048; }
__device__ __forceinline__ int crow(int r, int hi) { return (r & 3) + 8 * (r >> 2) + 4 * hi; }
__device__ __forceinline__ bf16x8 load8(const bf16_t* p) { return *reinterpret_cast<const bf16x8*>(p); }
__device__ __forceinline__ void mask_tile(f32x16& p0, f32x16& p1, int dq, unsigned W) {
    const float NEG = -__builtin_inff();
#pragma unroll
    for (int r = 0; r < 16; ++r) {
        const int c = (r & 3) + 8 * (r >> 2);
        if ((unsigned)(dq - c) >= W) p0[r] = NEG;
        if ((unsigned)(dq - c - 32) >= W) p1[r] = NEG;
    }
}
__device__ __forceinline__ void partialSM(f32x16& p0, f32x16& p1, float& m_reg, float& mn, float& alpha) {
    float pmax = p0[0];
#pragma unroll
    for (int r = 1; r < 16; ++r) pmax = fmaxf(pmax, p0[r]);
#pragma unroll
    for (int r = 0; r < 16; ++r) pmax = fmaxf(pmax, p1[r]);
    { auto rr = __builtin_amdgcn_permlane32_swap(__float_as_uint(pmax), __float_as_uint(pmax), false, false);
      pmax = fmaxf(__uint_as_float(rr[0]), __uint_as_float(rr[1])); }
    constexpr float C2 = 1.4426950408889634f * SCALE;
    if (__builtin_expect(__all((pmax - m_reg) * SCALE <= THR), 1)) { mn = m_reg; alpha = 1.f; }
    else { mn = fmaxf(m_reg, pmax); alpha = __builtin_amdgcn_exp2f((m_reg - mn) * C2); m_reg = mn; }
    const float mnL = -mn * C2;
#pragma unroll
    for (int r = 0; r < 16; ++r) p0[r] = fmaf(p0[r], C2, mnL);
#pragma unroll
    for (int r = 0; r < 16; ++r) p1[r] = fmaf(p1[r], C2, mnL);
#pragma unroll
    for (int r = 0; r < 16; ++r) p0[r] = __builtin_amdgcn_exp2f(p0[r]);
}
__device__ __forceinline__ void finishSM(f32x16& p0, f32x16& p1, float alpha, float& l_reg, bf16x8& pa0, bf16x8& pa1, bf16x8& pa2, bf16x8& pa3) {
#pragma unroll
    for (int r = 0; r < 16; ++r) p1[r] = __builtin_amdgcn_exp2f(p1[r]);
    float ps = 0;
#pragma unroll
    for (int r = 0; r < 16; ++r) ps += p0[r];
#pragma unroll
    for (int r = 0; r < 16; ++r) ps += p1[r];
    { auto rr = __builtin_amdgcn_permlane32_swap(__float_as_uint(ps), __float_as_uint(ps), false, false);
      ps = __uint_as_float(rr[0]) + __uint_as_float(rr[1]); }
    l_reg = l_reg * alpha + ps;
#define PK4(P, B_, OUT) do { unsigned a0 = cvt_pk_bf16(P[B_+0], P[B_+1]), a1 = cvt_pk_bf16(P[B_+2], P[B_+3]);                          \
        unsigned b0 = cvt_pk_bf16(P[B_+4], P[B_+5]), b1 = cvt_pk_bf16(P[B_+6], P[B_+7]);                                             \
        auto r0 = __builtin_amdgcn_permlane32_swap(a0, b0, false, false); auto r1 = __builtin_amdgcn_permlane32_swap(a1, b1, false, false); \
        u32x4 w = {r0[0], r1[0], r0[1], r1[1]}; OUT = *reinterpret_cast<bf16x8*>(&w); } while (0)
    PK4(p0, 0, pa0); PK4(p0, 8, pa1); PK4(p1, 0, pa2); PK4(p1, 8, pa3);
#undef PK4
}
template <int KB>
__device__ __forceinline__ void qkt(f32x16& p0, f32x16& p1, const char* K_lds, int r32, int hi, const bf16x8* qr) {
    p0 = f32x16{}; p1 = f32x16{};
    const char* kb[4];
#pragma unroll
    for (int dd = 0; dd < 4; ++dd) kb[dd] = K_lds + KB * SHM_K + KSWZ(r32, (dd * 16 + hi * 8) * 2);
#pragma unroll
    for (int d0 = 0; d0 < 8; ++d0) { const char* a = kb[d0 & 3] + (d0 >> 2) * 128;
        bf16x8 b0 = *reinterpret_cast<const bf16x8*>(a);
        bf16x8 b1 = *reinterpret_cast<const bf16x8*>(a + 32 * 256);
        p0 = __builtin_amdgcn_mfma_f32_32x32x16_bf16(b0, qr[d0], p0, 0, 0, 0);
        p1 = __builtin_amdgcn_mfma_f32_32x32x16_bf16(b1, qr[d0], p1, 0, 0, 0); }
}
template <int VB>
__device__ __forceinline__ void pv_tile(f32x16* o, int vb0, bf16x8 pa0, bf16x8 pa1, bf16x8 pa2, bf16x8 pa3) {
#define TRRD(dst, off) asm volatile("ds_read_b64_tr_b16 %0, %1 offset:%2" : "=&v"(dst) : "v"(vb0), "i"(off) : "memory")
#define PV_D0(d0) do { s16x4 l0, l1, l2, l3, h0, h1, h2, h3; constexpr int b_ = VB * SHM_V + v_rd_off(d0, 0, 0); \
        TRRD(l0, b_); TRRD(h0, b_ + 2048); TRRD(l1, b_ + 4096); TRRD(h1, b_ + 6144); TRRD(l2, b_ + 8192); TRRD(h2, b_ + 10240); TRRD(l3, b_ + 12288); TRRD(h3, b_ + 14336); \
        asm volatile("s_waitcnt lgkmcnt(0)" ::: "memory"); SBAR();   \
        o[d0] = __builtin_amdgcn_mfma_f32_32x32x16_bf16(pa0, (bf16x8){l0[0], l0[1], l0[2], l0[3], h0[0], h0[1], h0[2], h0[3]}, o[d0], 0, 0, 0);   \
        o[d0] = __builtin_amdgcn_mfma_f32_32x32x16_bf16(pa1, (bf16x8){l1[0], l1[1], l1[2], l1[3], h1[0], h1[1], h1[2], h1[3]}, o[d0], 0, 0, 0);   \
        o[d0] = __builtin_amdgcn_mfma_f32_32x32x16_bf16(pa2, (bf16x8){l2[0], l2[1], l2[2], l2[3], h2[0], h2[1], h2[2], h2[3]}, o[d0], 0, 0, 0);   \
        o[d0] = __builtin_amdgcn_mfma_f32_32x32x16_bf16(pa3, (bf16x8){l3[0], l3[1], l3[2], l3[3], h3[0], h3[1], h3[2], h3[3]}, o[d0], 0, 0, 0); } while (0)
    PV_D0(0); PV_D0(1); PV_D0(2); PV_D0(3);
#undef PV_D0
#undef TRRD
}
struct BlockRef { const bf16_t* Q; const bf16_t* K; const bf16_t* V; bf16_t* O; int P0; };
struct Seam { bf16x8 qr[8]; bf16x8 st_v0, st_v1, st_k0, st_k1; };
#define ROW(p, k0, rr) ((p) + (size_t)((k0) + (rr)) * LDZ + sc)
#define VMW() asm volatile("s_waitcnt vmcnt(0)" ::: "memory")
#define VMWN(n) asm volatile("s_waitcnt vmcnt(%0)" :: "i"(n) : "memory")
#define SLOAD_H(Kp, Vp, k0) do { S.st_v0 = load8(ROW(Vp, k0, sr)); S.st_v1 = load8(ROW(Vp, k0, 32 + sr));              \
                         S.st_k0 = load8(ROW(Kp, k0, sr)); S.st_k1 = load8(ROW(Kp, k0, 32 + sr)); } while (0)
#define SWRITE_HK(bf) do { *(bf16x8*)(K_lds + (bf) * SHM_K + kws) = S.st_k0; *(bf16x8*)(K_lds + (bf) * SHM_K + kws + 32 * 256) = S.st_k1; } while (0)
#define SWRITE_HV(bf) do { *(bf16x8*)(V_lds + (bf) * SHM_V + vst0) = S.st_v0; *(bf16x8*)(V_lds + (bf) * SHM_V + vst1) = S.st_v1; } while (0)
#define SWRITE_H(bf) do { SWRITE_HV(bf); SWRITE_HK(bf); } while (0)
__device__ __forceinline__ void causal_prime(const BlockRef& cur, char* lds, Seam& S) {
    const int tid = ltid(), wid = __builtin_amdgcn_readfirstlane(tid >> 6), lane = tid & 63, r32 = lane & 31, hi = lane >> 5;
    const int sr = tid >> 4, sc = (tid & 15) * 8, kws = KSWZ(sr, sc * 2); char* K_lds = lds + 2 * SHM_V;
    const int kb0 = 0;
#pragma unroll
    for (int d0 = 0; d0 < 8; ++d0) S.qr[d0] = load8(cur.Q + (size_t)(wid * QBLK + r32) * LDZ + d0 * 16 + hi * 8);
    SLOAD_H(cur.K, cur.V, kb0); VMW(); SWRITE_HK(0);
    __syncthreads();
}
template <int ORD>
__device__ __forceinline__ void causal_block(const BlockRef& cur, const BlockRef& nxt, int skv, char* lds, Seam& S) {
    const int tid = ltid(), wid = __builtin_amdgcn_readfirstlane(tid >> 6), lane = tid & 63, r32 = lane & 31, hi = lane >> 5;
    const int W = 1 << 30;
    const int j_lo = 0;
    int j_hi = (cur.P0 + QB - 1) / KVBLK + 1; if (j_hi > skv / KVBLK) j_hi = skv / KVBLK;
    const int NT = j_hi - j_lo;
    const int kbn = 0;
    const int qlo = cur.P0 + wid * QBLK, qm = qlo + r32 - 4 * hi;
    char* V_lds = lds; char* K_lds = lds + 2 * SHM_V;
    float* ws = (float*)(lds + 2 * SHM_V + 2 * SHM_K) + wid * 64; float* li_l = ws, * al_l = ws + 32;
    float m_reg = -1e30f, l_reg = 0; f32x16 o[4];
    { float z_ = 0.f; asm volatile("" : "+v"(z_));
#pragma unroll
      for (int d_ = 0; d_ < 4; ++d_)
#pragma unroll
          for (int r = 0; r < 16; ++r) o[d_][r] = z_; }
    const int sr = tid >> 4, sc = (tid & 15) * 8, vst0 = v_st(sr, sc), vst1 = v_st(32 + sr, sc), kws = KSWZ(sr, sc * 2);
    const int vb0 = (int)(uintptr_t)V_lds + v_rd_base(lane);
    const bf16_t* Kh = cur.K; const bf16_t* Vh = cur.V;
#define RESC(a) do { if (__any((a) < 1.f)) { if (hi == 0) al_l[r32] = (a); asm volatile("s_waitcnt lgkmcnt(0)" ::: "memory");              \
                     _Pragma("unroll") for (int d_ = 0; d_ < 4; ++d_) _Pragma("unroll") for (int r = 0; r < 16; ++r) o[d_][r] *= al_l[crow(r, hi)]; } } while (0)
#define KBASE(t) ((j_lo + (t)) * KVBLK)
#define MASKT(P0_, P1_, t) do { const int kb_ = KBASE(t); if (kb_ + KVBLK - 1 > qlo) mask_tile(P0_, P1_, qm - kb_, (unsigned)W); } while (0)
    constexpr int NQL = 8;
#define SEAM_K0() do { VMWN(NQL); SWRITE_HK(0); SBAR(); } while (0)
    f32x16 pA0, pA1, pB0, pB1; float mnA, mnB, alA, alB; bf16x8 pa0, pa1, pa2, pa3;
    SWRITE_HV(0); SBAR();
    if (NT > 1) { SLOAD_H(Kh, Vh, KBASE(1)); }
    SBAR(); qkt<0>(pA0, pA1, K_lds, r32, hi, S.qr);
    MASKT(pA0, pA1, 0); partialSM(pA0, pA1, m_reg, mnA, alA);
    if (NT > 1) { VMW(); SWRITE_H(1); }
    __syncthreads();
#define HALF_STEP(PX0, PX1, mnX, alX, PY0, PY1, alY, t, KB, VB, SB) do {                                                      \
        SBAR(); qkt<KB>(PX0, PX1, K_lds, r32, hi, S.qr);                                                                      \
        finishSM(PY0, PY1, alY, l_reg, pa0, pa1, pa2, pa3); SBAR();                                                           \
        if ((t) + 1 < NT) { SLOAD_H(Kh, Vh, KBASE((t) + 1)); SBAR(); }                                                        \
        pv_tile<VB>(o, vb0, pa0, pa1, pa2, pa3); MASKT(PX0, PX1, (t)); partialSM(PX0, PX1, m_reg, mnX, alX);                  \
        __syncthreads();                                                                                                      \
        if ((t) + 1 < NT) { VMW(); SWRITE_H(SB); }                                                                            \
        RESC(alX); __syncthreads(); } while (0)
#define HALF_STEP_V(PX0, PX1, mnX, alX, PY0, PY1, alY, t, KB, VB, SB) do {                                                    \
        SBAR(); finishSM(PY0, PY1, alY, l_reg, pa0, pa1, pa2, pa3); SBAR();                                                   \
        qkt<KB>(PX0, PX1, K_lds, r32, hi, S.qr); SBAR();                                                                      \
        if ((t) + 1 < NT) { SLOAD_H(Kh, Vh, KBASE((t) + 1)); SBAR(); }                                                        \
        MASKT(PX0, PX1, (t)); partialSM(PX0, PX1, m_reg, mnX, alX); SBAR();                                                   \
        pv_tile<VB>(o, vb0, pa0, pa1, pa2, pa3);                                                                              \
        __syncthreads();                                                                                                      \
        if ((t) + 1 < NT) { VMW(); SWRITE_H(SB); }                                                                            \
        RESC(alX); __syncthreads(); } while (0)
    for (int t = 1; t + 1 < NT; t += 2) {
        if constexpr (ORD == 0) { HALF_STEP(pB0, pB1, mnB, alB, pA0, pA1, alA, t, 1, 0, 0);
                                  HALF_STEP(pA0, pA1, mnA, alA, pB0, pB1, alB, t + 1, 0, 1, 1); }
        else                    { HALF_STEP_V(pB0, pB1, mnB, alB, pA0, pA1, alA, t, 1, 0, 0);
                                  HALF_STEP_V(pA0, pA1, mnA, alA, pB0, pB1, alB, t + 1, 0, 1, 1); }
    }
    const bool even = (NT & 1) == 0;
    if (even) { SBAR(); qkt<1>(pB0, pB1, K_lds, r32, hi, S.qr); SBAR(); }
    SLOAD_H(nxt.K, nxt.V, kbn); SBAR();
#pragma unroll
    for (int d0 = 0; d0 < 8; ++d0) S.qr[d0] = load8(nxt.Q + (size_t)(wid * QBLK + r32) * LDZ + d0 * 16 + hi * 8);
    SBAR();
    finishSM(pA0, pA1, alA, l_reg, pa0, pa1, pa2, pa3); SBAR();
    pv_tile<0>(o, vb0, pa0, pa1, pa2, pa3);
    if (even) { MASKT(pB0, pB1, NT - 1); partialSM(pB0, pB1, m_reg, mnB, alB); __syncthreads(); RESC(alB);
        finishSM(pB0, pB1, alB, l_reg, pa0, pa1, pa2, pa3); SBAR(); pv_tile<1>(o, vb0, pa0, pa1, pa2, pa3); }
    SBAR(); SEAM_K0();
    if (hi == 0) li_l[r32] = l_reg; asm volatile("s_waitcnt lgkmcnt(0)" ::: "memory");
    float rli[16];
#pragma unroll
    for (int r = 0; r < 16; ++r) rli[r] = __builtin_amdgcn_rcpf(li_l[crow(r, hi)]);
    bf16_t* Ow = cur.O + (size_t)(wid * QBLK) * LDO;
#pragma unroll
    for (int r = 0; r < 16; ++r) { const int orow = crow(r, hi);
#pragma unroll
        for (int d0 = 0; d0 < 4; ++d0) { const float v = o[d0][r] * rli[r]; const float vn = lx1(v);
            if ((r32 & 1) == 0) *(unsigned*)(Ow + (size_t)orow * LDO + d0 * 32 + r32) = cvt_pk_bf16(v, vn); } }
    __syncthreads();
#undef RESC
#undef KBASE
#undef MASKT
#undef SEAM_K0
#undef HALF_STEP
#undef HALF_STEP_V
}
#undef ROW
#undef VMW
#undef VMWN
#undef SLOAD_H
#undef SWRITE_HK
#undef SWRITE_HV
#undef SWRITE_H
#undef KSWZ
#undef SBAR
}

#define XB_TMO      128
#define XB_XCNT(j)  (256  + 64 * (j))
#define XB_XSUB(j)  (1280 + 64 * (j))
#define XB_XGEN(j)  (2304 + 64 * (j))
#define XB_TOP      3328
#define XB_TOPGEN   3392
#define XCD_BAR_WORDS 3456
#define XB_SPIN_CAP (1u << 18)

__device__ __forceinline__ unsigned xb_ld(unsigned* p)              { return __hip_atomic_load(p, __ATOMIC_RELAXED, __HIP_MEMORY_SCOPE_AGENT); }
__device__ __forceinline__ unsigned xb_add(unsigned* p, unsigned v) { return __hip_atomic_fetch_add(p, v, __ATOMIC_RELAXED, __HIP_MEMORY_SCOPE_AGENT); }
__device__ __forceinline__ unsigned xb_xcc_id() { return (unsigned)__builtin_amdgcn_s_getreg((3 << 11) | 20) & 0xFu; }
#define XB_SPIN(cond, bar) do { unsigned _sp = 0; while (cond) { __builtin_amdgcn_s_sleep(1); \
    if ((++_sp & 255u) == 0u) { if (xb_ld(&(bar)[XB_TMO])) break; if (_sp > XB_SPIN_CAP) { atomicAdd(&(bar)[XB_TMO], 1u); break; } } } } while (0)

struct XcdBarrier {
    unsigned* bar; unsigned x;
    volatile LAS unsigned* st;
};

__device__ __forceinline__ XcdBarrier xcd_barrier_post(unsigned* bar, volatile LAS unsigned* st) {
    XcdBarrier b; b.bar = bar; b.x = xb_xcc_id(); b.st = st;
    if (threadIdx.x == 0) (void)xb_add(&bar[XB_XCNT(b.x)], 1u);
    return b;
}
__device__ __forceinline__ void xcd_barrier_complete(unsigned* bar, unsigned x, unsigned& nloc, unsigned& nx) {
    const unsigned G = gridDim.x * gridDim.y * gridDim.z;
    unsigned sum, cnt, mine, sp = 0u;
    for (;;) {
        sum = 0u; cnt = 0u; mine = 0u;
#pragma unroll
        for (unsigned j = 0; j < 16; ++j) { const unsigned c = xb_ld(&bar[XB_XCNT(j)]); sum += c; cnt += (c > 0u) ? 1u : 0u; mine = (j == x) ? c : mine; }
        if (sum == G) break;
        __builtin_amdgcn_s_sleep(1);
        if ((++sp & 255u) == 0u) { if (xb_ld(&bar[XB_TMO])) break; if (sp > XB_SPIN_CAP) { atomicAdd(&bar[XB_TMO], 1u); break; } }
    }
    nloc = mine > 0u ? mine : 1u; nx = cnt > 0u ? cnt : 1u;
}

template <bool FIRST> __device__ __forceinline__ void xcd_barrier(const XcdBarrier& b) {
    asm volatile("s_waitcnt vmcnt(0)" ::: "memory");
    __syncthreads();
    if (threadIdx.x == 0) {
        unsigned* bar = b.bar;
        __builtin_amdgcn_s_waitcnt(0);
        unsigned nloc = b.st[0], nx = b.st[1];
        if (FIRST) { if (nloc == 0u) { xcd_barrier_complete(bar, b.x, nloc, nx); b.st[0] = nloc; b.st[1] = nx; } }
        const unsigned old = xb_add(&bar[XB_XSUB(b.x)], 1u);
        const unsigned gen = old / nloc;
        if (old + 1u == (gen + 1u) * nloc) {
            __builtin_amdgcn_fence(__ATOMIC_RELEASE, "agent");
            asm volatile("s_waitcnt vmcnt(0)" ::: "memory");
            const unsigned og = xb_add(&bar[XB_TOP], 1u);
            const unsigned tg = og / nx;
            if (og + 1u == (tg + 1u) * nx) xb_add(&bar[XB_TOPGEN], 1u);
            else XB_SPIN(xb_ld(&bar[XB_TOPGEN]) == tg, bar);
            __builtin_amdgcn_fence(__ATOMIC_ACQUIRE, "agent");
            xb_add(&bar[XB_XGEN(b.x)], 1u);
            asm volatile("s_waitcnt vmcnt(0)" ::: "memory");
        } else {
            XB_SPIN(xb_ld(&bar[XB_XGEN(b.x)]) == gen, bar);
            __builtin_amdgcn_fence(__ATOMIC_ACQUIRE, "agent");
            asm volatile("s_waitcnt vmcnt(0)" ::: "memory");
        }
    }
    __syncthreads();
}

template <int KT, bool F8>
__device__ __forceinline__ void transpose_item(const float* W, int K, int N, void* WT, int drow0, int k0, int n0, LAS float* scr, int lane, const float* gk) {
    const int kr = lane >> 3, n4 = 4 * (lane & 7);
    f32x4 v[KT / 8];
#pragma unroll
    for (int i = 0; i < KT / 8; ++i) v[i] = *(const f32x4*)(W + (size_t)(k0 + kr + 8 * i) * N + n0 + n4);
    if (gk) {
#pragma unroll
        for (int i = 0; i < KT / 8; ++i) v[i] = v[i] * gk[k0 + kr + 8 * i]; }
#pragma unroll
    for (int i = 0; i < KT / 8; ++i) { LAS float* s = scr + (kr + 8 * i) * 33 + 4 * ((kr + 8 * i) >> 4) + n4; s[0] = v[i][0]; s[1] = v[i][1]; s[2] = v[i][2]; s[3] = v[i][3]; }
    LDS_WAIT(); asm volatile("" ::: "memory");
    const int c = lane & 7;
#pragma unroll
    for (int j = 0; j < 4; ++j) { const int n = (lane >> 3) + 8 * j;
        if constexpr (!F8) { static_assert(F8 || KT == 64, "bf16 item is 64 k");
            const LAS float* s = scr + (8 * c) * 33 + 4 * ((8 * c) >> 4) + n;
            u32x4 o; o.x = cvt_pk_bf16(s[0 * 33], s[1 * 33]); o.y = cvt_pk_bf16(s[2 * 33], s[3 * 33]); o.z = cvt_pk_bf16(s[4 * 33], s[5 * 33]); o.w = cvt_pk_bf16(s[6 * 33], s[7 * 33]);
            *(u32x4*)((bf16_t*)WT + (size_t)(drow0 + n) * K + k0 + 8 * c) = o;
        } else { static_assert(!F8 || KT == 128, "fp8 item is 128 k");
            const LAS float* s = scr + (16 * c) * 33 + 4 * c + n;
            u32x4 o;
            o.x = pk4_fp8(s[0 * 33] * W8_SCALE, s[1 * 33] * W8_SCALE, s[2 * 33] * W8_SCALE, s[3 * 33] * W8_SCALE);
            o.y = pk4_fp8(s[4 * 33] * W8_SCALE, s[5 * 33] * W8_SCALE, s[6 * 33] * W8_SCALE, s[7 * 33] * W8_SCALE);
            o.z = pk4_fp8(s[8 * 33] * W8_SCALE, s[9 * 33] * W8_SCALE, s[10 * 33] * W8_SCALE, s[11 * 33] * W8_SCALE);
            o.w = pk4_fp8(s[12 * 33] * W8_SCALE, s[13 * 33] * W8_SCALE, s[14 * 33] * W8_SCALE, s[15 * 33] * W8_SCALE);
            *(u32x4*)((unsigned char*)WT + (size_t)(drow0 + n) * K + k0 + 16 * c) = o;
        } }
    LDS_WAIT(); asm volatile("" ::: "memory");
}
template <bool F8> struct TrItem { static constexpr int NB = F8 ? 4 : 2; f32x4 v[NB][4]; f32x4 g[NB]; };
template <bool F8> __device__ __forceinline__ void tr_load(TrItem<F8>& T, const float* W, int N, int k0, int n0, int lane, const float* gk, bool useg) {
    const int kq = lane >> 3, nq = lane & 7;
#pragma unroll
    for (int b = 0; b < TrItem<F8>::NB; ++b) {
        const int kr = k0 + 32 * b + 4 * kq;
        const f32x4 gv = *(const f32x4*)(gk + (kr & (DM - 1)));
        T.g[b] = useg ? gv : (f32x4){1.f, 1.f, 1.f, 1.f};
#pragma unroll
        for (int i = 0; i < 4; ++i) T.v[b][i] = *(const f32x4*)(W + (size_t)(kr + i) * N + n0 + 4 * nq);
    }
}
template <bool F8> __device__ __forceinline__ void tr_store(const TrItem<F8>& T, void* WT, int K, int drow0, int dstep, int k0, LAS unsigned char* scr, int lane) {
    const int kq = lane >> 3, nq = lane & 7;
#pragma unroll
    for (int b = 0; b < TrItem<F8>::NB; ++b) {
        f32x4 x[4];
#pragma unroll
        for (int i = 0; i < 4; ++i) x[i] = T.v[b][i] * (T.g[b][i] * (F8 ? W8_SCALE : 1.0f));
#pragma unroll
        for (int e = 0; e < 4; ++e) {
            LAS unsigned char* row = scr + (4 * nq + e) * 144;
            if constexpr (F8) { const int kb = 32 * b + 4 * kq, ch = (kb >> 4) ^ nq;
                *(LAS unsigned*)(row + 16 * ch + (kb & 15)) = pk4_fp8(x[0][e], x[1][e], x[2][e], x[3][e]); }
            else { const int kb = 64 * b + 8 * kq, ch = (kb >> 4) ^ nq;
                u32x2 w; w.x = cvt_pk_bf16(x[0][e], x[1][e]); w.y = cvt_pk_bf16(x[2][e], x[3][e]); *(LAS u32x2*)(row + 16 * ch + (kb & 15)) = w; }
        }
    }
    LDS_WAIT(); asm volatile("" ::: "memory");
    const int c = lane & 7;
#pragma unroll
    for (int j = 0; j < 4; ++j) { const int n = (lane >> 3) + 8 * j;
        const u32x4 o = *(const LAS u32x4*)(scr + n * 144 + 16 * (c ^ ((n >> 2) & 7)));
        *(u32x4*)((unsigned char*)WT + ((size_t)(drow0 + n * dstep) * K + k0) * (F8 ? 1 : 2) + 16 * c) = o; }
    LDS_WAIT(); asm volatile("" ::: "memory");
}

__device__ __forceinline__ float row_copy_ss(const float* xrow, bf16_t* orow, int lane) {
    const f32x4* xr = (const f32x4*)xrow + lane; u32x2* o8 = (u32x2*)orow + lane;
    float s = 0.f;
#pragma unroll
    for (int j = 0; j < 8; ++j) { const f32x4 v = xr[64 * j]; s += (v.x * v.x + v.y * v.y) + (v.z * v.z + v.w * v.w); u32x2 w; w.x = cvt_pk_bf16(v.x, v.y); w.y = cvt_pk_bf16(v.z, v.w); o8[64 * j] = w; }
    return wave_sum(s);
}

struct ItemDesc { const float* W; void* WT; const float* gk; int K, N, drow0, dstep, k0, n0; bool useg; };
template <bool F8, class Dec> __device__ __forceinline__ void conv_loop(int first, int end, int stride, const Dec& dec, LAS unsigned char* scr, int lane) {
    int it = first; if (it >= end) return;
    TrItem<F8> A, B; ItemDesc da, db;
    dec(it, da); tr_load<F8>(A, da.W, da.N, da.k0, da.n0, lane, da.gk, da.useg);
    for (;;) {
        int nx = it + stride; bool hn = nx < end; dec(hn ? nx : it, db); tr_load<F8>(B, db.W, db.N, db.k0, db.n0, lane, db.gk, db.useg);
        tr_store<F8>(A, da.WT, da.K, da.drow0, da.dstep, da.k0, scr, lane);
        if (!hn) break; it = nx;
        nx = it + stride; hn = nx < end; dec(hn ? nx : it, da); tr_load<F8>(A, da.W, da.N, da.k0, da.n0, lane, da.gk, da.useg);
        tr_store<F8>(B, db.WT, db.K, db.drow0, db.dstep, db.k0, scr, lane);
        if (!hn) break; it = nx;
    }
}
constexpr int MOE_J = 8;
#ifndef CONV_NUM
#define CONV_NUM 12
#endif
struct DecMoe {
    volatile LAS unsigned* LW; int cbase, wave, blk;
    __device__ __forceinline__ int item(int q) const { return (q / MOE_J) * blk + cbase + (q % MOE_J) * 8 + wave; }
    __device__ __forceinline__ unsigned long long ptr(int i) const { return (unsigned long long)(unsigned)__builtin_amdgcn_readfirstlane((int)LW[64 + 2 * i]) | ((unsigned long long)(unsigned)__builtin_amdgcn_readfirstlane((int)LW[64 + 2 * i + 1]) << 32); }
    __device__ __forceinline__ void operator()(int q, ItemDesc& d) const {
        constexpr int PER = 3584; const int it = item(q);
        const int mat = it / PER, r = it - mat * PER, e = mat & 7, kind = mat >> 3;
        const bool up_ = kind < 2;
        const int nblk = up_ ? 224 : 64, kb = r / nblk, nb = r - kb * nblk;
        d.K = up_ ? DM : FFE; d.N = up_ ? FFE : DM; d.n0 = 32 * nb; d.k0 = 128 * kb; d.useg = up_; d.dstep = 1;
        d.drow0 = up_ ? (256 * (d.n0 >> 7) + kind * 128 + (d.n0 & 127)) : d.n0;
        d.W = (const float*)(GAS const float*)ptr(kind == 0 ? 17 : (kind == 1 ? 18 : 19)) + (size_t)e * DM * FFE;
        d.gk = (const float*)(GAS const float*)ptr(12) + DM;
        d.WT = (unsigned char*)(GAS unsigned char*)(ptr(21) + (up_ ? WS_WMGU : WS_WMD)) + (size_t)e * (up_ ? 2 : 1) * FFE * DM;
    }
};
constexpr int MOE_ITEMS = 24 * 3584;
struct DecMoeLin : DecMoe { int first, stride; __device__ __forceinline__ void operator()(int q, ItemDesc& d) const { DecMoe t = *this; t.cbase = first + q * stride; t.wave = 0; t.blk = 0; t.DecMoe::operator()(0, d); } };
struct DecP0 {
    volatile LAS unsigned* LW;
    static constexpr int I_IN = 32 * 160, I_OUT = 32 * 64, I_DG = 32 * 176, I_DD = 88 * 64, J_DG = 16 * 176, J_DD = 44 * 64;
    static constexpr int N16A = 2 * I_IN + 2 * I_OUT, N16B = N16A + (DUP8 ? 0 : 2 * I_DG), N16 = N16B + (DDN8 ? 0 : I_DD);
    static constexpr int N8A = DUP8 ? 2 * J_DG : 0, N8 = N8A + (DDN8 ? J_DD : 0);
    __device__ __forceinline__ unsigned long long ptr(int i) const { return (unsigned long long)(unsigned)__builtin_amdgcn_readfirstlane((int)LW[64 + 2 * i]) | ((unsigned long long)(unsigned)__builtin_amdgcn_readfirstlane((int)LW[64 + 2 * i + 1]) << 32); }
    __device__ __forceinline__ const float* inf(int i) const { return (const float*)(GAS const float*)ptr(i); }
    __device__ __forceinline__ unsigned char* wsp(size_t off) const { return (unsigned char*)(GAS unsigned char*)(ptr(21) + off); }
    __device__ __forceinline__ void fin(ItemDesc& d, int r, int mode, int kt) const {
        const int nblk = d.N / 32, kb = r / nblk, nb = r - kb * nblk; d.n0 = 32 * nb; d.k0 = kt * kb;
        d.drow0 = mode == 0 ? d.n0 : (256 * (d.n0 >> 7) + (mode - 1) * 128 + (d.n0 & 127)); d.dstep = 1;
        if (mode == 3) { const int dd = d.n0 & 127; d.drow0 = (d.n0 & ~127) + (dd < 64 ? 2 * dd : 2 * (dd - 64) + 1); d.dstep = 2; } }
};
struct DecP0b16 : DecP0 {
    __device__ __forceinline__ void operator()(int it, ItemDesc& d) const {
        int r = it, mode = 0; d.K = DM; d.useg = false; d.gk = inf(2);
        if (r < 2 * I_IN) { const int l = r / I_IN; r -= l * I_IN; d.W = inf(3) + (size_t)l * DM * INW; d.WT = wsp(WS_WIN) + (size_t)l * INW * DM * 2; d.N = INW; d.gk = inf(2) + l * DM; d.useg = true;
                            if ((r % (INW / 32)) * 32 < ZV) mode = 3; }
        else if (r < N16A) { r -= 2 * I_IN; const int l = r / I_OUT; r -= l * I_OUT; d.W = inf(11) + (size_t)l * DM * DM; d.WT = wsp(WS_WOUT) + (size_t)l * DM * DM * 2; d.N = DM; }
        else if (r < N16B) { r -= N16A; mode = 1 + r / I_DG; r -= (mode - 1) * I_DG; d.W = mode == 1 ? inf(13) : inf(14); d.WT = wsp(WS_WDGU); d.N = FFD; d.gk = inf(12); d.useg = true; }
        else { r -= N16B; d.W = inf(15); d.WT = wsp(WS_WDD); d.K = FFD; d.N = DM; }
        fin(d, r, mode == 3 ? 3 : mode, 64);
    }
};
struct DecP0f8 : DecP0 {
    __device__ __forceinline__ void operator()(int it, ItemDesc& d) const {
        int r = it, mode = 0; d.useg = false; d.gk = inf(12);
        if (r < N8A) { mode = 1 + r / J_DG; r -= (mode - 1) * J_DG; d.W = mode == 1 ? inf(13) : inf(14); d.WT = wsp(WS_WDGU); d.K = DM; d.N = FFD; d.useg = true; }
        else { r -= N8A; d.W = inf(15); d.WT = wsp(WS_WDD); d.K = FFD; d.N = DM; }
        fin(d, r, mode, 128);
    }
};
__device__ __forceinline__ void moe_conv_slots(volatile LAS unsigned* LW, LAS unsigned char* lds, int slot0, int nsl, int bx, int G) {
    const int tid = ltid(), lane = tid & 63, wave = __builtin_amdgcn_readfirstlane(tid >> 6), gw = bx * 8 + wave, NGW = G * 8;
#pragma unroll 1
    for (int q = 0; q < 2; ++q) {
        const int first = (slot0 * NGW + gw) * 2 + q, stride = 2 * NGW;
        int cnt = first < MOE_ITEMS ? (MOE_ITEMS - 1 - first) / stride + 1 : 0; cnt = cnt < nsl ? cnt : nsl;
        const DecMoeLin dec{{LW, 0, 0, 0}, first, stride};
        conv_loop<true>(0, cnt, 1, dec, lds + 1024 + wave * 4608, lane);
    }
}

struct Args { const void* in[20]; float* out; unsigned char* ws; };

__global__ void __launch_bounds__(512, 2) hybrid_fwd(Args args) {
    extern __shared__ __attribute__((aligned(16))) unsigned char lds_raw[];
    LAS unsigned char* lds = (LAS unsigned char*)lds_raw;
    volatile LAS unsigned* LW = (volatile LAS unsigned*)(lds + LDSCTL_OFF);
    const int tid = threadIdx.x, lane = tid & 63, wave = __builtin_amdgcn_readfirstlane(tid >> 6);
    const int G = gridDim.x, bx = blockIdx.x;
    const int gw = bx * 8 + wave, NGW = G * 8;
    for (int u = tid; u < LDSCTL_BYTES / 4; u += 512) LW[u] = 0u;
    __syncthreads();
    if (lane == 0) LW[128 + ((unsigned)__builtin_amdgcn_s_getreg((5 << 11) | 4) & 63u)] = (unsigned)wave;
    if (tid < 22) { const unsigned long long pv = tid < 20 ? (unsigned long long)args.in[tid] : (tid == 20 ? (unsigned long long)args.out : (unsigned long long)args.ws);
        LW[64 + 2 * tid] = (unsigned)pv; LW[64 + 2 * tid + 1] = (unsigned)(pv >> 32); }
    __syncthreads();
#define PTR(i) ((unsigned long long)(unsigned)__builtin_amdgcn_readfirstlane((int)LW[64 + 2 * (i)]) | ((unsigned long long)(unsigned)__builtin_amdgcn_readfirstlane((int)LW[64 + 2 * (i) + 1]) << 32))
#define INF(i) ((const float*)(GAS const float*)PTR(i))
#define WSP(T, off) ((T*)(GAS T*)(PTR(21) + (unsigned long long)(off)))
#define OUTP ((float*)(GAS float*)PTR(20))
    { const XcdBarrier b0 = xcd_barrier_post(WSP(unsigned, WS_CTL) + CW_BAR, LW); if (threadIdx.x == 0) LW[2] = b0.x; }
    __syncthreads();
#define GRID_BAR_T(F) do { XcdBarrier b_; b_.bar = WSP(unsigned, WS_CTL) + CW_BAR; b_.x = (unsigned)__builtin_amdgcn_readfirstlane((int)LW[2]); b_.st = LW; xcd_barrier<F>(b_); } while (0)
#define GRID_BAR() GRID_BAR_T(false)

    unsigned long long tacc_ = 0ull, tph_ = 0ull; (void)tacc_; (void)tph_;
#define PH_BEGIN() do { if (PROBE_MASK) tph_ = __builtin_amdgcn_s_memrealtime(); } while (0)
#define PH_END(id) do { if (PROBE_MASK & (1u << (id))) tacc_ += __builtin_amdgcn_s_memrealtime() - tph_; } while (0)
    PH_BEGIN();
    for (int rep_ = 0; rep_ < REP_P0; ++rep_) {
        LAS float* scr = (LAS float*)(lds + 1024 + wave * 17152);
        unsigned char* ws = WSP(unsigned char, 0);
        {
            LAS unsigned char* tscr = lds + 1024 + wave * 4608;
            DecP0b16 d16; d16.LW = LW; conv_loop<false>(gw, DecP0::I_IN, NGW, d16, tscr, lane);
        }
        {
            const int* positions = (const int*)(GAS const int*)PTR(1); float* cosT = (float*)(ws + WS_COS); float* sinT = (float*)(ws + WS_SIN);
            for (int idx = (bx * 512 + tid); idx < NTOK * 64; idx += G * 512) {
                const int t = idx >> 6, i = idx & 63;
                const float inv = 1.0f / powf(10000.0f, (float)(2 * i) / 128.0f);
                const float ang = (float)positions[t] * inv;
                double rev = (double)ang * 0.15915494309189535; rev -= rint(rev);
                const float rf = (float)rev;
                cosT[idx] = __builtin_amdgcn_cosf(rf); sinT[idx] = __builtin_amdgcn_sinf(rf);
            }
        }
        {
            const float* w_pool = INF(8); bf16_t* wpt = (bf16_t*)(ws + WS_WPT);
            for (int idx = (bx * 512 + tid); idx < 2 * 4 * 128 * 128; idx += G * 512) {
                const int c = idx & 127, d = (idx >> 7) & 127, lg = idx >> 14;
                const float v = w_pool[((size_t)lg * 128 + c) * 128 + d];
                wpt[idx] = (bf16_t)(cvt_pk_bf16(v, 0.f) & 0xffffu);
            }
        }
        {
            const float* x_in = INF(0); bf16_t* xb = (bf16_t*)(ws + WS_XR); float* ss0 = (float*)(ws + WS_SS);
            for (int m = gw; m < NTOK; m += NGW) { const float s = row_copy_ss(x_in + (size_t)m * DM, xb + (size_t)m * DM, lane); if (lane < 8) ss0[(size_t)m * 8 + lane] = lane == 0 ? s : 0.f; }
        }
    }
    GRID_BAR_T(true); PH_END(0); PH_BEGIN();

    constexpr int BG_P1 = 5, BG_P5 = 2, BG_DU = 11, BG_DD = 2, BG_L1 = BG_P1 + BG_P5 + BG_DU + BG_DD, BG_ALL = BG_L1 + BG_P1 + BG_P5;
    for (int l = 0; l < DEPTH; ++l) {
#define PHASE_IDS() const int tid = ltid(), lane = tid & 63, wave = __builtin_amdgcn_readfirstlane(tid >> 6), gw = bx * 8 + wave; (void)tid; (void)lane; (void)wave; (void)gw
        if (l == 0) {
            const int NCV = (G * CONV_NUM / 32) & ~7;
            if (bx < NCV) {
                PHASE_IDS();
                LAS unsigned char* tscr = lds + 1024 + wave * 4608; const int NGC = NCV * 8;
                { DecP0b16 d16; d16.LW = LW; conv_loop<false>(DecP0::I_IN + gw, DecP0::N16, NGC, d16, tscr, lane); }
                if (DecP0::N8 > 0) { DecP0f8 d8; d8.LW = LW; conv_loop<true>(gw, DecP0::N8, NGC, d8, tscr, lane); }
                { const DecMoe dm{LW, bx * 8 * MOE_J, wave, NGC * MOE_J}; int cnt = 0; while (dm.item(cnt) < MOE_ITEMS) ++cnt; conv_loop<true>(0, cnt, 1, dm, tscr, lane); }
            } else {
                pg8::Gemm g{WSP(bf16_t, WS_XR), WSP(bf16_t, WS_WIN), DM * 2, 0};
                pg8::StaticOrder S; S.init(NTOK / 256, INW / 256, G - NCV, bx - NCV);
                pg8::EpiZ E{WSP(bf16_t, WS_Z), INW, WSP(float, WS_SS), INF(4), INF(5), WSP(float, WS_COS), WSP(float, WS_SIN), (LAS float*)(lds + 1024)};
                pg8::gemm_phase<pg8::EpiZ, pg8::StaticOrder>(lds + RING_OFF, g, S, E);
            }
        } else
        for (int rep_ = 0; rep_ < REP_P1; ++rep_) {
            const int pos_ = BG_SPLIT ? (bx >> 3) % (BG_P1 + 1) : 0;
            for (int part_ = 0; part_ < 2; ++part_) {
            pg8::Gemm g{WSP(bf16_t, WS_XR), WSP(bf16_t, WS_WIN) + (size_t)l * INW * DM, DM * 2, 0};
            pg8::StaticOrder S; S.init(NTOK / 256, INW / 256, G, bx, part_ ? pos_ : 0, part_ ? (1 << 30) : pos_);
            pg8::EpiZ E{WSP(bf16_t, WS_Z), INW, WSP(float, WS_SS) + (size_t)(l == 0 ? 0 : 2) * NTOK * 8, INF(4) + l * 128, INF(5) + l * 128, WSP(float, WS_COS), WSP(float, WS_SIN), (LAS float*)(lds + 1024)};
            pg8::gemm_phase<pg8::EpiZ, pg8::StaticOrder>(lds + RING_OFF, g, S, E);
            if (BG_SPLIT && part_ == 0) { moe_conv_slots(LW, lds, l == 0 ? 0 : BG_L1, BG_P1, bx, G); __syncthreads(); }
            }
        }
        GRID_BAR(); PH_END(1); PH_BEGIN();
        for (int rep_ = 0; rep_ < REP_P3; ++rep_) {
            constexpr int NITEM = 512;
            char* alds = (char*)lds_raw + RING_OFF;
            int L = bx;
            if (L < NITEM) {
                const bf16_t* zb = WSP(bf16_t, WS_Z); bf16_t* ao = WSP(bf16_t, WS_AO);
#define ATT_REF(ref, LL, pass) do { const int xcd_ = (LL) & 7, k_ = (LL) >> 3, bh_ = (k_ >> 4) * 8 + xcd_, b_ = bh_ >> 2, h_ = bh_ & 3, vh_ = (k_ & 15) >> 2, mp_ = vh_ >> 1, vj_ = vh_ & 1, x_ = k_ & 3; \
                    const int qb_ = (pass) ? 7 - x_ : x_; const bf16_t* zb_ = zb + (size_t)b_ * SEQ * INW; \
                    (ref).Q = zb_ + (size_t)qb_ * 256 * INW + ZQ + h_ * 256 + mp_ * 128; (ref).K = zb_ + ZK + h_ * 256 + mp_ * 128; (ref).V = zb_ + ZV + h_ * 256 + vj_ * 128; \
                    (ref).O = ao + ((size_t)b_ * SEQ + (size_t)qb_ * 256) * DM + h_ * 512 + mp_ * 256 + vj_ * 128; (ref).P0 = qb_ * 256; } while (0)
#define ATT_ITEMS(ORD) do { att::BlockRef cur, nxt; int pass = 0; \
                ATT_REF(cur, L, 0); \
                att::Seam S; \
                att::causal_prime(cur, alds, S); \
                for (;;) { \
                    const bool more_pass = pass == 0, more_item = L + G < NITEM, last = !more_pass && !more_item; \
                    int passn = pass + 1, Ln = L; \
                    if (!more_pass) { passn = 0; Ln = more_item ? L + G : L; } \
                    if (last) nxt = cur; else ATT_REF(nxt, Ln, passn); \
                    att::causal_block<ORD>(cur, nxt, SEQ, alds, S); \
                    if (last) break; \
                    cur = nxt; pass = passn; L = Ln; \
                } } while (0)
                if (__builtin_amdgcn_readfirstlane(ltid() >> 8)) { __builtin_amdgcn_s_setprio(1); ATT_ITEMS(0); }
                else { ATT_ITEMS(1); }
#undef ATT_ITEMS
                __builtin_amdgcn_s_setprio(0);
#undef ATT_REF
            }
        }
        GRID_BAR(); PH_END(3); PH_BEGIN();
        if (PH_MASK & (1 << 2)) {
            PHASE_IDS();
            bf16_t* zb = WSP(bf16_t, WS_Z); bf16_t* mix = WSP(bf16_t, WS_MIX);
            {
            const float* qg = INF(4) + l * 128; const float* kg = INF(5) + l * 128;
            const float* cw = INF(10) + (size_t)l * 3 * 512;
            const float* cosT = WSP(float, WS_COS); const float* sinT = WSP(float, WS_SIN);
            {
                const int ch = 8 * lane;
                f32x4 wk[3][2];
#pragma unroll
                for (int j = 0; j < 3; ++j) { wk[j][0] = *(const f32x4*)(cw + j * 512 + ch); wk[j][1] = *(const f32x4*)(cw + j * 512 + ch + 4); }
                for (int grp = gw; grp < NTOK / 8; grp += NGW) {
                    const int t0 = 8 * grp, tb0 = t0 & (SEQ - 1);
                    u32x4 gbv[8], gcv[10], hv[10];
#pragma unroll
                    for (int i = 0; i < 10; ++i) { const int tt = t0 - 2 + i, tc = tt < 0 ? 0 : tt; const bf16_t* zr = zb + (size_t)tc * INW; gcv[i] = *(const u32x4*)(zr + ZGC + ch); hv[i] = *(const u32x4*)(zr + ZH + ch);
                        if (i >= 2) gbv[i - 2] = *(const u32x4*)(zr + ZGB + ch); }
                    float u[10][8];
#pragma unroll
                    for (int i = 0; i < 10; ++i) { const bool ok = (i >= 2) || (tb0 - 2 + i >= 0);
#pragma unroll
                        for (int j = 0; j < 4; ++j) { u[i][2 * j] = ok ? bflo(gcv[i][j]) * bflo(hv[i][j]) : 0.f; u[i][2 * j + 1] = ok ? bfhi(gcv[i][j]) * bfhi(hv[i][j]) : 0.f; } }
#pragma unroll
                    for (int i = 0; i < 8; ++i) { u32x4 w;
#pragma unroll
                        for (int j = 0; j < 4; ++j) { const int c0 = 2 * j, c1 = 2 * j + 1;
                            const float y0 = wk[0][c0 >> 2][c0 & 3] * u[i][c0] + wk[1][c0 >> 2][c0 & 3] * u[i + 1][c0] + wk[2][c0 >> 2][c0 & 3] * u[i + 2][c0];
                            const float y1 = wk[0][c1 >> 2][c1 & 3] * u[i][c1] + wk[1][c1 >> 2][c1 & 3] * u[i + 1][c1] + wk[2][c1 >> 2][c1 & 3] * u[i + 2][c1];
                            w[j] = cvt_pk_bf16(bflo(gbv[i][j]) * y0, bfhi(gbv[i][j]) * y1); }
                        *(u32x4*)(mix + (size_t)(t0 + i) * DM + 1536 + ch) = w; }
                }
            }
            }
            {
            const bf16_t* wpt = WSP(bf16_t, WS_WPT); const float* pool_scale = INF(9) + l * 512;
            const unsigned ptile = (unsigned)(uintptr_t)lds + (unsigned)(RING_OFF + wave * 12800);
            for (int it = gw; it < (NTOK / 32) * 4; it += NGW) {
                const int T = it >> 2, gi = it & 3, wn = 2 << gi, t0 = T * 32, tb0 = t0 & (SEQ - 1);
                const int r32 = lane & 31, hi = lane >> 5, tb = tb0 + r32;
                const float inv = 1.0f / (float)((tb + 1) < wn ? (tb + 1) : wn);
                const bf16_t* wp = wpt + ((size_t)(l * 4 + gi) * 128) * 128;
                {
                    u32x4 tv[12];
#pragma unroll
                    for (int n = 0; n < 12; ++n) { const int q = lane + 64 * n, row = q >> 4, c16 = q & 15; int tt = t0 - 15 + row; tt = tt < 0 ? 0 : (tt < NTOK ? tt : NTOK - 1);
                        tv[n] = *(const u32x4*)(zb + (size_t)tt * INW + ZP + gi * 128 + c16 * 8); }
#pragma unroll
                    for (int n = 0; n < 12; ++n) { const int q = lane + 64 * n, row = q >> 4, c16 = q & 15; const bool ok = (tb0 - 15 + row) >= 0;
                        if (row < 47) *(LAS u32x4*)(uintptr_t)(ptile + row * 272 + c16 * 16) = ok ? tv[n] : (u32x4){0u, 0u, 0u, 0u}; }
                    LDS_WAIT(); asm volatile("" ::: "memory");
                }
                f32x16 acc[4];
#pragma unroll
                for (int nb = 0; nb < 4; ++nb) acc[nb] = f32x16{};
                bf16x8 bcur[4];
#pragma unroll
                for (int nb = 0; nb < 4; ++nb) bcur[nb] = *(const bf16x8*)(wp + (size_t)(nb * 32 + r32) * 128 + 8 * hi);
                const unsigned rbase = ptile + (unsigned)((r32 + 15) * 272 + 16 * hi);
#pragma unroll 1
                for (int s = 0; s < 8; ++s) {
                    const int sn = s < 7 ? s + 1 : 7;
                    bf16x8 bnxt[4];
#pragma unroll
                    for (int nb = 0; nb < 4; ++nb) bnxt[nb] = *(const bf16x8*)(wp + (size_t)(nb * 32 + r32) * 128 + 16 * sn + 8 * hi);
                    float sum[8], self[8];
#pragma unroll
                    for (int j = 0; j < 8; ++j) { sum[j] = 0.f; self[j] = 0.f; }
                    u32x4 rv[16];
#pragma unroll
                    for (int d = 0; d < 16; ++d) { rv[d] = (u32x4){0u, 0u, 0u, 0u}; if (d < wn) rv[d] = *(const LAS u32x4*)(uintptr_t)(rbase + (unsigned)(32 * s) - (unsigned)(272 * d)); }
#pragma unroll
                    for (int d = 0; d < 16; ++d) {
#pragma unroll
                        for (int j = 0; j < 4; ++j) { const float a = bflo(rv[d][j]), b = bfhi(rv[d][j]); sum[2 * j] += a; sum[2 * j + 1] += b; if (d == 0) { self[2 * j] = a; self[2 * j + 1] = b; } }
                    }
                    u32x4 aw;
#pragma unroll
                    for (int j = 0; j < 4; ++j) aw[j] = cvt_pk_bf16(sum[2 * j] * inv - self[2 * j], sum[2 * j + 1] * inv - self[2 * j + 1]);
                    const bf16x8 af = __builtin_bit_cast(bf16x8, aw);
#pragma unroll
                    for (int nb = 0; nb < 4; ++nb) { acc[nb] = __builtin_amdgcn_mfma_f32_32x32x16_bf16(af, bcur[nb], acc[nb], 0, 0, 0); bcur[nb] = bnxt[nb]; }
                }
#pragma unroll
                for (int nb = 0; nb < 4; ++nb) { const int col = gi * 128 + nb * 32 + r32; const float ps = pool_scale[col];
#pragma unroll
                    for (int r = 0; r < 16; ++r) { const int row = (r & 3) + 8 * (r >> 2) + 4 * hi; const float v = acc[nb][r] * ps, vn = lx1(v);
                        if ((r32 & 1) == 0) *(unsigned*)(mix + (size_t)(t0 + row) * DM + 1024 + col) = cvt_pk_bf16(v, vn); } }
                LDS_WAIT(); asm volatile("" ::: "memory");
            }
            }
        }
        if (PH_MASK & (1 << 4)) {
            PHASE_IDS();
            const float lam_init = (l == 0) ? 0.2f : 0.35550906759096926f;
            const float* lv = INF(6) + (size_t)l * 512;
            const float d01 = wave_sum(lv[lane] * lv[128 + lane] + lv[64 + lane] * lv[192 + lane]);
            const float d23 = wave_sum(lv[256 + lane] * lv[384 + lane] + lv[320 + lane] * lv[448 + lane]);
            const float lam = expf(d01) - expf(d23) + lam_init;
            const float oscale = 1.0f - lam_init;
            const int h = lane >> 4, e0 = (lane & 15) * 16;
            const float* sg = INF(7) + l * 256 + e0;
            const bf16_t* ao = WSP(bf16_t, WS_AO); bf16_t* mix = WSP(bf16_t, WS_MIX);
            float sgv[16];
#pragma unroll
            for (int j = 0; j < 16; ++j) sgv[j] = sg[j];
            for (int tb_ = gw; tb_ < NTOK; tb_ += 4 * NGW) {
                u32x4 av[4][2], bv[4][2];
#pragma unroll
                for (int q2 = 0; q2 < 4; ++q2) { int t = tb_ + q2 * NGW; t = t < NTOK ? t : NTOK - 1;
                    const bf16_t* o0 = ao + (size_t)t * DM + h * 512 + e0; const bf16_t* o1 = o0 + 256;
#pragma unroll
                    for (int j = 0; j < 2; ++j) { av[q2][j] = *(const u32x4*)(o0 + 8 * j); bv[q2][j] = *(const u32x4*)(o1 + 8 * j); } }
#pragma unroll
                for (int q2 = 0; q2 < 4; ++q2) { const int t = tb_ + q2 * NGW; if (t < NTOK) {
                float dv[16]; float ss = 0.f;
#pragma unroll
                for (int j = 0; j < 2; ++j) { const u32x4 a = av[q2][j], b = bv[q2][j];
#pragma unroll
                    for (int q = 0; q < 4; ++q) { const float d0_ = bflo(a[q]) - lam * bflo(b[q]), d1_ = bfhi(a[q]) - lam * bfhi(b[q]); dv[8 * j + 2 * q] = d0_; dv[8 * j + 2 * q + 1] = d1_; ss += d0_ * d0_ + d1_ * d1_; } }
                ss = row16_sum(ss);
                const float rstd = oscale / sqrtf(ss * (1.0f / 256.0f) + EPS);
                u32x4 w0, w1;
#pragma unroll
                for (int j = 0; j < 4; ++j) { w0[j] = cvt_pk_bf16(dv[2 * j] * rstd * sgv[2 * j], dv[2 * j + 1] * rstd * sgv[2 * j + 1]);
                                              w1[j] = cvt_pk_bf16(dv[8 + 2 * j] * rstd * sgv[8 + 2 * j], dv[8 + 2 * j + 1] * rstd * sgv[8 + 2 * j + 1]); }
                bf16_t* mp = mix + (size_t)t * DM + h * 256 + e0;
                *(u32x4*)mp = w0; *(u32x4*)(mp + 8) = w1; } }
            }
        }
        GRID_BAR(); PH_END(4); PH_BEGIN();
        if (PH_MASK & (1 << 5)) {
            const int pos_ = BG_SPLIT ? (bx >> 3) % (BG_P5 + 1) : 0;
            for (int part_ = 0; part_ < 2; ++part_) {
            pg8::Gemm g{WSP(bf16_t, WS_MIX), WSP(bf16_t, WS_WOUT) + (size_t)l * DM * DM, DM * 2, 0};
            pg8::StaticOrder S; S.init(NTOK / 256, DM / 256, G, bx, part_ ? pos_ : 0, part_ ? (1 << 30) : pos_);
            pg8::EpiResF32 E{INF(0), WSP(bf16_t, WS_XR), DM, WSP(unsigned char, WS_XN), WSP(float, WS_SS) + (size_t)(l == 0 ? 1 : 3) * NTOK * 8, 0  , l == 0 ? (int)DUP8 : 1, (LAS float*)(lds + 1024)};
            pg8::gemm_phase<pg8::EpiResF32, pg8::StaticOrder>(lds + RING_OFF, g, S, E);
            if (BG_SPLIT && part_ == 0) { moe_conv_slots(LW, lds, (l == 0 ? 0 : BG_L1) + BG_P1, BG_P5, bx, G); __syncthreads(); }
            }
        }
        GRID_BAR(); PH_END(5); PH_BEGIN();
        if (l == 0 && (PH_MASK & (1 << 6))) {
            {
                const int pos_ = BG_SPLIT ? (bx >> 3) % (BG_DU + 1) : 0;
                for (int part_ = 0; part_ < 2; ++part_) {
                pg8::Gemm g{DUP8 ? WSP(unsigned char, WS_XN) : WSP(unsigned char, WS_XR), WSP(unsigned char, WS_WDGU), DUP8 ? DM : 2 * DM, 0};
                pg8::StaticOrder S; S.init(NTOK / 256, 2 * FFD / 256, G, bx, part_ ? pos_ : 0, part_ ? (1 << 30) : pos_);
                const float* ss1 = WSP(float, WS_SS) + (size_t)NTOK * 8;
                if constexpr (DDN8) { pg8::EpiSwigluF8<1> E{WSP(unsigned char, WS_ACTD), FFD, ss1};
                    pg8::gemm_phase<pg8::EpiSwigluF8<1>, pg8::StaticOrder, (bool)DUP8, DUP8 ? SC_W : SC_ONE, SC_ONE>(lds + RING_OFF, g, S, E); }
                else { pg8::EpiSwiglu<1> E{WSP(bf16_t, WS_ACTD), FFD, ss1};
                    pg8::gemm_phase<pg8::EpiSwiglu<1>, pg8::StaticOrder, (bool)DUP8, DUP8 ? SC_W : SC_ONE, SC_ONE>(lds + RING_OFF, g, S, E); }
                if (BG_SPLIT && part_ == 0) { moe_conv_slots(LW, lds, BG_P1 + BG_P5, BG_DU, bx, G); __syncthreads(); }
                }
            }
            GRID_BAR(); PH_END(6); PH_BEGIN();
            {
                const int pos_ = BG_SPLIT ? (bx >> 3) % (BG_DD + 1) : 0;
                for (int part_ = 0; part_ < 2; ++part_) {
                pg8::Gemm g{WSP(unsigned char, WS_ACTD), WSP(unsigned char, WS_WDD), DDN8 ? FFD : 2 * FFD, 0};
                pg8::StaticOrder S; S.init(NTOK / 256, DM / 256, G, bx, part_ ? pos_ : 0, part_ ? (1 << 30) : pos_);
                pg8::EpiResF32 E{nullptr, WSP(bf16_t, WS_XR), DM, nullptr, WSP(float, WS_SS) + (size_t)2 * NTOK * 8, 0, 0, (LAS float*)(lds + 1024)};
                pg8::gemm_phase<pg8::EpiResF32, pg8::StaticOrder, (bool)DDN8, DDN8 ? SC_W : SC_ONE, DDN8 ? SC_A : SC_ONE>(lds + RING_OFF, g, S, E);
                if (BG_SPLIT && part_ == 0) { moe_conv_slots(LW, lds, BG_P1 + BG_P5 + BG_DU, BG_DD, bx, G); __syncthreads(); }
                }
            }
            GRID_BAR(); PH_END(7); PH_BEGIN();
        } else if (PH_MASK & (1 << 7)) {
            const int TPW = (NTOK + G - 1) / G;
            {
                PHASE_IDS();
                if (BG_SPLIT) { int nrem = 0; while ((BG_ALL + nrem) * (G * 8) * 2 < 24 * 3584) ++nrem; if (nrem) { moe_conv_slots(LW, lds, BG_ALL, nrem, bx, G); __syncthreads(); } }
                if (tid < 8) LW[LW_CNT + tid] = 0u;
                LAS float* RT = (LAS float*)(lds + RING_OFF);
                { const float* router_w = INF(16); const float* gn = INF(12) + DM;
                  for (int k = tid; k < DM; k += 512) { const f32x4 ra = *(const f32x4*)(router_w + (size_t)k * 8), rb = *(const f32x4*)(router_w + (size_t)k * 8 + 4); const float gk = gn[k];
                      RT[0 * DM + k] = ra[0] * gk; RT[1 * DM + k] = ra[1] * gk; RT[2 * DM + k] = ra[2] * gk; RT[3 * DM + k] = ra[3] * gk;
                      RT[4 * DM + k] = rb[0] * gk; RT[5 * DM + k] = rb[1] * gk; RT[6 * DM + k] = rb[2] * gk; RT[7 * DM + k] = rb[3] * gk; } }
                __syncthreads();
                const bf16_t* xrs = WSP(bf16_t, WS_XR); const float* ss3 = WSP(float, WS_SS) + (size_t)3 * NTOK * 8;
                int* tokE = WSP(int, WS_TOKE); int* tokR = WSP(int, WS_TOKR); float* tokG = WSP(float, WS_TOKG);
                const int tlo = bx * TPW, thi = (tlo + TPW) < NTOK ? (tlo + TPW) : NTOK;
                for (int tq = tlo + wave; tq < thi; tq += 32) {
                    float rstd[4]; f32x4 xv[4][8];
#pragma unroll
                    for (int q = 0; q < 4; ++q) { int t = tq + 8 * q; t = t < thi ? t : thi - 1;
                        rstd[q] = ss_rstd(ss3 + (size_t)t * 8);
                        const u32x2* xr = (const u32x2*)(xrs + (size_t)t * DM) + lane;
#pragma unroll
                        for (int j = 0; j < 8; ++j) { const u32x2 w = xr[64 * j]; xv[q][j] = (f32x4){bflo(w.x), bfhi(w.x), bflo(w.y), bfhi(w.y)}; } }
                    float lg[4][8];
#pragma unroll
                    for (int e = 0; e < 8; ++e) { float a[4] = {0.f, 0.f, 0.f, 0.f};
#pragma unroll
                        for (int j = 0; j < 8; ++j) { const f32x4 rv = *(const LAS f32x4*)(RT + e * DM + 256 * j + 4 * lane);
#pragma unroll
                            for (int q = 0; q < 4; ++q) a[q] += (xv[q][j][0] * rv[0] + xv[q][j][1] * rv[1]) + (xv[q][j][2] * rv[2] + xv[q][j][3] * rv[3]); }
#pragma unroll
                        for (int q = 0; q < 4; ++q) lg[q][e] = wave_sum(a[q]) * rstd[q]; }
#pragma unroll
                    for (int q = 0; q < 4; ++q) { const int t = tq + 8 * q;
                        if (lane == 0 && t < thi) {
                            int e0 = 0; float v0 = lg[q][0];
#pragma unroll
                            for (int e = 1; e < 8; ++e) if (lg[q][e] > v0) { v0 = lg[q][e]; e0 = e; }
                            int e1 = -1; float v1 = -3.0e38f;
#pragma unroll
                            for (int e = 0; e < 8; ++e) if (e != e0 && lg[q][e] > v1) { v1 = lg[q][e]; e1 = e; }
                            const float ex = expf(v1 - v0), g0 = 1.0f / (1.0f + ex), g1 = ex / (1.0f + ex);
                            const int r0 = (int)atomicAdd((unsigned*)(lds_raw + LDSCTL_OFF) + LW_CNT + e0, 1u);
                            const int r1 = (int)atomicAdd((unsigned*)(lds_raw + LDSCTL_OFF) + LW_CNT + e1, 1u);
                            tokE[2 * t] = e0; tokE[2 * t + 1] = e1; tokR[2 * t] = r0; tokR[2 * t + 1] = r1; tokG[2 * t] = g0; tokG[2 * t + 1] = g1;
                        } }
                }
                __syncthreads();
                if (tid < 8) WSP(int, WS_CNTWG)[bx * 8 + tid] = (int)LW[LW_CNT + tid];
            }
            GRID_BAR(); PH_END(8); PH_BEGIN();
            {
                PHASE_IDS();
                if (tid < 8) { LW[LW_TOT + tid] = 0u; LW[LW_PRE + tid] = 0u; }
                __syncthreads();
                {
                const int* cntWG = WSP(int, WS_CNTWG);
                for (int j0 = wave * 64; j0 < G; j0 += 512) { const int j = j0 + lane; const bool ok = j < G; const int jc = ok ? j : 0;
                    const i32x4 ca = *(const i32x4*)(cntWG + jc * 8), cb = *(const i32x4*)(cntWG + jc * 8 + 4);
                    unsigned* lw = (unsigned*)(lds_raw + LDSCTL_OFF);
#pragma unroll
                    for (int e = 0; e < 8; ++e) { const float c = ok ? (float)(e < 4 ? ca[e & 3] : cb[e & 3]) : 0.f;
                        const float tot = wave_sum(c), pre = wave_sum(j < bx ? c : 0.f);
                        if (lane == 0) { atomicAdd(lw + LW_TOT + e, (unsigned)tot); atomicAdd(lw + LW_PRE + e, (unsigned)pre); } }
                }
                }
                __syncthreads();
                if (tid == 0) { unsigned base = 0;
                    for (int e = 0; e < 8; ++e) { const unsigned tot = LW[LW_TOT + e]; LW[LW_BP + e] = base + LW[LW_PRE + e]; LW[LW_TOFF + e] = base >> 8; base += (tot + 255u) & ~255u; }
                    LW[LW_TOFF + 8] = base >> 8; }
                __syncthreads();
                const int* tokE = WSP(int, WS_TOKE); const int* tokR = WSP(int, WS_TOKR); int* tokS = WSP(int, WS_TOKS);
                const float* ss3 = WSP(float, WS_SS) + (size_t)3 * NTOK * 8; float* rslot = WSP(float, WS_RSLOT);
                const unsigned char* xn8 = WSP(unsigned char, WS_XN); unsigned char* hp = WSP(unsigned char, WS_HP);
                const int tlo = bx * TPW, thi = (tlo + TPW) < NTOK ? (tlo + TPW) : NTOK;
                for (int tb_ = tlo + wave; tb_ < thi; tb_ += 16) {
                    int sa[2], sb[2]; u32x4 v[2][2];
#pragma unroll
                    for (int q2 = 0; q2 < 2; ++q2) { int t = tb_ + 8 * q2; t = t < thi ? t : thi - 1;
                        const int e0 = tokE[2 * t], e1 = tokE[2 * t + 1];
                        sa[q2] = (int)LW[LW_BP + e0] + tokR[2 * t]; sb[q2] = (int)LW[LW_BP + e1] + tokR[2 * t + 1];
                        const u32x4* src_ = (const u32x4*)(xn8 + (size_t)t * DM) + lane; v[q2][0] = src_[0]; v[q2][1] = src_[64]; }
#pragma unroll
                    for (int q2 = 0; q2 < 2; ++q2) { const int t = tb_ + 8 * q2; if (t < thi) {
                        const int s0 = sa[q2], s1 = sb[q2];
                        if (lane == 0) { tokS[2 * t] = s0; tokS[2 * t + 1] = s1; const float rstd = ss_rstd(ss3 + (size_t)t * 8); rslot[s0] = rstd; rslot[s1] = rstd; }
                        u32x4* d0 = (u32x4*)(hp + (size_t)s0 * DM) + lane; u32x4* d1 = (u32x4*)(hp + (size_t)s1 * DM) + lane;
                        d0[0] = v[q2][0]; d0[64] = v[q2][1]; d1[0] = v[q2][0]; d1[64] = v[q2][1]; } }
                }
                for (int e = 0; e < 8; ++e) {
                    const int rlo = (int)LW[LW_TOFF + e] * 256 + (int)LW[LW_TOT + e], rhi = (int)LW[LW_TOFF + e + 1] * 256;
                    for (int r = rlo + gw; r < rhi; r += NGW) { if (lane == 0) rslot[r] = 0.f; u32x4* d0 = (u32x4*)(hp + (size_t)r * DM) + lane;
#pragma unroll
                        for (int j = 0; j < 2; ++j) d0[64 * j] = (u32x4){0u, 0u, 0u, 0u}; }
                }
            }
            GRID_BAR(); PH_END(9); PH_BEGIN();
#define RFL(i) __builtin_amdgcn_readfirstlane((int)LW[LW_TOFF + (i)])
#define MOE_TAIL_SP(R, G) ((R) == 0 ? 1 : ((R) * 4 <= (G) ? 4 : ((R) * 2 <= (G) ? 2 : 1)))
            for (int rep_ = 0; rep_ < REP_P7; ++rep_) {
                pg8::Gemm g{WSP(unsigned char, WS_HP), WSP(unsigned char, WS_WMGU), DM, (size_t)2 * FFE * DM};
                pg8::MoeOrder S; S.S.init(RFL(8), 2 * FFE / 256, G, bx);
                S.t1 = RFL(1); S.t2 = RFL(2); S.t3 = RFL(3); S.t4 = RFL(4); S.t5 = RFL(5); S.t6 = RFL(6); S.t7 = RFL(7); S.SP = 1; S.nfull = 0; S.R = 0; S.ntp = 0; S.kbs = 0;
                pg8::EpiSwigluF8<2> E{WSP(unsigned char, WS_ACTM), FFE, WSP(float, WS_RSLOT)};
                pg8::gemm_phase<pg8::EpiSwigluF8<2>, pg8::MoeOrder, true, SC_W, SC_ONE>(lds + RING_OFF, g, S, E);
            }
            GRID_BAR(); PH_END(10); PH_BEGIN();
            {
                pg8::Gemm g{WSP(unsigned char, WS_ACTM), WSP(unsigned char, WS_WMD), FFE, (size_t)DM * FFE};
                pg8::MoeOrder S; S.S.init(RFL(8), DM / 256, G, bx);
                S.t1 = RFL(1); S.t2 = RFL(2); S.t3 = RFL(3); S.t4 = RFL(4); S.t5 = RFL(5); S.t6 = RFL(6); S.t7 = RFL(7);
                { const int nwg_ = RFL(8) * (DM / 256), R_ = nwg_ % G; S.nfull = nwg_ / G; S.R = R_; S.SP = MOE_TAIL_SP(R_, G); S.ntp = (FFE / 128) / S.SP; S.kbs = FFE / S.SP; }
                S.rev = 1;
                pg8::EpiMoeDown E{WSP(bf16_t, WS_Y), DM, WSP(float, WS_PB), WSP(int, WS_TMAP), S.SP};
                pg8::gemm_phase<pg8::EpiMoeDown, pg8::MoeOrder, true, SC_W, SC_A>(lds + RING_OFF, g, S, E);
            }
            GRID_BAR(); PH_END(11); PH_BEGIN();
            {
                PHASE_IDS();
                const int* tokS = WSP(int, WS_TOKS); const float* tokG = WSP(float, WS_TOKG); float* out = OUTP; const bf16_t* yb = WSP(bf16_t, WS_Y); const bf16_t* xrs = WSP(bf16_t, WS_XR);
                const int* tmap = WSP(int, WS_TMAP); const float* PB = WSP(float, WS_PB);
                const int SP = MOE_TAIL_SP((RFL(8) * (DM / 256)) % G, G);
                for (int tb_ = gw; tb_ < NTOK; tb_ += 2 * NGW) {
                    int s0[2], s1[2]; float g0[2], g1[2];
#pragma unroll
                    for (int q2 = 0; q2 < 2; ++q2) { int t = tb_ + q2 * NGW; t = t < NTOK ? t : NTOK - 1; s0[q2] = tokS[2 * t]; s1[q2] = tokS[2 * t + 1]; g0[q2] = tokG[2 * t]; g1[q2] = tokG[2 * t + 1]; }
                    u32x4 ya[2][4], yc[2][4], xw[2][4]; int ea[2][4], ec[2][4];
#pragma unroll
                    for (int q2 = 0; q2 < 2; ++q2) { int t = tb_ + q2 * NGW; t = t < NTOK ? t : NTOK - 1;
                        const u32x4* o = (const u32x4*)(xrs + (size_t)t * DM) + lane; const u32x4* y0 = (const u32x4*)(yb + (size_t)s0[q2] * DM) + lane; const u32x4* y1 = (const u32x4*)(yb + (size_t)s1[q2] * DM) + lane;
#pragma unroll
                        for (int j = 0; j < 4; ++j) { ya[q2][j] = y0[64 * j]; yc[q2][j] = y1[64 * j]; xw[q2][j] = o[64 * j];
                            ea[q2][j] = tmap[(s0[q2] >> 8) * 8 + ((64 * j + lane) >> 5)]; ec[q2][j] = tmap[(s1[q2] >> 8) * 8 + ((64 * j + lane) >> 5)]; } }
#pragma unroll
                    for (int q2 = 0; q2 < 2; ++q2) { const int t = tb_ + q2 * NGW; if (t < NTOK) {
                        f32x4* o = (f32x4*)(out + (size_t)t * DM) + 2 * lane; const float ga = g0[q2], gb = g1[q2];
#pragma unroll
                        for (int j = 0; j < 4; ++j) { const u32x4 a = ya[q2][j], b = yc[q2][j], xx = xw[q2][j]; f32x4 o0 = {bflo(xx[0]), bfhi(xx[0]), bflo(xx[1]), bfhi(xx[1])}, o1 = {bflo(xx[2]), bfhi(xx[2]), bflo(xx[3]), bfhi(xx[3])};
                            f32x4 a0 = {bflo(a[0]), bfhi(a[0]), bflo(a[1]), bfhi(a[1])}, a1 = {bflo(a[2]), bfhi(a[2]), bflo(a[3]), bfhi(a[3])};
                            f32x4 b0 = {bflo(b[0]), bfhi(b[0]), bflo(b[1]), bfhi(b[1])}, b1 = {bflo(b[2]), bfhi(b[2]), bflo(b[3]), bfhi(b[3])};
                            const int cc = (8 * (64 * j + lane)) & 255;
                            if (ea[q2][j]) { a0 = (f32x4){0.f, 0.f, 0.f, 0.f}; a1 = a0;
                                for (int p = 0; p < SP; ++p) { const float* sp = PB + ((size_t)((ea[q2][j] - 1) * SP + p) * 256 + (s0[q2] & 255)) * 256 + cc; a0 += *(const f32x4*)sp; a1 += *(const f32x4*)(sp + 4); } }
                            if (ec[q2][j]) { b0 = (f32x4){0.f, 0.f, 0.f, 0.f}; b1 = b0;
                                for (int p = 0; p < SP; ++p) { const float* sp = PB + ((size_t)((ec[q2][j] - 1) * SP + p) * 256 + (s1[q2] & 255)) * 256 + cc; b0 += *(const f32x4*)sp; b1 += *(const f32x4*)(sp + 4); } }
                            o0 += a0 * ga + b0 * gb; o1 += a1 * ga + b1 * gb;
                            o[128 * j] = o0; o[128 * j + 1] = o1; } } }
                }
            }
#undef RFL
            PH_END(12);
        }
    }
    if (PROBE_MASK) { __syncthreads(); if (threadIdx.x == 0) { const unsigned long long t0_ = __builtin_amdgcn_s_memrealtime(); while (__builtin_amdgcn_s_memrealtime() - t0_ < tacc_) __builtin_amdgcn_s_sleep(8); } __syncthreads(); }
}

extern "C" void kernel_launch(void* const* d_in, const int* in_sizes, int n_in, void* d_out, int out_size, void* d_ws, size_t ws_size, hipStream_t stream) {
    static int grid = 0;
    if (grid == 0) {
        if (n_in != 20 || in_sizes[0] != NTOK * DM || out_size != NTOK * DM || ws_size < WS_END) {
            fprintf(stderr, "kernel_launch: unexpected shapes (n_in %d, in0 %d, out %d, ws %zu < %zu); nothing launched\n", n_in, n_in > 0 ? in_sizes[0] : -1, out_size, ws_size, (size_t)WS_END); grid = -1; return; }
        int dev = 0, cus = 0, per_cu = 0;
        if (hipGetDevice(&dev) != hipSuccess || hipDeviceGetAttribute(&cus, hipDeviceAttributeMultiprocessorCount, dev) != hipSuccess) { grid = -1; return; }
        if (hipFuncSetAttribute((const void*)hybrid_fwd, hipFuncAttributeMaxDynamicSharedMemorySize, LDS_BYTES) != hipSuccess) { fprintf(stderr, "kernel_launch: hipFuncSetAttribute failed\n"); grid = -1; return; }
        if (hipOccupancyMaxActiveBlocksPerMultiprocessor(&per_cu, (const void*)hybrid_fwd, 512, LDS_BYTES) != hipSuccess || per_cu < 1)
            fprintf(stderr, "kernel_launch: note: occupancy query reports %d workgroups per CU\n", per_cu);
        (void)hipGetLastError();
        grid = cus > 512 ? 512 : cus;
    }
    if (grid < 0) return;
    if (hipMemsetAsync((char*)d_ws + WS_CTL, 0, CTL_ZERO_BYTES, stream) != hipSuccess) { fprintf(stderr, "kernel_launch: memset failed\n"); return; }
    Args a{};
    for (int i = 0; i < 20; ++i) a.in[i] = d_in[i];
    a.out = (float*)d_out; a.ws = (unsigned char*)d_ws;
    hipLaunchKernelGGL(hybrid_fwd, dim3(grid), dim3(512), LDS_BYTES, stream, a);
    const hipError_t le = hipPeekAtLastError();
    if (le != hipSuccess) fprintf(stderr, "kernel_launch: launch failed: %s\n", hipGetErrorName(le));
}
```
